# Optimizing an MI355X kernel written in HIP

```python
import jax, jax.numpy as jnp
from jax import lax
import numpy as np

D_MODEL = 2048
BATCH = 4
SEQ = 8192
DEPTH = 1

N_HEADS = 8
N_KV_HEADS = 2
HEAD_DIM = 128
ATTN_WIDTH = N_HEADS * HEAD_DIM
KV_WIDTH = N_KV_HEADS * HEAD_DIM
ROPE_THETA = 500000.0
ROPE_FRACTION = 4
IDX_HEADS = 16
IDX_DIM = 64
TOPK_MAX = 256
Q_BLOCK = 128
POOL_GROUPS = 4
POOL_WINDOWS = (2, 4, 8, 16)
POOL_WIDTH = D_MODEL - ATTN_WIDTH
POOL_GROUP_DIM = POOL_WIDTH // POOL_GROUPS
MIX_WIDTH = ATTN_WIDTH + POOL_WIDTH
N_EXPERT_GROUPS = 4
EXPERTS_PER_GROUP = 8
N_EXPERTS = N_EXPERT_GROUPS * EXPERTS_PER_GROUP
EXPERT_TOPK = 2
D_EXPERT = 512
NORM_EPS = 1e-6
PROJ_SPLITS = (ATTN_WIDTH, KV_WIDTH, KV_WIDTH, IDX_HEADS * IDX_DIM, IDX_DIM, IDX_HEADS, POOL_WIDTH)
PROJ_WIDTH = sum(PROJ_SPLITS)

kernel_name = "hymba_dsa_pool_hiermoe_adaln"


def rmsnorm(x, g):
    xf = x.astype(jnp.float32)
    y = xf * lax.rsqrt(jnp.mean(xf * xf, axis=-1, keepdims=True) + NORM_EPS)
    return y.astype(x.dtype) * g


def modulate(xn, shift, scale):
    return xn * (1.0 + scale[:, None, :]) + shift[:, None, :]


def rope_partial(x, pos):
    d = x.shape[-1]
    rd = d // ROPE_FRACTION
    half = rd // 2
    inv = jnp.float32(ROPE_THETA) ** (-(jnp.arange(half, dtype=jnp.float32) * 2.0) / rd)
    ang = pos[:, None] * inv[None, :]
    cos = jnp.cos(ang)[None, :, None, :]
    sin = jnp.sin(ang)[None, :, None, :]
    xr = x[..., :rd].astype(jnp.float32)
    x1, x2 = xr[..., :half], xr[..., half:]
    rot = jnp.concatenate([x1 * cos - x2 * sin, x2 * cos + x1 * sin], axis=-1).astype(x.dtype)
    return jnp.concatenate([rot, x[..., rd:]], axis=-1)


def dsa_attention(q, k, v, qi, ki, wi):
    B, S = q.shape[0], q.shape[1]
    n_sel = min(TOPK_MAX, S // 4)
    nb = S // Q_BLOCK
    rep = N_HEADS // N_KV_HEADS

    def to_blocks(a):
        return jnp.moveaxis(a.reshape((B, nb, Q_BLOCK) + a.shape[2:]), 1, 0)

    t_blocks = jnp.arange(S, dtype=jnp.int32).reshape(nb, Q_BLOCK)
    s_pos = jnp.arange(S, dtype=jnp.int32)
    b_ix = jnp.arange(B)[:, None, None]
    idx_scale = (IDX_DIM ** -0.5) * (IDX_HEADS ** -0.5)
    attn_scale = HEAD_DIM ** -0.5
    kif = ki.astype(jnp.float32)

    def one_block(args):
        qb, qib, wib, tb = args
        logits = jnp.einsum('bthd,bsd->bths', qib.astype(jnp.float32), kif)
        score = jnp.einsum('bths,bth->bts', jax.nn.relu(logits), wib.astype(jnp.float32)) * idx_scale
        causal = s_pos[None, :] <= tb[:, None]
        score = jnp.where(causal[None], score, -jnp.inf)
        _, sel = lax.top_k(score, n_sel)
        valid = sel <= tb[None, :, None]
        kg = k[b_ix, sel].astype(jnp.float32)
        vg = v[b_ix, sel].astype(jnp.float32)
        qg = qb.reshape(B, Q_BLOCK, N_KV_HEADS, rep, HEAD_DIM).astype(jnp.float32)
        s = jnp.einsum('btgrd,btkgd->btgrk', qg, kg) * attn_scale
        s = jnp.where(valid[:, :, None, None, :], s, -jnp.inf)
        p = jax.nn.softmax(s, axis=-1)
        o = jnp.einsum('btgrk,btkgd->btgrd', p, vg).astype(qb.dtype)
        return o.reshape(B, Q_BLOCK, ATTN_WIDTH)

    out = lax.map(one_block, (to_blocks(q), to_blocks(qi), to_blocks(wi), t_blocks))
    return jnp.moveaxis(out, 0, 1).reshape(B, S, ATTN_WIDTH)


def multiscale_pool(p, w_pool, pool_scale):
    B, S = p.shape[0], p.shape[1]
    pg = p.reshape(B, S, POOL_GROUPS, POOL_GROUP_DIM).astype(jnp.float32)
    cs = jnp.cumsum(pg, axis=1)
    cs_pad = jnp.pad(cs, ((0, 0), (1, 0), (0, 0), (0, 0)))
    win = jnp.array(POOL_WINDOWS, dtype=jnp.int32)
    t = jnp.arange(S, dtype=jnp.int32)[:, None]
    lo = jnp.maximum(t + 1 - win[None, :], 0)
    lag = cs_pad[:, lo, jnp.arange(POOL_GROUPS)[None, :], :]
    count = jnp.minimum(t + 1, win[None, :]).astype(jnp.float32)
    mixed = (cs - lag) / count[None, :, :, None] - pg
    y = jnp.einsum('bsgc,gcd->bsgd', mixed.astype(p.dtype), w_pool) * pool_scale
    return y.reshape(B, S, POOL_WIDTH)


def hier_moe(h, w_grp, w_exp, w1, w3, w2):
    B, S, D = h.shape
    ht = h.reshape(-1, D)
    pg = jax.nn.softmax((ht @ w_grp).astype(jnp.float32), axis=-1)
    g_sel = jnp.argmax(pg, axis=-1)
    p_g = jnp.max(pg, axis=-1)
    el = (ht @ w_exp).astype(jnp.float32).reshape(-1, N_EXPERT_GROUPS, EXPERTS_PER_GROUP)
    el_sel = jnp.take_along_axis(el, g_sel[:, None, None], axis=1)[:, 0]
    pe = jax.nn.softmax(el_sel, axis=-1)
    top_p, top_i = lax.top_k(pe, EXPERT_TOPK)
    top_w = top_p / jnp.sum(top_p, axis=-1, keepdims=True) * p_g[:, None]
    eid = g_sel[:, None] * EXPERTS_PER_GROUP + top_i
    combine = jnp.einsum('tke,tk->te', jax.nn.one_hot(eid, N_EXPERTS, dtype=jnp.float32), top_w)
    y = jnp.zeros((ht.shape[0], D), jnp.float32)
    for e in range(N_EXPERTS):
        a = jax.nn.silu(ht @ w1[e]) * (ht @ w3[e])
        y = y + combine[:, e:e + 1] * (a @ w2[e]).astype(jnp.float32)
    return y.astype(h.dtype).reshape(B, S, D)


def setup_inputs(seed: int = 0) -> dict:
    key = jax.random.key(seed)
    ks = jax.random.split(key, 20)
    f32 = jnp.float32
    L, D = DEPTH, D_MODEL
    nrm = lambda k, shape, s: jax.random.normal(k, shape, f32) * s
    return {
        "x": nrm(ks[0], (BATCH, SEQ, D), 1.0),
        "c": nrm(ks[1], (BATCH, D), 1.0),
        "w_ada": nrm(ks[2], (L, D, 6 * D), 0.5 * D ** -0.5),
        "b_ada": nrm(ks[3], (L, 6 * D), 0.02),
        "norm1_g": 1.0 + nrm(ks[4], (L, D), 0.02),
        "w_in": nrm(ks[5], (L, D, PROJ_WIDTH), D ** -0.5),
        "q_norm_g": 1.0 + nrm(ks[6], (L, HEAD_DIM), 0.02),
        "k_norm_g": 1.0 + nrm(ks[7], (L, HEAD_DIM), 0.02),
        "w_pool": nrm(ks[8], (L, POOL_GROUPS, POOL_GROUP_DIM, POOL_GROUP_DIM), POOL_GROUP_DIM ** -0.5),
        "pool_scale": 1.0 + nrm(ks[9], (L, POOL_GROUPS, POOL_GROUP_DIM), 0.02),
        "w_out": nrm(ks[10], (L, MIX_WIDTH, D), MIX_WIDTH ** -0.5),
        "norm2_g": 1.0 + nrm(ks[11], (L, D), 0.02),
        "w_grp": nrm(ks[12], (L, D, N_EXPERT_GROUPS), D ** -0.5),
        "w_exp": nrm(ks[13], (L, D, N_EXPERTS), D ** -0.5),
        "w1": nrm(ks[14], (L, N_EXPERTS, D, D_EXPERT), D ** -0.5),
        "w3": nrm(ks[15], (L, N_EXPERTS, D, D_EXPERT), D ** -0.5),
        "w2": nrm(ks[16], (L, N_EXPERTS, D_EXPERT, D), D_EXPERT ** -0.5),
    }


def reference(x, c, w_ada, b_ada, norm1_g, w_in, q_norm_g, k_norm_g, w_pool, pool_scale,
              w_out, norm2_g, w_grp, w_exp, w1, w3, w2):
    B, S, D = x.shape
    pos = jnp.arange(S, dtype=jnp.float32)
    offsets = [int(o) for o in np.cumsum(PROJ_SPLITS)[:-1]]
    for l in range(DEPTH):
        ada = jax.nn.silu(c) @ w_ada[l] + b_ada[l]
        sh1, sc1, gt1, sh2, sc2, gt2 = jnp.split(ada, 6, axis=-1)
        h = modulate(rmsnorm(x, norm1_g[l]), sh1, sc1)
        proj = h @ w_in[l]
        q, k, v, qi, ki, wi, p = jnp.split(proj, offsets, axis=-1)
        q = rope_partial(rmsnorm(q.reshape(B, S, N_HEADS, HEAD_DIM), q_norm_g[l]), pos)
        k = rope_partial(rmsnorm(k.reshape(B, S, N_KV_HEADS, HEAD_DIM), k_norm_g[l]), pos)
        v = v.reshape(B, S, N_KV_HEADS, HEAD_DIM)
        qi = rope_partial(qi.reshape(B, S, IDX_HEADS, IDX_DIM), pos)
        ki = rope_partial(ki.reshape(B, S, 1, IDX_DIM), pos)[:, :, 0]
        attn_out = dsa_attention(q, k, v, qi, ki, wi)
        pool_out = multiscale_pool(p, w_pool[l], pool_scale[l])
        mix = jnp.concatenate([attn_out, pool_out], axis=-1) @ w_out[l]
        x = x + gt1[:, None, :] * mix
        h2 = modulate(rmsnorm(x, norm2_g[l]), sh2, sc2)
        x = x + gt2[:, None, :] * hier_moe(h2, w_grp[l], w_exp[l], w1[l], w3[l], w2[l])
    return x
```

```cpp
#include <hip/hip_runtime.h>
#include <cstdio>
#include <cstdint>
#include <cstddef>

#ifndef MK_MULTI
#define MK_MULTI 0
#endif

#define LAS __attribute__((address_space(3)))
typedef unsigned short bf16_t;
typedef short bf16x8 __attribute__((ext_vector_type(8)));
typedef short s16x4 __attribute__((ext_vector_type(4)));
typedef float f32x4 __attribute__((ext_vector_type(4)));
typedef float f32x16 __attribute__((ext_vector_type(16)));
typedef unsigned u32x4 __attribute__((ext_vector_type(4)));
typedef unsigned u32x2 __attribute__((ext_vector_type(2)));
typedef __bf16 bf16v2 __attribute__((ext_vector_type(2)));
typedef _Float16 f16v2 __attribute__((ext_vector_type(2)));

constexpr int T = 32768, S = 8192, NB = 4, D = 2048;
constexpr int NPROJ = 3840;
constexpr int CQ = 0, CK = 1024, CV = 1280, CQI = 1536, CP = 2560, CKI = 3584, CWI = 3648;
constexpr int NTHREADS = 512;
constexpr int LDS_BYTES = 147456;
constexpr float NORM_EPS = 1e-6f;
constexpr size_t SC_BATCH = 34078720ull;
constexpr int MAXROWS = 81920;

constexpr size_t WS_CTL = 0;
constexpr size_t WS_ADA = 65536;
constexpr size_t WS_TAB = 262144;
constexpr size_t WS_WR = 1835008;
constexpr size_t WS_TOKE = 2031616;
constexpr size_t WS_TOKW = 2293760;
constexpr size_t WS_ROWTOK = 2555904;
constexpr size_t WS_ROWW = 2883584;
constexpr size_t WS_WI = 3211264;
constexpr size_t WS_KI = 5308416;
constexpr size_t WS_WPOOL = 9502720;
constexpr size_t WS_WOUT = 10027008;
constexpr size_t WS_WIN = 18415616;
constexpr size_t WS_W13 = 34144256;
constexpr size_t WS_W2 = 168361984;
constexpr size_t WS_H = 235470848;
constexpr size_t WS_X = 369688576;
constexpr size_t WS_QB = 642318336;
constexpr size_t WS_KV = 709427200;
constexpr size_t WS_QI = 742981632;
constexpr size_t WS_PM = 810090496;
constexpr size_t WS_SEL = 877199360;
constexpr size_t WS_ADAP = 893976576;
constexpr size_t WS_END = 900268032;
constexpr int CW_GCOUNT = 4096, CW_GCURSOR = 4160, CW_CHK = 4224, CW_TINFO = 4352, CW_TILEB = 4416;

__device__ __forceinline__ unsigned pk_bf16(float a, float b) { bf16v2 v; v.x = (__bf16)a; v.y = (__bf16)b; return __builtin_bit_cast(unsigned, v); }
__device__ __forceinline__ float bf_lo(unsigned u) { return __uint_as_float(u << 16); }
__device__ __forceinline__ float bf_hi(unsigned u) { return __uint_as_float(u & 0xffff0000u); }
__device__ __forceinline__ void unpack8(const u32x4 v, float* f) {
    f[0] = bf_lo(v.x); f[1] = bf_hi(v.x); f[2] = bf_lo(v.y); f[3] = bf_hi(v.y); f[4] = bf_lo(v.z); f[5] = bf_hi(v.z); f[6] = bf_lo(v.w); f[7] = bf_hi(v.w);
}
__device__ __forceinline__ u32x4 pack8(const float* f) { u32x4 v; v.x = pk_bf16(f[0], f[1]); v.y = pk_bf16(f[2], f[3]); v.z = pk_bf16(f[4], f[5]); v.w = pk_bf16(f[6], f[7]); return v; }
__device__ __forceinline__ float wave_sum(float v) {
#pragma unroll
    for (int d = 32; d >= 1; d >>= 1) v += __shfl_xor(v, d);
    return v;
}

#define XB_TMO      128
#define XB_XCNT(j)  (256  + 64 * (j))
#define XB_XSUB(j)  (1280 + 64 * (j))
#define XB_XGEN(j)  (2304 + 64 * (j))
#define XB_TOP      3328
#define XB_TOPGEN   3392
#define XCD_BAR_WORDS 3456
#define XB_SPIN_CAP (1u << 23)

__device__ __forceinline__ unsigned xb_ld(unsigned* p)              { return __hip_atomic_load(p, __ATOMIC_RELAXED, __HIP_MEMORY_SCOPE_AGENT); }
__device__ __forceinline__ unsigned xb_add(unsigned* p, unsigned v) { return __hip_atomic_fetch_add(p, v, __ATOMIC_RELAXED, __HIP_MEMORY_SCOPE_AGENT); }
__device__ __forceinline__ unsigned xb_xcc_id() { return (unsigned)__builtin_amdgcn_s_getreg((3 << 11) | 20) & 0xFu; }
#define XB_SPIN(cond, bar) do { unsigned _sp = 0; while (cond) { __builtin_amdgcn_s_sleep(1); \
    if ((++_sp & 255u) == 0u) { if (xb_ld(&(bar)[XB_TMO])) break; if (_sp > XB_SPIN_CAP) { atomicAdd(&(bar)[XB_TMO], 1u); break; } } } } while (0)

struct XcdBarrier { unsigned* bar; unsigned x; volatile LAS unsigned* st; };

__device__ __forceinline__ XcdBarrier xcd_barrier_post(unsigned* bar, volatile LAS unsigned* st) {
    XcdBarrier b; b.bar = bar; b.x = xb_xcc_id(); b.st = st;
    if (threadIdx.x == 0) (void)xb_add(&bar[XB_XCNT(b.x)], 1u);
    return b;
}
__device__ __forceinline__ void xcd_barrier_complete(unsigned* bar, unsigned x, unsigned& nloc, unsigned& nx) {
    const unsigned G = gridDim.x * gridDim.y * gridDim.z;
    unsigned sum, cnt, mine, sp = 0u;
    for (;;) {
        sum = 0u; cnt = 0u; mine = 0u;
#pragma unroll
        for (unsigned j = 0; j < 16; ++j) { const unsigned c = xb_ld(&bar[XB_XCNT(j)]); sum += c; cnt += (c > 0u) ? 1u : 0u; mine = (j == x) ? c : mine; }
        if (sum == G) break;
        __builtin_amdgcn_s_sleep(1);
        if ((++sp & 255u) == 0u) { if (xb_ld(&bar[XB_TMO])) break; if (sp > XB_SPIN_CAP) { atomicAdd(&bar[XB_TMO], 1u); break; } }
    }
    nloc = mine > 0u ? mine : 1u; nx = cnt > 0u ? cnt : 1u;
}
__device__ __forceinline__ void xcd_barrier(const XcdBarrier& b) {
    asm volatile("s_waitcnt vmcnt(0)" ::: "memory");
    __syncthreads();
    if (threadIdx.x == 0) {
        unsigned* bar = b.bar;
        __builtin_amdgcn_s_waitcnt(0);
        unsigned nloc = b.st[0], nx = b.st[1];
        if (nloc == 0u) { xcd_barrier_complete(bar, b.x, nloc, nx); b.st[0] = nloc; b.st[1] = nx; }
        const unsigned old = xb_add(&bar[XB_XSUB(b.x)], 1u);
        const unsigned gen = old / nloc;
        if (old + 1u == (gen + 1u) * nloc) {
            __builtin_amdgcn_fence(__ATOMIC_RELEASE, "agent");
            asm volatile("s_waitcnt vmcnt(0)" ::: "memory");
            const unsigned og = xb_add(&bar[XB_TOP], 1u);
            const unsigned tg = og / nx;
            if (og + 1u == (tg + 1u) * nx) xb_add(&bar[XB_TOPGEN], 1u);
            else XB_SPIN(xb_ld(&bar[XB_TOPGEN]) == tg, bar);
            __builtin_amdgcn_fence(__ATOMIC_ACQUIRE, "agent");
            xb_add(&bar[XB_XGEN(b.x)], 1u);
            asm volatile("s_waitcnt vmcnt(0)" ::: "memory");
        } else {
            XB_SPIN(xb_ld(&bar[XB_XGEN(b.x)]) == gen, bar);
            __builtin_amdgcn_fence(__ATOMIC_ACQUIRE, "agent");
            asm volatile("s_waitcnt vmcnt(0)" ::: "memory");
        }
    }
    __syncthreads();
}

struct Frame {
    LAS unsigned char* lds;
    int tid, lane, wave, G, bid;
    const float *x, *c, *w_ada, *b_ada, *norm1_g, *w_in, *q_norm_g, *k_norm_g, *w_pool, *pool_scale, *w_out, *norm2_g, *w_grp, *w_exp, *w1, *w3, *w2;
    float* out;
    unsigned* ctl;
    float* ADA; float* ADAP; float* TAB; bf16_t* WR; int* TOKE; float* TOKW; int* ROWTOK; float* ROWW; float* WI; bf16_t* KI;
    bf16_t *WPOOL, *WOUT, *WIN, *W13, *W2, *H, *PROJ; unsigned short* SC; bf16_t *QB, *KV, *QI, *PM, *ACT, *CONCAT; unsigned short* SEL;
};

namespace pg8 {
constexpr int BM = 256, BK = 64, HALF = 128, HTB = HALF * BK * 2, STAGE_BYTES = 8 * HTB, NXCD = 8, WGM = 8;
__device__ __forceinline__ int lds_byte(int r, int c) { const int st = (r >> 4) * 2 + (c >> 5), rr = r & 15, cc = c & 31, ob = rr * 64 + cc * 2; return st * 1024 + (ob ^ (((ob >> 9) & 1) << 5)); }
__device__ __forceinline__ void stage_rc(int b, int& R, int& C) { const int st = b / 1024, sb = b % 1024, swz = sb ^ (((sb >> 9) & 1) << 5); R = (st >> 1) * 16 + swz / 64; C = (st & 1) * 32 + (swz % 64) / 2; }
__device__ __forceinline__ int perm32(int rho) { const int n = rho >> 4, i = rho & 15; return 8 * (i >> 2) + 4 * n + (i & 3); }
struct Unit { int pm, pn; };
struct Gemm { const bf16_t* A; const bf16_t* Bt; int K; };

struct StaticOrder {
    int nM, nN, nwg, G, c;
    __device__ void init(int M, int N, int G_, int c_) { nM = M / BM; nN = N / BM; nwg = nM * nN; G = G_; c = c_; }
    __device__ bool next(int i, Unit& u) const {
        const long L = (long)i * G + c; if (L >= nwg) return false;
        int wgid = (int)L; { const int q = nwg / NXCD, r = nwg % NXCD, xcd = wgid % NXCD, off = wgid / NXCD; wgid = (xcd < r ? xcd * (q + 1) : r * (q + 1) + (xcd - r) * q) + off; }
        const int nig = WGM * nN, gid = wgid / nig, fm = gid * WGM, gsz = (nM - fm) < WGM ? (nM - fm) : WGM;
        u.pm = fm + ((wgid % nig) % gsz); u.pn = (wgid % nig) / gsz; return true;
    }
    __device__ __forceinline__ unsigned arow(const Unit& u, int rr) const { return (unsigned)(u.pm * BM + rr); }
};
struct PoolOrder {
    int G, c;
    __device__ bool next(int i, Unit& u) const { const int L = i * G + c; if (L >= 512) return false; u.pm = L; u.pn = L >> 7; return true; }
    __device__ __forceinline__ unsigned arow(const Unit& u, int rr) const { return (unsigned)(u.pm * BM + rr); }
};
template <int NC, bool GATHER> struct MoeOrder {
    const int* tileb; const int* rowtok; int lo, hi, G, c;
    __device__ bool next(int i, Unit& u) const {
        const int L = i * G + c; if (L >= (hi - lo) * NC) return false;
        u.pm = lo + L / NC; const int e = tileb[u.pm] & 31; u.pn = e * NC + (L % NC); return true;
    }
    __device__ __forceinline__ unsigned arow(const Unit& u, int rr) const {
        if (GATHER) { const int tok = rowtok[u.pm * BM + rr]; return (unsigned)(tok < 0 ? 0 : tok); }
        return (unsigned)(u.pm * BM + rr);
    }
};

template <class Epi, class Sched>
__device__ __forceinline__ void gemm_phase(LAS unsigned char* lds, const Gemm g, const Sched& S, const Epi& E) {
    const int tid = threadIdx.x, wid = __builtin_amdgcn_readfirstlane(tid >> 6), lane = tid & 63, wr = wid >> 2, wc = wid & 3, fr = lane & 15, fq = lane >> 4;
    const int K = g.K, nt = K / BK;
    int R0, C0; stage_rc(tid * 16, R0, C0);
    unsigned voffB[2];
#pragma unroll
    for (int i = 0; i < 2; ++i) { const int R = R0 + 64 * i; const int Rb = Epi::PERM ? ((R & ~31) + perm32(R & 31)) : R; voffB[i] = (unsigned)(Rb * K + C0) * 2u; }
    const unsigned rowb = (unsigned)K * 2u, colb = (unsigned)C0 * 2u;
    const size_t kstep = (size_t)(BK * 2);
    const size_t hstep = (size_t)HALF * K * 2;
    const size_t tstep = 2 * hstep;
    const unsigned ldsw = (unsigned)wid * 1024u;
    const int aoff = lds_byte(wr * 64 + fr, fq * 8), boff = lds_byte(wc * 32 + fr, fq * 8);
#define PG8_SA(b, h) (((b) * 2 + (h)) * HTB)
#define PG8_SB(b, h) ((4 + (b) * 2 + (h)) * HTB)
#define PG8_STAGE(bufoff, gbase, voff) do { _Pragma("unroll") for (int _i = 0; _i < 2; ++_i) \
        __builtin_amdgcn_global_load_lds((const unsigned*)((const char*)(gbase) + (voff)[_i]), (LAS unsigned*)(lds + (bufoff) + ldsw + _i * 8192), 16, 0, 0); } while (0)
#define PG8_LDA(dst, b, h) do { _Pragma("unroll") for (int m = 0; m < 4; ++m) _Pragma("unroll") for (int k = 0; k < 2; ++k) dst[m][k] = *(const LAS bf16x8*)(lds + PG8_SA(b, h) + aoff + m * 2048 + k * 1024); } while (0)
#define PG8_LDB(dst, b, h) do { _Pragma("unroll") for (int n = 0; n < 2; ++n) _Pragma("unroll") for (int k = 0; k < 2; ++k) dst[n][k] = *(const LAS bf16x8*)(lds + PG8_SB(b, h) + boff + n * 2048 + k * 1024); } while (0)
#define PG8_MMA(ai, bj, At, Bt) do { __builtin_amdgcn_s_setprio(1); _Pragma("unroll") for (int m = 0; m < 4; ++m) _Pragma("unroll") for (int n = 0; n < 2; ++n) _Pragma("unroll") for (int k = 0; k < 2; ++k) \
        acc[ai][bj][m][n] = __builtin_amdgcn_mfma_f32_16x16x32_bf16(Bt[n][k], At[m][k], acc[ai][bj][m][n], 0, 0, 0); __builtin_amdgcn_s_setprio(0); } while (0)
#define PG8_WAIT_V(n) asm volatile("s_waitcnt vmcnt(" #n ")" ::: "memory")
#define PG8_WAIT_L(n) asm volatile("s_waitcnt lgkmcnt(" #n ")" ::: "memory")
#define PG8_BAR __builtin_amdgcn_s_barrier()
#define PG8_SCHED __builtin_amdgcn_sched_barrier(0)
#define PG8_ROWS(dst, u) do { _Pragma("unroll") for (int _h = 0; _h < 2; ++_h) _Pragma("unroll") for (int _i = 0; _i < 2; ++_i) dst[_h][_i] = S.arow(u, _h * HALF + R0 + 64 * _i) * rowb + colb; } while (0)
    Unit cur, nxt; int ui = 0;
    if (!S.next(0, cur)) return;
    f32x4 acc[2][2][4][2];
#pragma unroll
    for (int a = 0; a < 2; ++a)
#pragma unroll
        for (int b = 0; b < 2; ++b)
#pragma unroll
            for (int m = 0; m < 4; ++m)
#pragma unroll
                for (int n = 0; n < 2; ++n) acc[a][b][m][n] = (f32x4){0.f, 0.f, 0.f, 0.f};
    bf16x8 At[4][2], B0[2][2], B1[2][2];
    unsigned oc[2][2], on[2][2];
    PG8_ROWS(oc, cur);
    const char* gA = (const char*)g.A;
    const char* cB = (const char*)g.Bt + (size_t)cur.pn * tstep;
    PG8_STAGE(PG8_SB(0, 0), cB, voffB); PG8_STAGE(PG8_SA(0, 0), gA, oc[0]); PG8_STAGE(PG8_SB(0, 1), cB + hstep, voffB); PG8_STAGE(PG8_SA(0, 1), gA, oc[1]);
    if (wr == 1) PG8_BAR;
    PG8_WAIT_V(4); PG8_BAR;
    PG8_STAGE(PG8_SB(1, 0), cB + kstep, voffB); PG8_STAGE(PG8_SA(1, 0), gA + kstep, oc[0]); PG8_STAGE(PG8_SB(1, 1), cB + hstep + kstep, voffB);
    PG8_WAIT_V(6); PG8_BAR;
    const int tpre = nt >= 4 ? nt - 4 : nt - 2;
    for (;;) {
        const bool has_next = S.next(ui + 1, nxt);
#pragma unroll
        for (int h = 0; h < 2; ++h)
#pragma unroll
            for (int i = 0; i < 2; ++i) on[h][i] = oc[h][i];
        const char* nB = has_next ? (const char*)g.Bt + (size_t)nxt.pn * tstep : cB;
        for (int t = 0; t < nt; t += 2) {
            const bool last = (t == nt - 2);
            if (has_next && t == tpre) PG8_ROWS(on, nxt);
            const char* a1 = gA + (size_t)(t + 1) * kstep;
            const char* a2 = last ? gA : gA + (size_t)(t + 2) * kstep; const char* b2 = last ? nB : cB + (size_t)(t + 2) * kstep;
            const char* a3 = a2 + kstep; const char* b3 = b2 + kstep;
            unsigned o2[2][2];
#pragma unroll
            for (int h = 0; h < 2; ++h)
#pragma unroll
                for (int i = 0; i < 2; ++i) o2[h][i] = last ? on[h][i] : oc[h][i];
            PG8_LDB(B0, 0, 0); PG8_SCHED; PG8_LDA(At, 0, 0); PG8_STAGE(PG8_SA(1, 1), a1, oc[1]);
            PG8_WAIT_L(8); PG8_BAR; PG8_WAIT_L(0); PG8_MMA(0, 0, At, B0); PG8_BAR; PG8_SCHED;
            PG8_LDB(B1, 0, 1); PG8_STAGE(PG8_SB(0, 0), b2, voffB);
            PG8_BAR; PG8_WAIT_L(0); PG8_MMA(0, 1, At, B1); PG8_BAR;
            PG8_LDA(At, 0, 1); PG8_STAGE(PG8_SA(0, 0), a2, o2[0]);
            PG8_BAR; PG8_WAIT_L(0); PG8_MMA(1, 0, At, B0); PG8_BAR; PG8_SCHED;
            PG8_STAGE(PG8_SB(0, 1), b2 + hstep, voffB);
            PG8_WAIT_V(6); PG8_BAR; PG8_MMA(1, 1, At, B1); PG8_BAR;
            PG8_LDB(B0, 1, 0); PG8_SCHED; PG8_LDA(At, 1, 0); PG8_STAGE(PG8_SA(0, 1), a2, o2[1]);
            PG8_WAIT_L(8); PG8_BAR; PG8_WAIT_L(0); PG8_MMA(0, 0, At, B0); PG8_BAR; PG8_SCHED;
            PG8_LDB(B1, 1, 1); PG8_STAGE(PG8_SB(1, 0), b3, voffB);
            PG8_BAR; PG8_WAIT_L(0); PG8_MMA(0, 1, At, B1); PG8_BAR;
            PG8_LDA(At, 1, 1); PG8_STAGE(PG8_SA(1, 0), a3, o2[0]);
            PG8_BAR; PG8_WAIT_L(0); PG8_MMA(1, 0, At, B0); PG8_BAR; PG8_SCHED;
            PG8_STAGE(PG8_SB(1, 1), b3 + hstep, voffB);
            PG8_WAIT_V(6); PG8_BAR; PG8_MMA(1, 1, At, B1); PG8_BAR;
        }
        E(acc, cur, wr, wc, fr, fq);
        if (!has_next) break;
#pragma unroll
        for (int a = 0; a < 2; ++a)
#pragma unroll
            for (int b = 0; b < 2; ++b)
#pragma unroll
                for (int m = 0; m < 4; ++m)
#pragma unroll
                    for (int n = 0; n < 2; ++n) acc[a][b][m][n] = (f32x4){0.f, 0.f, 0.f, 0.f};
        cur = nxt; cB = nB; ++ui;
#pragma unroll
        for (int h = 0; h < 2; ++h)
#pragma unroll
            for (int i = 0; i < 2; ++i) oc[h][i] = on[h][i];
    }
    PG8_WAIT_V(0);
    if (wr == 0) PG8_BAR;
    PG8_BAR;
#undef PG8_SA
#undef PG8_SB
#undef PG8_STAGE
#undef PG8_LDA
#undef PG8_LDB
#undef PG8_MMA
#undef PG8_WAIT_V
#undef PG8_WAIT_L
#undef PG8_BAR
#undef PG8_SCHED
#undef PG8_ROWS
}

struct EpiBf16 {
    static constexpr bool PERM = true;
    bf16_t* O; int ldc; int mode;
    __device__ __forceinline__ void operator()(const f32x4 (&acc)[2][2][4][2], const Unit& u, int wr, int wc, int fr, int fq) const {
        const int rowb = (mode == 1 ? (u.pm & 127) : u.pm) * BM, colb = (mode == 1 ? 1024 : 0) + u.pn * BM;
        const int row0 = rowb + wr * 64 + fr, col0 = colb + wc * 32 + 8 * fq;
#pragma unroll
        for (int ai = 0; ai < 2; ++ai)
#pragma unroll
            for (int m = 0; m < 4; ++m) { bf16_t* rowp = O + (size_t)(row0 + ai * HALF + m * 16) * ldc + col0;
#pragma unroll
                for (int bj = 0; bj < 2; ++bj) { const f32x4 v0 = acc[ai][bj][m][0], v1 = acc[ai][bj][m][1];
                    u32x4 w; w.x = pk_bf16(v0[0], v0[1]); w.y = pk_bf16(v0[2], v0[3]); w.z = pk_bf16(v1[0], v1[1]); w.w = pk_bf16(v1[2], v1[3]);
                    *(u32x4*)(rowp + bj * HALF) = w; } }
    }
};
struct EpiMix {
    static constexpr bool PERM = false;
    const float* x; const float* ada; float* out;
    __device__ __forceinline__ void operator()(const f32x4 (&acc)[2][2][4][2], const Unit& u, int wr, int wc, int fr, int fq) const {
        const int row0 = u.pm * BM + wr * 64 + fr, col0 = u.pn * BM + wc * 32 + 4 * fq;
        const float* gate = ada + (size_t)(u.pm >> 5) * 12288 + 2 * 2048;
        f32x4 gv[2][2];
#pragma unroll
        for (int bj = 0; bj < 2; ++bj)
#pragma unroll
            for (int n = 0; n < 2; ++n) gv[bj][n] = *(const f32x4*)(gate + col0 + bj * HALF + n * 16);
#pragma unroll
        for (int ai = 0; ai < 2; ++ai)
#pragma unroll
            for (int m = 0; m < 4; ++m) { const size_t ro = (size_t)(row0 + ai * HALF + m * 16) * D + col0;
#pragma unroll
                for (int bj = 0; bj < 2; ++bj)
#pragma unroll
                    for (int n = 0; n < 2; ++n) { const f32x4 xv = *(const f32x4*)(x + ro + bj * HALF + n * 16); *(f32x4*)(out + ro + bj * HALF + n * 16) = xv + gv[bj][n] * acc[ai][bj][m][n]; } }
    }
};
struct EpiAct {
    static constexpr bool PERM = true;
    bf16_t* ACT;
    __device__ __forceinline__ void operator()(const f32x4 (&acc)[2][2][4][2], const Unit& u, int wr, int wc, int fr, int fq) const {
        const int row0 = u.pm * BM + wr * 64 + fr, col0 = (u.pn & 3) * 128 + wc * 32 + 8 * fq;
#pragma unroll
        for (int ai = 0; ai < 2; ++ai)
#pragma unroll
            for (int m = 0; m < 4; ++m) {
                float v[8];
#pragma unroll
                for (int n = 0; n < 2; ++n)
#pragma unroll
                    for (int e = 0; e < 4; ++e) { const float a = acc[ai][0][m][n][e], b = acc[ai][1][m][n][e]; v[n * 4 + e] = a / (1.0f + __expf(-a)) * b; }
                *(u32x4*)(ACT + (size_t)(row0 + ai * HALF + m * 16) * 512 + col0) = pack8(v);
            }
    }
};
struct EpiMoeOut {
    static constexpr bool PERM = false;
    const int* rowtok; const float* roww; const float* ada; float* out;
    __device__ __forceinline__ void operator()(const f32x4 (&acc)[2][2][4][2], const Unit& u, int wr, int wc, int fr, int fq) const {
        const int row0 = u.pm * BM + wr * 64 + fr, col0 = (u.pn & 7) * BM + wc * 32 + 4 * fq;
#pragma unroll
        for (int ai = 0; ai < 2; ++ai)
#pragma unroll
            for (int m = 0; m < 4; ++m) { const int row = row0 + ai * HALF + m * 16; const int tok = rowtok[row];
                if (tok >= 0) { const float w = roww[row]; const float* gate = ada + (size_t)(tok >> 13) * 12288 + 5 * 2048 + col0; float* op = out + (size_t)tok * D + col0;
#pragma unroll
                    for (int bj = 0; bj < 2; ++bj)
#pragma unroll
                        for (int n = 0; n < 2; ++n) { const f32x4 gvv = *(const f32x4*)(gate + bj * HALF + n * 16); f32x4 o = *(f32x4*)(op + bj * HALF + n * 16); o += gvv * w * acc[ai][bj][m][n]; *(f32x4*)(op + bj * HALF + n * 16) = o; } } }
    }
};
}

__device__ __forceinline__ int colmap(int n) { return n < 2560 ? n : (n < 2624 ? 3584 + (n - 2560) : (n < 2640 ? 3648 + (n - 2624) : 2560 + (n - 2640))); }

template <class RowMap>
__device__ __forceinline__ void tr_tile(const Frame& F, const float* src, size_t ldS, int k0, int n0, int N, const float* cscale, RowMap rm) {
    LAS float* tile = (LAS float*)F.lds;
    const int tid = F.tid, r = tid >> 4, c4 = tid & 15;
    f32x4 v[4];
    const int n = n0 + c4 * 4;
#pragma unroll
    for (int i = 0; i < 4; ++i) v[i] = (n < N) ? *(const f32x4*)(src + (size_t)(k0 + r + 32 * i) * ldS + n) : (f32x4){0.f, 0.f, 0.f, 0.f};
    __syncthreads();
#pragma unroll
    for (int i = 0; i < 4; ++i)
#pragma unroll
        for (int e = 0; e < 4; ++e) tile[(r + 32 * i) * 65 + c4 * 4 + e] = v[i][e];
    __syncthreads();
    const int nn = tid >> 3, kc = tid & 7;
    if (n0 + nn < N) {
        const float sc = cscale ? cscale[n0 + nn] : 1.0f;
        float f[16];
#pragma unroll
        for (int j = 0; j < 16; ++j) f[j] = tile[(kc * 16 + j) * 65 + nn] * sc;
        bf16_t* d = rm(n0 + nn) + k0 + kc * 16;
        *(u32x4*)d = pack8(f); *(u32x4*)(d + 8) = pack8(f + 8);
    }
}

__device__ void p0_prologue(const Frame& F) {
    constexpr int U_ADA = 192, T_WIN = 16 * 58, T_WOUT = 16 * 32, T_POOL = 4 * 2 * 4, T_W1 = 32 * 128, T_W2 = 32 * 128, U_TAB = 16, U_WR = 4, U_PAD = 2;
    constexpr int B0 = U_ADA, B1 = B0 + T_WIN, B2 = B1 + T_WOUT, B3 = B2 + T_POOL, B4 = B3 + T_W1, B5 = B4 + T_W1, B6 = B5 + T_W2, B7 = B6 + U_TAB, B8 = B7 + U_WR, B9 = B8 + U_PAD;
    const int tid = F.tid;
    for (int u = F.bid; u < B9; u += F.G) {
        if (u < B0) {
            const int kc = u / 6, cb = u % 6;
            LAS float* sc = (LAS float*)F.lds;
            __syncthreads();
            if (tid < 256) { const int b = tid >> 6, k = tid & 63; const float cv = F.c[b * D + kc * 64 + k]; sc[tid] = cv / (1.0f + __expf(-cv)); }
            __syncthreads();
            const int n = cb * 2048 + tid * 4;
            f32x4 a[4];
#pragma unroll
            for (int b = 0; b < 4; ++b) a[b] = (f32x4){0.f, 0.f, 0.f, 0.f};
            const float* wp = F.w_ada + (size_t)(kc * 64) * 12288 + n;
#pragma unroll 8
            for (int k = 0; k < 64; ++k) { const f32x4 w = *(const f32x4*)(wp + (size_t)k * 12288);
#pragma unroll
                for (int b = 0; b < 4; ++b) a[b] += sc[b * 64 + k] * w; }
            const f32x4 bias = (kc == 0) ? *(const f32x4*)(F.b_ada + n) : (f32x4){0.f, 0.f, 0.f, 0.f};
#pragma unroll
            for (int b = 0; b < 4; ++b) *(f32x4*)(F.ADAP + ((size_t)kc * 4 + b) * 12288 + n) = a[b] + bias;
        } else if (u < B1) {
            const int v = u - B0, kt = v / 58, ntl = v % 58; bf16_t* W = F.WIN;
            tr_tile(F, F.w_in, 3664, kt * 128, ntl * 64, 3664, nullptr, [=](int n) { return W + (size_t)colmap(n) * 2048; });
        } else if (u < B2) {
            const int v = u - B1, kt = v / 32, ntl = v % 32; bf16_t* W = F.WOUT;
            tr_tile(F, F.w_out, 2048, kt * 128, ntl * 64, 2048, nullptr, [=](int n) { return W + (size_t)n * 2048; });
        } else if (u < B3) {
            const int v = u - B2, g = v / 8, kt = (v % 8) / 4, ntl = v % 4; bf16_t* W = F.WPOOL + (size_t)g * 256 * 256;
            tr_tile(F, F.w_pool + (size_t)g * 65536, 256, kt * 128, ntl * 64, 256, F.pool_scale + g * 256, [=](int n) { return W + (size_t)n * 256; });
        } else if (u < B5) {
            const bool is3 = u >= B4; const int v = u - (is3 ? B4 : B3), e = v / 128, kt = (v % 128) / 8, ntl = v % 8;
            bf16_t* W = F.W13 + (size_t)e * 1024 * 2048 + (is3 ? (size_t)128 * 2048 : 0);
            tr_tile(F, (is3 ? F.w3 : F.w1) + (size_t)e * 2048 * 512, 512, kt * 128, ntl * 64, 512, nullptr, [=](int n) { return W + (size_t)((n >> 7) * 256 + (n & 127)) * 2048; });
        } else if (u < B6) {
            const int v = u - B5, e = v / 128, kt = (v % 128) / 32, ntl = v % 32; bf16_t* W = F.W2 + (size_t)e * 2048 * 512;
            tr_tile(F, F.w2 + (size_t)e * 512 * 2048, 2048, kt * 128, ntl * 64, 2048, nullptr, [=](int n) { return W + (size_t)n * 512; });
        } else if (u < B7) {
            const int pos = (u - B6) * 512 + tid; float* tp = F.TAB + (size_t)pos * 48;
            for (int i = 0; i < 16; ++i) { const double inv = pow(500000.0, -(double)(2 * i) / 32.0); double sn, cs; sincos((double)pos * inv, &sn, &cs); tp[i] = (float)cs; tp[16 + i] = (float)sn; }
            for (int i = 0; i < 8; ++i) { const double inv = pow(500000.0, -(double)(2 * i) / 16.0); double sn, cs; sincos((double)pos * inv, &sn, &cs); tp[32 + i] = (float)cs; tp[40 + i] = (float)sn; }
        } else if (u < B8) {
            const int j0 = (u - B7) * 12;
            for (int idx = tid; idx < 12 * 2048; idx += NTHREADS) { const int j = j0 + idx / 2048, k = idx % 2048;
                const float v = j < 4 ? F.w_grp[k * 4 + j] : (j < 36 ? F.w_exp[k * 32 + (j - 4)] : 0.f);
                bf16v2 t; t.x = (__bf16)v; t.y = (__bf16)0.f; F.WR[(size_t)j * 2048 + k] = (bf16_t)(__builtin_bit_cast(unsigned, t) & 0xffffu); }
        } else {
            const int h = u - B8; u32x4* p = (u32x4*)(F.WIN + (size_t)3664 * 2048) + (size_t)h * 22528;
            for (int i = tid; i < 22528; i += NTHREADS) p[i] = (u32x4){0u, 0u, 0u, 0u};
        }
    }
}

__device__ __forceinline__ void norm_rows(const Frame& F, const float* src, const float* gain, const float* shiftp, const float* scalep) {
    const int lane = F.lane;
    f32x4 Gv[8], Sv[8];
#pragma unroll
    for (int i = 0; i < 8; ++i) { const int col = 4 * lane + 256 * i; const f32x4 g = *(const f32x4*)(gain + col), sc = *(const f32x4*)(scalep + col);
        Gv[i] = g * (1.0f + sc); Sv[i] = *(const f32x4*)(shiftp + col); }
    for (int j = 0; j < 16; ++j) {
        const int t = F.bid * 128 + F.wave + 8 * j;
        const float* xr = src + (size_t)t * D;
        f32x4 v[8]; float ss = 0.f;
#pragma unroll
        for (int i = 0; i < 8; ++i) { v[i] = *(const f32x4*)(xr + 4 * lane + 256 * i); ss += v[i][0] * v[i][0] + v[i][1] * v[i][1] + v[i][2] * v[i][2] + v[i][3] * v[i][3]; }
        ss = wave_sum(ss);
        const float rstd = rsqrtf(ss * (1.0f / 2048.0f) + NORM_EPS);
        bf16_t* hr = F.H + (size_t)t * D;
#pragma unroll
        for (int i = 0; i < 8; ++i) { const f32x4 y = v[i] * rstd * Gv[i] + Sv[i]; u32x2 w; w.x = pk_bf16(y[0], y[1]); w.y = pk_bf16(y[2], y[3]); *(u32x2*)(hr + 4 * lane + 256 * i) = w; }
    }
}

__device__ void p3_post(const Frame& F) {
    const int lane = F.lane;
    const float QSCALE = 0.08838834764831845f * 1.4426950408889634f;
    const float IDX_SCALE = 0.125f * 0.25f;
    for (int j = 0; j < 16; ++j) {
        const int t = F.bid * 128 + F.wave + 8 * j, pos = t & (S - 1);
        const bf16_t* pr = F.PROJ + (size_t)t * NPROJ;
        const float* tab = F.TAB + (size_t)pos * 48;
        {
            float f[16]; unpack8(*(const u32x4*)(pr + CQ + 16 * lane), f); unpack8(*(const u32x4*)(pr + CQ + 16 * lane + 8), f + 8);
            float ss = 0.f;
#pragma unroll
            for (int e = 0; e < 16; ++e) ss += f[e] * f[e];
            ss += __shfl_xor(ss, 1); ss += __shfl_xor(ss, 2); ss += __shfl_xor(ss, 4);
            const float rstd = rsqrtf(ss * (1.0f / 128.0f) + NORM_EPS);
            const int d0 = (lane & 7) * 16;
#pragma unroll
            for (int e = 0; e < 16; ++e) f[e] = f[e] * rstd * F.q_norm_g[d0 + e];
            float o[16];
#pragma unroll
            for (int e = 0; e < 16; ++e) o[e] = __shfl_xor(f[e], 1);
            const int l8 = lane & 7;
            if (l8 < 2) {
#pragma unroll
                for (int e = 0; e < 16; ++e) { const float cs = tab[e], sn = tab[16 + e]; f[e] = (l8 == 0) ? (f[e] * cs - o[e] * sn) : (f[e] * cs + o[e] * sn); }
            }
#pragma unroll
            for (int e = 0; e < 16; ++e) f[e] *= QSCALE;
            bf16_t* qo = F.QB + (size_t)t * 1024 + 16 * lane;
            *(u32x4*)qo = pack8(f); *(u32x4*)(qo + 8) = pack8(f + 8);
        }
        {
            const int l = lane & 31;
            float f[16]; unpack8(*(const u32x4*)(pr + CK + 16 * l), f); unpack8(*(const u32x4*)(pr + CK + 16 * l + 8), f + 8);
            float kf[16]; float ss = 0.f;
#pragma unroll
            for (int e = 0; e < 16; ++e) ss += f[e] * f[e];
            ss += __shfl_xor(ss, 1); ss += __shfl_xor(ss, 2); ss += __shfl_xor(ss, 4);
            const float rstd = rsqrtf(ss * (1.0f / 128.0f) + NORM_EPS);
            const int d0 = (l & 7) * 16;
#pragma unroll
            for (int e = 0; e < 16; ++e) kf[e] = f[e] * rstd * F.k_norm_g[d0 + e];
            float o[16];
#pragma unroll
            for (int e = 0; e < 16; ++e) o[e] = __shfl_xor(kf[e], 1);
            const int l8 = l & 7;
            if (l8 < 2) {
#pragma unroll
                for (int e = 0; e < 16; ++e) { const float cs = tab[e], sn = tab[16 + e]; kf[e] = (l8 == 0) ? (kf[e] * cs - o[e] * sn) : (kf[e] * cs + o[e] * sn); }
            }
            if (lane < 32) {
                const bool isv = lane >= 16; const int ll = lane & 15, g = ll >> 3, dd = (ll & 7) * 16;
                bf16_t* dst = F.KV + (size_t)t * 512 + g * 256 + (isv ? 128 : 0) + dd;
                *(u32x4*)dst = pack8(isv ? f : kf); *(u32x4*)(dst + 8) = pack8(isv ? f + 8 : kf + 8);
            }
        }
        {
            float f[16]; unpack8(*(const u32x4*)(pr + CQI + 16 * lane), f); unpack8(*(const u32x4*)(pr + CQI + 16 * lane + 8), f + 8);
            if ((lane & 3) == 0) {
#pragma unroll
                for (int i = 0; i < 8; ++i) { const float cs = tab[32 + i], sn = tab[40 + i]; const float x1 = f[i], x2 = f[i + 8]; f[i] = x1 * cs - x2 * sn; f[i + 8] = x2 * cs + x1 * sn; }
            }
            bf16_t* qo = F.QI + (size_t)t * 1024 + 16 * lane;
            *(u32x4*)qo = pack8(f); *(u32x4*)(qo + 8) = pack8(f + 8);
        }
        if (lane < 5) {
            float f[16]; unpack8(*(const u32x4*)(pr + CKI + 16 * lane), f); unpack8(*(const u32x4*)(pr + CKI + 16 * lane + 8), f + 8);
            if (lane == 0) {
#pragma unroll
                for (int i = 0; i < 8; ++i) { const float cs = tab[32 + i], sn = tab[40 + i]; const float x1 = f[i], x2 = f[i + 8]; f[i] = x1 * cs - x2 * sn; f[i + 8] = x2 * cs + x1 * sn; }
            }
            if (lane < 4) { bf16_t* ko = F.KI + (size_t)t * 64 + 16 * lane; *(u32x4*)ko = pack8(f); *(u32x4*)(ko + 8) = pack8(f + 8); }
            else { float* wo = F.WI + (size_t)t * 16;
#pragma unroll
                for (int e = 0; e < 16; ++e) wo[e] = f[e] * IDX_SCALE; }
        }
        {
            const int g = lane >> 4, w = 2 << g;
            float cur[16], sum[16];
            unpack8(*(const u32x4*)(pr + CP + 16 * lane), cur); unpack8(*(const u32x4*)(pr + CP + 16 * lane + 8), cur + 8);
#pragma unroll
            for (int e = 0; e < 16; ++e) sum[e] = cur[e];
            for (int r = 1; r < 16; ++r) {
                if (r < w && r <= pos) { float f[16]; const bf16_t* pp = pr - (size_t)r * NPROJ + CP + 16 * lane; unpack8(*(const u32x4*)pp, f); unpack8(*(const u32x4*)(pp + 8), f + 8);
#pragma unroll
                    for (int e = 0; e < 16; ++e) sum[e] += f[e]; }
            }
            const float inv = 1.0f / (float)((pos + 1) < w ? (pos + 1) : w);
#pragma unroll
            for (int e = 0; e < 16; ++e) sum[e] = sum[e] * inv - cur[e];
            bf16_t* po = F.PM + ((size_t)g * T + t) * 256 + (lane & 15) * 16;
            *(u32x4*)po = pack8(sum); *(u32x4*)(po + 8) = pack8(sum + 8);
        }
    }
}

__device__ __forceinline__ size_t sc_block_base(int b, int qb) { return (size_t)b * SC_BATCH + (size_t)16384 * ((size_t)qb * (qb + 1) / 2); }

__device__ void indexer_unit(const Frame& F, int b, int qb, int kb) {
    const int lane = F.lane, wid = F.wave, c = lane & 31, hf = lane >> 5;
    bf16x8 kf[4][4];
    const bf16_t* kib = F.KI + ((size_t)b * S + kb * 128) * 64;
#pragma unroll
    for (int sub = 0; sub < 4; ++sub)
#pragma unroll
        for (int kk = 0; kk < 4; ++kk) kf[sub][kk] = *(const bf16x8*)(kib + (4 * c + sub) * 64 + 16 * kk + 8 * hf);
    const int qq = (c >> 2) & 1, head = (c & 3) + 4 * (c >> 3);
    const size_t rowlen = (size_t)(qb + 1) * 128;
    unsigned short* scb = F.SC + sc_block_base(b, qb);
    for (int pair = 0; pair < 8; ++pair) {
        const int r0 = wid * 16 + pair * 2;
        const size_t tA = (size_t)b * S + qb * 128 + r0 + qq, tw = (size_t)b * S + qb * 128 + r0 + hf;
        bf16x8 af[4];
#pragma unroll
        for (int kk = 0; kk < 4; ++kk) af[kk] = *(const bf16x8*)(F.QI + tA * 1024 + head * 64 + 16 * kk + 8 * hf);
        f32x4 wv[4];
#pragma unroll
        for (int i = 0; i < 4; ++i) wv[i] = *(const f32x4*)(F.WI + tw * 16 + 4 * i);
        float sc[4];
#pragma unroll
        for (int sub = 0; sub < 4; ++sub) {
            f32x16 acc;
#pragma unroll
            for (int i = 0; i < 16; ++i) acc[i] = 0.f;
#pragma unroll
            for (int kk = 0; kk < 4; ++kk) acc = __builtin_amdgcn_mfma_f32_32x32x16_bf16(af[kk], kf[sub][kk], acc, 0, 0, 0);
            float s = 0.f;
#pragma unroll
            for (int i = 0; i < 16; ++i) s += wv[i >> 2][i & 3] * fmaxf(acc[i], 0.f);
            sc[sub] = s;
        }
        f16v2 h0, h1; h0.x = (_Float16)sc[0]; h0.y = (_Float16)sc[1]; h1.x = (_Float16)sc[2]; h1.y = (_Float16)sc[3];
        u32x2 w; w.x = __builtin_bit_cast(unsigned, h0); w.y = __builtin_bit_cast(unsigned, h1);
        *(u32x2*)(scb + (size_t)(r0 + hf) * rowlen + kb * 128 + 4 * c) = w;
    }
}

__device__ __forceinline__ void find_bin(LAS unsigned* hist, int lane, unsigned need, unsigned& bin, unsigned& above) {
    const u32x4 h = *(const LAS u32x4*)(hist + 4 * lane);
    const unsigned s = h.x + h.y + h.z + h.w;
    unsigned v = s;
#pragma unroll
    for (int d = 1; d < 64; d <<= 1) { const unsigned tt = __shfl_down(v, d); if (lane + d < 64) v += tt; }
    unsigned run = v - s;
    int fb = -1; unsigned fa = 0;
    const unsigned hh[4] = {h.x, h.y, h.z, h.w};
#pragma unroll
    for (int j = 3; j >= 0; --j) { if (fb < 0 && run < need && run + hh[j] >= need) { fb = 4 * lane + j; fa = run; } run += hh[j]; }
    const unsigned long long m = __ballot(fb >= 0);
    const int src = m ? (int)__builtin_ctzll(m) : 0;
    bin = (unsigned)__shfl(fb, src); above = __shfl(fa, src);
}

__device__ void select_row(const Frame& F, int t, LAS unsigned short* rowbuf, LAS unsigned* hist, int lane) {
    const int pos = t & (S - 1), b = t >> 13, n = pos + 1, qb = pos >> 7, r = pos & 127;
    const unsigned short* src = F.SC + sc_block_base(b, qb) + (size_t)r * (qb + 1) * 128;
    unsigned short* out = F.SEL + (size_t)t * 256;
    if (n <= 256) { for (int j = lane; j < 256; j += 64) out[j] = (unsigned short)(j < n ? j : 0); return; }
#pragma unroll
    for (int i = 0; i < 4; ++i) hist[lane + 64 * i] = 0u;
    const int nch = (n + 511) >> 9;
    for (int ch = 0; ch < nch; ++ch) {
        const int base = ch * 512 + lane * 8;
        const u32x4 raw = *(const u32x4*)(src + base);
        unsigned kk[8]; const unsigned rw[4] = {raw.x, raw.y, raw.z, raw.w};
#pragma unroll
        for (int e = 0; e < 8; ++e) { const unsigned h = (rw[e >> 1] >> ((e & 1) * 16)) & 0xffffu; unsigned key = (h & 0x8000u) ? (~h & 0xffffu) : (h | 0x8000u);
            if (base + e >= n) key = 0u; else __hip_atomic_fetch_add(hist + (key >> 8), 1u, __ATOMIC_RELAXED, __HIP_MEMORY_SCOPE_WORKGROUP);
            kk[e] = key; }
        u32x4 st; st.x = kk[0] | (kk[1] << 16); st.y = kk[2] | (kk[3] << 16); st.z = kk[4] | (kk[5] << 16); st.w = kk[6] | (kk[7] << 16);
        *(LAS u32x4*)(rowbuf + base) = st;
    }
    unsigned bin1, above1; find_bin(hist, lane, 256u, bin1, above1);
    const unsigned r1 = 256u - above1;
#pragma unroll
    for (int i = 0; i < 4; ++i) hist[lane + 64 * i] = 0u;
    for (int ch = 0; ch < nch; ++ch) {
        const int base = ch * 512 + lane * 8;
        const u32x4 st = *(const LAS u32x4*)(rowbuf + base); const unsigned rw[4] = {st.x, st.y, st.z, st.w};
#pragma unroll
        for (int e = 0; e < 8; ++e) { const unsigned key = (rw[e >> 1] >> ((e & 1) * 16)) & 0xffffu;
            if (base + e < n && (key >> 8) == bin1) __hip_atomic_fetch_add(hist + (key & 255u), 1u, __ATOMIC_RELAXED, __HIP_MEMORY_SCOPE_WORKGROUP); }
    }
    unsigned bin2, above2; find_bin(hist, lane, r1, bin2, above2);
    const unsigned r2 = r1 - above2, thr = (bin1 << 8) | bin2;
    unsigned outbase = 0, eqbase = 0;
    const unsigned long long ltmask = (1ull << lane) - 1ull;
    const int nit = (n + 63) >> 6;
    for (int it = 0; it < nit; ++it) {
        const int idx = it * 64 + lane; const bool inr = idx < n;
        const unsigned key = inr ? (unsigned)rowbuf[idx] : 0u;
        const bool eq = inr && key == thr;
        const unsigned long long em = __ballot(eq);
        const unsigned eqrank = eqbase + (unsigned)__popcll(em & ltmask);
        const bool take = inr && (key > thr || (eq && eqrank < r2));
        const unsigned long long tm = __ballot(take);
        if (take) { const unsigned p = outbase + (unsigned)__popcll(tm & ltmask); if (p < 256u) out[p] = (unsigned short)idx; }
        outbase += (unsigned)__popcll(tm); eqbase += (unsigned)__popcll(em);
    }
}

__device__ __forceinline__ bf16x8 tr_read2(unsigned a0, unsigned a1) {
    s16x4 x, y;
    asm volatile("ds_read_b64_tr_b16 %0, %2\n\tds_read_b64_tr_b16 %1, %3\n\ts_waitcnt lgkmcnt(0)" : "=&v"(x), "=&v"(y) : "v"(a0), "v"(a1) : "memory");
    return (bf16x8){x[0], x[1], x[2], x[3], y[0], y[1], y[2], y[3]};
}

__device__ void attn_query(const Frame& F, int t, LAS unsigned char* vbuf, int lane) {
    const int pos = t & (S - 1), b = t >> 13, cnt = (pos + 1) < 256 ? (pos + 1) : 256;
    const int li = lane & 15, q4 = lane >> 4;
    int idx[16];
#pragma unroll
    for (int c = 0; c < 16; ++c) { const int slot = c * 16 + li; const int v = F.SEL[(size_t)t * 256 + slot]; idx[c] = slot < cnt ? v : 0; }
    const bf16_t* kvb = F.KV + (size_t)b * S * 512;
    const unsigned vb = (unsigned)(uintptr_t)vbuf;
    const unsigned tra = vb + (unsigned)((4 * q4 + (li >> 2)) * 288 + (li & 3) * 8);
    for (int g = 0; g < 2; ++g) {
        bf16x8 bq[4];
#pragma unroll
        for (int kk = 0; kk < 4; ++kk) {
            bq[kk] = (bf16x8){0, 0, 0, 0, 0, 0, 0, 0};
            if (li < 4) bq[kk] = *(const bf16x8*)(F.QB + (size_t)t * 1024 + (4 * g + li) * 128 + 32 * kk + 8 * q4);
        }
        f32x4 s[16];
#pragma unroll
        for (int c = 0; c < 16; ++c) {
            const bf16_t* krow = kvb + (size_t)idx[c] * 512 + g * 256;
            f32x4 acc = (f32x4){0.f, 0.f, 0.f, 0.f};
#pragma unroll
            for (int kk = 0; kk < 4; ++kk) { const bf16x8 a = *(const bf16x8*)(krow + 32 * kk + 8 * q4); acc = __builtin_amdgcn_mfma_f32_16x16x32_bf16(a, bq[kk], acc, 0, 0, 0); }
            s[c] = acc;
        }
        float m = -INFINITY;
#pragma unroll
        for (int c = 0; c < 16; ++c)
#pragma unroll
            for (int i = 0; i < 4; ++i) { const int slot = c * 16 + 4 * q4 + i; if (slot >= cnt) s[c][i] = -INFINITY; m = fmaxf(m, s[c][i]); }
        m = fmaxf(m, __shfl_xor(m, 16)); m = fmaxf(m, __shfl_xor(m, 32));
        float sum = 0.f;
#pragma unroll
        for (int c = 0; c < 16; ++c)
#pragma unroll
            for (int i = 0; i < 4; ++i) { const float p = exp2f(s[c][i] - m); s[c][i] = p; sum += p; }
        sum += __shfl_xor(sum, 16); sum += __shfl_xor(sum, 32);
        f32x4 o[8];
#pragma unroll
        for (int d = 0; d < 8; ++d) o[d] = (f32x4){0.f, 0.f, 0.f, 0.f};
#pragma unroll
        for (int ks = 0; ks < 8; ++ks) {
            const int rr = lane >> 1, half = lane & 1;
            const int i0 = __shfl(idx[2 * ks], rr & 15), i1 = __shfl(idx[2 * ks + 1], rr & 15);
            const int vi = rr < 16 ? i0 : i1;
            const bf16_t* vrow = kvb + (size_t)vi * 512 + g * 256 + 128 + half * 64;
            u32x4 vv[8];
#pragma unroll
            for (int j = 0; j < 8; ++j) vv[j] = *(const u32x4*)(vrow + 8 * j);
#pragma unroll
            for (int j = 0; j < 8; ++j) *(LAS u32x4*)(vbuf + rr * 288 + half * 128 + j * 16) = vv[j];
            u32x4 pk; pk.x = pk_bf16(s[2 * ks][0], s[2 * ks][1]); pk.y = pk_bf16(s[2 * ks][2], s[2 * ks][3]); pk.z = pk_bf16(s[2 * ks + 1][0], s[2 * ks + 1][1]); pk.w = pk_bf16(s[2 * ks + 1][2], s[2 * ks + 1][3]);
            const bf16x8 bp = __builtin_bit_cast(bf16x8, pk);
            asm volatile("s_waitcnt lgkmcnt(0)" ::: "memory");
#pragma unroll
            for (int d = 0; d < 8; ++d) { const bf16x8 a = tr_read2(tra + d * 32, tra + 16 * 288 + d * 32); o[d] = __builtin_amdgcn_mfma_f32_16x16x32_bf16(a, bp, o[d], 0, 0, 0); }
        }
        const float inv = 1.0f / sum;
        if (li < 4) {
            bf16_t* op = F.CONCAT + (size_t)t * D + g * 512 + li * 128 + 4 * q4;
#pragma unroll
            for (int d = 0; d < 8; ++d) { u32x2 w; w.x = pk_bf16(o[d][0] * inv, o[d][1] * inv); w.y = pk_bf16(o[d][2] * inv, o[d][3] * inv); *(u32x2*)(op + d * 16) = w; }
        }
    }
}

__device__ void r1_route(const Frame& F) {
    { const float* ada = F.ADA + (size_t)(F.bid >> 6) * 12288; norm_rows(F, F.out, F.norm2_g, ada + 3 * 2048, ada + 4 * 2048); }
    LAS unsigned* lh = (LAS unsigned*)(F.lds + 65536);
    LAS float* lg = (LAS float*)F.lds + F.wave * 768;
    if (F.tid < 64) lh[F.tid] = 0u;
    asm volatile("s_waitcnt vmcnt(0)" ::: "memory");
    __syncthreads();
    const int lane = F.lane, li = lane & 15, q4 = lane >> 4;
    const int t0 = F.bid * 128 + F.wave * 16;
    f32x4 acc[3];
#pragma unroll
    for (int nb = 0; nb < 3; ++nb) acc[nb] = (f32x4){0.f, 0.f, 0.f, 0.f};
    const bf16_t* hp = F.H + (size_t)(t0 + li) * D + 8 * q4;
    const bf16_t* wp = F.WR + (size_t)li * D + 8 * q4;
#pragma unroll 4
    for (int ks = 0; ks < 64; ++ks) {
        const bf16x8 a = *(const bf16x8*)(hp + 32 * ks);
#pragma unroll
        for (int nb = 0; nb < 3; ++nb) { const bf16x8 bb = *(const bf16x8*)(wp + (size_t)nb * 16 * D + 32 * ks); acc[nb] = __builtin_amdgcn_mfma_f32_16x16x32_bf16(a, bb, acc[nb], 0, 0, 0); }
    }
#pragma unroll
    for (int nb = 0; nb < 3; ++nb)
#pragma unroll
        for (int i = 0; i < 4; ++i) lg[(4 * q4 + i) * 48 + nb * 16 + li] = acc[nb][i];
    asm volatile("s_waitcnt lgkmcnt(0)" ::: "memory");
    if (lane < 16) {
        const int t = t0 + lane; const LAS float* l = lg + lane * 48;
        int gs = 0; float gm = l[0];
#pragma unroll
        for (int j = 1; j < 4; ++j) if (l[j] > gm) { gm = l[j]; gs = j; }
        float den = 0.f;
#pragma unroll
        for (int j = 0; j < 4; ++j) den += __expf(l[j] - gm);
        const float pg = 1.0f / den;
        const LAS float* el = l + 4 + gs * 8;
        int i0 = 0; float m0 = el[0];
#pragma unroll
        for (int j = 1; j < 8; ++j) if (el[j] > m0) { m0 = el[j]; i0 = j; }
        int i1 = -1; float m1 = -INFINITY;
#pragma unroll
        for (int j = 0; j < 8; ++j) if (j != i0 && el[j] > m1) { m1 = el[j]; i1 = j; }
        const float e1 = __expf(m1 - m0), w0 = pg / (1.0f + e1), w1 = pg * e1 / (1.0f + e1);
        const int b0 = gs * 8 + i0, b1 = 32 + gs * 8 + i1;
        F.TOKE[2 * t] = b0; F.TOKE[2 * t + 1] = b1; F.TOKW[2 * t] = w0; F.TOKW[2 * t + 1] = w1;
        __hip_atomic_fetch_add(lh + b0, 1u, __ATOMIC_RELAXED, __HIP_MEMORY_SCOPE_WORKGROUP);
        __hip_atomic_fetch_add(lh + b1, 1u, __ATOMIC_RELAXED, __HIP_MEMORY_SCOPE_WORKGROUP);
    }
    __syncthreads();
    if (F.tid < 64) { const unsigned cn = lh[F.tid]; if (cn) __hip_atomic_fetch_add(F.ctl + CW_GCOUNT + F.tid, cn, __ATOMIC_RELAXED, __HIP_MEMORY_SCOPE_AGENT); }
}

__device__ void r2_rows(const Frame& F) {
    LAS unsigned* lh = (LAS unsigned*)F.lds;
    LAS unsigned* lbase = lh + 64;
    LAS unsigned* tstart = lh + 128;
    const int tid = F.tid;
    if (tid < 64) lh[tid] = 0u;
    __syncthreads();
    if (tid == 0) {
        unsigned ts = 0;
        for (int k = 0; k < 64; ++k) { tstart[k] = ts; const unsigned cn = __hip_atomic_load(F.ctl + CW_GCOUNT + k, __ATOMIC_RELAXED, __HIP_MEMORY_SCOPE_AGENT); ts += (cn + 255u) >> 8; if (k == 31) tstart[64 + 1] = ts; }
        tstart[64] = ts;
    }
    const int t = F.bid * 128 + (tid >> 1), sl = tid & 1;
    int bucket = 0; float w = 0.f;
    if (tid < 256) { bucket = F.TOKE[2 * t + sl]; w = F.TOKW[2 * t + sl]; __hip_atomic_fetch_add(lh + bucket, 1u, __ATOMIC_RELAXED, __HIP_MEMORY_SCOPE_WORKGROUP); }
    __syncthreads();
    if (tid < 64) { const unsigned cn = lh[tid]; unsigned base = 0; if (cn) base = __hip_atomic_fetch_add(F.ctl + CW_GCURSOR + tid, cn, __ATOMIC_RELAXED, __HIP_MEMORY_SCOPE_AGENT); lbase[tid] = tstart[tid] * 256u + base; }
    __syncthreads();
    if (tid < 64) lh[tid] = 0u;
    __syncthreads();
    if (tid < 256) { const unsigned rk = __hip_atomic_fetch_add(lh + bucket, 1u, __ATOMIC_RELAXED, __HIP_MEMORY_SCOPE_WORKGROUP); const unsigned p = lbase[bucket] + rk;
        if (p < (unsigned)MAXROWS) { F.ROWTOK[p] = t; F.ROWW[p] = w; } }
    if (F.bid == 0) {
        if (tid == 0) { ((int*)F.ctl)[CW_TINFO] = (int)tstart[65]; ((int*)F.ctl)[CW_TINFO + 1] = (int)tstart[64]; }
        if (tid < 64) { const unsigned a = tstart[tid], e = (tid == 63) ? tstart[64] : tstart[tid + 1]; for (unsigned p = a; p < e && p < 512u; ++p) ((int*)F.ctl)[CW_TILEB + p] = tid; }
    }
}

struct Args { const float* in[17]; float* out; unsigned char* ws; int ph_lo, ph_hi; };
constexpr int N_PHASES = 13;

__global__ void __launch_bounds__(NTHREADS, 2) mk_fwd(Args args) {
    extern __shared__ __attribute__((aligned(16))) unsigned char lds_raw[];
    Frame F;
    F.lds = (LAS unsigned char*)lds_raw;
    F.tid = threadIdx.x; F.lane = F.tid & 63; F.wave = __builtin_amdgcn_readfirstlane(F.tid >> 6); F.G = gridDim.x; F.bid = blockIdx.x;
    F.x = args.in[0]; F.c = args.in[1]; F.w_ada = args.in[2]; F.b_ada = args.in[3]; F.norm1_g = args.in[4]; F.w_in = args.in[5]; F.q_norm_g = args.in[6]; F.k_norm_g = args.in[7];
    F.w_pool = args.in[8]; F.pool_scale = args.in[9]; F.w_out = args.in[10]; F.norm2_g = args.in[11]; F.w_grp = args.in[12]; F.w_exp = args.in[13]; F.w1 = args.in[14]; F.w3 = args.in[15]; F.w2 = args.in[16];
    F.out = args.out;
    unsigned char* ws = args.ws;
    F.ctl = (unsigned*)(ws + WS_CTL); F.ADA = (float*)(ws + WS_ADA); F.ADAP = (float*)(ws + WS_ADAP); F.TAB = (float*)(ws + WS_TAB); F.WR = (bf16_t*)(ws + WS_WR); F.TOKE = (int*)(ws + WS_TOKE); F.TOKW = (float*)(ws + WS_TOKW);
    F.ROWTOK = (int*)(ws + WS_ROWTOK); F.ROWW = (float*)(ws + WS_ROWW); F.WI = (float*)(ws + WS_WI); F.KI = (bf16_t*)(ws + WS_KI);
    F.WPOOL = (bf16_t*)(ws + WS_WPOOL); F.WOUT = (bf16_t*)(ws + WS_WOUT); F.WIN = (bf16_t*)(ws + WS_WIN); F.W13 = (bf16_t*)(ws + WS_W13); F.W2 = (bf16_t*)(ws + WS_W2);
    F.H = (bf16_t*)(ws + WS_H); F.CONCAT = (bf16_t*)(ws + WS_H); F.PROJ = (bf16_t*)(ws + WS_X); F.SC = (unsigned short*)(ws + WS_X);
    F.QB = (bf16_t*)(ws + WS_QB); F.ACT = (bf16_t*)(ws + WS_QB); F.KV = (bf16_t*)(ws + WS_KV); F.QI = (bf16_t*)(ws + WS_QI); F.PM = (bf16_t*)(ws + WS_PM); F.SEL = (unsigned short*)(ws + WS_SEL);

    volatile LAS unsigned* bst = (volatile LAS unsigned*)(F.lds + LDS_BYTES - 16);
    if (F.tid == 0) { bst[0] = 0u; bst[1] = 0u; bst[2] = 0u; bst[3] = 0u; }
    __syncthreads();
    XcdBarrier bar = xcd_barrier_post(F.ctl, bst);
    const int lo = args.ph_lo, hi = args.ph_hi;
#define IN(k) (lo <= (k) && (k) < hi)
#define SEAM(k) do { if (IN(k) && IN((k) + 1)) xcd_barrier(bar); } while (0)

    if (IN(0)) { p0_prologue(F); } SEAM(0);
    if (IN(1)) {
        if (F.tid < 192) { const int v = F.bid * 192 + F.tid; float s = 0.f; for (int kc = 0; kc < 32; ++kc) s += F.ADAP[(size_t)kc * 49152 + v]; F.ADA[v] = s; }
        LAS float* sl = (LAS float*)F.lds;
        { const int b = F.bid >> 6; for (int idx = F.tid; idx < 4096; idx += NTHREADS) { float s = 0.f; for (int kc = 0; kc < 32; ++kc) s += F.ADAP[(size_t)kc * 49152 + b * 12288 + idx]; sl[idx] = s; } }
        __syncthreads();
        norm_rows(F, F.x, F.norm1_g, (const float*)sl, (const float*)(sl + 2048));
    } SEAM(1);
    if (IN(2)) {
        pg8::Gemm g{F.H, F.WIN, D}; pg8::StaticOrder So; So.init(T, NPROJ, F.G, F.bid);
        pg8::EpiBf16 E{F.PROJ, NPROJ, 0};
        pg8::gemm_phase<pg8::EpiBf16, pg8::StaticOrder>(F.lds, g, So, E);
    } SEAM(2);
    if (IN(3)) { p3_post(F); } SEAM(3);
    if (IN(4)) {
        {
            pg8::Gemm g{F.PM, F.WPOOL, 256}; pg8::PoolOrder So{F.G, F.bid};
            pg8::EpiBf16 E{F.CONCAT, D, 1};
            pg8::gemm_phase<pg8::EpiBf16, pg8::PoolOrder>(F.lds, g, So, E);
        }
        for (int u = F.bid; u < 4 * 2080; u += F.G) {
            const int b = u / 2080, v = u % 2080;
            int qb = (int)((sqrtf(8.0f * (float)v + 1.0f) - 1.0f) * 0.5f);
            while (qb * (qb + 1) / 2 > v) --qb;
            while ((qb + 1) * (qb + 2) / 2 <= v) ++qb;
            indexer_unit(F, b, qb, v - qb * (qb + 1) / 2);
        }
    } SEAM(4);
    if (IN(5)) {
        LAS unsigned short* rowbuf = (LAS unsigned short*)(F.lds + F.wave * 17408);
        LAS unsigned* hist = (LAS unsigned*)(F.lds + F.wave * 17408 + 16384);
        for (int i = F.bid * 8 + F.wave; i < T; i += F.G * 8) {
            const int t = (i & 1) ? (T - 1 - (i >> 1)) : (i >> 1);
            select_row(F, t, rowbuf, hist, F.lane);
        }
    } SEAM(5);
    if (IN(6)) {
        LAS unsigned char* vbuf = F.lds + F.wave * 9216;
        for (int i = F.bid * 8 + F.wave; i < T; i += F.G * 8) attn_query(F, i, vbuf, F.lane);
    } SEAM(6);
    if (IN(7)) {
        pg8::Gemm g{F.CONCAT, F.WOUT, D}; pg8::StaticOrder So; So.init(T, D, F.G, F.bid);
        pg8::EpiMix E{F.x, F.ADA, F.out};
        pg8::gemm_phase<pg8::EpiMix, pg8::StaticOrder>(F.lds, g, So, E);
    } SEAM(7);
    if (IN(8)) { r1_route(F); } SEAM(8);
    if (IN(9)) { r2_rows(F); } SEAM(9);
    if (IN(10)) {
        const int* ti = (const int*)F.ctl + CW_TINFO;
        pg8::Gemm g{F.H, F.W13, D}; pg8::MoeOrder<4, true> So{(const int*)F.ctl + CW_TILEB, F.ROWTOK, 0, ti[1], F.G, F.bid};
        pg8::EpiAct E{F.ACT};
        pg8::gemm_phase<pg8::EpiAct, pg8::MoeOrder<4, true>>(F.lds, g, So, E);
    } SEAM(10);
    if (IN(11)) {
        const int* ti = (const int*)F.ctl + CW_TINFO;
        pg8::Gemm g{F.ACT, F.W2, 512}; pg8::MoeOrder<8, false> So{(const int*)F.ctl + CW_TILEB, F.ROWTOK, 0, ti[0], F.G, F.bid};
        pg8::EpiMoeOut E{F.ROWTOK, F.ROWW, F.ADA, F.out};
        pg8::gemm_phase<pg8::EpiMoeOut, pg8::MoeOrder<8, false>>(F.lds, g, So, E);
    } SEAM(11);
    if (IN(12)) {
        const int* ti = (const int*)F.ctl + CW_TINFO;
        pg8::Gemm g{F.ACT, F.W2, 512}; pg8::MoeOrder<8, false> So{(const int*)F.ctl + CW_TILEB, F.ROWTOK, ti[0], ti[1], F.G, F.bid};
        pg8::EpiMoeOut E{F.ROWTOK, F.ROWW, F.ADA, F.out};
        pg8::gemm_phase<pg8::EpiMoeOut, pg8::MoeOrder<8, false>>(F.lds, g, So, E);
    }
#undef IN
#undef SEAM
}

extern "C" void kernel_launch(void* const* d_in, const int* in_sizes, int n_in, void* d_out, int out_size, void* d_ws, size_t ws_size, hipStream_t stream) {
    static int grid = 0;
    if (grid == 0) {
        if (n_in != 17 || out_size != T * D || ws_size < WS_END) { fprintf(stderr, "kernel_launch: unexpected problem (n_in %d out %d ws %zu)\n", n_in, out_size, ws_size); grid = -1; return; }
        int dev = 0, cus = 0, per_cu = 0;
        if (hipGetDevice(&dev) != hipSuccess || hipDeviceGetAttribute(&cus, hipDeviceAttributeMultiprocessorCount, dev) != hipSuccess) { grid = -1; return; }
        if (hipFuncSetAttribute((const void*)mk_fwd, hipFuncAttributeMaxDynamicSharedMemorySize, LDS_BYTES) != hipSuccess) { fprintf(stderr, "kernel_launch: hipFuncSetAttribute failed\n"); grid = -1; return; }
        if (hipOccupancyMaxActiveBlocksPerMultiprocessor(&per_cu, (const void*)mk_fwd, NTHREADS, LDS_BYTES) != hipSuccess || per_cu < 1) { fprintf(stderr, "kernel_launch: occupancy query says %d\n", per_cu); }
        (void)hipGetLastError();
        grid = cus;
        if (grid != 256) { fprintf(stderr, "kernel_launch: built for 256 CUs, found %d\n", cus); grid = -1; return; }
    }
    if (grid < 0) return;
    (void)hipMemsetAsync((char*)d_ws + WS_CTL, 0, WS_ADA - WS_CTL, stream);
    (void)hipMemsetAsync((char*)d_ws + WS_ROWTOK, 0xFF, (size_t)MAXROWS * 4, stream);
    Args a{};
    for (int i = 0; i < 17; ++i) a.in[i] = (const float*)d_in[i];
    a.out = (float*)d_out; a.ws = (unsigned char*)d_ws;
#if MK_MULTI
    for (int p = 0; p < N_PHASES; ++p) { a.ph_lo = p; a.ph_hi = p + 1; hipLaunchKernelGGL(mk_fwd, dim3(grid), dim3(NTHREADS), LDS_BYTES, stream, a); }
#else
    a.ph_lo = 0; a.ph_hi = N_PHASES; hipLaunchKernelGGL(mk_fwd, dim3(grid), dim3(NTHREADS), LDS_BYTES, stream, a);
#endif
}
```

```cpp
#include <hip/hip_runtime.h>
#include <cstdio>
#include <cstdint>
#include <cstddef>

#ifndef MK_MULTI
#define MK_MULTI 0
#endif

#ifndef ATT_PROBE
#define ATT_PROBE 0
#endif
#ifndef SELFCHECK
#define SELFCHECK 0
#endif
#ifndef REPEAT_UNITS
#define REPEAT_UNITS 0
#endif
#ifndef REPEAT_MASK
#define REPEAT_MASK 0
#endif
#define LAS __attribute__((address_space(3)))
typedef unsigned short bf16_t;
typedef short bf16x8 __attribute__((ext_vector_type(8)));
typedef short s16x4 __attribute__((ext_vector_type(4)));
typedef float f32x4 __attribute__((ext_vector_type(4)));
typedef float f32x16 __attribute__((ext_vector_type(16)));
typedef unsigned u32x4 __attribute__((ext_vector_type(4)));
typedef unsigned u32x2 __attribute__((ext_vector_type(2)));
typedef __bf16 bf16v2 __attribute__((ext_vector_type(2)));
typedef _Float16 f16v2 __attribute__((ext_vector_type(2)));

constexpr int T = 32768, S = 8192, NB = 4, D = 2048;
constexpr int NPROJ = 3840;
constexpr int CQ = 0, CK = 1024, CV = 1280, CQI = 1536, CP = 2560, CKI = 3584, CWI = 3648;
constexpr int NTHREADS = 512;
constexpr int LDS_BYTES = 147456;
constexpr float NORM_EPS = 1e-6f;
constexpr size_t SC_BATCH = 34078720ull;
constexpr int MAXROWS = 81920;

constexpr size_t WS_CTL = 0;
constexpr size_t WS_ADA = 65536;
constexpr size_t WS_TAB = 262144;
constexpr size_t WS_WR = 1835008;
constexpr size_t WS_TOKE = 2031616;
constexpr size_t WS_TOKW = 2293760;
constexpr size_t WS_ROWTOK = 2555904;
constexpr size_t WS_ROWW = 2883584;
constexpr size_t WS_WI = 3211264;
constexpr size_t WS_KI = 5308416;
constexpr size_t WS_WPOOL = 9502720;
constexpr size_t WS_WOUT = 10027008;
constexpr size_t WS_WIN = 18415616;
constexpr size_t WS_W13 = 34144256;
constexpr size_t WS_W2 = 168361984;
constexpr size_t WS_H = 235470848;
constexpr size_t WS_X = 369688576;
constexpr size_t WS_QB = 642318336;
constexpr size_t WS_KV = 709427200;
constexpr size_t WS_QI = 742981632;
constexpr size_t WS_PM = 810090496;
constexpr size_t WS_SEL = 877199360;
constexpr size_t WS_ADAP = 893976576;
constexpr size_t WS_END = 900268032;
constexpr int CW_GCOUNT = 4096, CW_GCURSOR = 4160, CW_CHK = 4224, CW_TINFO = 4352, CW_TILEB = 4416;

__device__ __forceinline__ unsigned pk_bf16(float a, float b) { bf16v2 v; v.x = (__bf16)a; v.y = (__bf16)b; return __builtin_bit_cast(unsigned, v); }
__device__ __forceinline__ float bf_lo(unsigned u) { return __uint_as_float(u << 16); }
__device__ __forceinline__ float bf_hi(unsigned u) { return __uint_as_float(u & 0xffff0000u); }
__device__ __forceinline__ void unpack8(const u32x4 v, float* f) {
    f[0] = bf_lo(v.x); f[1] = bf_hi(v.x); f[2] = bf_lo(v.y); f[3] = bf_hi(v.y); f[4] = bf_lo(v.z); f[5] = bf_hi(v.z); f[6] = bf_lo(v.w); f[7] = bf_hi(v.w);
}
__device__ __forceinline__ u32x4 pack8(const float* f) { u32x4 v; v.x = pk_bf16(f[0], f[1]); v.y = pk_bf16(f[2], f[3]); v.z = pk_bf16(f[4], f[5]); v.w = pk_bf16(f[6], f[7]); return v; }
__device__ __forceinline__ int fresh_lane() { int l; asm volatile("v_mbcnt_lo_u32_b32 %0, -1, 0\n\tv_mbcnt_hi_u32_b32 %0, -1, %0" : "=v"(l)); return l; }
__device__ __forceinline__ float wave_sum(float v) {
#pragma unroll
    for (int d = 32; d >= 1; d >>= 1) v += __shfl_xor(v, d);
    return v;
}

#define XB_TMO      128
#define XB_XCNT(j)  (256  + 64 * (j))
#define XB_XSUB(j)  (1280 + 64 * (j))
#define XB_XGEN(j)  (2304 + 64 * (j))
#define XB_TOP      3328
#define XB_TOPGEN   3392
#define XCD_BAR_WORDS 3456
#define XB_SPIN_CAP (1u << 23)

__device__ __forceinline__ unsigned xb_ld(unsigned* p)              { return __hip_atomic_load(p, __ATOMIC_RELAXED, __HIP_MEMORY_SCOPE_AGENT); }
__device__ __forceinline__ unsigned xb_add(unsigned* p, unsigned v) { return __hip_atomic_fetch_add(p, v, __ATOMIC_RELAXED, __HIP_MEMORY_SCOPE_AGENT); }
__device__ __forceinline__ unsigned xb_xcc_id() { return (unsigned)__builtin_amdgcn_s_getreg((3 << 11) | 20) & 0xFu; }
#define XB_SPIN(cond, bar) do { unsigned _sp = 0; while (cond) { __builtin_amdgcn_s_sleep(1); \
    if ((++_sp & 255u) == 0u) { if (xb_ld(&(bar)[XB_TMO])) break; if (_sp > XB_SPIN_CAP) { atomicAdd(&(bar)[XB_TMO], 1u); break; } } } } while (0)

struct XcdBarrier { unsigned* bar; unsigned x; volatile LAS unsigned* st; };

__device__ __forceinline__ XcdBarrier xcd_barrier_post(unsigned* bar, volatile LAS unsigned* st) {
    XcdBarrier b; b.bar = bar; b.x = xb_xcc_id(); b.st = st;
    if (threadIdx.x == 0) (void)xb_add(&bar[XB_XCNT(b.x)], 1u);
    return b;
}
__device__ __forceinline__ void xcd_barrier_complete(unsigned* bar, unsigned x, unsigned& nloc, unsigned& nx) {
    const unsigned G = gridDim.x * gridDim.y * gridDim.z;
    unsigned sum, cnt, mine, sp = 0u;
    for (;;) {
        sum = 0u; cnt = 0u; mine = 0u;
#pragma unroll
        for (unsigned j = 0; j < 16; ++j) { const unsigned c = xb_ld(&bar[XB_XCNT(j)]); sum += c; cnt += (c > 0u) ? 1u : 0u; mine = (j == x) ? c : mine; }
        if (sum == G) break;
        __builtin_amdgcn_s_sleep(1);
        if ((++sp & 255u) == 0u) { if (xb_ld(&bar[XB_TMO])) break; if (sp > XB_SPIN_CAP) { atomicAdd(&bar[XB_TMO], 1u); break; } }
    }
    nloc = mine > 0u ? mine : 1u; nx = cnt > 0u ? cnt : 1u;
}
__device__ __forceinline__ void xcd_barrier(const XcdBarrier& b) {
    asm volatile("s_waitcnt vmcnt(0)" ::: "memory");
    __syncthreads();
    if (threadIdx.x == 0) {
        unsigned* bar = b.bar;
        __builtin_amdgcn_s_waitcnt(0);
        unsigned nloc = b.st[0], nx = b.st[1];
        if (nloc == 0u) { xcd_barrier_complete(bar, b.x, nloc, nx); b.st[0] = nloc; b.st[1] = nx; }
        const unsigned old = xb_add(&bar[XB_XSUB(b.x)], 1u);
        const unsigned gen = old / nloc;
        if (old + 1u == (gen + 1u) * nloc) {
            __builtin_amdgcn_fence(__ATOMIC_RELEASE, "agent");
            asm volatile("s_waitcnt vmcnt(0)" ::: "memory");
            const unsigned og = xb_add(&bar[XB_TOP], 1u);
            const unsigned tg = og / nx;
            if (og + 1u == (tg + 1u) * nx) xb_add(&bar[XB_TOPGEN], 1u);
            else XB_SPIN(xb_ld(&bar[XB_TOPGEN]) == tg, bar);
            __builtin_amdgcn_fence(__ATOMIC_ACQUIRE, "agent");
            xb_add(&bar[XB_XGEN(b.x)], 1u);
            asm volatile("s_waitcnt vmcnt(0)" ::: "memory");
        } else {
            XB_SPIN(xb_ld(&bar[XB_XGEN(b.x)]) == gen, bar);
            __builtin_amdgcn_fence(__ATOMIC_ACQUIRE, "agent");
            asm volatile("s_waitcnt vmcnt(0)" ::: "memory");
        }
    }
    __syncthreads();
}

struct Frame {
    LAS unsigned char* lds;
    int tid, lane, wave, G, bid;
    const float *x, *c, *w_ada, *b_ada, *norm1_g, *w_in, *q_norm_g, *k_norm_g, *w_pool, *pool_scale, *w_out, *norm2_g, *w_grp, *w_exp, *w1, *w3, *w2;
    float* out;
    unsigned* ctl;
    float* ADA; float* ADAP; float* TAB; bf16_t* WR; int* TOKE; float* TOKW; int* ROWTOK; float* ROWW; float* WI; bf16_t* KI;
    bf16_t *WPOOL, *WOUT, *WIN, *W13, *W2, *H, *PROJ; unsigned short* SC; bf16_t *QB, *KV, *QI, *PM, *ACT, *CONCAT; unsigned short* SEL;
};

namespace pg8 {
constexpr int BM = 256, BK = 64, HALF = 128, HTB = HALF * BK * 2, STAGE_BYTES = 8 * HTB, NXCD = 8, WGM = 8;
__device__ __forceinline__ int lds_byte(int r, int c) { const int st = (r >> 4) * 2 + (c >> 5), rr = r & 15, cc = c & 31, ob = rr * 64 + cc * 2; return st * 1024 + (ob ^ (((ob >> 9) & 1) << 5)); }
__device__ __forceinline__ void stage_rc(int b, int& R, int& C) { const int st = b / 1024, sb = b % 1024, swz = sb ^ (((sb >> 9) & 1) << 5); R = (st >> 1) * 16 + swz / 64; C = (st & 1) * 32 + (swz % 64) / 2; }
__device__ __forceinline__ int perm32(int rho) { const int n = rho >> 4, i = rho & 15; return 8 * (i >> 2) + 4 * n + (i & 3); }
struct Unit { int pm, pn; };
struct Gemm { const bf16_t* A; const bf16_t* Bt; int K; };

struct StaticOrder {
    int nM, nN, nwg, G, c, rep;
    __device__ void init(int M, int N, int G_, int c_, int rep_ = 1) { nM = M / BM; nN = N / BM; nwg = nM * nN; G = G_; c = c_; rep = rep_; }
    __device__ bool next(int i, Unit& u) const {
        long L = (long)i * G + c; if (L >= (long)nwg * rep) return false;
        if (L >= nwg) L -= nwg;
        int wgid = (int)L; { const int q = nwg / NXCD, r = nwg % NXCD, xcd = wgid % NXCD, off = wgid / NXCD; wgid = (xcd < r ? xcd * (q + 1) : r * (q + 1) + (xcd - r) * q) + off; }
        const int nig = WGM * nN, gid = wgid / nig, fm = gid * WGM, gsz = (nM - fm) < WGM ? (nM - fm) : WGM;
        u.pm = fm + ((wgid % nig) % gsz); u.pn = (wgid % nig) / gsz; return true;
    }
    __device__ __forceinline__ unsigned arow(const Unit& u, int rr) const { return (unsigned)(u.pm * BM + rr); }
};
struct PoolOrder {
    int G, c;
    __device__ bool next(int i, Unit& u) const { const int L = i * G + c; if (L >= 512) return false; u.pm = L; u.pn = L >> 7; return true; }
    __device__ __forceinline__ unsigned arow(const Unit& u, int rr) const { return (unsigned)(u.pm * BM + rr); }
};
template <int NC, bool GATHER> struct MoeOrder {
    const int* tileb; const int* rowtok; int lo, hi, G, c, rep;
    __device__ bool next(int i, Unit& u) const {
        int L = i * G + c; if (L >= (hi - lo) * NC * rep) return false;
        if (L >= (hi - lo) * NC) L -= (hi - lo) * NC;
        u.pm = lo + L / NC; const int e = tileb[u.pm] & 31; u.pn = e * NC + (L % NC); return true;
    }
    __device__ __forceinline__ unsigned arow(const Unit& u, int rr) const {
        if (GATHER) { const int tok = rowtok[u.pm * BM + rr]; return (unsigned)(tok < 0 ? 0 : tok); }
        return (unsigned)(u.pm * BM + rr);
    }
};

template <class Epi, class Sched>
__device__ __forceinline__ void gemm_phase(LAS unsigned char* lds, const Gemm g, const Sched& S, const Epi& E, const int tid) {
    const int wid = __builtin_amdgcn_readfirstlane(tid >> 6), lane = tid & 63, wr = wid >> 2, wc = wid & 3, fr = lane & 15, fq = lane >> 4;
    const int K = g.K, nt = K / BK;
    int R0, C0; stage_rc(tid * 16, R0, C0);
    unsigned voffB[2];
#pragma unroll
    for (int i = 0; i < 2; ++i) { const int R = R0 + 64 * i; const int Rb = Epi::PERM ? ((R & ~31) + perm32(R & 31)) : R; voffB[i] = (unsigned)(Rb * K + C0) * 2u; }
    const unsigned rowb = (unsigned)K * 2u, colb = (unsigned)C0 * 2u;
    const size_t kstep = (size_t)(BK * 2);
    const size_t hstep = (size_t)HALF * K * 2;
    const size_t tstep = 2 * hstep;
    const unsigned ldsw = (unsigned)wid * 1024u;
    const int aoff = lds_byte(wr * 64 + fr, fq * 8), boff = lds_byte(wc * 32 + fr, fq * 8);
#define PG8_SA(b, h) (((b) * 2 + (h)) * HTB)
#define PG8_SB(b, h) ((4 + (b) * 2 + (h)) * HTB)
#define PG8_STAGE(bufoff, gbase, voff) do { _Pragma("unroll") for (int _i = 0; _i < 2; ++_i) \
        __builtin_amdgcn_global_load_lds((const unsigned*)((const char*)(gbase) + (voff)[_i]), (LAS unsigned*)(lds + (bufoff) + ldsw + _i * 8192), 16, 0, 0); } while (0)
#define PG8_LDA(dst, b, h) do { _Pragma("unroll") for (int m = 0; m < 4; ++m) _Pragma("unroll") for (int k = 0; k < 2; ++k) dst[m][k] = *(const LAS bf16x8*)(lds + PG8_SA(b, h) + aoff + m * 2048 + k * 1024); } while (0)
#define PG8_LDB(dst, b, h) do { _Pragma("unroll") for (int n = 0; n < 2; ++n) _Pragma("unroll") for (int k = 0; k < 2; ++k) dst[n][k] = *(const LAS bf16x8*)(lds + PG8_SB(b, h) + boff + n * 2048 + k * 1024); } while (0)
#define PG8_MMA(ai, bj, At, Bt) do { __builtin_amdgcn_s_setprio(1); _Pragma("unroll") for (int m = 0; m < 4; ++m) _Pragma("unroll") for (int n = 0; n < 2; ++n) _Pragma("unroll") for (int k = 0; k < 2; ++k) \
        acc[ai][bj][m][n] = __builtin_amdgcn_mfma_f32_16x16x32_bf16(Bt[n][k], At[m][k], acc[ai][bj][m][n], 0, 0, 0); __builtin_amdgcn_s_setprio(0); } while (0)
#define PG8_WAIT_V(n) asm volatile("s_waitcnt vmcnt(" #n ")" ::: "memory")
#define PG8_WAIT_L(n) asm volatile("s_waitcnt lgkmcnt(" #n ")" ::: "memory")
#define PG8_BAR __builtin_amdgcn_s_barrier()
#define PG8_SCHED __builtin_amdgcn_sched_barrier(0)
#define PG8_ROWS(dst, u) do { _Pragma("unroll") for (int _h = 0; _h < 2; ++_h) _Pragma("unroll") for (int _i = 0; _i < 2; ++_i) dst[_h][_i] = S.arow(u, _h * HALF + R0 + 64 * _i) * rowb + colb; } while (0)
    Unit cur, nxt; int ui = 0;
    if (!S.next(0, cur)) return;
    f32x4 acc[2][2][4][2];
#pragma unroll
    for (int a = 0; a < 2; ++a)
#pragma unroll
        for (int b = 0; b < 2; ++b)
#pragma unroll
            for (int m = 0; m < 4; ++m)
#pragma unroll
                for (int n = 0; n < 2; ++n) acc[a][b][m][n] = (f32x4){0.f, 0.f, 0.f, 0.f};
    bf16x8 At[4][2], B0[2][2], B1[2][2];
    unsigned oc[2][2], on[2][2];
    PG8_ROWS(oc, cur);
    const char* gA = (const char*)g.A;
    const char* cB = (const char*)g.Bt + (size_t)cur.pn * tstep;
    PG8_STAGE(PG8_SB(0, 0), cB, voffB); PG8_STAGE(PG8_SA(0, 0), gA, oc[0]); PG8_STAGE(PG8_SB(0, 1), cB + hstep, voffB); PG8_STAGE(PG8_SA(0, 1), gA, oc[1]);
    if (wr == 1) PG8_BAR;
    PG8_WAIT_V(4); PG8_BAR;
    PG8_STAGE(PG8_SB(1, 0), cB + kstep, voffB); PG8_STAGE(PG8_SA(1, 0), gA + kstep, oc[0]); PG8_STAGE(PG8_SB(1, 1), cB + hstep + kstep, voffB);
    PG8_WAIT_V(6); PG8_BAR;
    const int tpre = nt >= 4 ? nt - 4 : nt - 2;
    for (;;) {
        const bool has_next = S.next(ui + 1, nxt);
#pragma unroll
        for (int h = 0; h < 2; ++h)
#pragma unroll
            for (int i = 0; i < 2; ++i) on[h][i] = oc[h][i];
        const char* nB = has_next ? (const char*)g.Bt + (size_t)nxt.pn * tstep : cB;
        for (int t = 0; t < nt; t += 2) {
            const bool last = (t == nt - 2);
            if (has_next && t == tpre) PG8_ROWS(on, nxt);
            const char* a1 = gA + (size_t)(t + 1) * kstep;
            const char* a2 = last ? gA : gA + (size_t)(t + 2) * kstep; const char* b2 = last ? nB : cB + (size_t)(t + 2) * kstep;
            const char* a3 = a2 + kstep; const char* b3 = b2 + kstep;
            unsigned o2[2][2];
#pragma unroll
            for (int h = 0; h < 2; ++h)
#pragma unroll
                for (int i = 0; i < 2; ++i) o2[h][i] = last ? on[h][i] : oc[h][i];
            PG8_LDB(B0, 0, 0); PG8_SCHED; PG8_LDA(At, 0, 0); PG8_STAGE(PG8_SA(1, 1), a1, oc[1]);
            PG8_WAIT_L(8); PG8_BAR; PG8_WAIT_L(0); PG8_MMA(0, 0, At, B0); PG8_BAR; PG8_SCHED;
            PG8_LDB(B1, 0, 1); PG8_STAGE(PG8_SB(0, 0), b2, voffB);
            PG8_BAR; PG8_WAIT_L(0); PG8_MMA(0, 1, At, B1); PG8_BAR;
            PG8_LDA(At, 0, 1); PG8_STAGE(PG8_SA(0, 0), a2, o2[0]);
            PG8_BAR; PG8_WAIT_L(0); PG8_MMA(1, 0, At, B0); PG8_BAR; PG8_SCHED;
            PG8_STAGE(PG8_SB(0, 1), b2 + hstep, voffB);
            PG8_WAIT_V(6); PG8_BAR; PG8_MMA(1, 1, At, B1); PG8_BAR;
            PG8_LDB(B0, 1, 0); PG8_SCHED; PG8_LDA(At, 1, 0); PG8_STAGE(PG8_SA(0, 1), a2, o2[1]);
            PG8_WAIT_L(8); PG8_BAR; PG8_WAIT_L(0); PG8_MMA(0, 0, At, B0); PG8_BAR; PG8_SCHED;
            PG8_LDB(B1, 1, 1); PG8_STAGE(PG8_SB(1, 0), b3, voffB);
            PG8_BAR; PG8_WAIT_L(0); PG8_MMA(0, 1, At, B1); PG8_BAR;
            PG8_LDA(At, 1, 1); PG8_STAGE(PG8_SA(1, 0), a3, o2[0]);
            PG8_BAR; PG8_WAIT_L(0); PG8_MMA(1, 0, At, B0); PG8_BAR; PG8_SCHED;
            PG8_STAGE(PG8_SB(1, 1), b3 + hstep, voffB);
            PG8_WAIT_V(6); PG8_BAR; PG8_MMA(1, 1, At, B1); PG8_BAR;
        }
        E(acc, cur, wr, wc, fr, fq);
        if (!has_next) break;
#pragma unroll
        for (int a = 0; a < 2; ++a)
#pragma unroll
            for (int b = 0; b < 2; ++b)
#pragma unroll
                for (int m = 0; m < 4; ++m)
#pragma unroll
                    for (int n = 0; n < 2; ++n) acc[a][b][m][n] = (f32x4){0.f, 0.f, 0.f, 0.f};
        cur = nxt; cB = nB; ++ui;
#pragma unroll
        for (int h = 0; h < 2; ++h)
#pragma unroll
            for (int i = 0; i < 2; ++i) oc[h][i] = on[h][i];
    }
    PG8_WAIT_V(0);
    if (wr == 0) PG8_BAR;
    PG8_BAR;
#undef PG8_SA
#undef PG8_SB
#undef PG8_STAGE
#undef PG8_LDA
#undef PG8_LDB
#undef PG8_MMA
#undef PG8_WAIT_V
#undef PG8_WAIT_L
#undef PG8_BAR
#undef PG8_SCHED
#undef PG8_ROWS
}

struct EpiBf16 {
    static constexpr bool PERM = true;
    bf16_t* O; int ldc; int mode;
    __device__ __forceinline__ void operator()(const f32x4 (&acc)[2][2][4][2], const Unit& u, int wr, int wc, int fr, int fq) const {
        const int rowb = (mode == 1 ? (u.pm & 127) : u.pm) * BM, colb = (mode == 1 ? 1024 : 0) + u.pn * BM;
        const int row0 = rowb + wr * 64 + fr, col0 = colb + wc * 32 + 8 * fq;
#pragma unroll
        for (int ai = 0; ai < 2; ++ai)
#pragma unroll
            for (int m = 0; m < 4; ++m) { bf16_t* rowp = O + (size_t)(row0 + ai * HALF + m * 16) * ldc + col0;
#pragma unroll
                for (int bj = 0; bj < 2; ++bj) { const f32x4 v0 = acc[ai][bj][m][0], v1 = acc[ai][bj][m][1];
                    u32x4 w; w.x = pk_bf16(v0[0], v0[1]); w.y = pk_bf16(v0[2], v0[3]); w.z = pk_bf16(v1[0], v1[1]); w.w = pk_bf16(v1[2], v1[3]);
                    *(u32x4*)(rowp + bj * HALF) = w; } }
    }
};
struct EpiMix {
    static constexpr bool PERM = false;
    const float* x; const float* ada; float* out;
    __device__ __forceinline__ void operator()(const f32x4 (&acc)[2][2][4][2], const Unit& u, int wr, int wc, int fr, int fq) const {
        const int row0 = u.pm * BM + wr * 64 + fr, col0 = u.pn * BM + wc * 32 + 4 * fq;
        const float* gate = ada + (size_t)(u.pm >> 5) * 12288 + 2 * 2048;
        f32x4 gv[2][2];
#pragma unroll
        for (int bj = 0; bj < 2; ++bj)
#pragma unroll
            for (int n = 0; n < 2; ++n) gv[bj][n] = *(const f32x4*)(gate + col0 + bj * HALF + n * 16);
#pragma unroll
        for (int ai = 0; ai < 2; ++ai)
#pragma unroll
            for (int m = 0; m < 4; ++m) { const size_t ro = (size_t)(row0 + ai * HALF + m * 16) * D + col0;
#pragma unroll
                for (int bj = 0; bj < 2; ++bj)
#pragma unroll
                    for (int n = 0; n < 2; ++n) { const f32x4 xv = *(const f32x4*)(x + ro + bj * HALF + n * 16); *(f32x4*)(out + ro + bj * HALF + n * 16) = xv + gv[bj][n] * acc[ai][bj][m][n]; } }
    }
};
struct EpiAct {
    static constexpr bool PERM = true;
    bf16_t* ACT;
    __device__ __forceinline__ void operator()(const f32x4 (&acc)[2][2][4][2], const Unit& u, int wr, int wc, int fr, int fq) const {
        const int row0 = u.pm * BM + wr * 64 + fr, col0 = (u.pn & 3) * 128 + wc * 32 + 8 * fq;
#pragma unroll
        for (int ai = 0; ai < 2; ++ai)
#pragma unroll
            for (int m = 0; m < 4; ++m) {
                float v[8];
#pragma unroll
                for (int n = 0; n < 2; ++n)
#pragma unroll
                    for (int e = 0; e < 4; ++e) { const float a = acc[ai][0][m][n][e], b = acc[ai][1][m][n][e]; v[n * 4 + e] = a / (1.0f + __expf(-a)) * b; }
                *(u32x4*)(ACT + (size_t)(row0 + ai * HALF + m * 16) * 512 + col0) = pack8(v);
            }
    }
};
struct EpiMoeOut {
    static constexpr bool PERM = false;
    const int* rowtok; const float* roww; const float* ada; float* out;
    __device__ __forceinline__ void operator()(const f32x4 (&acc)[2][2][4][2], const Unit& u, int wr, int wc, int fr, int fq) const {
        const int row0 = u.pm * BM + wr * 64 + fr, col0 = (u.pn & 7) * BM + wc * 32 + 4 * fq;
#pragma unroll
        for (int ai = 0; ai < 2; ++ai)
#pragma unroll
            for (int m = 0; m < 4; ++m) { const int row = row0 + ai * HALF + m * 16; const int tok = rowtok[row];
                if (tok >= 0) { const float w = roww[row]; const float* gate = ada + (size_t)(tok >> 13) * 12288 + 5 * 2048 + col0; float* op = out + (size_t)tok * D + col0;
#pragma unroll
                    for (int bj = 0; bj < 2; ++bj)
#pragma unroll
                        for (int n = 0; n < 2; ++n) { const f32x4 gvv = *(const f32x4*)(gate + bj * HALF + n * 16); f32x4 o = *(f32x4*)(op + bj * HALF + n * 16); o += gvv * w * acc[ai][bj][m][n]; *(f32x4*)(op + bj * HALF + n * 16) = o; } } }
    }
};
}

__device__ __forceinline__ int colmap(int n) { return n < 2560 ? n : (n < 2624 ? 3584 + (n - 2560) : (n < 2640 ? 3648 + (n - 2624) : 2560 + (n - 2640))); }

template <class RowMap>
__device__ __forceinline__ void tr_tile(const Frame& F, const float* src, size_t ldS, int k0, int n0, int N, const float* cscale, RowMap rm) {
    LAS float* tile = (LAS float*)F.lds;
    const int tid = F.tid, r = tid >> 4, c4 = tid & 15;
    f32x4 v[4];
    const int n = n0 + c4 * 4;
#pragma unroll
    for (int i = 0; i < 4; ++i) v[i] = (n < N) ? *(const f32x4*)(src + (size_t)(k0 + r + 32 * i) * ldS + n) : (f32x4){0.f, 0.f, 0.f, 0.f};
    __syncthreads();
#pragma unroll
    for (int i = 0; i < 4; ++i)
#pragma unroll
        for (int e = 0; e < 4; ++e) tile[(r + 32 * i) * 65 + c4 * 4 + e] = v[i][e];
    __syncthreads();
    const int nn = tid >> 3, kc = tid & 7;
    if (n0 + nn < N) {
        const float sc = cscale ? cscale[n0 + nn] : 1.0f;
        float f[16];
#pragma unroll
        for (int j = 0; j < 16; ++j) f[j] = tile[(kc * 16 + j) * 65 + nn] * sc;
        bf16_t* d = rm(n0 + nn) + k0 + kc * 16;
        *(u32x4*)d = pack8(f); *(u32x4*)(d + 8) = pack8(f + 8);
    }
}

__device__ void p0_prologue(const Frame& F) {
    constexpr int U_ADA = 192, T_WIN = 16 * 58, T_WOUT = 16 * 32, T_POOL = 4 * 2 * 4, T_W1 = 32 * 128, T_W2 = 32 * 128, U_TAB = 16, U_WR = 4, U_PAD = 2;
    constexpr int B0 = U_ADA, B1 = B0 + T_WIN, B2 = B1 + T_WOUT, B3 = B2 + T_POOL, B4 = B3 + T_W1, B5 = B4 + T_W1, B6 = B5 + T_W2, B7 = B6 + U_TAB, B8 = B7 + U_WR, B9 = B8 + U_PAD;
    const int tid = F.tid;
    for (int u = F.bid; u < B9; u += F.G) {
        if (u < B0) {
            const int kc = u / 6, cb = u % 6;
            LAS float* sc = (LAS float*)F.lds;
            __syncthreads();
            if (tid < 256) { const int b = tid >> 6, k = tid & 63; const float cv = F.c[b * D + kc * 64 + k]; sc[tid] = cv / (1.0f + __expf(-cv)); }
            __syncthreads();
            const int n = cb * 2048 + tid * 4;
            f32x4 a[4];
#pragma unroll
            for (int b = 0; b < 4; ++b) a[b] = (f32x4){0.f, 0.f, 0.f, 0.f};
            const float* wp = F.w_ada + (size_t)(kc * 64) * 12288 + n;
#pragma unroll 8
            for (int k = 0; k < 64; ++k) { const f32x4 w = *(const f32x4*)(wp + (size_t)k * 12288);
#pragma unroll
                for (int b = 0; b < 4; ++b) a[b] += sc[b * 64 + k] * w; }
            const f32x4 bias = (kc == 0) ? *(const f32x4*)(F.b_ada + n) : (f32x4){0.f, 0.f, 0.f, 0.f};
#pragma unroll
            for (int b = 0; b < 4; ++b) *(f32x4*)(F.ADAP + ((size_t)kc * 4 + b) * 12288 + n) = a[b] + bias;
        } else if (u < B1) {
            const int v = u - B0, kt = v / 58, ntl = v % 58; bf16_t* W = F.WIN;
            tr_tile(F, F.w_in, 3664, kt * 128, ntl * 64, 3664, nullptr, [=](int n) { return W + (size_t)colmap(n) * 2048; });
        } else if (u < B2) {
            const int v = u - B1, kt = v / 32, ntl = v % 32; bf16_t* W = F.WOUT;
            tr_tile(F, F.w_out, 2048, kt * 128, ntl * 64, 2048, nullptr, [=](int n) { return W + (size_t)n * 2048; });
        } else if (u < B3) {
            const int v = u - B2, g = v / 8, kt = (v % 8) / 4, ntl = v % 4; bf16_t* W = F.WPOOL + (size_t)g * 256 * 256;
            tr_tile(F, F.w_pool + (size_t)g * 65536, 256, kt * 128, ntl * 64, 256, F.pool_scale + g * 256, [=](int n) { return W + (size_t)n * 256; });
        } else if (u < B5) {
            const bool is3 = u >= B4; const int v = u - (is3 ? B4 : B3), e = v / 128, kt = (v % 128) / 8, ntl = v % 8;
            bf16_t* W = F.W13 + (size_t)e * 1024 * 2048 + (is3 ? (size_t)128 * 2048 : 0);
            tr_tile(F, (is3 ? F.w3 : F.w1) + (size_t)e * 2048 * 512, 512, kt * 128, ntl * 64, 512, nullptr, [=](int n) { return W + (size_t)((n >> 7) * 256 + (n & 127)) * 2048; });
        } else if (u < B6) {
            const int v = u - B5, e = v / 128, kt = (v % 128) / 32, ntl = v % 32; bf16_t* W = F.W2 + (size_t)e * 2048 * 512;
            tr_tile(F, F.w2 + (size_t)e * 512 * 2048, 2048, kt * 128, ntl * 64, 2048, nullptr, [=](int n) { return W + (size_t)n * 512; });
        } else if (u < B7) {
            const int pos = (u - B6) * 512 + tid; float* tp = F.TAB + (size_t)pos * 48;
            for (int i = 0; i < 16; ++i) { const double inv = pow(500000.0, -(double)(2 * i) / 32.0); double sn, cs; sincos((double)pos * inv, &sn, &cs); tp[i] = (float)cs; tp[16 + i] = (float)sn; }
            for (int i = 0; i < 8; ++i) { const double inv = pow(500000.0, -(double)(2 * i) / 16.0); double sn, cs; sincos((double)pos * inv, &sn, &cs); tp[32 + i] = (float)cs; tp[40 + i] = (float)sn; }
        } else if (u < B8) {
            const int j0 = (u - B7) * 12;
            for (int idx = tid; idx < 12 * 2048; idx += NTHREADS) { const int j = j0 + idx / 2048, k = idx % 2048;
                const float v = j < 4 ? F.w_grp[k * 4 + j] : (j < 36 ? F.w_exp[k * 32 + (j - 4)] : 0.f);
                bf16v2 t; t.x = (__bf16)v; t.y = (__bf16)0.f; F.WR[(size_t)j * 2048 + k] = (bf16_t)(__builtin_bit_cast(unsigned, t) & 0xffffu); }
        } else {
            const int h = u - B8; u32x4* p = (u32x4*)(F.WIN + (size_t)3664 * 2048) + (size_t)h * 22528;
            for (int i = tid; i < 22528; i += NTHREADS) p[i] = (u32x4){0u, 0u, 0u, 0u};
        }
    }
}

__device__ __forceinline__ void norm_rows(const Frame& F, const float* src, const float* gain, const float* shiftp, const float* scalep) {
    const int lane = F.lane;
    f32x4 Gv[8], Sv[8];
#pragma unroll
    for (int i = 0; i < 8; ++i) { const int col = 4 * lane + 256 * i; const f32x4 g = *(const f32x4*)(gain + col), sc = *(const f32x4*)(scalep + col);
        Gv[i] = g * (1.0f + sc); Sv[i] = *(const f32x4*)(shiftp + col); }
    for (int j = 0; j < 16; ++j) {
        const int t = F.bid * 128 + F.wave + 8 * j;
        const float* xr = src + (size_t)t * D;
        f32x4 v[8]; float ss = 0.f;
#pragma unroll
        for (int i = 0; i < 8; ++i) { v[i] = *(const f32x4*)(xr + 4 * lane + 256 * i); ss += v[i][0] * v[i][0] + v[i][1] * v[i][1] + v[i][2] * v[i][2] + v[i][3] * v[i][3]; }
        ss = wave_sum(ss);
        const float rstd = rsqrtf(ss * (1.0f / 2048.0f) + NORM_EPS);
        bf16_t* hr = F.H + (size_t)t * D;
#pragma unroll
        for (int i = 0; i < 8; ++i) { const f32x4 y = v[i] * rstd * Gv[i] + Sv[i]; u32x2 w; w.x = pk_bf16(y[0], y[1]); w.y = pk_bf16(y[2], y[3]); *(u32x2*)(hr + 4 * lane + 256 * i) = w; }
    }
}

__device__ void p3_post(const Frame& F) {
    const int lane = F.lane;
    const float QSCALE = 0.08838834764831845f * 1.4426950408889634f;
    const float IDX_SCALE = 0.125f * 0.25f;
    for (int j = 0; j < 16; ++j) {
        const int t = F.bid * 128 + F.wave + 8 * j, pos = t & (S - 1);
        const bf16_t* pr = F.PROJ + (size_t)t * NPROJ;
        const float* tab = F.TAB + (size_t)pos * 48;
        {
            float f[16]; unpack8(*(const u32x4*)(pr + CQ + 16 * lane), f); unpack8(*(const u32x4*)(pr + CQ + 16 * lane + 8), f + 8);
            float ss = 0.f;
#pragma unroll
            for (int e = 0; e < 16; ++e) ss += f[e] * f[e];
            ss += __shfl_xor(ss, 1); ss += __shfl_xor(ss, 2); ss += __shfl_xor(ss, 4);
            const float rstd = rsqrtf(ss * (1.0f / 128.0f) + NORM_EPS);
            const int d0 = (lane & 7) * 16;
#pragma unroll
            for (int e = 0; e < 16; ++e) f[e] = f[e] * rstd * F.q_norm_g[d0 + e];
            float o[16];
#pragma unroll
            for (int e = 0; e < 16; ++e) o[e] = __shfl_xor(f[e], 1);
            const int l8 = lane & 7;
            if (l8 < 2) {
#pragma unroll
                for (int e = 0; e < 16; ++e) { const float cs = tab[e], sn = tab[16 + e]; f[e] = (l8 == 0) ? (f[e] * cs - o[e] * sn) : (f[e] * cs + o[e] * sn); }
            }
#pragma unroll
            for (int e = 0; e < 16; ++e) f[e] *= QSCALE;
            bf16_t* qo = F.QB + (size_t)t * 1024 + 16 * lane;
            *(u32x4*)qo = pack8(f); *(u32x4*)(qo + 8) = pack8(f + 8);
        }
        {
            const int l = lane & 31;
            float f[16]; unpack8(*(const u32x4*)(pr + CK + 16 * l), f); unpack8(*(const u32x4*)(pr + CK + 16 * l + 8), f + 8);
            float kf[16]; float ss = 0.f;
#pragma unroll
            for (int e = 0; e < 16; ++e) ss += f[e] * f[e];
            ss += __shfl_xor(ss, 1); ss += __shfl_xor(ss, 2); ss += __shfl_xor(ss, 4);
            const float rstd = rsqrtf(ss * (1.0f / 128.0f) + NORM_EPS);
            const int d0 = (l & 7) * 16;
#pragma unroll
            for (int e = 0; e < 16; ++e) kf[e] = f[e] * rstd * F.k_norm_g[d0 + e];
            float o[16];
#pragma unroll
            for (int e = 0; e < 16; ++e) o[e] = __shfl_xor(kf[e], 1);
            const int l8 = l & 7;
            if (l8 < 2) {
#pragma unroll
                for (int e = 0; e < 16; ++e) { const float cs = tab[e], sn = tab[16 + e]; kf[e] = (l8 == 0) ? (kf[e] * cs - o[e] * sn) : (kf[e] * cs + o[e] * sn); }
            }
            if (lane < 32) {
                const bool isv = lane >= 16; const int ll = lane & 15, g = ll >> 3, dd = (ll & 7) * 16;
                bf16_t* dst = F.KV + (size_t)t * 512 + g * 256 + (isv ? 128 : 0) + dd;
                *(u32x4*)dst = pack8(isv ? f : kf); *(u32x4*)(dst + 8) = pack8(isv ? f + 8 : kf + 8);
            }
        }
        {
            float f[16]; unpack8(*(const u32x4*)(pr + CQI + 16 * lane), f); unpack8(*(const u32x4*)(pr + CQI + 16 * lane + 8), f + 8);
            if ((lane & 3) == 0) {
#pragma unroll
                for (int i = 0; i < 8; ++i) { const float cs = tab[32 + i], sn = tab[40 + i]; const float x1 = f[i], x2 = f[i + 8]; f[i] = x1 * cs - x2 * sn; f[i + 8] = x2 * cs + x1 * sn; }
            }
            bf16_t* qo = F.QI + (size_t)t * 1024 + 16 * lane;
            *(u32x4*)qo = pack8(f); *(u32x4*)(qo + 8) = pack8(f + 8);
        }
        if (lane < 5) {
            float f[16]; unpack8(*(const u32x4*)(pr + CKI + 16 * lane), f); unpack8(*(const u32x4*)(pr + CKI + 16 * lane + 8), f + 8);
            if (lane == 0) {
#pragma unroll
                for (int i = 0; i < 8; ++i) { const float cs = tab[32 + i], sn = tab[40 + i]; const float x1 = f[i], x2 = f[i + 8]; f[i] = x1 * cs - x2 * sn; f[i + 8] = x2 * cs + x1 * sn; }
            }
            if (lane < 4) { bf16_t* ko = F.KI + (size_t)t * 64 + 16 * lane; *(u32x4*)ko = pack8(f); *(u32x4*)(ko + 8) = pack8(f + 8); }
            else { float* wo = F.WI + (size_t)t * 16;
#pragma unroll
                for (int e = 0; e < 16; ++e) wo[e] = f[e] * IDX_SCALE; }
        }
        {
            const int g = lane >> 4, w = 2 << g;
            float cur[16], sum[16];
            unpack8(*(const u32x4*)(pr + CP + 16 * lane), cur); unpack8(*(const u32x4*)(pr + CP + 16 * lane + 8), cur + 8);
#pragma unroll
            for (int e = 0; e < 16; ++e) sum[e] = cur[e];
            for (int r = 1; r < 16; ++r) {
                if (r < w && r <= pos) { float f[16]; const bf16_t* pp = pr - (size_t)r * NPROJ + CP + 16 * lane; unpack8(*(const u32x4*)pp, f); unpack8(*(const u32x4*)(pp + 8), f + 8);
#pragma unroll
                    for (int e = 0; e < 16; ++e) sum[e] += f[e]; }
            }
            const float inv = 1.0f / (float)((pos + 1) < w ? (pos + 1) : w);
#pragma unroll
            for (int e = 0; e < 16; ++e) sum[e] = sum[e] * inv - cur[e];
            bf16_t* po = F.PM + ((size_t)g * T + t) * 256 + (lane & 15) * 16;
            *(u32x4*)po = pack8(sum); *(u32x4*)(po + 8) = pack8(sum + 8);
        }
    }
}

__device__ __forceinline__ size_t sc_block_base(int b, int qb) { return (size_t)b * SC_BATCH + (size_t)16384 * ((size_t)qb * (qb + 1) / 2); }

__device__ void indexer_unit(const Frame& F, int b, int qb, int kb) {
    const int lane = F.lane, wid = F.wave, c = lane & 31, hf = lane >> 5;
    bf16x8 kf[4][4];
    const bf16_t* kib = F.KI + ((size_t)b * S + kb * 128) * 64;
#pragma unroll
    for (int sub = 0; sub < 4; ++sub)
#pragma unroll
        for (int kk = 0; kk < 4; ++kk) kf[sub][kk] = *(const bf16x8*)(kib + (4 * c + sub) * 64 + 16 * kk + 8 * hf);
    const int qq = (c >> 2) & 1, head = (c & 3) + 4 * (c >> 3);
    const size_t rowlen = (size_t)(qb + 1) * 128;
    unsigned short* scb = F.SC + sc_block_base(b, qb);
    for (int pair = 0; pair < 8; ++pair) {
        const int r0 = wid * 16 + pair * 2;
        const size_t tA = (size_t)b * S + qb * 128 + r0 + qq, tw = (size_t)b * S + qb * 128 + r0 + hf;
        bf16x8 af[4];
#pragma unroll
        for (int kk = 0; kk < 4; ++kk) af[kk] = *(const bf16x8*)(F.QI + tA * 1024 + head * 64 + 16 * kk + 8 * hf);
        f32x4 wv[4];
#pragma unroll
        for (int i = 0; i < 4; ++i) wv[i] = *(const f32x4*)(F.WI + tw * 16 + 4 * i);
        float sc[4];
#pragma unroll
        for (int sub = 0; sub < 4; ++sub) {
            f32x16 acc;
#pragma unroll
            for (int i = 0; i < 16; ++i) acc[i] = 0.f;
#pragma unroll
            for (int kk = 0; kk < 4; ++kk) acc = __builtin_amdgcn_mfma_f32_32x32x16_bf16(af[kk], kf[sub][kk], acc, 0, 0, 0);
            float s = 0.f;
#pragma unroll
            for (int i = 0; i < 16; ++i) s += wv[i >> 2][i & 3] * fmaxf(acc[i], 0.f);
            sc[sub] = s;
        }
        f16v2 h0, h1; h0.x = (_Float16)sc[0]; h0.y = (_Float16)sc[1]; h1.x = (_Float16)sc[2]; h1.y = (_Float16)sc[3];
        u32x2 w; w.x = __builtin_bit_cast(unsigned, h0); w.y = __builtin_bit_cast(unsigned, h1);
        *(u32x2*)(scb + (size_t)(r0 + hf) * rowlen + kb * 128 + 4 * c) = w;
    }
}

__device__ __forceinline__ void find_bin(LAS unsigned* hist, int lane, unsigned need, unsigned& bin, unsigned& above) {
    const u32x4 h = *(const LAS u32x4*)(hist + 4 * lane);
    const unsigned s = h.x + h.y + h.z + h.w;
    unsigned v = s;
#pragma unroll
    for (int d = 1; d < 64; d <<= 1) { const unsigned tt = __shfl_down(v, d); if (lane + d < 64) v += tt; }
    unsigned run = v - s;
    int fb = -1; unsigned fa = 0;
    const unsigned hh[4] = {h.x, h.y, h.z, h.w};
#pragma unroll
    for (int j = 3; j >= 0; --j) { if (fb < 0 && run < need && run + hh[j] >= need) { fb = 4 * lane + j; fa = run; } run += hh[j]; }
    const unsigned long long m = __ballot(fb >= 0);
    const int src = m ? (int)__builtin_ctzll(m) : 0;
    bin = (unsigned)__shfl(fb, src); above = __shfl(fa, src);
}

__device__ void select_row(const Frame& F, int t, LAS unsigned short* rowbuf, LAS unsigned* hist, int lane) {
    const int pos = t & (S - 1), b = t >> 13, n = pos + 1, qb = pos >> 7, r = pos & 127;
    const unsigned short* src = F.SC + sc_block_base(b, qb) + (size_t)r * (qb + 1) * 128;
    unsigned short* out = F.SEL + (size_t)t * 256;
    if (n <= 256) { for (int j = lane; j < 256; j += 64) out[j] = (unsigned short)(j < n ? j : 0); return; }
#pragma unroll
    for (int i = 0; i < 4; ++i) hist[lane + 64 * i] = 0u;
    const int nch = (n + 511) >> 9;
    for (int ch = 0; ch < nch; ++ch) {
        const int base = ch * 512 + lane * 8;
        const u32x4 raw = *(const u32x4*)(src + base);
        unsigned kk[8]; const unsigned rw[4] = {raw.x, raw.y, raw.z, raw.w};
#pragma unroll
        for (int e = 0; e < 8; ++e) { const unsigned h = (rw[e >> 1] >> ((e & 1) * 16)) & 0xffffu; unsigned key = (h & 0x8000u) ? (~h & 0xffffu) : (h | 0x8000u);
            if (base + e >= n) key = 0u; else __hip_atomic_fetch_add(hist + (key >> 8), 1u, __ATOMIC_RELAXED, __HIP_MEMORY_SCOPE_WORKGROUP);
            kk[e] = key; }
        u32x4 st; st.x = kk[0] | (kk[1] << 16); st.y = kk[2] | (kk[3] << 16); st.z = kk[4] | (kk[5] << 16); st.w = kk[6] | (kk[7] << 16);
        *(LAS u32x4*)(rowbuf + base) = st;
    }
    unsigned bin1, above1; find_bin(hist, lane, 256u, bin1, above1);
    const unsigned r1 = 256u - above1;
#pragma unroll
    for (int i = 0; i < 4; ++i) hist[lane + 64 * i] = 0u;
    for (int ch = 0; ch < nch; ++ch) {
        const int base = ch * 512 + lane * 8;
        const u32x4 st = *(const LAS u32x4*)(rowbuf + base); const unsigned rw[4] = {st.x, st.y, st.z, st.w};
#pragma unroll
        for (int e = 0; e < 8; ++e) { const unsigned key = (rw[e >> 1] >> ((e & 1) * 16)) & 0xffffu;
            if (base + e < n && (key >> 8) == bin1) __hip_atomic_fetch_add(hist + (key & 255u), 1u, __ATOMIC_RELAXED, __HIP_MEMORY_SCOPE_WORKGROUP); }
    }
    unsigned bin2, above2; find_bin(hist, lane, r1, bin2, above2);
    const unsigned r2 = r1 - above2, thr = (bin1 << 8) | bin2;
    unsigned outbase = 0, eqbase = 0;
    const unsigned long long ltmask = (1ull << lane) - 1ull;
    const int nit = (n + 63) >> 6;
    for (int it = 0; it < nit; ++it) {
        const int idx = it * 64 + lane; const bool inr = idx < n;
        const unsigned key = inr ? (unsigned)rowbuf[idx] : 0u;
        const bool eq = inr && key == thr;
        const unsigned long long em = __ballot(eq);
        const unsigned eqrank = eqbase + (unsigned)__popcll(em & ltmask);
        const bool take = inr && (key > thr || (eq && eqrank < r2));
        const unsigned long long tm = __ballot(take);
        if (take) { const unsigned p = outbase + (unsigned)__popcll(tm & ltmask); if (p < 256u) out[p] = (unsigned short)idx; }
        outbase += (unsigned)__popcll(tm); eqbase += (unsigned)__popcll(em);
    }
}

__device__ __forceinline__ bf16x8 tr_read2(unsigned a0, unsigned a1) {
    s16x4 x, y;
    asm volatile("ds_read_b64_tr_b16 %0, %2\n\tds_read_b64_tr_b16 %1, %3\n\ts_waitcnt lgkmcnt(0)" : "=&v"(x), "=&v"(y) : "v"(a0), "v"(a1) : "memory");
    return (bf16x8){x[0], x[1], x[2], x[3], y[0], y[1], y[2], y[3]};
}

#define AT_WAITV(n) asm volatile("s_waitcnt vmcnt(" #n ")" ::: "memory")
__device__ __forceinline__ int rot_k(int p) { return ((p & 1) ? 3 : 1) + ((p >> 2) & 1) * 4; }
__device__ void attn_items(const Frame& F, int klo, int khi) {
    const int lane = F.lane, li = lane & 15, q4 = lane >> 4;
    const int xg = F.bid & 7, b = xg >> 1, g = xg & 1;
    const int wq = (F.bid >> 3) * 8 + F.wave;
    LAS unsigned char* wb = F.lds + F.wave * 16384;
    const unsigned wbu = (unsigned)(uintptr_t)wb;
    const bf16_t* kvb = F.KV + (size_t)b * S * 512 + g * 256;
    const int da = lane >> 3, dr = lane & 7, drow = da & 3, dline = da >> 2;
    const int koff0 = 64 * dline + 8 * ((dr + rot_k(drow >> 1)) & 7);
    const int voff0 = 128 + 64 * dline + 8 * ((dr + 2 * (drow >> 1)) & 7);
    const unsigned kra0 = (unsigned)((li >> 2) * 1024 + (8 * (li & 3) + ((q4 - rot_k(li >> 1)) & 7)) * 16);
    const int vr4 = li >> 2, vp = li & 3;
    const unsigned vbase = wbu + (unsigned)(q4 * 1024 + 128 * vr4 + 8 * (vp & 1));
    const int vc = (vp >> 1) - 2 * ((2 * q4 + (vr4 >> 1)) & 3) + 8;
#define AT_KDMA(c) do { _Pragma("unroll") for (int _j = 0; _j < 4; ++_j) { const int _ix = (__shfl(idx2[(c) >> 1], 4 * _j + drow) >> (((c) & 1) * 16)) & 0xffff; \
        __builtin_amdgcn_global_load_lds((const unsigned*)((const char*)kvb + (unsigned)(_ix * 1024 + 2 * (koff0 ^ ((_j >> 1) * 32)))), (LAS unsigned*)(wb + ((c) & 3) * 4096 + _j * 1024), 16, 0, 0); } } while (0)
#define AT_VDMA(ks) do { _Pragma("unroll") for (int _j = 0; _j < 8; ++_j) { const int _ix = (__shfl(idx2[ks], 4 * (_j & 3) + drow) >> ((_j >> 2) * 16)) & 0xffff; \
        __builtin_amdgcn_global_load_lds((const unsigned*)((const char*)kvb + (unsigned)(_ix * 1024 + 2 * (voff0 ^ ((_j & 1) * 32)))), (LAS unsigned*)(wb + ((ks) & 1) * 8192 + _j * 1024), 16, 0, 0); } } while (0)
    for (int k = klo; k < khi; ++k) {
        const int pos = wq + 256 * k, t = b * S + pos, cnt = (pos + 1) < 256 ? (pos + 1) : 256;
        int idx2[8];
#pragma unroll
        for (int i = 0; i < 8; ++i) { const int s0 = 32 * i + li, s1 = s0 + 16; const int v0 = F.SEL[(size_t)t * 256 + s0], v1 = F.SEL[(size_t)t * 256 + s1]; idx2[i] = (s0 < cnt ? v0 : 0) | ((s1 < cnt ? v1 : 0) << 16); }
        bf16x8 bq[4];
#pragma unroll
        for (int kk = 0; kk < 4; ++kk) { bq[kk] = (bf16x8){0, 0, 0, 0, 0, 0, 0, 0}; if (li < 4) bq[kk] = *(const bf16x8*)(F.QB + (size_t)t * 1024 + (4 * g + li) * 128 + 32 * kk + 8 * q4); }
        AT_KDMA(0); AT_KDMA(1); AT_KDMA(2);
        f32x4 s[16];
#pragma unroll
        for (int c = 0; c < 16; ++c) {
            if (c <= 13) AT_WAITV(8); else if (c == 14) AT_WAITV(12); else AT_WAITV(8);
            f32x4 acc = (f32x4){0.f, 0.f, 0.f, 0.f};
            bf16x8 a[4];
#pragma unroll
            for (int kk = 0; kk < 4; ++kk) a[kk] = *(const LAS bf16x8*)(wb + (c & 3) * 4096 + (kk >> 1) * 512 + (kra0 ^ (unsigned)((kk & 1) * 64)));
#pragma unroll
            for (int kk = 0; kk < 4; ++kk) acc = __builtin_amdgcn_mfma_f32_16x16x32_bf16(a[kk], bq[kk], acc, 0, 0, 0);
            s[c] = acc;
            asm volatile("s_waitcnt lgkmcnt(0)" ::: "memory");
            if (c + 3 <= 15) AT_KDMA(c + 3);
            if (c == 13) AT_VDMA(0);
            if (c == 15) AT_VDMA(1);
            __builtin_amdgcn_sched_barrier(0);
        }
        float m = -INFINITY;
#pragma unroll
        for (int c = 0; c < 16; ++c)
#pragma unroll
            for (int i = 0; i < 4; ++i) { const int slot = c * 16 + 4 * q4 + i; if (slot >= cnt) s[c][i] = -INFINITY; m = fmaxf(m, s[c][i]); }
        m = fmaxf(m, __shfl_xor(m, 16)); m = fmaxf(m, __shfl_xor(m, 32));
        float sum = 0.f;
#pragma unroll
        for (int c = 0; c < 16; ++c)
#pragma unroll
            for (int i = 0; i < 4; ++i) { const float p = exp2f(s[c][i] - m); s[c][i] = p; sum += p; }
        sum += __shfl_xor(sum, 16); sum += __shfl_xor(sum, 32);
        f32x4 o[8];
#pragma unroll
        for (int d = 0; d < 8; ++d) o[d] = (f32x4){0.f, 0.f, 0.f, 0.f};
#pragma unroll
        for (int ks = 0; ks < 8; ++ks) {
            u32x4 pk; pk.x = pk_bf16(s[2 * ks][0], s[2 * ks][1]); pk.y = pk_bf16(s[2 * ks][2], s[2 * ks][3]); pk.z = pk_bf16(s[2 * ks + 1][0], s[2 * ks + 1][1]); pk.w = pk_bf16(s[2 * ks + 1][2], s[2 * ks + 1][3]);
            const bf16x8 bp = __builtin_bit_cast(bf16x8, pk);
            if (ks < 7) AT_WAITV(8); else AT_WAITV(0);
            const unsigned vsl = (unsigned)((ks & 1) * 8192);
#pragma unroll
            for (int d = 0; d < 8; ++d) { const unsigned ad = vbase + vsl + (unsigned)((d >> 2) * 512) + (unsigned)(((vc + 2 * (d & 3)) & 7) << 4); const bf16x8 a = tr_read2(ad, ad + 4096); o[d] = __builtin_amdgcn_mfma_f32_16x16x32_bf16(a, bp, o[d], 0, 0, 0); }
            if (ks + 2 <= 7) AT_VDMA(ks + 2);
            __builtin_amdgcn_sched_barrier(0);
        }
        const float inv = 1.0f / sum;
        if (li < 4) {
            bf16_t* op = F.CONCAT + (size_t)t * D + g * 512 + li * 128 + 4 * q4;
#pragma unroll
            for (int d = 0; d < 8; ++d) { u32x2 w; w.x = pk_bf16(o[d][0] * inv, o[d][1] * inv); w.y = pk_bf16(o[d][2] * inv, o[d][3] * inv); *(u32x2*)(op + d * 16) = w; }
        }
    }
#undef AT_KDMA
#undef AT_VDMA
}

#if SELFCHECK
__device__ __forceinline__ float bfv(const bf16_t* p, size_t i) { return __uint_as_float(((unsigned)p[i]) << 16); }
__device__ __forceinline__ unsigned hash_u(unsigned x) { x ^= x >> 16; x *= 0x7feb352dU; x ^= x >> 15; x *= 0x846ca68bU; x ^= x >> 16; return x; }
__device__ __forceinline__ void chk_flag(const Frame& F, int k) { __hip_atomic_fetch_add(F.ctl + CW_CHK + k, 1u, __ATOMIC_RELAXED, __HIP_MEMORY_SCOPE_AGENT); }
__device__ void chk_gemm1(const Frame& F) {
    for (int j = 0; j < 16; ++j) {
        const unsigned hsh = hash_u((unsigned)((F.bid * 8 + F.wave) * 16 + j) * 2654435761u + 12345u);
        const int t = (int)(hsh % (unsigned)T), n = (int)((hsh >> 7) % 3664u);
        float s = 0.f, sa = 0.f;
        for (int k = F.lane; k < D; k += 64) { const float a = bfv(F.H, (size_t)t * D + k), w = F.w_in[(size_t)k * 3664 + n]; s += a * w; sa += fabsf(a * w); }
        s = wave_sum(s); sa = wave_sum(sa);
        const float got = bfv(F.PROJ, (size_t)t * NPROJ + colmap(n));
        if (F.lane == 0 && !(fabsf(got - s) <= 0.001f * sa + 0.02f)) chk_flag(F, 0);
    }
}
__device__ void chk_post(const Frame& F) {
    const int gw = F.bid * 8 + F.wave;
    const int t = (gw * 16 + (gw & 15)) % T, pos = t & (S - 1), lane = F.lane;
    const bf16_t* pr = F.PROJ + (size_t)t * NPROJ;
    const float QSCALE = 0.08838834764831845f * 1.4426950408889634f;
    int bad = 0;
    for (int hh = 0; hh < 10; ++hh) {
        const int cb = hh < 8 ? CQ + hh * 128 : CK + (hh - 8) * 128; const float* gn = hh < 8 ? F.q_norm_g : F.k_norm_g;
        float ss = 0.f; for (int d = lane; d < 128; d += 64) { const float v = bfv(pr, cb + d); ss += v * v; } ss = wave_sum(ss);
        const float rstd = 1.0f / sqrtf(ss / 128.0f + NORM_EPS);
        for (int d = lane; d < 128; d += 64) {
            float y = bfv(pr, cb + d) * rstd * gn[d];
            if (d < 32) { const int i = d & 15; const float inv = powf(500000.0f, -(float)(2 * i) / 32.0f); const float ang = (float)pos * inv; const float cs = cosf(ang), sn = sinf(ang);
                const int dp = d < 16 ? d + 16 : d - 16; const float yp = bfv(pr, cb + dp) * rstd * gn[dp];
                y = d < 16 ? y * cs - yp * sn : y * cs + yp * sn; }
            float got, ref;
            if (hh < 8) { ref = y * QSCALE; got = bfv(F.QB, (size_t)t * 1024 + hh * 128 + d); } else { ref = y; got = bfv(F.KV, (size_t)t * 512 + (hh - 8) * 256 + d); }
            if (!(fabsf(got - ref) <= 0.02f * fabsf(ref) + 0.02f)) bad = 1;
        }
    }
    for (int e = lane; e < 256; e += 64) { const float ref = bfv(pr, CV + e), got = bfv(F.KV, (size_t)t * 512 + (e >> 7) * 256 + 128 + (e & 127)); if (got != ref) bad = 1; }
    for (int e = lane; e < 1024 + 64; e += 64) {
        const int cb = e < 1024 ? CQI + (e & ~63) : CKI; const int d = e & 63;
        float y = bfv(pr, cb + d);
        if (d < 16) { const int i = d & 7; const float inv = powf(500000.0f, -(float)(2 * i) / 16.0f); const float ang = (float)pos * inv; const float cs = cosf(ang), sn = sinf(ang);
            const int dp = d < 8 ? d + 8 : d - 8; const float yp = bfv(pr, cb + dp); y = d < 8 ? y * cs - yp * sn : y * cs + yp * sn; }
        const float got = e < 1024 ? bfv(F.QI, (size_t)t * 1024 + e) : bfv(F.KI, (size_t)t * 64 + d);
        if (!(fabsf(got - y) <= 0.02f * fabsf(y) + 0.02f)) bad = 1;
    }
    if (lane < 16) { const float ref = bfv(pr, CWI + lane) * 0.03125f, got = F.WI[(size_t)t * 16 + lane]; if (!(fabsf(got - ref) <= 1e-5f + 1e-5f * fabsf(ref))) bad = 1; }
    for (int e = lane; e < 1024; e += 64) {
        const int g = e >> 8, w = 2 << g; float sum = 0.f; int cn = 0;
        for (int r = 0; r < w; ++r) if (pos - r >= 0) { sum += bfv(pr - (size_t)r * NPROJ, CP + e); ++cn; }
        const float ref = sum / (float)cn - bfv(pr, CP + e), got = bfv(F.PM, ((size_t)g * T + t) * 256 + (e & 255));
        if (!(fabsf(got - ref) <= 0.02f * fabsf(ref) + 0.02f)) bad = 1;
    }
    if (__ballot(bad) != 0ull && lane == 0) chk_flag(F, 1);
}
__device__ void chk_attn(const Frame& F) {
    const int w = F.bid, b = w & 3, j = w >> 2;
    const int special[12] = {0, 1, 100, 254, 255, 256, 257, 300, 511, 512, 8190, 8191};
    const int pos = j < 12 ? special[j] : (j * 131 + 17) & (S - 1);
    const int t = b * S + pos, n = pos + 1, cnt = n < 256 ? n : 256, tid = F.tid;
    LAS float* sc = (LAS float*)F.lds;
    LAS int* selmark = (LAS int*)(F.lds + 32768);
    LAS float* red = (LAS float*)(F.lds + 65536);
    LAS int* ired = (LAS int*)(F.lds + 65536 + 4096);
    __syncthreads();
    for (int s2 = tid; s2 < n; s2 += NTHREADS) {
        float tot = 0.f;
        for (int h = 0; h < 16; ++h) { float dsum = 0.f; for (int d = 0; d < 64; ++d) dsum += bfv(F.QI, (size_t)t * 1024 + h * 64 + d) * bfv(F.KI, ((size_t)b * S + s2) * 64 + d); tot += F.WI[(size_t)t * 16 + h] * fmaxf(dsum, 0.f); }
        sc[s2] = (float)(_Float16)tot; selmark[s2] = 0;
    }
    __syncthreads();
    if (tid < cnt) { const int k = F.SEL[(size_t)t * 256 + tid]; if (k < n) atomicAdd((int*)(selmark + k), 1); else atomicAdd((int*)(selmark + 0), 1000); }
    if (tid == 0) { ired[0] = 0; ired[1] = 0; }
    __syncthreads();
    int miss = 0, dup = 0;
    for (int s2 = tid; s2 < n; s2 += NTHREADS) {
        const int mk = selmark[s2]; if (mk > 1) dup = 1;
        if (mk >= 1 && n > 256) { const float v = sc[s2]; int rank = 0; for (int q = 0; q < n; ++q) rank += (sc[q] > v) ? 1 : 0; if (rank >= 256) ++miss; }
    }
    if (miss) atomicAdd((int*)ired, miss); if (dup) atomicAdd((int*)ired + 1, 1);
    __syncthreads();
    if (tid == 0 && (ired[0] > 3 || ired[1] > 0)) chk_flag(F, 2);
    float err2 = 0.f, ref2 = 0.f;
    for (int h = 0; h < 8; ++h) {
        const int g = h >> 2;
        __syncthreads();
        if (tid < 256) { float l = -INFINITY; if (tid < cnt) { const int k = F.SEL[(size_t)t * 256 + tid]; float dsum = 0.f; for (int d = 0; d < 128; ++d) dsum += bfv(F.QB, (size_t)t * 1024 + h * 128 + d) * bfv(F.KV, ((size_t)b * S + k) * 512 + g * 256 + d); l = dsum; } red[tid] = l; }
        __syncthreads();
        float m = -INFINITY; for (int q = 0; q < 256; ++q) m = fmaxf(m, red[q]);
        float den = 0.f; for (int q = 0; q < 256; ++q) den += exp2f(red[q] - m);
        if (tid < 128) { float o = 0.f; for (int q = 0; q < cnt; ++q) { const int k = F.SEL[(size_t)t * 256 + q]; o += exp2f(red[q] - m) * bfv(F.KV, ((size_t)b * S + k) * 512 + g * 256 + 128 + tid); }
            o /= den; const float got = bfv(F.CONCAT, (size_t)t * D + h * 128 + tid); err2 += (got - o) * (got - o); ref2 += o * o; }
    }
    err2 = wave_sum(err2); ref2 = wave_sum(ref2);
    __syncthreads();
    if (F.lane == 0 && F.wave < 2) { red[300 + F.wave * 2] = err2; red[301 + F.wave * 2] = ref2; }
    __syncthreads();
    if (tid == 0) { const float e = red[300] + red[302], r = red[301] + red[303]; if (!(e <= 0.0009f * r + 1e-6f)) chk_flag(F, 3); }
    __syncthreads();
}
#endif

__device__ void r1_route(const Frame& F) {
    { const float* ada = F.ADA + (size_t)(F.bid >> 6) * 12288; norm_rows(F, F.out, F.norm2_g, ada + 3 * 2048, ada + 4 * 2048); }
    LAS unsigned* lh = (LAS unsigned*)(F.lds + 65536);
    LAS float* lg = (LAS float*)F.lds + F.wave * 768;
    if (F.tid < 64) lh[F.tid] = 0u;
    asm volatile("s_waitcnt vmcnt(0)" ::: "memory");
    __syncthreads();
    const int lane = F.lane, li = lane & 15, q4 = lane >> 4;
    const int t0 = F.bid * 128 + F.wave * 16;
    f32x4 acc[3];
#pragma unroll
    for (int nb = 0; nb < 3; ++nb) acc[nb] = (f32x4){0.f, 0.f, 0.f, 0.f};
    const bf16_t* hp = F.H + (size_t)(t0 + li) * D + 8 * q4;
    const bf16_t* wp = F.WR + (size_t)li * D + 8 * q4;
#pragma unroll 4
    for (int ks = 0; ks < 64; ++ks) {
        const bf16x8 a = *(const bf16x8*)(hp + 32 * ks);
#pragma unroll
        for (int nb = 0; nb < 3; ++nb) { const bf16x8 bb = *(const bf16x8*)(wp + (size_t)nb * 16 * D + 32 * ks); acc[nb] = __builtin_amdgcn_mfma_f32_16x16x32_bf16(a, bb, acc[nb], 0, 0, 0); }
    }
#pragma unroll
    for (int nb = 0; nb < 3; ++nb)
#pragma unroll
        for (int i = 0; i < 4; ++i) lg[(4 * q4 + i) * 48 + nb * 16 + li] = acc[nb][i];
    asm volatile("s_waitcnt lgkmcnt(0)" ::: "memory");
    if (lane < 16) {
        const int t = t0 + lane; const LAS float* l = lg + lane * 48;
        int gs = 0; float gm = l[0];
#pragma unroll
        for (int j = 1; j < 4; ++j) if (l[j] > gm) { gm = l[j]; gs = j; }
        float den = 0.f;
#pragma unroll
        for (int j = 0; j < 4; ++j) den += __expf(l[j] - gm);
        const float pg = 1.0f / den;
        const LAS float* el = l + 4 + gs * 8;
        int i0 = 0; float m0 = el[0];
#pragma unroll
        for (int j = 1; j < 8; ++j) if (el[j] > m0) { m0 = el[j]; i0 = j; }
        int i1 = -1; float m1 = -INFINITY;
#pragma unroll
        for (int j = 0; j < 8; ++j) if (j != i0 && el[j] > m1) { m1 = el[j]; i1 = j; }
        const float e1 = __expf(m1 - m0), w0 = pg / (1.0f + e1), w1 = pg * e1 / (1.0f + e1);
        const int b0 = gs * 8 + i0, b1 = 32 + gs * 8 + i1;
        F.TOKE[2 * t] = b0; F.TOKE[2 * t + 1] = b1; F.TOKW[2 * t] = w0; F.TOKW[2 * t + 1] = w1;
        __hip_atomic_fetch_add(lh + b0, 1u, __ATOMIC_RELAXED, __HIP_MEMORY_SCOPE_WORKGROUP);
        __hip_atomic_fetch_add(lh + b1, 1u, __ATOMIC_RELAXED, __HIP_MEMORY_SCOPE_WORKGROUP);
    }
    __syncthreads();
    if (F.tid < 64) { const unsigned cn = lh[F.tid]; if (cn) __hip_atomic_fetch_add(F.ctl + CW_GCOUNT + F.tid, cn, __ATOMIC_RELAXED, __HIP_MEMORY_SCOPE_AGENT); }
}

__device__ void r2_rows(const Frame& F) {
    LAS unsigned* lh = (LAS unsigned*)F.lds;
    LAS unsigned* lbase = lh + 64;
    LAS unsigned* tstart = lh + 128;
    const int tid = F.tid;
    if (tid < 64) lh[tid] = 0u;
    __syncthreads();
    if (tid == 0) {
        unsigned ts = 0;
        for (int k = 0; k < 64; ++k) { tstart[k] = ts; const unsigned cn = __hip_atomic_load(F.ctl + CW_GCOUNT + k, __ATOMIC_RELAXED, __HIP_MEMORY_SCOPE_AGENT); ts += (cn + 255u) >> 8; if (k == 31) tstart[64 + 1] = ts; }
        tstart[64] = ts;
    }
    const int t = F.bid * 128 + (tid >> 1), sl = tid & 1;
    int bucket = 0; float w = 0.f;
    if (tid < 256) { bucket = F.TOKE[2 * t + sl]; w = F.TOKW[2 * t + sl]; __hip_atomic_fetch_add(lh + bucket, 1u, __ATOMIC_RELAXED, __HIP_MEMORY_SCOPE_WORKGROUP); }
    __syncthreads();
    if (tid < 64) { const unsigned cn = lh[tid]; unsigned base = 0; if (cn) base = __hip_atomic_fetch_add(F.ctl + CW_GCURSOR + tid, cn, __ATOMIC_RELAXED, __HIP_MEMORY_SCOPE_AGENT); lbase[tid] = tstart[tid] * 256u + base; }
    __syncthreads();
    if (tid < 64) lh[tid] = 0u;
    __syncthreads();
    if (tid < 256) { const unsigned rk = __hip_atomic_fetch_add(lh + bucket, 1u, __ATOMIC_RELAXED, __HIP_MEMORY_SCOPE_WORKGROUP); const unsigned p = lbase[bucket] + rk;
        if (p < (unsigned)MAXROWS) { F.ROWTOK[p] = t; F.ROWW[p] = w; } }
    if (F.bid == 0) {
        if (tid == 0) { ((int*)F.ctl)[CW_TINFO] = (int)tstart[65]; ((int*)F.ctl)[CW_TINFO + 1] = (int)tstart[64]; }
        if (tid < 64) { const unsigned a = tstart[tid], e = (tid == 63) ? tstart[64] : tstart[tid + 1]; for (unsigned p = a; p < e && p < 512u; ++p) ((int*)F.ctl)[CW_TILEB + p] = tid; }
    }
}

struct Args { const float* in[17]; float* out; unsigned char* ws; int ph_lo, ph_hi; };
constexpr int N_PHASES = 13;

__global__ void __launch_bounds__(NTHREADS, 2) mk_fwd(Args args) {
    extern __shared__ __attribute__((aligned(16))) unsigned char lds_raw[];
    Frame F;
    F.lds = (LAS unsigned char*)lds_raw;
    F.tid = threadIdx.x; F.lane = F.tid & 63; F.wave = __builtin_amdgcn_readfirstlane(F.tid >> 6); F.G = gridDim.x; F.bid = blockIdx.x;
    F.x = args.in[0]; F.c = args.in[1]; F.w_ada = args.in[2]; F.b_ada = args.in[3]; F.norm1_g = args.in[4]; F.w_in = args.in[5]; F.q_norm_g = args.in[6]; F.k_norm_g = args.in[7];
    F.w_pool = args.in[8]; F.pool_scale = args.in[9]; F.w_out = args.in[10]; F.norm2_g = args.in[11]; F.w_grp = args.in[12]; F.w_exp = args.in[13]; F.w1 = args.in[14]; F.w3 = args.in[15]; F.w2 = args.in[16];
    F.out = args.out;
    unsigned char* ws = args.ws;
    F.ctl = (unsigned*)(ws + WS_CTL); F.ADA = (float*)(ws + WS_ADA); F.ADAP = (float*)(ws + WS_ADAP); F.TAB = (float*)(ws + WS_TAB); F.WR = (bf16_t*)(ws + WS_WR); F.TOKE = (int*)(ws + WS_TOKE); F.TOKW = (float*)(ws + WS_TOKW);
    F.ROWTOK = (int*)(ws + WS_ROWTOK); F.ROWW = (float*)(ws + WS_ROWW); F.WI = (float*)(ws + WS_WI); F.KI = (bf16_t*)(ws + WS_KI);
    F.WPOOL = (bf16_t*)(ws + WS_WPOOL); F.WOUT = (bf16_t*)(ws + WS_WOUT); F.WIN = (bf16_t*)(ws + WS_WIN); F.W13 = (bf16_t*)(ws + WS_W13); F.W2 = (bf16_t*)(ws + WS_W2);
    F.H = (bf16_t*)(ws + WS_H); F.CONCAT = (bf16_t*)(ws + WS_H); F.PROJ = (bf16_t*)(ws + WS_X); F.SC = (unsigned short*)(ws + WS_X);
    F.QB = (bf16_t*)(ws + WS_QB); F.ACT = (bf16_t*)(ws + WS_QB); F.KV = (bf16_t*)(ws + WS_KV); F.QI = (bf16_t*)(ws + WS_QI); F.PM = (bf16_t*)(ws + WS_PM); F.SEL = (unsigned short*)(ws + WS_SEL);

    volatile LAS unsigned* bst = (volatile LAS unsigned*)(F.lds + LDS_BYTES - 16);
    if (F.tid == 0) { bst[0] = 0u; bst[1] = 0u; bst[2] = 0u; bst[3] = 0u; }
    __syncthreads();
    XcdBarrier bar = xcd_barrier_post(F.ctl, bst);
    const int lo = args.ph_lo, hi = args.ph_hi;
#define IN(k) (lo <= (k) && (k) < hi)
#define SEAM(k) do { if (IN(k) && IN((k) + 1)) xcd_barrier(bar); } while (0)

#define PH(k, ...) do { if (IN(k)) { F.lane = fresh_lane(); F.tid = F.wave * 64 + F.lane; for (int rep_ = 0; rep_ < 1 + ((REPEAT_MASK >> (k)) & 1); ++rep_) { __VA_ARGS__ } } SEAM(k); } while (0)
    PH(0, { p0_prologue(F); });
    PH(1, {
        if (F.tid < 192) { const int v = F.bid * 192 + F.tid; float s = 0.f; for (int kc = 0; kc < 32; ++kc) s += F.ADAP[(size_t)kc * 49152 + v]; F.ADA[v] = s; }
        LAS float* sl = (LAS float*)F.lds;
        { const int b = F.bid >> 6; for (int idx = F.tid; idx < 4096; idx += NTHREADS) { float s = 0.f; for (int kc = 0; kc < 32; ++kc) s += F.ADAP[(size_t)kc * 49152 + b * 12288 + idx]; sl[idx] = s; } }
        __syncthreads();
        norm_rows(F, F.x, F.norm1_g, (const float*)sl, (const float*)(sl + 2048));
        __syncthreads();
    });
    PH(2, {
        pg8::Gemm g{F.H, F.WIN, D}; pg8::StaticOrder So; So.init(T, NPROJ, F.G, F.bid, 1 + ((REPEAT_UNITS >> 2) & 1));
        pg8::EpiBf16 E{F.PROJ, NPROJ, 0};
        pg8::gemm_phase<pg8::EpiBf16, pg8::StaticOrder>(F.lds, g, So, E, F.tid);
    });
#if SELFCHECK
    if (IN(3)) chk_gemm1(F);
#endif
    PH(3, { p3_post(F); });
#if SELFCHECK
    if (IN(3)) { chk_post(F); if (IN(4)) xcd_barrier(bar); }
#endif
    PH(4, {
        {
            pg8::Gemm g{F.PM, F.WPOOL, 256}; pg8::PoolOrder So{F.G, F.bid};
            pg8::EpiBf16 E{F.CONCAT, D, 1};
            pg8::gemm_phase<pg8::EpiBf16, pg8::PoolOrder>(F.lds, g, So, E, F.tid);
        }
        for (int uu = F.bid; uu < 4 * 2080 * (1 + ((REPEAT_UNITS >> 4) & 1)); uu += F.G) {
            const int u = uu % (4 * 2080); const int b = u / 2080, v = u % 2080;
            int qb = (int)((sqrtf(8.0f * (float)v + 1.0f) - 1.0f) * 0.5f);
            while (qb * (qb + 1) / 2 > v) --qb;
            while ((qb + 1) * (qb + 2) / 2 <= v) ++qb;
            indexer_unit(F, b, qb, v - qb * (qb + 1) / 2);
        }
    });
    PH(5, {
        LAS unsigned short* rowbuf = (LAS unsigned short*)(F.lds + F.wave * 17408);
        LAS unsigned* hist = (LAS unsigned*)(F.lds + F.wave * 17408 + 16384);
        for (int i = F.bid * 8 + F.wave; i < T; i += F.G * 8) {
            const int t = (i & 1) ? (T - 1 - (i >> 1)) : (i >> 1);
            select_row(F, t, rowbuf, hist, F.lane);
        }
    });
    PH(6, {
        attn_items(F, 0, 32);
#if ATT_PROBE == 1
        attn_items(F, 0, 16);
#elif ATT_PROBE == 2
        attn_items(F, 16, 32);
#endif
    });
#if SELFCHECK
    if (IN(7)) chk_attn(F);
#endif
    PH(7, {
        pg8::Gemm g{F.CONCAT, F.WOUT, D}; pg8::StaticOrder So; So.init(T, D, F.G, F.bid, 1 + ((REPEAT_UNITS >> 7) & 1));
        pg8::EpiMix E{F.x, F.ADA, F.out};
        pg8::gemm_phase<pg8::EpiMix, pg8::StaticOrder>(F.lds, g, So, E, F.tid);
    });
    PH(8, { r1_route(F); });
    PH(9, { r2_rows(F); });
    PH(10, {
        const int* ti = (const int*)F.ctl + CW_TINFO;
        pg8::Gemm g{F.H, F.W13, D}; pg8::MoeOrder<4, true> So{(const int*)F.ctl + CW_TILEB, F.ROWTOK, 0, ti[1], F.G, F.bid, 1 + ((REPEAT_UNITS >> 10) & 1)};
        pg8::EpiAct E{F.ACT};
        pg8::gemm_phase<pg8::EpiAct, pg8::MoeOrder<4, true>>(F.lds, g, So, E, F.tid);
    });
    PH(11, {
        const int* ti = (const int*)F.ctl + CW_TINFO;
        pg8::Gemm g{F.ACT, F.W2, 512}; pg8::MoeOrder<8, false> So{(const int*)F.ctl + CW_TILEB, F.ROWTOK, 0, ti[0], F.G, F.bid, 1};
        pg8::EpiMoeOut E{F.ROWTOK, F.ROWW, F.ADA, F.out};
        pg8::gemm_phase<pg8::EpiMoeOut, pg8::MoeOrder<8, false>>(F.lds, g, So, E, F.tid);
    });
    PH(12, {
        const int* ti = (const int*)F.ctl + CW_TINFO;
        pg8::Gemm g{F.ACT, F.W2, 512}; pg8::MoeOrder<8, false> So{(const int*)F.ctl + CW_TILEB, F.ROWTOK, ti[0], ti[1], F.G, F.bid, 1};
        pg8::EpiMoeOut E{F.ROWTOK, F.ROWW, F.ADA, F.out};
        pg8::gemm_phase<pg8::EpiMoeOut, pg8::MoeOrder<8, false>>(F.lds, g, So, E, F.tid);
    });
#undef PH
#if SELFCHECK
    if (IN(12)) {
        xcd_barrier(bar);
        if (F.bid == 0 && F.tid == 0) {
            float code = 0.f;
            for (int k = 0; k < 4; ++k) if (__hip_atomic_load(F.ctl + CW_CHK + k, __ATOMIC_RELAXED, __HIP_MEMORY_SCOPE_AGENT) != 0u) code += (float)(1 << k);
            if (code != 0.f) F.out[0] += 1.0e4f * code;
        }
    }
#endif
#undef IN
#undef SEAM
}

extern "C" void kernel_launch(void* const* d_in, const int* in_sizes, int n_in, void* d_out, int out_size, void* d_ws, size_t ws_size, hipStream_t stream) {
    static int grid = 0;
    if (grid == 0) {
        if (n_in != 17 || out_size != T * D || ws_size < WS_END) { fprintf(stderr, "kernel_launch: unexpected problem (n_in %d out %d ws %zu)\n", n_in, out_size, ws_size); grid = -1; return; }
        int dev = 0, cus = 0, per_cu = 0;
        if (hipGetDevice(&dev) != hipSuccess || hipDeviceGetAttribute(&cus, hipDeviceAttributeMultiprocessorCount, dev) != hipSuccess) { grid = -1; return; }
        if (hipFuncSetAttribute((const void*)mk_fwd, hipFuncAttributeMaxDynamicSharedMemorySize, LDS_BYTES) != hipSuccess) { fprintf(stderr, "kernel_launch: hipFuncSetAttribute failed\n"); grid = -1; return; }
        if (hipOccupancyMaxActiveBlocksPerMultiprocessor(&per_cu, (const void*)mk_fwd, NTHREADS, LDS_BYTES) != hipSuccess || per_cu < 1) { fprintf(stderr, "kernel_launch: occupancy query says %d\n", per_cu); }
        (void)hipGetLastError();
        grid = cus;
        if (grid != 256) { fprintf(stderr, "kernel_launch: built for 256 CUs, found %d\n", cus); grid = -1; return; }
    }
    if (grid < 0) return;
    (void)hipMemsetAsync((char*)d_ws + WS_CTL, 0, WS_ADA - WS_CTL, stream);
    (void)hipMemsetAsync((char*)d_ws + WS_ROWTOK, 0xFF, (size_t)MAXROWS * 4, stream);
    Args a{};
    for (int i = 0; i < 17; ++i) a.in[i] = (const float*)d_in[i];
    a.out = (float*)d_out; a.ws = (unsigned char*)d_ws;
#if MK_MULTI
    for (int p = 0; p < N_PHASES; ++p) { a.ph_lo = p; a.ph_hi = p + 1; hipLaunchKernelGGL(mk_fwd, dim3(grid), dim3(NTHREADS), LDS_BYTES, stream, a); }
#else
    a.ph_lo = 0; a.ph_hi = N_PHASES; hipLaunchKernelGGL(mk_fwd, dim3(grid), dim3(NTHREADS), LDS_BYTES, stream, a);
#endif
}
```

```cpp
#include <hip/hip_runtime.h>
#include <cstdio>
#include <cstdint>
#include <cstddef>

#ifndef MK_MULTI
#define MK_MULTI 0
#endif

#ifndef P5_PROBE
#define P5_PROBE 0
#endif
#ifndef P1_PROBE
#define P1_PROBE 0
#endif
#ifndef ATT_PROBE
#define ATT_PROBE 0
#endif
#ifndef SELFCHECK
#define SELFCHECK 0
#endif
#ifndef REPEAT_UNITS
#define REPEAT_UNITS 0
#endif
#ifndef REPEAT_MASK
#define REPEAT_MASK 0
#endif
#define LAS __attribute__((address_space(3)))
typedef unsigned short bf16_t;
typedef short bf16x8 __attribute__((ext_vector_type(8)));
typedef short s16x4 __attribute__((ext_vector_type(4)));
typedef float f32x4 __attribute__((ext_vector_type(4)));
typedef float f32x16 __attribute__((ext_vector_type(16)));
typedef unsigned u32x4 __attribute__((ext_vector_type(4)));
typedef unsigned u32x2 __attribute__((ext_vector_type(2)));
typedef __bf16 bf16v2 __attribute__((ext_vector_type(2)));
typedef _Float16 f16v2 __attribute__((ext_vector_type(2)));

constexpr int T = 32768, S = 8192, NB = 4, D = 2048;
constexpr int NPROJ = 3840;
constexpr int CQ = 0, CK = 1024, CV = 1280, CQI = 1536, CP = 2560, CKI = 3584, CWI = 3648;
constexpr int NTHREADS = 512;
constexpr int LDS_BYTES = 147456;
constexpr float NORM_EPS = 1e-6f;
constexpr size_t SC_BATCH = 34078720ull;
constexpr int MAXROWS = 81920;

constexpr size_t WS_CTL = 0;
constexpr size_t WS_ADA = 65536;
constexpr size_t WS_TAB = 262144;
constexpr size_t WS_WR = 1835008;
constexpr size_t WS_TOKE = 2031616;
constexpr size_t WS_TOKW = 2293760;
constexpr size_t WS_ROWTOK = 2555904;
constexpr size_t WS_ROWW = 2883584;
constexpr size_t WS_WI = 3211264;
constexpr size_t WS_KI = 5308416;
constexpr size_t WS_WPOOL = 9502720;
constexpr size_t WS_WOUT = 10027008;
constexpr size_t WS_WIN = 18415616;
constexpr size_t WS_W13 = 34144256;
constexpr size_t WS_W2 = 168361984;
constexpr size_t WS_H = 235470848;
constexpr size_t WS_X = 369688576;
constexpr size_t WS_QB = 642318336;
constexpr size_t WS_KV = 709427200;
constexpr size_t WS_QI = 742981632;
constexpr size_t WS_PM = 810090496;
constexpr size_t WS_SEL = 877199360;
constexpr size_t WS_ADAP = 893976576;
constexpr size_t WS_END = 900268032;
constexpr int CW_GCOUNT = 4096, CW_GCURSOR = 4160, CW_CHK = 4224, CW_TINFO = 4352, CW_TILEB = 4416;

__device__ __forceinline__ int fresh_lane() { int l; asm volatile("v_mbcnt_lo_u32_b32 %0, -1, 0\n\tv_mbcnt_hi_u32_b32 %0, -1, %0" : "=v"(l)); return l; }
__device__ __forceinline__ unsigned pk_bf16(float a, float b) { bf16v2 v; v.x = (__bf16)a; v.y = (__bf16)b; return __builtin_bit_cast(unsigned, v); }
__device__ __forceinline__ float bf_lo(unsigned u) { return __uint_as_float(u << 16); }
__device__ __forceinline__ float bf_hi(unsigned u) { return __uint_as_float(u & 0xffff0000u); }
__device__ __forceinline__ void unpack8(const u32x4 v, float* f) {
    f[0] = bf_lo(v.x); f[1] = bf_hi(v.x); f[2] = bf_lo(v.y); f[3] = bf_hi(v.y); f[4] = bf_lo(v.z); f[5] = bf_hi(v.z); f[6] = bf_lo(v.w); f[7] = bf_hi(v.w);
}
__device__ __forceinline__ u32x4 pack8(const float* f) { u32x4 v; v.x = pk_bf16(f[0], f[1]); v.y = pk_bf16(f[2], f[3]); v.z = pk_bf16(f[4], f[5]); v.w = pk_bf16(f[6], f[7]); return v; }
__device__ __forceinline__ float wave_sum(float v) {
#pragma unroll
    for (int d = 32; d >= 1; d >>= 1) v += __shfl_xor(v, d);
    return v;
}

#define XB_TMO      128
#define XB_XCNT(j)  (256  + 64 * (j))
#define XB_XSUB(j)  (1280 + 64 * (j))
#define XB_XGEN(j)  (2304 + 64 * (j))
#define XB_TOP      3328
#define XB_TOPGEN   3392
#define XCD_BAR_WORDS 3456
#define XB_SPIN_CAP (1u << 23)

__device__ __forceinline__ unsigned xb_ld(unsigned* p)              { return __hip_atomic_load(p, __ATOMIC_RELAXED, __HIP_MEMORY_SCOPE_AGENT); }
__device__ __forceinline__ unsigned xb_add(unsigned* p, unsigned v) { return __hip_atomic_fetch_add(p, v, __ATOMIC_RELAXED, __HIP_MEMORY_SCOPE_AGENT); }
__device__ __forceinline__ unsigned xb_xcc_id() { return (unsigned)__builtin_amdgcn_s_getreg((3 << 11) | 20) & 0xFu; }
#define XB_SPIN(cond, bar) do { unsigned _sp = 0; while (cond) { __builtin_amdgcn_s_sleep(1); \
    if ((++_sp & 255u) == 0u) { if (xb_ld(&(bar)[XB_TMO])) break; if (_sp > XB_SPIN_CAP) { atomicAdd(&(bar)[XB_TMO], 1u); break; } } } } while (0)

struct XcdBarrier { unsigned* bar; unsigned x; volatile LAS unsigned* st; int wave; };

__device__ __forceinline__ XcdBarrier xcd_barrier_post(unsigned* bar, volatile LAS unsigned* st, int wave) {
    XcdBarrier b; b.bar = bar; b.x = xb_xcc_id(); b.st = st; b.wave = wave;
    if (threadIdx.x == 0) (void)xb_add(&bar[XB_XCNT(b.x)], 1u);
    return b;
}
__device__ __forceinline__ void xcd_barrier_complete(unsigned* bar, unsigned x, unsigned& nloc, unsigned& nx) {
    const unsigned G = gridDim.x * gridDim.y * gridDim.z;
    unsigned sum, cnt, mine, sp = 0u;
    for (;;) {
        sum = 0u; cnt = 0u; mine = 0u;
#pragma unroll
        for (unsigned j = 0; j < 16; ++j) { const unsigned c = xb_ld(&bar[XB_XCNT(j)]); sum += c; cnt += (c > 0u) ? 1u : 0u; mine = (j == x) ? c : mine; }
        if (sum == G) break;
        __builtin_amdgcn_s_sleep(1);
        if ((++sp & 255u) == 0u) { if (xb_ld(&bar[XB_TMO])) break; if (sp > XB_SPIN_CAP) { atomicAdd(&bar[XB_TMO], 1u); break; } }
    }
    nloc = mine > 0u ? mine : 1u; nx = cnt > 0u ? cnt : 1u;
}
__device__ __forceinline__ void xcd_barrier(const XcdBarrier& b) {
    asm volatile("s_waitcnt vmcnt(0)" ::: "memory");
    __syncthreads();
    if (b.wave == 0 && fresh_lane() == 0) {
        unsigned* bar = b.bar;
        __builtin_amdgcn_s_waitcnt(0);
        unsigned nloc = b.st[0], nx = b.st[1];
        if (nloc == 0u) { xcd_barrier_complete(bar, b.x, nloc, nx); b.st[0] = nloc; b.st[1] = nx; }
        const unsigned old = xb_add(&bar[XB_XSUB(b.x)], 1u);
        const unsigned gen = old / nloc;
        if (old + 1u == (gen + 1u) * nloc) {
            __builtin_amdgcn_fence(__ATOMIC_RELEASE, "agent");
            asm volatile("s_waitcnt vmcnt(0)" ::: "memory");
            const unsigned og = xb_add(&bar[XB_TOP], 1u);
            const unsigned tg = og / nx;
            if (og + 1u == (tg + 1u) * nx) xb_add(&bar[XB_TOPGEN], 1u);
            else XB_SPIN(xb_ld(&bar[XB_TOPGEN]) == tg, bar);
            __builtin_amdgcn_fence(__ATOMIC_ACQUIRE, "agent");
            xb_add(&bar[XB_XGEN(b.x)], 1u);
            asm volatile("s_waitcnt vmcnt(0)" ::: "memory");
        } else {
            XB_SPIN(xb_ld(&bar[XB_XGEN(b.x)]) == gen, bar);
            __builtin_amdgcn_fence(__ATOMIC_ACQUIRE, "agent");
            asm volatile("s_waitcnt vmcnt(0)" ::: "memory");
        }
    }
    __syncthreads();
}

struct Frame {
    LAS unsigned char* lds;
    int tid, lane, wave, G, bid;
    const float *x, *c, *w_ada, *b_ada, *norm1_g, *w_in, *q_norm_g, *k_norm_g, *w_pool, *pool_scale, *w_out, *norm2_g, *w_grp, *w_exp, *w1, *w3, *w2;
    float* out;
    unsigned* ctl;
    float* ADA; float* ADAP; float* TAB; bf16_t* WR; int* TOKE; float* TOKW; int* ROWTOK; float* ROWW; float* WI; bf16_t* KI;
    bf16_t *WPOOL, *WOUT, *WIN, *W13, *W2, *H, *PROJ; unsigned short* SC; bf16_t *QB, *KV, *QI, *PM, *ACT, *CONCAT; unsigned short* SEL;
};

namespace pg8 {
constexpr int BM = 256, BK = 64, HALF = 128, HTB = HALF * BK * 2, STAGE_BYTES = 8 * HTB, NXCD = 8, WGM = 8;
__device__ __forceinline__ int lds_byte(int r, int c) { const int st = (r >> 4) * 2 + (c >> 5), rr = r & 15, cc = c & 31, ob = rr * 64 + cc * 2; return st * 1024 + (ob ^ (((ob >> 9) & 1) << 5)); }
__device__ __forceinline__ void stage_rc(int b, int& R, int& C) { const int st = b / 1024, sb = b % 1024, swz = sb ^ (((sb >> 9) & 1) << 5); R = (st >> 1) * 16 + swz / 64; C = (st & 1) * 32 + (swz % 64) / 2; }
__device__ __forceinline__ int perm32(int rho) { const int n = rho >> 4, i = rho & 15; return 8 * (i >> 2) + 4 * n + (i & 3); }
struct Unit { int pm, pn; };
struct Gemm { const bf16_t* A; const bf16_t* Bt; int K; };

struct StaticOrder {
    int nM, nN, nwg, G, c, rep;
    __device__ void init(int M, int N, int G_, int c_, int rep_ = 1) { nM = M / BM; nN = N / BM; nwg = nM * nN; G = G_; c = c_; rep = rep_; }
    __device__ bool next(int i, Unit& u) const {
        long L = (long)i * G + c; if (L >= (long)nwg * rep) return false;
        if (L >= nwg) L -= nwg;
        int wgid = (int)L; { const int q = nwg / NXCD, r = nwg % NXCD, xcd = wgid % NXCD, off = wgid / NXCD; wgid = (xcd < r ? xcd * (q + 1) : r * (q + 1) + (xcd - r) * q) + off; }
        const int nig = WGM * nN, gid = wgid / nig, fm = gid * WGM, gsz = (nM - fm) < WGM ? (nM - fm) : WGM;
        u.pm = fm + ((wgid % nig) % gsz); u.pn = (wgid % nig) / gsz; return true;
    }
    __device__ __forceinline__ unsigned arow(const Unit& u, int rr) const { return (unsigned)(u.pm * BM + rr); }
};
struct PoolOrder {
    int G, c;
    __device__ bool next(int i, Unit& u) const { const int L = i * G + c; if (L >= 512) return false; u.pm = L; u.pn = L >> 7; return true; }
    __device__ __forceinline__ unsigned arow(const Unit& u, int rr) const { return (unsigned)(u.pm * BM + rr); }
};
template <int NC, bool GATHER> struct MoeOrder {
    const int* tileb; const int* rowtok; int lo, hi, G, c, rep;
    __device__ bool next(int i, Unit& u) const {
        int L = i * G + c; if (L >= (hi - lo) * NC * rep) return false;
        if (L >= (hi - lo) * NC) L -= (hi - lo) * NC;
        u.pm = lo + L / NC; const int e = tileb[u.pm] & 31; u.pn = e * NC + (L % NC); return true;
    }
    __device__ __forceinline__ unsigned arow(const Unit& u, int rr) const {
        if (GATHER) { const int tok = rowtok[u.pm * BM + rr]; return (unsigned)(tok < 0 ? 0 : tok); }
        return (unsigned)(u.pm * BM + rr);
    }
};

template <class Epi, class Sched>
__device__ __forceinline__ void gemm_phase(LAS unsigned char* lds, const Gemm g, const Sched& S, const Epi& E, const int tid) {
    const int wid = __builtin_amdgcn_readfirstlane(tid >> 6), lane = tid & 63, wr = wid >> 2, wc = wid & 3, fr = lane & 15, fq = lane >> 4;
    const int K = g.K, nt = K / BK;
    int R0, C0; stage_rc(tid * 16, R0, C0);
    unsigned voffB[2];
#pragma unroll
    for (int i = 0; i < 2; ++i) { const int R = R0 + 64 * i; const int Rb = Epi::PERM ? ((R & ~31) + perm32(R & 31)) : R; voffB[i] = (unsigned)(Rb * K + C0) * 2u; }
    const unsigned rowb = (unsigned)K * 2u, colb = (unsigned)C0 * 2u;
    const size_t kstep = (size_t)(BK * 2);
    const size_t hstep = (size_t)HALF * K * 2;
    const size_t tstep = 2 * hstep;
    const unsigned ldsw = (unsigned)wid * 1024u;
    const int aoff = lds_byte(wr * 64 + fr, fq * 8), boff = lds_byte(wc * 32 + fr, fq * 8);
#define PG8_SA(b, h) (((b) * 2 + (h)) * HTB)
#define PG8_SB(b, h) ((4 + (b) * 2 + (h)) * HTB)
#define PG8_STAGE(bufoff, gbase, voff) do { _Pragma("unroll") for (int _i = 0; _i < 2; ++_i) \
        __builtin_amdgcn_global_load_lds((const unsigned*)((const char*)(gbase) + (voff)[_i]), (LAS unsigned*)(lds + (bufoff) + ldsw + _i * 8192), 16, 0, 0); } while (0)
#define PG8_LDA(dst, b, h) do { _Pragma("unroll") for (int m = 0; m < 4; ++m) _Pragma("unroll") for (int k = 0; k < 2; ++k) dst[m][k] = *(const LAS bf16x8*)(lds + PG8_SA(b, h) + aoff + m * 2048 + k * 1024); } while (0)
#define PG8_LDB(dst, b, h) do { _Pragma("unroll") for (int n = 0; n < 2; ++n) _Pragma("unroll") for (int k = 0; k < 2; ++k) dst[n][k] = *(const LAS bf16x8*)(lds + PG8_SB(b, h) + boff + n * 2048 + k * 1024); } while (0)
#define PG8_MMA(ai, bj, At, Bt) do { __builtin_amdgcn_s_setprio(1); _Pragma("unroll") for (int m = 0; m < 4; ++m) _Pragma("unroll") for (int n = 0; n < 2; ++n) _Pragma("unroll") for (int k = 0; k < 2; ++k) \
        acc[ai][bj][m][n] = __builtin_amdgcn_mfma_f32_16x16x32_bf16(Bt[n][k], At[m][k], acc[ai][bj][m][n], 0, 0, 0); __builtin_amdgcn_s_setprio(0); } while (0)
#define PG8_WAIT_V(n) asm volatile("s_waitcnt vmcnt(" #n ")" ::: "memory")
#define PG8_WAIT_L(n) asm volatile("s_waitcnt lgkmcnt(" #n ")" ::: "memory")
#define PG8_BAR __builtin_amdgcn_s_barrier()
#define PG8_SCHED __builtin_amdgcn_sched_barrier(0)
#define PG8_ROWS(dst, u) do { _Pragma("unroll") for (int _h = 0; _h < 2; ++_h) _Pragma("unroll") for (int _i = 0; _i < 2; ++_i) dst[_h][_i] = S.arow(u, _h * HALF + R0 + 64 * _i) * rowb + colb; } while (0)
    Unit cur, nxt; int ui = 0;
    if (!S.next(0, cur)) return;
    f32x4 acc[2][2][4][2];
#pragma unroll
    for (int a = 0; a < 2; ++a)
#pragma unroll
        for (int b = 0; b < 2; ++b)
#pragma unroll
            for (int m = 0; m < 4; ++m)
#pragma unroll
                for (int n = 0; n < 2; ++n) acc[a][b][m][n] = (f32x4){0.f, 0.f, 0.f, 0.f};
    bf16x8 At[4][2], B0[2][2], B1[2][2];
    unsigned oc[2][2], on[2][2];
    PG8_ROWS(oc, cur);
    const char* gA = (const char*)g.A;
    const char* cB = (const char*)g.Bt + (size_t)cur.pn * tstep;
    PG8_STAGE(PG8_SB(0, 0), cB, voffB); PG8_STAGE(PG8_SA(0, 0), gA, oc[0]); PG8_STAGE(PG8_SB(0, 1), cB + hstep, voffB); PG8_STAGE(PG8_SA(0, 1), gA, oc[1]);
    if (wr == 1) PG8_BAR;
    PG8_WAIT_V(4); PG8_BAR;
    PG8_STAGE(PG8_SB(1, 0), cB + kstep, voffB); PG8_STAGE(PG8_SA(1, 0), gA + kstep, oc[0]); PG8_STAGE(PG8_SB(1, 1), cB + hstep + kstep, voffB);
    PG8_WAIT_V(6); PG8_BAR;
    const int tpre = nt >= 4 ? nt - 4 : nt - 2;
    for (;;) {
        const bool has_next = S.next(ui + 1, nxt);
#pragma unroll
        for (int h = 0; h < 2; ++h)
#pragma unroll
            for (int i = 0; i < 2; ++i) on[h][i] = oc[h][i];
        const char* nB = has_next ? (const char*)g.Bt + (size_t)nxt.pn * tstep : cB;
        for (int t = 0; t < nt; t += 2) {
            const bool last = (t == nt - 2);
            if (has_next && t == tpre) PG8_ROWS(on, nxt);
            const char* a1 = gA + (size_t)(t + 1) * kstep;
            const char* a2 = last ? gA : gA + (size_t)(t + 2) * kstep; const char* b2 = last ? nB : cB + (size_t)(t + 2) * kstep;
            const char* a3 = a2 + kstep; const char* b3 = b2 + kstep;
            unsigned o2[2][2];
#pragma unroll
            for (int h = 0; h < 2; ++h)
#pragma unroll
                for (int i = 0; i < 2; ++i) o2[h][i] = last ? on[h][i] : oc[h][i];
            PG8_LDB(B0, 0, 0); PG8_SCHED; PG8_LDA(At, 0, 0); PG8_STAGE(PG8_SA(1, 1), a1, oc[1]);
            PG8_WAIT_L(8); PG8_BAR; PG8_WAIT_L(0); PG8_MMA(0, 0, At, B0); PG8_BAR; PG8_SCHED;
            PG8_LDB(B1, 0, 1); PG8_STAGE(PG8_SB(0, 0), b2, voffB);
            PG8_BAR; PG8_WAIT_L(0); PG8_MMA(0, 1, At, B1); PG8_BAR;
            PG8_LDA(At, 0, 1); PG8_STAGE(PG8_SA(0, 0), a2, o2[0]);
            PG8_BAR; PG8_WAIT_L(0); PG8_MMA(1, 0, At, B0); PG8_BAR; PG8_SCHED;
            PG8_STAGE(PG8_SB(0, 1), b2 + hstep, voffB);
            PG8_WAIT_V(6); PG8_BAR; PG8_MMA(1, 1, At, B1); PG8_BAR;
            PG8_LDB(B0, 1, 0); PG8_SCHED; PG8_LDA(At, 1, 0); PG8_STAGE(PG8_SA(0, 1), a2, o2[1]);
            PG8_WAIT_L(8); PG8_BAR; PG8_WAIT_L(0); PG8_MMA(0, 0, At, B0); PG8_BAR; PG8_SCHED;
            PG8_LDB(B1, 1, 1); PG8_STAGE(PG8_SB(1, 0), b3, voffB);
            PG8_BAR; PG8_WAIT_L(0); PG8_MMA(0, 1, At, B1); PG8_BAR;
            PG8_LDA(At, 1, 1); PG8_STAGE(PG8_SA(1, 0), a3, o2[0]);
            PG8_BAR; PG8_WAIT_L(0); PG8_MMA(1, 0, At, B0); PG8_BAR; PG8_SCHED;
            PG8_STAGE(PG8_SB(1, 1), b3 + hstep, voffB);
            PG8_WAIT_V(6); PG8_BAR; PG8_MMA(1, 1, At, B1); PG8_BAR;
        }
        E(acc, cur, wr, wc, fr, fq);
        if (!has_next) break;
#pragma unroll
        for (int a = 0; a < 2; ++a)
#pragma unroll
            for (int b = 0; b < 2; ++b)
#pragma unroll
                for (int m = 0; m < 4; ++m)
#pragma unroll
                    for (int n = 0; n < 2; ++n) acc[a][b][m][n] = (f32x4){0.f, 0.f, 0.f, 0.f};
        cur = nxt; cB = nB; ++ui;
#pragma unroll
        for (int h = 0; h < 2; ++h)
#pragma unroll
            for (int i = 0; i < 2; ++i) oc[h][i] = on[h][i];
    }
    PG8_WAIT_V(0);
    if (wr == 0) PG8_BAR;
    PG8_BAR;
#undef PG8_SA
#undef PG8_SB
#undef PG8_STAGE
#undef PG8_LDA
#undef PG8_LDB
#undef PG8_MMA
#undef PG8_WAIT_V
#undef PG8_WAIT_L
#undef PG8_BAR
#undef PG8_SCHED
#undef PG8_ROWS
}

struct EpiBf16 {
    static constexpr bool PERM = true;
    bf16_t* O; int ldc; int mode;
    __device__ __forceinline__ void operator()(const f32x4 (&acc)[2][2][4][2], const Unit& u, int wr, int wc, int fr, int fq) const {
        const int rowb = (mode == 1 ? (u.pm & 127) : u.pm) * BM, colb = (mode == 1 ? 1024 : 0) + u.pn * BM;
        const int row0 = rowb + wr * 64 + fr, col0 = colb + wc * 32 + 8 * fq;
#pragma unroll
        for (int ai = 0; ai < 2; ++ai)
#pragma unroll
            for (int m = 0; m < 4; ++m) { bf16_t* rowp = O + (size_t)(row0 + ai * HALF + m * 16) * ldc + col0;
#pragma unroll
                for (int bj = 0; bj < 2; ++bj) { const f32x4 v0 = acc[ai][bj][m][0], v1 = acc[ai][bj][m][1];
                    u32x4 w; w.x = pk_bf16(v0[0], v0[1]); w.y = pk_bf16(v0[2], v0[3]); w.z = pk_bf16(v1[0], v1[1]); w.w = pk_bf16(v1[2], v1[3]);
                    *(u32x4*)(rowp + bj * HALF) = w; } }
    }
};
struct EpiMix {
    static constexpr bool PERM = false;
    const float* x; const float* ada; float* out;
    __device__ __forceinline__ void operator()(const f32x4 (&acc)[2][2][4][2], const Unit& u, int wr, int wc, int fr, int fq) const {
        const int row0 = u.pm * BM + wr * 64 + fr, col0 = u.pn * BM + wc * 32 + 4 * fq;
        const float* gate = ada + (size_t)(u.pm >> 5) * 12288 + 2 * 2048;
        f32x4 gv[2][2];
#pragma unroll
        for (int bj = 0; bj < 2; ++bj)
#pragma unroll
            for (int n = 0; n < 2; ++n) gv[bj][n] = *(const f32x4*)(gate + col0 + bj * HALF + n * 16);
#pragma unroll
        for (int ai = 0; ai < 2; ++ai)
#pragma unroll
            for (int m = 0; m < 4; ++m) { const size_t ro = (size_t)(row0 + ai * HALF + m * 16) * D + col0;
#pragma unroll
                for (int bj = 0; bj < 2; ++bj)
#pragma unroll
                    for (int n = 0; n < 2; ++n) { const f32x4 xv = *(const f32x4*)(x + ro + bj * HALF + n * 16); *(f32x4*)(out + ro + bj * HALF + n * 16) = xv + gv[bj][n] * acc[ai][bj][m][n]; } }
    }
};
struct EpiAct {
    static constexpr bool PERM = true;
    bf16_t* ACT;
    __device__ __forceinline__ void operator()(const f32x4 (&acc)[2][2][4][2], const Unit& u, int wr, int wc, int fr, int fq) const {
        const int row0 = u.pm * BM + wr * 64 + fr, col0 = (u.pn & 3) * 128 + wc * 32 + 8 * fq;
#pragma unroll
        for (int ai = 0; ai < 2; ++ai)
#pragma unroll
            for (int m = 0; m < 4; ++m) {
                float v[8];
#pragma unroll
                for (int n = 0; n < 2; ++n)
#pragma unroll
                    for (int e = 0; e < 4; ++e) { const float a = acc[ai][0][m][n][e], b = acc[ai][1][m][n][e]; v[n * 4 + e] = a / (1.0f + __expf(-a)) * b; }
                *(u32x4*)(ACT + (size_t)(row0 + ai * HALF + m * 16) * 512 + col0) = pack8(v);
            }
    }
};
struct EpiMoeOut {
    static constexpr bool PERM = false;
    const int* rowtok; const float* roww; const float* ada; float* out;
    __device__ __forceinline__ void operator()(const f32x4 (&acc)[2][2][4][2], const Unit& u, int wr, int wc, int fr, int fq) const {
        const int row0 = u.pm * BM + wr * 64 + fr, col0 = (u.pn & 7) * BM + wc * 32 + 4 * fq;
#pragma unroll
        for (int ai = 0; ai < 2; ++ai)
#pragma unroll
            for (int m = 0; m < 4; ++m) { const int row = row0 + ai * HALF + m * 16; const int tok = rowtok[row];
                if (tok >= 0) { const float w = roww[row]; const float* gate = ada + (size_t)(tok >> 13) * 12288 + 5 * 2048 + col0; float* op = out + (size_t)tok * D + col0;
#pragma unroll
                    for (int bj = 0; bj < 2; ++bj)
#pragma unroll
                        for (int n = 0; n < 2; ++n) { const f32x4 gvv = *(const f32x4*)(gate + bj * HALF + n * 16); f32x4 o = *(f32x4*)(op + bj * HALF + n * 16); o += gvv * w * acc[ai][bj][m][n]; *(f32x4*)(op + bj * HALF + n * 16) = o; } } }
    }
};
}

__device__ __forceinline__ int colmap(int n) { return n < 2560 ? n : (n < 2624 ? 3584 + (n - 2560) : (n < 2640 ? 3648 + (n - 2624) : 2560 + (n - 2640))); }

template <class RowMap>
__device__ __forceinline__ void tr_tile(const Frame& F, const float* src, size_t ldS, int k0, int n0, int N, const float* cscale, RowMap rm) {
    LAS float* tile = (LAS float*)F.lds;
    const int tid = F.tid, r = tid >> 4, c4 = tid & 15;
    f32x4 v[4];
    const int n = n0 + c4 * 4;
#pragma unroll
    for (int i = 0; i < 4; ++i) v[i] = (n < N) ? *(const f32x4*)(src + (size_t)(k0 + r + 32 * i) * ldS + n) : (f32x4){0.f, 0.f, 0.f, 0.f};
    __syncthreads();
#pragma unroll
    for (int i = 0; i < 4; ++i)
#pragma unroll
        for (int e = 0; e < 4; ++e) tile[(r + 32 * i) * 65 + c4 * 4 + e] = v[i][e];
    __syncthreads();
    const int nn = tid >> 3, kc = tid & 7;
    if (n0 + nn < N) {
        const float sc = cscale ? cscale[n0 + nn] : 1.0f;
        float f[16];
#pragma unroll
        for (int j = 0; j < 16; ++j) f[j] = tile[(kc * 16 + j) * 65 + nn] * sc;
        bf16_t* d = rm(n0 + nn) + k0 + kc * 16;
        *(u32x4*)d = pack8(f); *(u32x4*)(d + 8) = pack8(f + 8);
    }
}

__device__ __forceinline__ void p0_prologue(const Frame& F) {
    constexpr int U_ADA = 192, T_WIN = 16 * 58, T_WOUT = 16 * 32, T_POOL = 4 * 2 * 4, T_W1 = 32 * 128, T_W2 = 32 * 128, U_TAB = 16, U_WR = 4, U_PAD = 2;
    constexpr int B0 = U_ADA, B1 = B0 + T_WIN, B2 = B1 + T_WOUT, B3 = B2 + T_POOL, B4 = B3 + T_W1, B5 = B4 + T_W1, B6 = B5 + T_W2, B7 = B6 + U_TAB, B8 = B7 + U_WR, B9 = B8 + U_PAD;
    const int tid = F.tid;
    constexpr int NTILE = B6 - B0;
    static_assert(NTILE == 13760, "tile split");
    const int nmine = 1 + 50 + (F.bid >= 192 ? 15 : 0);
    for (int it = 0; it < nmine; ++it) {
        int u;
        if (it == 0) { u = F.bid < 192 ? F.bid : (F.bid - 192 < 22 ? B6 + (F.bid - 192) : -1); if (u < 0) continue; }
        else if (it <= 50) u = B0 + F.bid + 256 * (it - 1);
        else u = B0 + 12800 + (F.bid - 192) + 64 * (it - 51);
        if (u < B0) {
            const int kc = u / 6, cb = u % 6;
            LAS float* sc = (LAS float*)F.lds;
            __syncthreads();
            if (tid < 256) { const int b = tid >> 6, k = tid & 63; const float cv = F.c[b * D + kc * 64 + k]; sc[tid] = cv / (1.0f + __expf(-cv)); }
            __syncthreads();
            const int n = cb * 2048 + tid * 4;
            f32x4 a[4];
#pragma unroll
            for (int b = 0; b < 4; ++b) a[b] = (f32x4){0.f, 0.f, 0.f, 0.f};
            const float* wp = F.w_ada + (size_t)(kc * 64) * 12288 + n;
#pragma unroll 8
            for (int k = 0; k < 64; ++k) { const f32x4 w = *(const f32x4*)(wp + (size_t)k * 12288);
#pragma unroll
                for (int b = 0; b < 4; ++b) a[b] += sc[b * 64 + k] * w; }
            const f32x4 bias = (kc == 0) ? *(const f32x4*)(F.b_ada + n) : (f32x4){0.f, 0.f, 0.f, 0.f};
#pragma unroll
            for (int b = 0; b < 4; ++b) *(f32x4*)(F.ADAP + ((size_t)kc * 4 + b) * 12288 + n) = a[b] + bias;
        } else if (u < B1) {
            const int v = u - B0, kt = v / 58, ntl = v % 58; bf16_t* W = F.WIN;
            tr_tile(F, F.w_in, 3664, kt * 128, ntl * 64, 3664, nullptr, [=](int n) { return W + (size_t)colmap(n) * 2048; });
        } else if (u < B2) {
            const int v = u - B1, kt = v / 32, ntl = v % 32; bf16_t* W = F.WOUT;
            tr_tile(F, F.w_out, 2048, kt * 128, ntl * 64, 2048, nullptr, [=](int n) { return W + (size_t)n * 2048; });
        } else if (u < B3) {
            const int v = u - B2, g = v / 8, kt = (v % 8) / 4, ntl = v % 4; bf16_t* W = F.WPOOL + (size_t)g * 256 * 256;
            tr_tile(F, F.w_pool + (size_t)g * 65536, 256, kt * 128, ntl * 64, 256, F.pool_scale + g * 256, [=](int n) { return W + (size_t)n * 256; });
        } else if (u < B5) {
            const bool is3 = u >= B4; const int v = u - (is3 ? B4 : B3), e = v / 128, kt = (v % 128) / 8, ntl = v % 8;
            bf16_t* W = F.W13 + (size_t)e * 1024 * 2048 + (is3 ? (size_t)128 * 2048 : 0);
            tr_tile(F, (is3 ? F.w3 : F.w1) + (size_t)e * 2048 * 512, 512, kt * 128, ntl * 64, 512, nullptr, [=](int n) { return W + (size_t)((n >> 7) * 256 + (n & 127)) * 2048; });
        } else if (u < B6) {
            const int v = u - B5, e = v / 128, kt = (v % 128) / 32, ntl = v % 32; bf16_t* W = F.W2 + (size_t)e * 2048 * 512;
            tr_tile(F, F.w2 + (size_t)e * 512 * 2048, 2048, kt * 128, ntl * 64, 2048, nullptr, [=](int n) { return W + (size_t)n * 512; });
        } else if (u < B7) {
            const int pos = (u - B6) * 512 + tid; float* tp = F.TAB + (size_t)pos * 48;
            for (int i = 0; i < 16; ++i) { const double inv = pow(500000.0, -(double)(2 * i) / 32.0); double sn, cs; sincos((double)pos * inv, &sn, &cs); tp[i] = (float)cs; tp[16 + i] = (float)sn; }
            for (int i = 0; i < 8; ++i) { const double inv = pow(500000.0, -(double)(2 * i) / 16.0); double sn, cs; sincos((double)pos * inv, &sn, &cs); tp[32 + i] = (float)cs; tp[40 + i] = (float)sn; }
        } else if (u < B8) {
            const int j0 = (u - B7) * 12;
            for (int idx = tid; idx < 12 * 2048; idx += NTHREADS) { const int j = j0 + idx / 2048, k = idx % 2048;
                const float v = j < 4 ? F.w_grp[k * 4 + j] : (j < 36 ? F.w_exp[k * 32 + (j - 4)] : 0.f);
                bf16v2 t; t.x = (__bf16)v; t.y = (__bf16)0.f; F.WR[(size_t)j * 2048 + k] = (bf16_t)(__builtin_bit_cast(unsigned, t) & 0xffffu); }
        } else {
            const int h = u - B8; u32x4* p = (u32x4*)(F.WIN + (size_t)3664 * 2048) + (size_t)h * 22528;
            for (int i = tid; i < 22528; i += NTHREADS) p[i] = (u32x4){0u, 0u, 0u, 0u};
        }
    }
}

__device__ __forceinline__ size_t qi_off(size_t t, int head, int d) { return (t >> 1) * 2048 + (size_t)((d >> 4) * 512 + (((head & 3) + 4 * (int)(t & 1) + 8 * (head >> 2)) + 32 * ((d >> 3) & 1)) * 8 + (d & 7)); }
__device__ __forceinline__ size_t ki_off(size_t s, int d) { const int kin = (int)(s & 127); return (s >> 7) * 8192 + (size_t)(((kin & 3) * 4 + (d >> 4)) * 512 + ((kin >> 2) + 32 * ((d >> 3) & 1)) * 8 + (d & 7)); }

__device__ __forceinline__ void norm_rows(const Frame& F, const float* src, const float* gain, const float* shiftp, const float* scalep) {
    const int lane = F.lane;
    f32x4 Gv[8], Sv[8];
#pragma unroll
    for (int i = 0; i < 8; ++i) { const int col = 4 * lane + 256 * i; const f32x4 g = *(const f32x4*)(gain + col), sc = *(const f32x4*)(scalep + col);
        Gv[i] = g * (1.0f + sc); Sv[i] = *(const f32x4*)(shiftp + col); }
    f32x4 v[8], vn[8];
    { const float* xr = src + (size_t)(F.bid * 128 + F.wave) * D;
#pragma unroll
      for (int i = 0; i < 8; ++i) v[i] = *(const f32x4*)(xr + 4 * lane + 256 * i); }
    for (int j = 0; j < 16; ++j) {
        const int t = F.bid * 128 + F.wave + 8 * j;
        if (j < 15) { const float* xn = src + (size_t)(t + 8) * D;
#pragma unroll
            for (int i = 0; i < 8; ++i) vn[i] = *(const f32x4*)(xn + 4 * lane + 256 * i); }
        float ss = 0.f;
#pragma unroll
        for (int i = 0; i < 8; ++i) ss += v[i][0] * v[i][0] + v[i][1] * v[i][1] + v[i][2] * v[i][2] + v[i][3] * v[i][3];
        ss = wave_sum(ss);
        const float rstd = rsqrtf(ss * (1.0f / 2048.0f) + NORM_EPS);
        bf16_t* hr = F.H + (size_t)t * D;
#pragma unroll
        for (int i = 0; i < 8; ++i) { const f32x4 y = v[i] * rstd * Gv[i] + Sv[i]; u32x2 w; w.x = pk_bf16(y[0], y[1]); w.y = pk_bf16(y[2], y[3]); *(u32x2*)(hr + 4 * lane + 256 * i) = w; }
        if (j < 15) {
#pragma unroll
            for (int i = 0; i < 8; ++i) v[i] = vn[i]; }
    }
}

__device__ __forceinline__ void p3_post(const Frame& F) {
    const int lane = F.lane;
    const float QSCALE = 0.08838834764831845f * 1.4426950408889634f;
    const float IDX_SCALE = 0.125f * 0.25f;
    for (int j = 0; j < 16; ++j) {
        const int t = F.bid * 128 + F.wave + 8 * j, pos = t & (S - 1);
        const bf16_t* pr = F.PROJ + (size_t)t * NPROJ;
        const float* tab = F.TAB + (size_t)pos * 48;
        const int gpl = lane >> 4, wpl = 2 << gpl;
        const u32x4 Lq0 = *(const u32x4*)(pr + CQ + 16 * lane), Lq1 = *(const u32x4*)(pr + CQ + 16 * lane + 8);
        const u32x4 Lk0 = *(const u32x4*)(pr + CK + 16 * (lane & 31)), Lk1 = *(const u32x4*)(pr + CK + 16 * (lane & 31) + 8);
        const u32x4 Li0 = *(const u32x4*)(pr + CQI + 16 * lane), Li1 = *(const u32x4*)(pr + CQI + 16 * lane + 8);
        const u32x4 Lw0 = *(const u32x4*)(pr + CKI + 16 * (lane & 7)), Lw1 = *(const u32x4*)(pr + CKI + 16 * (lane & 7) + 8);
        const u32x4 Lp0 = *(const u32x4*)(pr + CP + 16 * lane), Lp1 = *(const u32x4*)(pr + CP + 16 * lane + 8);
        u32x4 wl[15][2];
#pragma unroll
        for (int r = 1; r < 16; ++r) { int rr = r < wpl ? r : wpl - 1; rr = rr <= pos ? rr : pos; const bf16_t* pp = pr - (size_t)rr * NPROJ + CP + 16 * lane; wl[r - 1][0] = *(const u32x4*)pp; wl[r - 1][1] = *(const u32x4*)(pp + 8); }
        {
            float f[16]; unpack8(Lq0, f); unpack8(Lq1, f + 8);
            float ss = 0.f;
#pragma unroll
            for (int e = 0; e < 16; ++e) ss += f[e] * f[e];
            ss += __shfl_xor(ss, 1); ss += __shfl_xor(ss, 2); ss += __shfl_xor(ss, 4);
            const float rstd = rsqrtf(ss * (1.0f / 128.0f) + NORM_EPS);
            const int d0 = (lane & 7) * 16;
#pragma unroll
            for (int e = 0; e < 16; ++e) f[e] = f[e] * rstd * F.q_norm_g[d0 + e];
            float o[16];
#pragma unroll
            for (int e = 0; e < 16; ++e) o[e] = __shfl_xor(f[e], 1);
            const int l8 = lane & 7;
            if (l8 < 2) {
#pragma unroll
                for (int e = 0; e < 16; ++e) { const float cs = tab[e], sn = tab[16 + e]; f[e] = (l8 == 0) ? (f[e] * cs - o[e] * sn) : (f[e] * cs + o[e] * sn); }
            }
#pragma unroll
            for (int e = 0; e < 16; ++e) f[e] *= QSCALE;
            bf16_t* qo = F.QB + (size_t)t * 1024 + 16 * lane;
            *(u32x4*)qo = pack8(f); *(u32x4*)(qo + 8) = pack8(f + 8);
        }
        {
            const int l = lane & 31;
            float f[16]; unpack8(Lk0, f); unpack8(Lk1, f + 8);
            float kf[16]; float ss = 0.f;
#pragma unroll
            for (int e = 0; e < 16; ++e) ss += f[e] * f[e];
            ss += __shfl_xor(ss, 1); ss += __shfl_xor(ss, 2); ss += __shfl_xor(ss, 4);
            const float rstd = rsqrtf(ss * (1.0f / 128.0f) + NORM_EPS);
            const int d0 = (l & 7) * 16;
#pragma unroll
            for (int e = 0; e < 16; ++e) kf[e] = f[e] * rstd * F.k_norm_g[d0 + e];
            float o[16];
#pragma unroll
            for (int e = 0; e < 16; ++e) o[e] = __shfl_xor(kf[e], 1);
            const int l8 = l & 7;
            if (l8 < 2) {
#pragma unroll
                for (int e = 0; e < 16; ++e) { const float cs = tab[e], sn = tab[16 + e]; kf[e] = (l8 == 0) ? (kf[e] * cs - o[e] * sn) : (kf[e] * cs + o[e] * sn); }
            }
            if (lane < 32) {
                const bool isv = lane >= 16; const int ll = lane & 15, g = ll >> 3, dd = (ll & 7) * 16;
                bf16_t* dst = F.KV + (size_t)t * 512 + g * 256 + (isv ? 128 : 0) + dd;
                *(u32x4*)dst = pack8(isv ? f : kf); *(u32x4*)(dst + 8) = pack8(isv ? f + 8 : kf + 8);
            }
        }
        {
            float f[16]; unpack8(Li0, f); unpack8(Li1, f + 8);
            if ((lane & 3) == 0) {
#pragma unroll
                for (int i = 0; i < 8; ++i) { const float cs = tab[32 + i], sn = tab[40 + i]; const float x1 = f[i], x2 = f[i + 8]; f[i] = x1 * cs - x2 * sn; f[i + 8] = x2 * cs + x1 * sn; }
            }
            const int hd = lane >> 2, d0 = (lane & 3) * 16;
            *(u32x4*)(F.QI + qi_off((size_t)t, hd, d0)) = pack8(f); *(u32x4*)(F.QI + qi_off((size_t)t, hd, d0 + 8)) = pack8(f + 8);
        }
        if (lane < 5) {
            float f[16]; unpack8(Lw0, f); unpack8(Lw1, f + 8);
            if (lane == 0) {
#pragma unroll
                for (int i = 0; i < 8; ++i) { const float cs = tab[32 + i], sn = tab[40 + i]; const float x1 = f[i], x2 = f[i + 8]; f[i] = x1 * cs - x2 * sn; f[i + 8] = x2 * cs + x1 * sn; }
            }
            if (lane < 4) { *(u32x4*)(F.KI + ki_off((size_t)t, 16 * lane)) = pack8(f); *(u32x4*)(F.KI + ki_off((size_t)t, 16 * lane + 8)) = pack8(f + 8); }
            else { float* wo = F.WI + (size_t)t * 16;
#pragma unroll
                for (int e = 0; e < 16; ++e) wo[e] = f[e] * IDX_SCALE; }
        }
        {
            const int g = lane >> 4, w = 2 << g;
            float cur[16], sum[16];
            unpack8(Lp0, cur); unpack8(Lp1, cur + 8);
#pragma unroll
            for (int e = 0; e < 16; ++e) sum[e] = cur[e];
#pragma unroll
            for (int r = 1; r < 16; ++r) {
                float f[16]; unpack8(wl[r - 1][0], f); unpack8(wl[r - 1][1], f + 8);
                const float use = (r < w && r <= pos) ? 1.0f : 0.0f;
#pragma unroll
                for (int e = 0; e < 16; ++e) sum[e] += use * f[e];
            }
            const float inv = 1.0f / (float)((pos + 1) < w ? (pos + 1) : w);
#pragma unroll
            for (int e = 0; e < 16; ++e) sum[e] = sum[e] * inv - cur[e];
            bf16_t* po = F.PM + ((size_t)g * T + t) * 256 + (lane & 15) * 16;
            *(u32x4*)po = pack8(sum); *(u32x4*)(po + 8) = pack8(sum + 8);
        }
    }
}

__device__ __forceinline__ size_t sc_block_base(int b, int qb) { return (size_t)b * SC_BATCH + (size_t)16384 * ((size_t)qb * (qb + 1) / 2); }

__device__ __forceinline__ void indexer_unit(const Frame& F, int b, int qb, int kb) {
    const int lane = F.lane, wid = F.wave, c = lane & 31, hf = lane >> 5;
    bf16x8 kf[4][4];
    const bf16_t* kib = F.KI + (((size_t)b * S + kb * 128) >> 7) * 8192 + lane * 8;
#pragma unroll
    for (int sub = 0; sub < 4; ++sub)
#pragma unroll
        for (int kk = 0; kk < 4; ++kk) kf[sub][kk] = *(const bf16x8*)(kib + (sub * 4 + kk) * 512);
    const int qq = (c >> 2) & 1, head = (c & 3) + 4 * (c >> 3);
    const size_t rowlen = (size_t)(qb + 1) * 128;
    unsigned short* scb = F.SC + sc_block_base(b, qb);
    const size_t tq0 = (size_t)b * S + qb * 128 + wid * 16;
    bf16x8 af[4], afn[4]; f32x4 wv[4], wvn[4];
#pragma unroll
    for (int kk = 0; kk < 4; ++kk) af[kk] = *(const bf16x8*)(F.QI + (tq0 >> 1) * 2048 + kk * 512 + lane * 8);
#pragma unroll
    for (int i = 0; i < 4; ++i) wv[i] = *(const f32x4*)(F.WI + (tq0 + hf) * 16 + 4 * i);
#pragma unroll
    for (int pair = 0; pair < 8; ++pair) {
        const int r0 = wid * 16 + pair * 2;
        if (pair < 7) {
#pragma unroll
            for (int kk = 0; kk < 4; ++kk) afn[kk] = *(const bf16x8*)(F.QI + ((tq0 >> 1) + pair + 1) * 2048 + kk * 512 + lane * 8);
#pragma unroll
            for (int i = 0; i < 4; ++i) wvn[i] = *(const f32x4*)(F.WI + (tq0 + 2 * (pair + 1) + hf) * 16 + 4 * i);
        }
        float sc[4];
#pragma unroll
        for (int sub = 0; sub < 4; ++sub) {
            f32x16 acc;
#pragma unroll
            for (int i = 0; i < 16; ++i) acc[i] = 0.f;
#pragma unroll
            for (int kk = 0; kk < 4; ++kk) acc = __builtin_amdgcn_mfma_f32_32x32x16_bf16(af[kk], kf[sub][kk], acc, 0, 0, 0);
            float s = 0.f;
#pragma unroll
            for (int i = 0; i < 16; ++i) { const float av = acc[i]; const int ai = __float_as_int(av); const float rl = __int_as_float(ai > 0 ? ai : 0); const float wi_ = wv[i >> 2][i & 3];
                asm("v_fmac_f32 %0, %1, %2" : "+v"(s) : "v"(wi_), "v"(rl)); }
            sc[sub] = s;
        }
        f16v2 h0, h1; h0.x = (_Float16)sc[0]; h0.y = (_Float16)sc[1]; h1.x = (_Float16)sc[2]; h1.y = (_Float16)sc[3];
        u32x2 w; w.x = __builtin_bit_cast(unsigned, h0); w.y = __builtin_bit_cast(unsigned, h1);
        *(u32x2*)(scb + (size_t)(r0 + hf) * rowlen + kb * 128 + 4 * c) = w;
        if (pair < 7) {
#pragma unroll
            for (int kk = 0; kk < 4; ++kk) af[kk] = afn[kk];
#pragma unroll
            for (int i = 0; i < 4; ++i) wv[i] = wvn[i];
        }
    }
}

__device__ __forceinline__ void find_bin(LAS unsigned* hist, int lane, unsigned need, unsigned& bin, unsigned& above) {
    const u32x4 h = *(const LAS u32x4*)(hist + 4 * lane);
    const unsigned s = h.x + h.y + h.z + h.w;
    unsigned v = s;
#pragma unroll
    for (int d = 1; d < 64; d <<= 1) { const unsigned tt = __shfl_down(v, d); if (lane + d < 64) v += tt; }
    unsigned run = v - s;
    int fb = -1; unsigned fa = 0;
    const unsigned hh[4] = {h.x, h.y, h.z, h.w};
#pragma unroll
    for (int j = 3; j >= 0; --j) { if (fb < 0 && run < need && run + hh[j] >= need) { fb = 4 * lane + j; fa = run; } run += hh[j]; }
    const unsigned long long m = __ballot(fb >= 0);
    const int src = m ? (int)__builtin_ctzll(m) : 0;
    bin = (unsigned)__shfl(fb, src); above = __shfl(fa, src);
}

__device__ __forceinline__ unsigned okey(unsigned h) { return (h & 0x8000u) ? (~h & 0xffffu) : (h | 0x8000u); }
__device__ __forceinline__ const unsigned short* sel_src(const Frame& F, int t) { const int pos = t & (S - 1), qb = pos >> 7; return F.SC + sc_block_base(t >> 13, qb) + (size_t)(pos & 127) * (qb + 1) * 128; }
__device__ __forceinline__ void select_row(const Frame& F, int t, const u32x4 (&pre)[16], LAS unsigned char* wbuf, int lane) {
    LAS unsigned* rowb = (LAS unsigned*)wbuf;
    LAS unsigned* hist = (LAS unsigned*)(wbuf + 16384);
    LAS unsigned short* lst = (LAS unsigned short*)(wbuf + 16384 + 1024);
    const int pos = t & (S - 1), n = pos + 1;
    unsigned short* out = F.SEL + (size_t)t * 256;
    if (n <= 256) { for (int j = lane; j < 256; j += 64) out[j] = (unsigned short)(j < n ? j : 0); return; }
    const int nch = (n + 511) >> 9;
#pragma unroll
    for (int ch = 0; ch < 16; ++ch) if (ch < nch) *(LAS u32x4*)(rowb + ch * 256 + lane * 4) = pre[ch];
#pragma unroll
    for (int i = 0; i < 4; ++i) hist[lane + 64 * i] = 0u;
    for (int ch = 0; ch < nch; ++ch) {
        const int base = ch * 512 + lane * 8;
        u32x4 raw = *(const LAS u32x4*)(rowb + ch * 256 + lane * 4);
#pragma unroll
        for (int w = 0; w < 4; ++w) {
            const unsigned k0 = (base + 2 * w < n) ? okey(raw[w] & 0xffffu) : 0u, k1 = (base + 2 * w + 1 < n) ? okey(raw[w] >> 16) : 0u;
            __hip_atomic_fetch_add(hist + (k0 >> 8), 1u, __ATOMIC_RELAXED, __HIP_MEMORY_SCOPE_WORKGROUP);
            __hip_atomic_fetch_add(hist + (k1 >> 8), 1u, __ATOMIC_RELAXED, __HIP_MEMORY_SCOPE_WORKGROUP);
            raw[w] = k0 | (k1 << 16);
        }
        *(LAS u32x4*)(rowb + ch * 256 + lane * 4) = raw;
    }
#if P5_PROBE == 1
    for (int ch = 0; ch < nch; ++ch) {
        const u32x4 raw = *(const LAS u32x4*)(rowb + ch * 256 + lane * 4);
#pragma unroll
        for (int w = 0; w < 4; ++w) {
            __hip_atomic_fetch_add(hist + ((raw[w] & 0xffffu) >> 8), 0u, __ATOMIC_RELAXED, __HIP_MEMORY_SCOPE_WORKGROUP);
            __hip_atomic_fetch_add(hist + (raw[w] >> 24), 0u, __ATOMIC_RELAXED, __HIP_MEMORY_SCOPE_WORKGROUP);
        }
    }
#endif
    unsigned bin1, above1; find_bin(hist, lane, 256u, bin1, above1);
    const unsigned r1 = 256u - above1;
#pragma unroll
    for (int i = 0; i < 4; ++i) hist[lane + 64 * i] = 0u;
    for (int ch = 0; ch < nch; ++ch) {
        const u32x4 raw = *(const LAS u32x4*)(rowb + ch * 256 + lane * 4);
#pragma unroll
        for (int w = 0; w < 4; ++w) {
            const unsigned k0 = raw[w] & 0xffffu, k1 = raw[w] >> 16;
            if ((k0 >> 8) == bin1) __hip_atomic_fetch_add(hist + (k0 & 255u), 1u, __ATOMIC_RELAXED, __HIP_MEMORY_SCOPE_WORKGROUP);
            if ((k1 >> 8) == bin1) __hip_atomic_fetch_add(hist + (k1 & 255u), 1u, __ATOMIC_RELAXED, __HIP_MEMORY_SCOPE_WORKGROUP);
        }
    }
    unsigned bin2, above2; find_bin(hist, lane, r1, bin2, above2);
#if P5_PROBE == 4
    { unsigned bx, ax; find_bin(hist, lane, r1, bx, ax); if (bx != bin2) bin2 = bx; find_bin(hist, lane, r1, bx, ax); if (bx != bin2) bin2 = bx; }
#endif
    const unsigned r2 = r1 - above2, thr = (bin1 << 8) | bin2;
    unsigned cg = 0, ce = 0;
    for (int ch = 0; ch < nch; ++ch) {
        const u32x4 raw = *(const LAS u32x4*)(rowb + ch * 256 + lane * 4);
#pragma unroll
        for (int e = 0; e < 8; ++e) { const unsigned key = (raw[e >> 1] >> ((e & 1) * 16)) & 0xffffu; cg += (key > thr) ? 1u : 0u; ce += (key == thr) ? 1u : 0u; }
    }
#if P5_PROBE == 2
    { unsigned cg2 = 0, ce2 = 0;
      for (int ch = 0; ch < nch; ++ch) {
        const u32x4 raw = *(const LAS u32x4*)(rowb + ch * 256 + lane * 4);
#pragma unroll
        for (int e = 0; e < 8; ++e) { const unsigned key = (raw[e >> 1] >> ((e & 1) * 16)) & 0xffffu; cg2 += (key > thr + 1u) ? 1u : 0u; ce2 += (key == thr + 1u) ? 1u : 0u; }
      }
      if (cg2 + ce2 == 0xffffffffu) cg += 1u; }
#endif
    unsigned og = cg, oe = ce;
#pragma unroll
    for (int d = 1; d < 64; d <<= 1) { const unsigned tg = __shfl_up(og, d), te = __shfl_up(oe, d); if (lane >= d) { og += tg; oe += te; } }
    og -= cg; oe -= ce;
    const unsigned G = above1 + above2;
    for (int ch = 0; ch < nch; ++ch) {
        const u32x4 raw = *(const LAS u32x4*)(rowb + ch * 256 + lane * 4);
#pragma unroll
        for (int e = 0; e < 8; ++e) {
            const unsigned key = (raw[e >> 1] >> ((e & 1) * 16)) & 0xffffu;
            const unsigned short id = (unsigned short)(ch * 512 + lane * 8 + e);
            if (key > thr) { if (og < 256u) lst[og] = id; ++og; }
            if (key == thr) { if (oe < r2 && G + oe < 256u) lst[G + oe] = id; ++oe; }
        }
    }
    *(u32x2*)(out + 4 * lane) = *(const LAS u32x2*)(lst + 4 * lane);
}

__device__ __forceinline__ bf16x8 tr_read2(unsigned a0, unsigned a1) {
    s16x4 x, y;
    asm volatile("ds_read_b64_tr_b16 %0, %2\n\tds_read_b64_tr_b16 %1, %3\n\ts_waitcnt lgkmcnt(0)" : "=&v"(x), "=&v"(y) : "v"(a0), "v"(a1) : "memory");
    return (bf16x8){x[0], x[1], x[2], x[3], y[0], y[1], y[2], y[3]};
}

__device__ __forceinline__ void tr_read16(const unsigned (&va)[4], s16x4 (&r)[16]) {
    asm volatile(
        "ds_read_b64_tr_b16 %0, %16\n\tds_read_b64_tr_b16 %1, %16 offset:4096\n\tds_read_b64_tr_b16 %2, %17\n\tds_read_b64_tr_b16 %3, %17 offset:4096\n\t"
        "ds_read_b64_tr_b16 %4, %18\n\tds_read_b64_tr_b16 %5, %18 offset:4096\n\tds_read_b64_tr_b16 %6, %19\n\tds_read_b64_tr_b16 %7, %19 offset:4096\n\t"
        "ds_read_b64_tr_b16 %8, %16 offset:512\n\tds_read_b64_tr_b16 %9, %16 offset:4608\n\tds_read_b64_tr_b16 %10, %17 offset:512\n\tds_read_b64_tr_b16 %11, %17 offset:4608\n\t"
        "ds_read_b64_tr_b16 %12, %18 offset:512\n\tds_read_b64_tr_b16 %13, %18 offset:4608\n\tds_read_b64_tr_b16 %14, %19 offset:512\n\tds_read_b64_tr_b16 %15, %19 offset:4608\n\t"
        "s_waitcnt lgkmcnt(0)"
        : "=&v"(r[0]), "=&v"(r[1]), "=&v"(r[2]), "=&v"(r[3]), "=&v"(r[4]), "=&v"(r[5]), "=&v"(r[6]), "=&v"(r[7]),
          "=&v"(r[8]), "=&v"(r[9]), "=&v"(r[10]), "=&v"(r[11]), "=&v"(r[12]), "=&v"(r[13]), "=&v"(r[14]), "=&v"(r[15])
        : "v"(va[0]), "v"(va[1]), "v"(va[2]), "v"(va[3]) : "memory");
}
#define AT_WAITV(n) asm volatile("s_waitcnt vmcnt(" #n ")" ::: "memory")
__device__ __forceinline__ int rot_k(int p) { return ((p & 1) ? 3 : 1) + ((p >> 2) & 1) * 4; }
__device__ __forceinline__ void attn_items(const Frame& F, int klo, int khi) {
    const int lane = F.lane, li = lane & 15, q4 = lane >> 4;
    const int xg = F.bid & 7, b = xg >> 1, g = xg & 1;
    const int wq = (F.bid >> 3) * 8 + F.wave;
    LAS unsigned char* wb = F.lds + F.wave * 16384;
    const unsigned wbu = (unsigned)(uintptr_t)wb;
    const bf16_t* kvb = F.KV + (size_t)b * S * 512 + g * 256;
    const int da = lane >> 3, dr = lane & 7, drow = da & 3, dline = da >> 2;
    const int koff0 = 64 * dline + 8 * ((dr + rot_k(drow >> 1)) & 7);
    const int voff0 = 128 + 64 * dline + 8 * ((dr + 2 * (drow >> 1)) & 7);
    const unsigned kra0 = (unsigned)((li >> 2) * 1024 + (8 * (li & 3) + ((q4 - rot_k(li >> 1)) & 7)) * 16);
    const int vr4 = li >> 2, vp = li & 3;
    const unsigned vbase = wbu + (unsigned)(q4 * 1024 + 128 * vr4 + 8 * (vp & 1));
    const int vc = (vp >> 1) - 2 * ((2 * q4 + (vr4 >> 1)) & 3) + 8;
#define AT_KDMA(c) do { _Pragma("unroll") for (int _j = 0; _j < 4; ++_j) { const int _ix = (__shfl(idx2[(c) >> 1], 4 * _j + drow) >> (((c) & 1) * 16)) & 0xffff; \
        __builtin_amdgcn_global_load_lds((const unsigned*)((const char*)kvb + (unsigned)(_ix * 1024 + 2 * (koff0 ^ ((_j >> 1) * 32)))), (LAS unsigned*)(wb + ((c) & 3) * 4096 + _j * 1024), 16, 0, 0); } } while (0)
#define AT_VDMA(ks) do { _Pragma("unroll") for (int _j = 0; _j < 8; ++_j) { const int _ix = (__shfl(idx2[ks], 4 * (_j & 3) + drow) >> ((_j >> 2) * 16)) & 0xffff; \
        __builtin_amdgcn_global_load_lds((const unsigned*)((const char*)kvb + (unsigned)(_ix * 1024 + 2 * (voff0 ^ ((_j & 1) * 32)))), (LAS unsigned*)(wb + ((ks) & 1) * 8192 + _j * 1024), 16, 0, 0); } } while (0)
    for (int k = klo; k < khi; ++k) {
        const int pos = wq + 256 * k, t = b * S + pos, cnt = (pos + 1) < 256 ? (pos + 1) : 256;
        int idx2[8];
#pragma unroll
        for (int i = 0; i < 8; ++i) { const int s0 = 32 * i + li, s1 = s0 + 16; const int v0 = F.SEL[(size_t)t * 256 + s0], v1 = F.SEL[(size_t)t * 256 + s1]; idx2[i] = (s0 < cnt ? v0 : 0) | ((s1 < cnt ? v1 : 0) << 16); }
        bf16x8 bq[4];
#pragma unroll
        for (int kk = 0; kk < 4; ++kk) { bq[kk] = (bf16x8){0, 0, 0, 0, 0, 0, 0, 0}; if (li < 4) bq[kk] = *(const bf16x8*)(F.QB + (size_t)t * 1024 + (4 * g + li) * 128 + 32 * kk + 8 * q4); }
        AT_KDMA(0); AT_KDMA(1); AT_KDMA(2);
        f32x4 s[16];
#pragma unroll
        for (int c = 0; c < 16; ++c) {
            if (c <= 13) AT_WAITV(8); else if (c == 14) AT_WAITV(12); else AT_WAITV(8);
            f32x4 acc = (f32x4){0.f, 0.f, 0.f, 0.f};
            bf16x8 a[4];
#pragma unroll
            for (int kk = 0; kk < 4; ++kk) a[kk] = *(const LAS bf16x8*)(wb + (c & 3) * 4096 + (kk >> 1) * 512 + (kra0 ^ (unsigned)((kk & 1) * 64)));
#pragma unroll
            for (int kk = 0; kk < 4; ++kk) acc = __builtin_amdgcn_mfma_f32_16x16x32_bf16(a[kk], bq[kk], acc, 0, 0, 0);
            s[c] = acc;
            asm volatile("s_waitcnt lgkmcnt(0)" ::: "memory");
            if (c + 3 <= 15) AT_KDMA(c + 3);
            if (c == 13) AT_VDMA(0);
            if (c == 15) AT_VDMA(1);
            __builtin_amdgcn_sched_barrier(0);
        }
        float m = -INFINITY;
#pragma unroll
        for (int c = 0; c < 16; ++c)
#pragma unroll
            for (int i = 0; i < 4; ++i) { const int slot = c * 16 + 4 * q4 + i; if (slot >= cnt) s[c][i] = -INFINITY; m = fmaxf(m, s[c][i]); }
        m = fmaxf(m, __shfl_xor(m, 16)); m = fmaxf(m, __shfl_xor(m, 32));
        float sum = 0.f;
#pragma unroll
        for (int c = 0; c < 16; ++c)
#pragma unroll
            for (int i = 0; i < 4; ++i) { const float p = exp2f(s[c][i] - m); s[c][i] = p; sum += p; }
        sum += __shfl_xor(sum, 16); sum += __shfl_xor(sum, 32);
        f32x4 o[8];
#pragma unroll
        for (int d = 0; d < 8; ++d) o[d] = (f32x4){0.f, 0.f, 0.f, 0.f};
#pragma unroll
        for (int ks = 0; ks < 8; ++ks) {
            u32x4 pk; pk.x = pk_bf16(s[2 * ks][0], s[2 * ks][1]); pk.y = pk_bf16(s[2 * ks][2], s[2 * ks][3]); pk.z = pk_bf16(s[2 * ks + 1][0], s[2 * ks + 1][1]); pk.w = pk_bf16(s[2 * ks + 1][2], s[2 * ks + 1][3]);
            const bf16x8 bp = __builtin_bit_cast(bf16x8, pk);
            if (ks < 7) AT_WAITV(8); else AT_WAITV(0);
            unsigned va[4];
#pragma unroll
            for (int dd = 0; dd < 4; ++dd) va[dd] = vbase + (unsigned)((ks & 1) * 8192) + (unsigned)(((vc + 2 * dd) & 7) << 4);
            s16x4 tr[16];
            tr_read16(va, tr);
#pragma unroll
            for (int d = 0; d < 8; ++d) { const int q = 8 * (d >> 2) + 2 * (d & 3); const bf16x8 a = (bf16x8){tr[q][0], tr[q][1], tr[q][2], tr[q][3], tr[q + 1][0], tr[q + 1][1], tr[q + 1][2], tr[q + 1][3]};
                o[d] = __builtin_amdgcn_mfma_f32_16x16x32_bf16(a, bp, o[d], 0, 0, 0); }
            if (ks + 2 <= 7) AT_VDMA(ks + 2);
            __builtin_amdgcn_sched_barrier(0);
        }
        const float inv = 1.0f / sum;
        if (li < 4) {
            bf16_t* op = F.CONCAT + (size_t)t * D + g * 512 + li * 128 + 4 * q4;
#pragma unroll
            for (int d = 0; d < 8; ++d) { u32x2 w; w.x = pk_bf16(o[d][0] * inv, o[d][1] * inv); w.y = pk_bf16(o[d][2] * inv, o[d][3] * inv); *(u32x2*)(op + d * 16) = w; }
        }
    }
#undef AT_KDMA
#undef AT_VDMA
}

#if SELFCHECK
__device__ __forceinline__ float bfv(const bf16_t* p, size_t i) { return __uint_as_float(((unsigned)p[i]) << 16); }
__device__ __forceinline__ unsigned hash_u(unsigned x) { x ^= x >> 16; x *= 0x7feb352dU; x ^= x >> 15; x *= 0x846ca68bU; x ^= x >> 16; return x; }
__device__ __forceinline__ void chk_flag(const Frame& F, int k) { __hip_atomic_fetch_add(F.ctl + CW_CHK + k, 1u, __ATOMIC_RELAXED, __HIP_MEMORY_SCOPE_AGENT); }
__device__ void chk_gemm1(const Frame& F) {
    for (int j = 0; j < 16; ++j) {
        const unsigned hsh = hash_u((unsigned)((F.bid * 8 + F.wave) * 16 + j) * 2654435761u + 12345u);
        const int t = (int)(hsh % (unsigned)T), n = (int)((hsh >> 7) % 3664u);
        float s = 0.f, sa = 0.f;
        for (int k = F.lane; k < D; k += 64) { const float a = bfv(F.H, (size_t)t * D + k), w = F.w_in[(size_t)k * 3664 + n]; s += a * w; sa += fabsf(a * w); }
        s = wave_sum(s); sa = wave_sum(sa);
        const float got = bfv(F.PROJ, (size_t)t * NPROJ + colmap(n));
        if (F.lane == 0 && !(fabsf(got - s) <= 0.001f * sa + 0.02f)) chk_flag(F, 0);
    }
}
__device__ void chk_post(const Frame& F) {
    const int gw = F.bid * 8 + F.wave;
    const int t = (gw * 16 + (gw & 15)) % T, pos = t & (S - 1), lane = F.lane;
    const bf16_t* pr = F.PROJ + (size_t)t * NPROJ;
    const float QSCALE = 0.08838834764831845f * 1.4426950408889634f;
    int bad = 0;
    for (int hh = 0; hh < 10; ++hh) {
        const int cb = hh < 8 ? CQ + hh * 128 : CK + (hh - 8) * 128; const float* gn = hh < 8 ? F.q_norm_g : F.k_norm_g;
        float ss = 0.f; for (int d = lane; d < 128; d += 64) { const float v = bfv(pr, cb + d); ss += v * v; } ss = wave_sum(ss);
        const float rstd = 1.0f / sqrtf(ss / 128.0f + NORM_EPS);
        for (int d = lane; d < 128; d += 64) {
            float y = bfv(pr, cb + d) * rstd * gn[d];
            if (d < 32) { const int i = d & 15; const float inv = powf(500000.0f, -(float)(2 * i) / 32.0f); const float ang = (float)pos * inv; const float cs = cosf(ang), sn = sinf(ang);
                const int dp = d < 16 ? d + 16 : d - 16; const float yp = bfv(pr, cb + dp) * rstd * gn[dp];
                y = d < 16 ? y * cs - yp * sn : y * cs + yp * sn; }
            float got, ref;
            if (hh < 8) { ref = y * QSCALE; got = bfv(F.QB, (size_t)t * 1024 + hh * 128 + d); } else { ref = y; got = bfv(F.KV, (size_t)t * 512 + (hh - 8) * 256 + d); }
            if (!(fabsf(got - ref) <= 0.02f * fabsf(ref) + 0.02f)) bad = 1;
        }
    }
    for (int e = lane; e < 256; e += 64) { const float ref = bfv(pr, CV + e), got = bfv(F.KV, (size_t)t * 512 + (e >> 7) * 256 + 128 + (e & 127)); if (got != ref) bad = 1; }
    for (int e = lane; e < 1024 + 64; e += 64) {
        const int cb = e < 1024 ? CQI + (e & ~63) : CKI; const int d = e & 63;
        float y = bfv(pr, cb + d);
        if (d < 16) { const int i = d & 7; const float inv = powf(500000.0f, -(float)(2 * i) / 16.0f); const float ang = (float)pos * inv; const float cs = cosf(ang), sn = sinf(ang);
            const int dp = d < 8 ? d + 8 : d - 8; const float yp = bfv(pr, cb + dp); y = d < 8 ? y * cs - yp * sn : y * cs + yp * sn; }
        const float got = e < 1024 ? bfv(F.QI, qi_off((size_t)t, e >> 6, d)) : bfv(F.KI, ki_off((size_t)t, d));
        if (!(fabsf(got - y) <= 0.02f * fabsf(y) + 0.02f)) bad = 1;
    }
    if (lane < 16) { const float ref = bfv(pr, CWI + lane) * 0.03125f, got = F.WI[(size_t)t * 16 + lane]; if (!(fabsf(got - ref) <= 1e-5f + 1e-5f * fabsf(ref))) bad = 1; }
    for (int e = lane; e < 1024; e += 64) {
        const int g = e >> 8, w = 2 << g; float sum = 0.f; int cn = 0;
        for (int r = 0; r < w; ++r) if (pos - r >= 0) { sum += bfv(pr - (size_t)r * NPROJ, CP + e); ++cn; }
        const float ref = sum / (float)cn - bfv(pr, CP + e), got = bfv(F.PM, ((size_t)g * T + t) * 256 + (e & 255));
        if (!(fabsf(got - ref) <= 0.02f * fabsf(ref) + 0.02f)) bad = 1;
    }
    if (__ballot(bad) != 0ull && lane == 0) chk_flag(F, 1);
}
__device__ void chk_attn(const Frame& F) {
    const int w = F.bid, b = w & 3, j = w >> 2;
    const int special[12] = {0, 1, 100, 254, 255, 256, 257, 300, 511, 512, 8190, 8191};
    const int pos = j < 12 ? special[j] : (j * 131 + 17) & (S - 1);
    const int t = b * S + pos, n = pos + 1, cnt = n < 256 ? n : 256, tid = F.tid;
    LAS float* sc = (LAS float*)F.lds;
    LAS int* selmark = (LAS int*)(F.lds + 32768);
    LAS float* red = (LAS float*)(F.lds + 65536);
    LAS int* ired = (LAS int*)(F.lds + 65536 + 4096);
    __syncthreads();
    for (int s2 = tid; s2 < n; s2 += NTHREADS) {
        float tot = 0.f;
        for (int h = 0; h < 16; ++h) { float dsum = 0.f; for (int d = 0; d < 64; ++d) dsum += bfv(F.QI, qi_off((size_t)t, h, d)) * bfv(F.KI, ki_off((size_t)b * S + s2, d)); tot += F.WI[(size_t)t * 16 + h] * fmaxf(dsum, 0.f); }
        sc[s2] = (float)(_Float16)tot; selmark[s2] = 0;
    }
    __syncthreads();
    if (tid < cnt) { const int k = F.SEL[(size_t)t * 256 + tid]; if (k < n) atomicAdd((int*)(selmark + k), 1); else atomicAdd((int*)(selmark + 0), 1000); }
    if (tid == 0) { ired[0] = 0; ired[1] = 0; }
    __syncthreads();
    int miss = 0, dup = 0;
    for (int s2 = tid; s2 < n; s2 += NTHREADS) {
        const int mk = selmark[s2]; if (mk > 1) dup = 1;
        if (mk >= 1 && n > 256) { const float v = sc[s2]; int rank = 0; for (int q = 0; q < n; ++q) rank += (sc[q] > v) ? 1 : 0; if (rank >= 256) ++miss; }
    }
    if (miss) atomicAdd((int*)ired, miss); if (dup) atomicAdd((int*)ired + 1, 1);
    __syncthreads();
    if (tid == 0 && (ired[0] > 3 || ired[1] > 0)) chk_flag(F, 2);
    float err2 = 0.f, ref2 = 0.f;
    for (int h = 0; h < 8; ++h) {
        const int g = h >> 2;
        __syncthreads();
        if (tid < 256) { float l = -INFINITY; if (tid < cnt) { const int k = F.SEL[(size_t)t * 256 + tid]; float dsum = 0.f; for (int d = 0; d < 128; ++d) dsum += bfv(F.QB, (size_t)t * 1024 + h * 128 + d) * bfv(F.KV, ((size_t)b * S + k) * 512 + g * 256 + d); l = dsum; } red[tid] = l; }
        __syncthreads();
        float m = -INFINITY; for (int q = 0; q < 256; ++q) m = fmaxf(m, red[q]);
        float den = 0.f; for (int q = 0; q < 256; ++q) den += exp2f(red[q] - m);
        if (tid < 128) { float o = 0.f; for (int q = 0; q < cnt; ++q) { const int k = F.SEL[(size_t)t * 256 + q]; o += exp2f(red[q] - m) * bfv(F.KV, ((size_t)b * S + k) * 512 + g * 256 + 128 + tid); }
            o /= den; const float got = bfv(F.CONCAT, (size_t)t * D + h * 128 + tid); err2 += (got - o) * (got - o); ref2 += o * o; }
    }
    err2 = wave_sum(err2); ref2 = wave_sum(ref2);
    __syncthreads();
    if (F.lane == 0 && F.wave < 2) { red[300 + F.wave * 2] = err2; red[301 + F.wave * 2] = ref2; }
    __syncthreads();
    if (tid == 0) { const float e = red[300] + red[302], r = red[301] + red[303]; if (!(e <= 0.0009f * r + 1e-6f)) chk_flag(F, 3); }
    __syncthreads();
}
#endif

__device__ __forceinline__ void r1_route(const Frame& F) {
    { const float* ada = F.ADA + (size_t)(F.bid >> 6) * 12288; norm_rows(F, F.out, F.norm2_g, ada + 3 * 2048, ada + 4 * 2048); }
    LAS unsigned* lh = (LAS unsigned*)(F.lds + 65536);
    LAS float* lg = (LAS float*)F.lds + F.wave * 768;
    if (F.tid < 64) lh[F.tid] = 0u;
    asm volatile("s_waitcnt vmcnt(0)" ::: "memory");
    __syncthreads();
    const int lane = F.lane, li = lane & 15, q4 = lane >> 4;
    const int t0 = F.bid * 128 + F.wave * 16;
    f32x4 acc[3];
#pragma unroll
    for (int nb = 0; nb < 3; ++nb) acc[nb] = (f32x4){0.f, 0.f, 0.f, 0.f};
    const bf16_t* hp = F.H + (size_t)(t0 + li) * D + 8 * q4;
    const bf16_t* wp = F.WR + (size_t)li * D + 8 * q4;
#pragma unroll 4
    for (int ks = 0; ks < 64; ++ks) {
        const bf16x8 a = *(const bf16x8*)(hp + 32 * ks);
#pragma unroll
        for (int nb = 0; nb < 3; ++nb) { const bf16x8 bb = *(const bf16x8*)(wp + (size_t)nb * 16 * D + 32 * ks); acc[nb] = __builtin_amdgcn_mfma_f32_16x16x32_bf16(a, bb, acc[nb], 0, 0, 0); }
    }
#pragma unroll
    for (int nb = 0; nb < 3; ++nb)
#pragma unroll
        for (int i = 0; i < 4; ++i) lg[(4 * q4 + i) * 48 + nb * 16 + li] = acc[nb][i];
    asm volatile("s_waitcnt lgkmcnt(0)" ::: "memory");
    if (lane < 16) {
        const int t = t0 + lane; const LAS float* l = lg + lane * 48;
        int gs = 0; float gm = l[0];
#pragma unroll
        for (int j = 1; j < 4; ++j) if (l[j] > gm) { gm = l[j]; gs = j; }
        float den = 0.f;
#pragma unroll
        for (int j = 0; j < 4; ++j) den += __expf(l[j] - gm);
        const float pg = 1.0f / den;
        const LAS float* el = l + 4 + gs * 8;
        int i0 = 0; float m0 = el[0];
#pragma unroll
        for (int j = 1; j < 8; ++j) if (el[j] > m0) { m0 = el[j]; i0 = j; }
        int i1 = -1; float m1 = -INFINITY;
#pragma unroll
        for (int j = 0; j < 8; ++j) if (j != i0 && el[j] > m1) { m1 = el[j]; i1 = j; }
        const float e1 = __expf(m1 - m0), w0 = pg / (1.0f + e1), w1 = pg * e1 / (1.0f + e1);
        const int b0 = gs * 8 + i0, b1 = 32 + gs * 8 + i1;
        F.TOKE[2 * t] = b0; F.TOKE[2 * t + 1] = b1; F.TOKW[2 * t] = w0; F.TOKW[2 * t + 1] = w1;
        __hip_atomic_fetch_add(lh + b0, 1u, __ATOMIC_RELAXED, __HIP_MEMORY_SCOPE_WORKGROUP);
        __hip_atomic_fetch_add(lh + b1, 1u, __ATOMIC_RELAXED, __HIP_MEMORY_SCOPE_WORKGROUP);
    }
    __syncthreads();
    if (F.tid < 64) { const unsigned cn = lh[F.tid]; if (cn) __hip_atomic_fetch_add(F.ctl + CW_GCOUNT + F.tid, cn, __ATOMIC_RELAXED, __HIP_MEMORY_SCOPE_AGENT); }
}

__device__ __forceinline__ void r2_rows(const Frame& F) {
    LAS unsigned* lh = (LAS unsigned*)F.lds;
    LAS unsigned* lbase = lh + 64;
    LAS unsigned* tstart = lh + 128;
    const int tid = F.tid;
    if (tid < 64) lh[tid] = 0u;
    __syncthreads();
    if (tid == 0) {
        unsigned ts = 0;
        for (int k = 0; k < 64; ++k) { tstart[k] = ts; const unsigned cn = __hip_atomic_load(F.ctl + CW_GCOUNT + k, __ATOMIC_RELAXED, __HIP_MEMORY_SCOPE_AGENT); ts += (cn + 255u) >> 8; if (k == 31) tstart[64 + 1] = ts; }
        tstart[64] = ts;
    }
    const int t = F.bid * 128 + (tid >> 1), sl = tid & 1;
    int bucket = 0; float w = 0.f;
    if (tid < 256) { bucket = F.TOKE[2 * t + sl]; w = F.TOKW[2 * t + sl]; __hip_atomic_fetch_add(lh + bucket, 1u, __ATOMIC_RELAXED, __HIP_MEMORY_SCOPE_WORKGROUP); }
    __syncthreads();
    if (tid < 64) { const unsigned cn = lh[tid]; unsigned base = 0; if (cn) base = __hip_atomic_fetch_add(F.ctl + CW_GCURSOR + tid, cn, __ATOMIC_RELAXED, __HIP_MEMORY_SCOPE_AGENT); lbase[tid] = tstart[tid] * 256u + base; }
    __syncthreads();
    if (tid < 64) lh[tid] = 0u;
    __syncthreads();
    if (tid < 256) { const unsigned rk = __hip_atomic_fetch_add(lh + bucket, 1u, __ATOMIC_RELAXED, __HIP_MEMORY_SCOPE_WORKGROUP); const unsigned p = lbase[bucket] + rk;
        if (p < (unsigned)MAXROWS) { F.ROWTOK[p] = t; F.ROWW[p] = w; } }
    if (F.bid == 0) {
        if (tid == 0) { ((int*)F.ctl)[CW_TINFO] = (int)tstart[65]; ((int*)F.ctl)[CW_TINFO + 1] = (int)tstart[64]; }
        if (tid < 64) { const unsigned a = tstart[tid], e = (tid == 63) ? tstart[64] : tstart[tid + 1]; for (unsigned p = a; p < e && p < 512u; ++p) ((int*)F.ctl)[CW_TILEB + p] = tid; }
    }
}

struct Args { const float* in[17]; float* out; unsigned char* ws; int ph_lo, ph_hi; };
constexpr int N_PHASES = 13;

__global__ void __launch_bounds__(NTHREADS, 2) mk_fwd(Args args) {
    extern __shared__ __attribute__((aligned(16))) unsigned char lds_raw[];
    Frame F;
    F.lds = (LAS unsigned char*)lds_raw;
    F.tid = threadIdx.x; F.lane = F.tid & 63; F.wave = __builtin_amdgcn_readfirstlane(F.tid >> 6); F.G = gridDim.x; F.bid = blockIdx.x;
    F.x = args.in[0]; F.c = args.in[1]; F.w_ada = args.in[2]; F.b_ada = args.in[3]; F.norm1_g = args.in[4]; F.w_in = args.in[5]; F.q_norm_g = args.in[6]; F.k_norm_g = args.in[7];
    F.w_pool = args.in[8]; F.pool_scale = args.in[9]; F.w_out = args.in[10]; F.norm2_g = args.in[11]; F.w_grp = args.in[12]; F.w_exp = args.in[13]; F.w1 = args.in[14]; F.w3 = args.in[15]; F.w2 = args.in[16];
    F.out = args.out;
    unsigned char* ws = args.ws;
    F.ctl = (unsigned*)(ws + WS_CTL); F.ADA = (float*)(ws + WS_ADA); F.ADAP = (float*)(ws + WS_ADAP); F.TAB = (float*)(ws + WS_TAB); F.WR = (bf16_t*)(ws + WS_WR); F.TOKE = (int*)(ws + WS_TOKE); F.TOKW = (float*)(ws + WS_TOKW);
    F.ROWTOK = (int*)(ws + WS_ROWTOK); F.ROWW = (float*)(ws + WS_ROWW); F.WI = (float*)(ws + WS_WI); F.KI = (bf16_t*)(ws + WS_KI);
    F.WPOOL = (bf16_t*)(ws + WS_WPOOL); F.WOUT = (bf16_t*)(ws + WS_WOUT); F.WIN = (bf16_t*)(ws + WS_WIN); F.W13 = (bf16_t*)(ws + WS_W13); F.W2 = (bf16_t*)(ws + WS_W2);
    F.H = (bf16_t*)(ws + WS_H); F.CONCAT = (bf16_t*)(ws + WS_H); F.PROJ = (bf16_t*)(ws + WS_X); F.SC = (unsigned short*)(ws + WS_X);
    F.QB = (bf16_t*)(ws + WS_QB); F.ACT = (bf16_t*)(ws + WS_QB); F.KV = (bf16_t*)(ws + WS_KV); F.QI = (bf16_t*)(ws + WS_QI); F.PM = (bf16_t*)(ws + WS_PM); F.SEL = (unsigned short*)(ws + WS_SEL);

    volatile LAS unsigned* bst = (volatile LAS unsigned*)(F.lds + LDS_BYTES - 16);
    if (F.tid == 0) { bst[0] = 0u; bst[1] = 0u; bst[2] = 0u; bst[3] = 0u; }
    __syncthreads();
    XcdBarrier bar = xcd_barrier_post(F.ctl, bst, F.wave);
    const int lo = args.ph_lo, hi = args.ph_hi;
#define IN(k) (lo <= (k) && (k) < hi)
#define SEAM(k) do { if (IN(k) && IN((k) + 1)) xcd_barrier(bar); } while (0)

#define PH(k, ...) do { F.lane = fresh_lane(); F.tid = F.wave * 64 + F.lane; if (IN(k)) { for (int rep_ = 0; rep_ < 1 + ((REPEAT_MASK >> (k)) & 1); ++rep_) { __VA_ARGS__ } } SEAM(k); } while (0)
    PH(0, { p0_prologue(F); });
    PH(1, {
        if (F.tid < 192) { const int v = F.bid * 192 + F.tid; float s = 0.f; for (int kc = 0; kc < 32; ++kc) s += F.ADAP[(size_t)kc * 49152 + v]; F.ADA[v] = s; }
        LAS float* sl = (LAS float*)F.lds;
        { const int b = F.bid >> 6; for (int idx = F.tid; idx < 4096; idx += NTHREADS) { float s = 0.f; for (int kc = 0; kc < 32; ++kc) s += F.ADAP[(size_t)kc * 49152 + b * 12288 + idx]; sl[idx] = s; } }
        __syncthreads();
        norm_rows(F, F.x, F.norm1_g, (const float*)sl, (const float*)(sl + 2048));
#if P1_PROBE == 1
        norm_rows(F, F.x, F.norm1_g, (const float*)sl, (const float*)(sl + 2048));
#elif P1_PROBE == 2
        __syncthreads();
        { const int b = F.bid >> 6; for (int idx = F.tid; idx < 4096; idx += NTHREADS) { float s = 0.f; for (int kc = 0; kc < 32; ++kc) s += F.ADAP[(size_t)kc * 49152 + b * 12288 + idx]; sl[idx] = s; } }
#endif
        __syncthreads();
    });
    PH(2, {
        pg8::Gemm g{F.H, F.WIN, D}; pg8::StaticOrder So; So.init(T, NPROJ, F.G, F.bid, 1 + ((REPEAT_UNITS >> 2) & 1));
        pg8::EpiBf16 E{F.PROJ, NPROJ, 0};
        pg8::gemm_phase<pg8::EpiBf16, pg8::StaticOrder>(F.lds, g, So, E, F.tid);
    });
#if SELFCHECK
    F.lane = fresh_lane(); F.tid = F.wave * 64 + F.lane; if (IN(3)) { chk_gemm1(F); }
#endif
    PH(3, { p3_post(F); });
#if SELFCHECK
    F.lane = fresh_lane(); F.tid = F.wave * 64 + F.lane; if (IN(3)) { chk_post(F); if (IN(4)) xcd_barrier(bar); }
#endif
    PH(4, {
        {
            pg8::Gemm g{F.PM, F.WPOOL, 256}; pg8::PoolOrder So{F.G, F.bid};
            pg8::EpiBf16 E{F.CONCAT, D, 1};
            pg8::gemm_phase<pg8::EpiBf16, pg8::PoolOrder>(F.lds, g, So, E, F.tid);
        }
        for (int uu = F.bid; uu < 4 * 2080 * (1 + ((REPEAT_UNITS >> 4) & 1)); uu += F.G) {
            const int u = uu % (4 * 2080); const int b = u / 2080, v = u % 2080;
            int qb = (int)((sqrtf(8.0f * (float)v + 1.0f) - 1.0f) * 0.5f);
            while (qb * (qb + 1) / 2 > v) --qb;
            while ((qb + 1) * (qb + 2) / 2 <= v) ++qb;
            indexer_unit(F, b, qb, v - qb * (qb + 1) / 2);
        }
    });
    PH(5, {
        LAS unsigned char* wbuf = F.lds + F.wave * 17920;
        u32x4 pre[16];
        int i = F.bid * 8 + F.wave;
        int t = (i & 1) ? (T - 1 - (i >> 1)) : (i >> 1);
        { const unsigned short* src = sel_src(F, t); const int n = (t & (S - 1)) + 1, nch = n > 256 ? (n + 511) >> 9 : 0;
          _Pragma("unroll") for (int ch = 0; ch < 16; ++ch) if (ch < nch) pre[ch] = *(const u32x4*)(src + ch * 512 + F.lane * 8); }
        for (; i < T; i += F.G * 8) {
            u32x4 cur[16];
            _Pragma("unroll") for (int ch = 0; ch < 16; ++ch) cur[ch] = pre[ch];
            const int tcur = t, inext = i + F.G * 8;
            if (inext < T) {
                t = (inext & 1) ? (T - 1 - (inext >> 1)) : (inext >> 1);
                const unsigned short* src = sel_src(F, t); const int n = (t & (S - 1)) + 1, nch = n > 256 ? (n + 511) >> 9 : 0;
                _Pragma("unroll") for (int ch = 0; ch < 16; ++ch) if (ch < nch) pre[ch] = *(const u32x4*)(src + ch * 512 + F.lane * 8);
            }
            select_row(F, tcur, cur, wbuf, F.lane);
        }
    });
    PH(6, {
        attn_items(F, 0, 32);
#if ATT_PROBE == 1
        attn_items(F, 0, 16);
#elif ATT_PROBE == 2
        attn_items(F, 16, 32);
#endif
    });
#if SELFCHECK
    F.lane = fresh_lane(); F.tid = F.wave * 64 + F.lane; if (IN(7)) { chk_attn(F); }
#endif
    PH(7, {
        pg8::Gemm g{F.CONCAT, F.WOUT, D}; pg8::StaticOrder So; So.init(T, D, F.G, F.bid, 1 + ((REPEAT_UNITS >> 7) & 1));
        pg8::EpiMix E{F.x, F.ADA, F.out};
        pg8::gemm_phase<pg8::EpiMix, pg8::StaticOrder>(F.lds, g, So, E, F.tid);
    });
    PH(8, { r1_route(F); });
    PH(9, { r2_rows(F); });
    PH(10, {
        const int* ti = (const int*)F.ctl + CW_TINFO;
        pg8::Gemm g{F.H, F.W13, D}; pg8::MoeOrder<4, true> So{(const int*)F.ctl + CW_TILEB, F.ROWTOK, 0, ti[1], F.G, F.bid, 1 + ((REPEAT_UNITS >> 10) & 1)};
        pg8::EpiAct E{F.ACT};
        pg8::gemm_phase<pg8::EpiAct, pg8::MoeOrder<4, true>>(F.lds, g, So, E, F.tid);
    });
    PH(11, {
        const int* ti = (const int*)F.ctl + CW_TINFO;
        pg8::Gemm g{F.ACT, F.W2, 512}; pg8::MoeOrder<8, false> So{(const int*)F.ctl + CW_TILEB, F.ROWTOK, 0, ti[0], F.G, F.bid, 1};
        pg8::EpiMoeOut E{F.ROWTOK, F.ROWW, F.ADA, F.out};
        pg8::gemm_phase<pg8::EpiMoeOut, pg8::MoeOrder<8, false>>(F.lds, g, So, E, F.tid);
    });
    PH(12, {
        const int* ti = (const int*)F.ctl + CW_TINFO;
        pg8::Gemm g{F.ACT, F.W2, 512}; pg8::MoeOrder<8, false> So{(const int*)F.ctl + CW_TILEB, F.ROWTOK, ti[0], ti[1], F.G, F.bid, 1};
        pg8::EpiMoeOut E{F.ROWTOK, F.ROWW, F.ADA, F.out};
        pg8::gemm_phase<pg8::EpiMoeOut, pg8::MoeOrder<8, false>>(F.lds, g, So, E, F.tid);
    });
#undef PH
#if SELFCHECK
    if (IN(12)) {
        xcd_barrier(bar);
        if (F.bid == 0 && F.tid == 0) {
            float code = 0.f;
            for (int k = 0; k < 4; ++k) if (__hip_atomic_load(F.ctl + CW_CHK + k, __ATOMIC_RELAXED, __HIP_MEMORY_SCOPE_AGENT) != 0u) code += (float)(1 << k);
            if (code != 0.f) F.out[0] += 1.0e4f * code;
        }
    }
#endif
#undef IN
#undef SEAM
}

extern "C" void kernel_launch(void* const* d_in, const int* in_sizes, int n_in, void* d_out, int out_size, void* d_ws, size_t ws_size, hipStream_t stream) {
    static int grid = 0;
    if (grid == 0) {
        if (n_in != 17 || out_size != T * D || ws_size < WS_END) { fprintf(stderr, "kernel_launch: unexpected problem (n_in %d out %d ws %zu)\n", n_in, out_size, ws_size); grid = -1; return; }
        int dev = 0, cus = 0, per_cu = 0;
        if (hipGetDevice(&dev) != hipSuccess || hipDeviceGetAttribute(&cus, hipDeviceAttributeMultiprocessorCount, dev) != hipSuccess) { grid = -1; return; }
        if (hipFuncSetAttribute((const void*)mk_fwd, hipFuncAttributeMaxDynamicSharedMemorySize, LDS_BYTES) != hipSuccess) { fprintf(stderr, "kernel_launch: hipFuncSetAttribute failed\n"); grid = -1; return; }
        if (hipOccupancyMaxActiveBlocksPerMultiprocessor(&per_cu, (const void*)mk_fwd, NTHREADS, LDS_BYTES) != hipSuccess || per_cu < 1) { fprintf(stderr, "kernel_launch: occupancy query says %d\n", per_cu); }
        (void)hipGetLastError();
        grid = cus;
        if (grid != 256) { fprintf(stderr, "kernel_launch: built for 256 CUs, found %d\n", cus); grid = -1; return; }
    }
    if (grid < 0) return;
    (void)hipMemsetAsync((char*)d_ws + WS_CTL, 0, WS_ADA - WS_CTL, stream);
    (void)hipMemsetAsync((char*)d_ws + WS_ROWTOK, 0xFF, (size_t)MAXROWS * 4, stream);
    Args a{};
    for (int i = 0; i < 17; ++i) a.in[i] = (const float*)d_in[i];
    a.out = (float*)d_out; a.ws = (unsigned char*)d_ws;
#if MK_MULTI
    for (int p = 0; p < N_PHASES; ++p) { a.ph_lo = p; a.ph_hi = p + 1; hipLaunchKernelGGL(mk_fwd, dim3(grid), dim3(NTHREADS), LDS_BYTES, stream, a); }
#else
    a.ph_lo = 0; a.ph_hi = N_PHASES; hipLaunchKernelGGL(mk_fwd, dim3(grid), dim3(NTHREADS), LDS_BYTES, stream, a);
#endif
}
```

```cpp
#include <hip/hip_runtime.h>
#include <cstdio>
#include <cstdint>
#include <cstddef>

#ifndef MK_MULTI
#define MK_MULTI 0
#endif

#ifndef P5_PROBE
#define P5_PROBE 0
#endif
#ifndef P1_PROBE
#define P1_PROBE 0
#endif
#ifndef ATT_PROBE
#define ATT_PROBE 0
#endif
#ifndef SELFCHECK
#define SELFCHECK 0
#endif
#ifndef REPEAT_UNITS
#define REPEAT_UNITS 0
#endif
#ifndef REPEAT_MASK
#define REPEAT_MASK 0
#endif
#define LAS __attribute__((address_space(3)))
typedef unsigned short bf16_t;
typedef short bf16x8 __attribute__((ext_vector_type(8)));
typedef short s16x4 __attribute__((ext_vector_type(4)));
typedef float f32x4 __attribute__((ext_vector_type(4)));
typedef float f32x16 __attribute__((ext_vector_type(16)));
typedef unsigned u32x4 __attribute__((ext_vector_type(4)));
typedef unsigned u32x2 __attribute__((ext_vector_type(2)));
typedef __bf16 bf16v2 __attribute__((ext_vector_type(2)));
typedef _Float16 f16v2 __attribute__((ext_vector_type(2)));

constexpr int T = 32768, S = 8192, NB = 4, D = 2048;
constexpr int NPROJ = 3840;
constexpr int CQ = 0, CK = 1024, CV = 1280, CQI = 1536, CP = 2560, CKI = 3584, CWI = 3648;
constexpr int NTHREADS = 512;
constexpr int LDS_BYTES = 147456;
constexpr float NORM_EPS = 1e-6f;
constexpr size_t SC_BATCH = 34078720ull;
constexpr int MAXROWS = 81920;

constexpr size_t WS_CTL = 0;
constexpr size_t WS_ADA = 65536;
constexpr size_t WS_TAB = 262144;
constexpr size_t WS_WR = 1835008;
constexpr size_t WS_TOKE = 2031616;
constexpr size_t WS_TOKW = 2293760;
constexpr size_t WS_ROWTOK = 2555904;
constexpr size_t WS_ROWW = 2883584;
constexpr size_t WS_WI = 3211264;
constexpr size_t WS_KI = 5308416;
constexpr size_t WS_WPOOL = 9502720;
constexpr size_t WS_WOUT = 10027008;
constexpr size_t WS_WIN = 18415616;
constexpr size_t WS_W13 = 34144256;
constexpr size_t WS_W2 = 168361984;
constexpr size_t WS_H = 235470848;
constexpr size_t WS_X = 369688576;
constexpr size_t WS_QB = 642318336;
constexpr size_t WS_KV = 709427200;
constexpr size_t WS_QI = 742981632;
constexpr size_t WS_PM = 810090496;
constexpr size_t WS_SEL = 877199360;
constexpr size_t WS_ADAP = 893976576;
constexpr size_t WS_END = 900268032;
constexpr int CW_GCOUNT = 4096, CW_GCURSOR = 4160, CW_CHK = 4224, CW_TINFO = 4352, CW_TILEB = 4416;

__device__ __forceinline__ int fresh_lane() { int l; asm volatile("v_mbcnt_lo_u32_b32 %0, -1, 0\n\tv_mbcnt_hi_u32_b32 %0, -1, %0" : "=v"(l)); return l; }
__device__ __forceinline__ unsigned pk_bf16(float a, float b) { bf16v2 v; v.x = (__bf16)a; v.y = (__bf16)b; return __builtin_bit_cast(unsigned, v); }
__device__ __forceinline__ float bf_lo(unsigned u) { return __uint_as_float(u << 16); }
__device__ __forceinline__ float bf_hi(unsigned u) { return __uint_as_float(u & 0xffff0000u); }
__device__ __forceinline__ void unpack8(const u32x4 v, float* f) {
    f[0] = bf_lo(v.x); f[1] = bf_hi(v.x); f[2] = bf_lo(v.y); f[3] = bf_hi(v.y); f[4] = bf_lo(v.z); f[5] = bf_hi(v.z); f[6] = bf_lo(v.w); f[7] = bf_hi(v.w);
}
__device__ __forceinline__ u32x4 pack8(const float* f) { u32x4 v; v.x = pk_bf16(f[0], f[1]); v.y = pk_bf16(f[2], f[3]); v.z = pk_bf16(f[4], f[5]); v.w = pk_bf16(f[6], f[7]); return v; }
__device__ __forceinline__ float wave_sum(float v) {
#pragma unroll
    for (int d = 32; d >= 1; d >>= 1) v += __shfl_xor(v, d);
    return v;
}

#define XB_TMO      128
#define XB_XCNT(j)  (256  + 64 * (j))
#define XB_XSUB(j)  (1280 + 64 * (j))
#define XB_XGEN(j)  (2304 + 64 * (j))
#define XB_TOP      3328
#define XB_TOPGEN   3392
#define XCD_BAR_WORDS 3456
#define XB_SPIN_CAP (1u << 23)

__device__ __forceinline__ unsigned xb_ld(unsigned* p)              { return __hip_atomic_load(p, __ATOMIC_RELAXED, __HIP_MEMORY_SCOPE_AGENT); }
__device__ __forceinline__ unsigned xb_add(unsigned* p, unsigned v) { return __hip_atomic_fetch_add(p, v, __ATOMIC_RELAXED, __HIP_MEMORY_SCOPE_AGENT); }
__device__ __forceinline__ unsigned xb_xcc_id() { return (unsigned)__builtin_amdgcn_s_getreg((3 << 11) | 20) & 0xFu; }
#define XB_SPIN(cond, bar) do { unsigned _sp = 0; while (cond) { __builtin_amdgcn_s_sleep(1); \
    if ((++_sp & 255u) == 0u) { if (xb_ld(&(bar)[XB_TMO])) break; if (_sp > XB_SPIN_CAP) { atomicAdd(&(bar)[XB_TMO], 1u); break; } } } } while (0)

struct XcdBarrier { unsigned* bar; unsigned x; volatile LAS unsigned* st; int wave; };

__device__ __forceinline__ XcdBarrier xcd_barrier_post(unsigned* bar, volatile LAS unsigned* st, int wave) {
    XcdBarrier b; b.bar = bar; b.x = xb_xcc_id(); b.st = st; b.wave = wave;
    if (threadIdx.x == 0) (void)xb_add(&bar[XB_XCNT(b.x)], 1u);
    return b;
}
__device__ __forceinline__ void xcd_barrier_complete(unsigned* bar, unsigned x, unsigned& nloc, unsigned& nx) {
    const unsigned G = gridDim.x * gridDim.y * gridDim.z;
    unsigned sum, cnt, mine, sp = 0u;
    for (;;) {
        sum = 0u; cnt = 0u; mine = 0u;
#pragma unroll
        for (unsigned j = 0; j < 16; ++j) { const unsigned c = xb_ld(&bar[XB_XCNT(j)]); sum += c; cnt += (c > 0u) ? 1u : 0u; mine = (j == x) ? c : mine; }
        if (sum == G) break;
        __builtin_amdgcn_s_sleep(1);
        if ((++sp & 255u) == 0u) { if (xb_ld(&bar[XB_TMO])) break; if (sp > XB_SPIN_CAP) { atomicAdd(&bar[XB_TMO], 1u); break; } }
    }
    nloc = mine > 0u ? mine : 1u; nx = cnt > 0u ? cnt : 1u;
}
__device__ __forceinline__ void xcd_barrier(const XcdBarrier& b) {
    asm volatile("s_waitcnt vmcnt(0)" ::: "memory");
    __syncthreads();
    if (b.wave == 0 && fresh_lane() == 0) {
        unsigned* bar = b.bar;
        __builtin_amdgcn_s_waitcnt(0);
        unsigned nloc = b.st[0], nx = b.st[1];
        if (nloc == 0u) { xcd_barrier_complete(bar, b.x, nloc, nx); b.st[0] = nloc; b.st[1] = nx; }
        const unsigned old = xb_add(&bar[XB_XSUB(b.x)], 1u);
        const unsigned gen = old / nloc;
        if (old + 1u == (gen + 1u) * nloc) {
            __builtin_amdgcn_fence(__ATOMIC_RELEASE, "agent");
            asm volatile("s_waitcnt vmcnt(0)" ::: "memory");
            const unsigned og = xb_add(&bar[XB_TOP], 1u);
            const unsigned tg = og / nx;
            if (og + 1u == (tg + 1u) * nx) xb_add(&bar[XB_TOPGEN], 1u);
            else XB_SPIN(xb_ld(&bar[XB_TOPGEN]) == tg, bar);
            __builtin_amdgcn_fence(__ATOMIC_ACQUIRE, "agent");
            xb_add(&bar[XB_XGEN(b.x)], 1u);
            asm volatile("s_waitcnt vmcnt(0)" ::: "memory");
        } else {
            XB_SPIN(xb_ld(&bar[XB_XGEN(b.x)]) == gen, bar);
            __builtin_amdgcn_fence(__ATOMIC_ACQUIRE, "agent");
            asm volatile("s_waitcnt vmcnt(0)" ::: "memory");
        }
    }
    __syncthreads();
}

struct Frame {
    LAS unsigned char* lds;
    int tid, lane, wave, G, bid;
    const float *x, *c, *w_ada, *b_ada, *norm1_g, *w_in, *q_norm_g, *k_norm_g, *w_pool, *pool_scale, *w_out, *norm2_g, *w_grp, *w_exp, *w1, *w3, *w2;
    float* out;
    unsigned* ctl;
    float* ADA; float* ADAP; float* TAB; bf16_t* WR; int* TOKE; float* TOKW; int* ROWTOK; float* ROWW; float* WI; bf16_t* KI;
    bf16_t *WPOOL, *WOUT, *WIN, *W13, *W2, *H, *PROJ; unsigned short* SC; bf16_t *QB, *KV, *QI, *PM, *ACT, *CONCAT; unsigned short* SEL;
    bf16_t* Y0;
};

namespace pg8 {
constexpr int BM = 256, BK = 64, HALF = 128, HTB = HALF * BK * 2, STAGE_BYTES = 8 * HTB, NXCD = 8, WGM = 8;
__device__ __forceinline__ int lds_byte(int r, int c) { const int st = (r >> 4) * 2 + (c >> 5), rr = r & 15, cc = c & 31, ob = rr * 64 + cc * 2; return st * 1024 + (ob ^ (((ob >> 9) & 1) << 5)); }
__device__ __forceinline__ void stage_rc(int b, int& R, int& C) { const int st = b / 1024, sb = b % 1024, swz = sb ^ (((sb >> 9) & 1) << 5); R = (st >> 1) * 16 + swz / 64; C = (st & 1) * 32 + (swz % 64) / 2; }
__device__ __forceinline__ int perm32(int rho) { const int n = rho >> 4, i = rho & 15; return 8 * (i >> 2) + 4 * n + (i & 3); }
struct Unit { int pm, pn; };
struct Gemm { const bf16_t* A; const bf16_t* Bt; int K; };

struct StaticOrder {
    int nM, nN, nwg, G, c, rep;
    __device__ void init(int M, int N, int G_, int c_, int rep_ = 1) { nM = M / BM; nN = N / BM; nwg = nM * nN; G = G_; c = c_; rep = rep_; }
    __device__ bool next(int i, Unit& u) const {
        long L = (long)i * G + c; if (L >= (long)nwg * rep) return false;
        if (L >= nwg) L -= nwg;
        int wgid = (int)L; { const int q = nwg / NXCD, r = nwg % NXCD, xcd = wgid % NXCD, off = wgid / NXCD; wgid = (xcd < r ? xcd * (q + 1) : r * (q + 1) + (xcd - r) * q) + off; }
        const int nig = WGM * nN, gid = wgid / nig, fm = gid * WGM, gsz = (nM - fm) < WGM ? (nM - fm) : WGM;
        u.pm = fm + ((wgid % nig) % gsz); u.pn = (wgid % nig) / gsz; return true;
    }
    __device__ __forceinline__ unsigned arow(const Unit& u, int rr) const { return (unsigned)(u.pm * BM + rr); }
};
struct PoolOrder {
    int G, c;
    __device__ bool next(int i, Unit& u) const { const int L = i * G + c; if (L >= 512) return false; u.pm = L; u.pn = L >> 7; return true; }
    __device__ __forceinline__ unsigned arow(const Unit& u, int rr) const { return (unsigned)(u.pm * BM + rr); }
};
template <int NC, bool GATHER> struct MoeOrder {
    const int* tileb; const int* rowtok; int lo, hi, G, c, rep;
    __device__ bool next(int i, Unit& u) const {
        int L = i * G + c; if (L >= (hi - lo) * NC * rep) return false;
        if (L >= (hi - lo) * NC) L -= (hi - lo) * NC;
        u.pm = lo + L / NC; const int e = tileb[u.pm] & 31; u.pn = e * NC + (L % NC); return true;
    }
    __device__ __forceinline__ unsigned arow(const Unit& u, int rr) const {
        if (GATHER) { const int tok = rowtok[u.pm * BM + rr]; return (unsigned)(tok < 0 ? 0 : tok); }
        return (unsigned)(u.pm * BM + rr);
    }
};

template <class Epi, class Sched>
__device__ __forceinline__ void gemm_phase(LAS unsigned char* lds, const Gemm g, const Sched& S, const Epi& E, const int tid) {
    const int wid = __builtin_amdgcn_readfirstlane(tid >> 6), lane = tid & 63, wr = wid >> 2, wc = wid & 3, fr = lane & 15, fq = lane >> 4;
    const int K = g.K, nt = K / BK;
    int R0, C0; stage_rc(tid * 16, R0, C0);
    unsigned voffB[2];
#pragma unroll
    for (int i = 0; i < 2; ++i) { const int R = R0 + 64 * i; const int Rb = Epi::PERM ? ((R & ~31) + perm32(R & 31)) : R; voffB[i] = (unsigned)(Rb * K + C0) * 2u; }
    const unsigned rowb = (unsigned)K * 2u, colb = (unsigned)C0 * 2u;
    const size_t kstep = (size_t)(BK * 2);
    const size_t hstep = (size_t)HALF * K * 2;
    const size_t tstep = 2 * hstep;
    const unsigned ldsw = (unsigned)wid * 1024u;
    const int aoff = lds_byte(wr * 64 + fr, fq * 8), boff = lds_byte(wc * 32 + fr, fq * 8);
#define PG8_SA(b, h) (((b) * 2 + (h)) * HTB)
#define PG8_SB(b, h) ((4 + (b) * 2 + (h)) * HTB)
#define PG8_STAGE(bufoff, gbase, voff) do { _Pragma("unroll") for (int _i = 0; _i < 2; ++_i) \
        __builtin_amdgcn_global_load_lds((const unsigned*)((const char*)(gbase) + (voff)[_i]), (LAS unsigned*)(lds + (bufoff) + ldsw + _i * 8192), 16, 0, 0); } while (0)
#define PG8_LDA(dst, b, h) do { _Pragma("unroll") for (int m = 0; m < 4; ++m) _Pragma("unroll") for (int k = 0; k < 2; ++k) dst[m][k] = *(const LAS bf16x8*)(lds + PG8_SA(b, h) + aoff + m * 2048 + k * 1024); } while (0)
#define PG8_LDB(dst, b, h) do { _Pragma("unroll") for (int n = 0; n < 2; ++n) _Pragma("unroll") for (int k = 0; k < 2; ++k) dst[n][k] = *(const LAS bf16x8*)(lds + PG8_SB(b, h) + boff + n * 2048 + k * 1024); } while (0)
#define PG8_MMA(ai, bj, At, Bt) do { __builtin_amdgcn_s_setprio(1); _Pragma("unroll") for (int m = 0; m < 4; ++m) _Pragma("unroll") for (int n = 0; n < 2; ++n) _Pragma("unroll") for (int k = 0; k < 2; ++k) \
        acc[ai][bj][m][n] = __builtin_amdgcn_mfma_f32_16x16x32_bf16(Bt[n][k], At[m][k], acc[ai][bj][m][n], 0, 0, 0); __builtin_amdgcn_s_setprio(0); } while (0)
#define PG8_WAIT_V(n) asm volatile("s_waitcnt vmcnt(" #n ")" ::: "memory")
#define PG8_WAIT_L(n) asm volatile("s_waitcnt lgkmcnt(" #n ")" ::: "memory")
#define PG8_BAR __builtin_amdgcn_s_barrier()
#define PG8_SCHED __builtin_amdgcn_sched_barrier(0)
#define PG8_ROWS(dst, u) do { _Pragma("unroll") for (int _h = 0; _h < 2; ++_h) _Pragma("unroll") for (int _i = 0; _i < 2; ++_i) dst[_h][_i] = S.arow(u, _h * HALF + R0 + 64 * _i) * rowb + colb; } while (0)
    Unit cur, nxt; int ui = 0;
    if (!S.next(0, cur)) return;
    f32x4 acc[2][2][4][2];
#pragma unroll
    for (int a = 0; a < 2; ++a)
#pragma unroll
        for (int b = 0; b < 2; ++b)
#pragma unroll
            for (int m = 0; m < 4; ++m)
#pragma unroll
                for (int n = 0; n < 2; ++n) acc[a][b][m][n] = (f32x4){0.f, 0.f, 0.f, 0.f};
    bf16x8 At[4][2], B0[2][2], B1[2][2];
    unsigned oc[2][2], on[2][2];
    PG8_ROWS(oc, cur);
    const char* gA = (const char*)g.A;
    const char* cB = (const char*)g.Bt + (size_t)cur.pn * tstep;
    PG8_STAGE(PG8_SB(0, 0), cB, voffB); PG8_STAGE(PG8_SA(0, 0), gA, oc[0]); PG8_STAGE(PG8_SB(0, 1), cB + hstep, voffB); PG8_STAGE(PG8_SA(0, 1), gA, oc[1]);
    if (wr == 1) PG8_BAR;
    PG8_WAIT_V(4); PG8_BAR;
    PG8_STAGE(PG8_SB(1, 0), cB + kstep, voffB); PG8_STAGE(PG8_SA(1, 0), gA + kstep, oc[0]); PG8_STAGE(PG8_SB(1, 1), cB + hstep + kstep, voffB);
    PG8_WAIT_V(6); PG8_BAR;
    const int tpre = nt >= 4 ? nt - 4 : nt - 2;
    for (;;) {
        const bool has_next = S.next(ui + 1, nxt);
#pragma unroll
        for (int h = 0; h < 2; ++h)
#pragma unroll
            for (int i = 0; i < 2; ++i) on[h][i] = oc[h][i];
        const char* nB = has_next ? (const char*)g.Bt + (size_t)nxt.pn * tstep : cB;
        for (int t = 0; t < nt; t += 2) {
            const bool last = (t == nt - 2);
            if (has_next && t == tpre) PG8_ROWS(on, nxt);
            const char* a1 = gA + (size_t)(t + 1) * kstep;
            const char* a2 = last ? gA : gA + (size_t)(t + 2) * kstep; const char* b2 = last ? nB : cB + (size_t)(t + 2) * kstep;
            const char* a3 = a2 + kstep; const char* b3 = b2 + kstep;
            unsigned o2[2][2];
#pragma unroll
            for (int h = 0; h < 2; ++h)
#pragma unroll
                for (int i = 0; i < 2; ++i) o2[h][i] = last ? on[h][i] : oc[h][i];
            PG8_LDB(B0, 0, 0); PG8_SCHED; PG8_LDA(At, 0, 0); PG8_STAGE(PG8_SA(1, 1), a1, oc[1]);
            PG8_WAIT_L(8); PG8_BAR; PG8_WAIT_L(0); PG8_MMA(0, 0, At, B0); PG8_BAR; PG8_SCHED;
            PG8_LDB(B1, 0, 1); PG8_STAGE(PG8_SB(0, 0), b2, voffB);
            PG8_BAR; PG8_WAIT_L(0); PG8_MMA(0, 1, At, B1); PG8_BAR;
            PG8_LDA(At, 0, 1); PG8_STAGE(PG8_SA(0, 0), a2, o2[0]);
            PG8_BAR; PG8_WAIT_L(0); PG8_MMA(1, 0, At, B0); PG8_BAR; PG8_SCHED;
            PG8_STAGE(PG8_SB(0, 1), b2 + hstep, voffB);
            PG8_WAIT_V(6); PG8_BAR; PG8_MMA(1, 1, At, B1); PG8_BAR;
            PG8_LDB(B0, 1, 0); PG8_SCHED; PG8_LDA(At, 1, 0); PG8_STAGE(PG8_SA(0, 1), a2, o2[1]);
            PG8_WAIT_L(8); PG8_BAR; PG8_WAIT_L(0); PG8_MMA(0, 0, At, B0); PG8_BAR; PG8_SCHED;
            PG8_LDB(B1, 1, 1); PG8_STAGE(PG8_SB(1, 0), b3, voffB);
            PG8_BAR; PG8_WAIT_L(0); PG8_MMA(0, 1, At, B1); PG8_BAR;
            PG8_LDA(At, 1, 1); PG8_STAGE(PG8_SA(1, 0), a3, o2[0]);
            PG8_BAR; PG8_WAIT_L(0); PG8_MMA(1, 0, At, B0); PG8_BAR; PG8_SCHED;
            PG8_STAGE(PG8_SB(1, 1), b3 + hstep, voffB);
            PG8_WAIT_V(6); PG8_BAR; PG8_MMA(1, 1, At, B1); PG8_BAR;
        }
        E(acc, cur, wr, wc, fr, fq);
        if (!has_next) break;
#pragma unroll
        for (int a = 0; a < 2; ++a)
#pragma unroll
            for (int b = 0; b < 2; ++b)
#pragma unroll
                for (int m = 0; m < 4; ++m)
#pragma unroll
                    for (int n = 0; n < 2; ++n) acc[a][b][m][n] = (f32x4){0.f, 0.f, 0.f, 0.f};
        cur = nxt; cB = nB; ++ui;
#pragma unroll
        for (int h = 0; h < 2; ++h)
#pragma unroll
            for (int i = 0; i < 2; ++i) oc[h][i] = on[h][i];
    }
    PG8_WAIT_V(0);
    if (wr == 0) PG8_BAR;
    PG8_BAR;
#undef PG8_SA
#undef PG8_SB
#undef PG8_STAGE
#undef PG8_LDA
#undef PG8_LDB
#undef PG8_MMA
#undef PG8_WAIT_V
#undef PG8_WAIT_L
#undef PG8_BAR
#undef PG8_SCHED
#undef PG8_ROWS
}

struct EpiBf16 {
    static constexpr bool PERM = true;
    bf16_t* O; int ldc; int mode;
    __device__ __forceinline__ void operator()(const f32x4 (&acc)[2][2][4][2], const Unit& u, int wr, int wc, int fr, int fq) const {
        const int rowb = (mode == 1 ? (u.pm & 127) : u.pm) * BM, colb = (mode == 1 ? 1024 : 0) + u.pn * BM;
        const int row0 = rowb + wr * 64 + fr, col0 = colb + wc * 32 + 8 * fq;
#pragma unroll
        for (int ai = 0; ai < 2; ++ai)
#pragma unroll
            for (int m = 0; m < 4; ++m) { bf16_t* rowp = O + (size_t)(row0 + ai * HALF + m * 16) * ldc + col0;
#pragma unroll
                for (int bj = 0; bj < 2; ++bj) { const f32x4 v0 = acc[ai][bj][m][0], v1 = acc[ai][bj][m][1];
                    u32x4 w; w.x = pk_bf16(v0[0], v0[1]); w.y = pk_bf16(v0[2], v0[3]); w.z = pk_bf16(v1[0], v1[1]); w.w = pk_bf16(v1[2], v1[3]);
                    *(u32x4*)(rowp + bj * HALF) = w; } }
    }
};
struct EpiMix {
    static constexpr bool PERM = false;
    const float* x; const float* ada; float* out;
    __device__ __forceinline__ void operator()(const f32x4 (&acc)[2][2][4][2], const Unit& u, int wr, int wc, int fr, int fq) const {
        const int row0 = u.pm * BM + wr * 64 + fr, col0 = u.pn * BM + wc * 32 + 4 * fq;
        const float* gate = ada + (size_t)(u.pm >> 5) * 12288 + 2 * 2048;
        f32x4 gv[2][2];
#pragma unroll
        for (int bj = 0; bj < 2; ++bj)
#pragma unroll
            for (int n = 0; n < 2; ++n) gv[bj][n] = *(const f32x4*)(gate + col0 + bj * HALF + n * 16);
#pragma unroll
        for (int ai = 0; ai < 2; ++ai)
#pragma unroll
            for (int m = 0; m < 4; ++m) { const size_t ro = (size_t)(row0 + ai * HALF + m * 16) * D + col0;
#pragma unroll
                for (int bj = 0; bj < 2; ++bj)
#pragma unroll
                    for (int n = 0; n < 2; ++n) { const f32x4 xv = *(const f32x4*)(x + ro + bj * HALF + n * 16); *(f32x4*)(out + ro + bj * HALF + n * 16) = xv + gv[bj][n] * acc[ai][bj][m][n]; } }
    }
};
struct EpiAct {
    static constexpr bool PERM = true;
    bf16_t* ACT;
    __device__ __forceinline__ void operator()(const f32x4 (&acc)[2][2][4][2], const Unit& u, int wr, int wc, int fr, int fq) const {
        const int row0 = u.pm * BM + wr * 64 + fr, col0 = (u.pn & 3) * 128 + wc * 32 + 8 * fq;
#pragma unroll
        for (int ai = 0; ai < 2; ++ai)
#pragma unroll
            for (int m = 0; m < 4; ++m) {
                float v[8];
#pragma unroll
                for (int n = 0; n < 2; ++n)
#pragma unroll
                    for (int e = 0; e < 4; ++e) { const float a = acc[ai][0][m][n][e], b = acc[ai][1][m][n][e]; v[n * 4 + e] = a / (1.0f + __expf(-a)) * b; }
                *(u32x4*)(ACT + (size_t)(row0 + ai * HALF + m * 16) * 512 + col0) = pack8(v);
            }
    }
};
struct EpiMoeY0 {
    static constexpr bool PERM = true;
    const int* rowtok; const float* roww; const float* ada; bf16_t* Y0;
    __device__ __forceinline__ void operator()(const f32x4 (&acc)[2][2][4][2], const Unit& u, int wr, int wc, int fr, int fq) const {
        const int row0 = u.pm * BM + wr * 64 + fr, col0 = (u.pn & 7) * BM + wc * 32 + 8 * fq;
#pragma unroll
        for (int ai = 0; ai < 2; ++ai)
#pragma unroll
            for (int m = 0; m < 4; ++m) { const int row = row0 + ai * HALF + m * 16; const int tok = rowtok[row];
                if (tok >= 0) { const float w = roww[row]; const float* gate = ada + (size_t)(tok >> 13) * 12288 + 5 * 2048 + col0; bf16_t* yp = Y0 + (size_t)tok * D + col0;
#pragma unroll
                    for (int bj = 0; bj < 2; ++bj) { const f32x4 g0 = *(const f32x4*)(gate + bj * HALF), g1 = *(const f32x4*)(gate + bj * HALF + 4);
                        const f32x4 v0 = g0 * w * acc[ai][bj][m][0], v1 = g1 * w * acc[ai][bj][m][1];
                        u32x4 o; o.x = pk_bf16(v0[0], v0[1]); o.y = pk_bf16(v0[2], v0[3]); o.z = pk_bf16(v1[0], v1[1]); o.w = pk_bf16(v1[2], v1[3]);
                        *(u32x4*)(yp + bj * HALF) = o; } } }
    }
};
struct EpiMoeOut {
    static constexpr bool PERM = false;
    const int* rowtok; const float* roww; const float* ada; const bf16_t* Y0; float* out;
    __device__ __forceinline__ void operator()(const f32x4 (&acc)[2][2][4][2], const Unit& u, int wr, int wc, int fr, int fq) const {
        const int row0 = u.pm * BM + wr * 64 + fr, col0 = (u.pn & 7) * BM + wc * 32 + 4 * fq;
#pragma unroll
        for (int ai = 0; ai < 2; ++ai)
#pragma unroll
            for (int m = 0; m < 4; ++m) { const int row = row0 + ai * HALF + m * 16; const int tok = rowtok[row];
                if (tok >= 0) { const float w = roww[row]; const float* gate = ada + (size_t)(tok >> 13) * 12288 + 5 * 2048 + col0; float* op = out + (size_t)tok * D + col0; const bf16_t* yp = Y0 + (size_t)tok * D + col0;
#pragma unroll
                    for (int bj = 0; bj < 2; ++bj)
#pragma unroll
                        for (int n = 0; n < 2; ++n) { const f32x4 gvv = *(const f32x4*)(gate + bj * HALF + n * 16); f32x4 o = *(f32x4*)(op + bj * HALF + n * 16); const u32x2 y = *(const u32x2*)(yp + bj * HALF + n * 16);
                            o += (f32x4){bf_lo(y.x), bf_hi(y.x), bf_lo(y.y), bf_hi(y.y)} + gvv * w * acc[ai][bj][m][n]; *(f32x4*)(op + bj * HALF + n * 16) = o; } } }
    }
};
}

__device__ __forceinline__ int colmap(int n) { return n < 2560 ? n : (n < 2624 ? 3584 + (n - 2560) : (n < 2640 ? 3648 + (n - 2624) : 2560 + (n - 2640))); }

template <class RowMap>
__device__ __forceinline__ void tr_tile(const Frame& F, const float* src, size_t ldS, int k0, int n0, int N, const float* cscale, RowMap rm) {
    LAS float* tile = (LAS float*)F.lds;
    const int tid = F.tid, r = tid >> 4, c4 = tid & 15;
    f32x4 v[4];
    const int n = n0 + c4 * 4;
#pragma unroll
    for (int i = 0; i < 4; ++i) v[i] = (n < N) ? *(const f32x4*)(src + (size_t)(k0 + r + 32 * i) * ldS + n) : (f32x4){0.f, 0.f, 0.f, 0.f};
    __syncthreads();
#pragma unroll
    for (int i = 0; i < 4; ++i)
#pragma unroll
        for (int e = 0; e < 4; ++e) tile[(r + 32 * i) * 65 + c4 * 4 + e] = v[i][e];
    __syncthreads();
    const int nn = tid >> 3, kc = tid & 7;
    if (n0 + nn < N) {
        const float sc = cscale ? cscale[n0 + nn] : 1.0f;
        float f[16];
#pragma unroll
        for (int j = 0; j < 16; ++j) f[j] = tile[(kc * 16 + j) * 65 + nn] * sc;
        bf16_t* d = rm(n0 + nn) + k0 + kc * 16;
        *(u32x4*)d = pack8(f); *(u32x4*)(d + 8) = pack8(f + 8);
    }
}

__device__ __forceinline__ void p0_prologue(const Frame& F) {
    constexpr int U_ADA = 192, T_WIN = 16 * 58, T_WOUT = 16 * 32, T_POOL = 4 * 2 * 4, T_W1 = 32 * 128, T_W2 = 32 * 128, U_TAB = 16, U_WR = 4, U_PAD = 2;
    constexpr int B0 = U_ADA, B1 = B0 + T_WIN, B2 = B1 + T_WOUT, B3 = B2 + T_POOL, B4 = B3 + T_W1, B5 = B4 + T_W1, B6 = B5 + T_W2, B7 = B6 + U_TAB, B8 = B7 + U_WR, B9 = B8 + U_PAD;
    const int tid = F.tid;
    constexpr int NTILE = B6 - B0;
    static_assert(NTILE == 13760, "tile split");
    const int nmine = 1 + 50 + (F.bid >= 192 ? 15 : 0);
    for (int it = 0; it < nmine; ++it) {
        int u;
        if (it == 0) { u = F.bid < 192 ? F.bid : (F.bid - 192 < 22 ? B6 + (F.bid - 192) : -1); if (u < 0) continue; }
        else if (it <= 50) u = B0 + F.bid + 256 * (it - 1);
        else u = B0 + 12800 + (F.bid - 192) + 64 * (it - 51);
        if (u < B0) {
            const int kc = u / 6, cb = u % 6;
            LAS float* sc = (LAS float*)F.lds;
            __syncthreads();
            if (tid < 256) { const int b = tid >> 6, k = tid & 63; const float cv = F.c[b * D + kc * 64 + k]; sc[tid] = cv / (1.0f + __expf(-cv)); }
            __syncthreads();
            const int n = cb * 2048 + tid * 4;
            f32x4 a[4];
#pragma unroll
            for (int b = 0; b < 4; ++b) a[b] = (f32x4){0.f, 0.f, 0.f, 0.f};
            const float* wp = F.w_ada + (size_t)(kc * 64) * 12288 + n;
#pragma unroll 8
            for (int k = 0; k < 64; ++k) { const f32x4 w = *(const f32x4*)(wp + (size_t)k * 12288);
#pragma unroll
                for (int b = 0; b < 4; ++b) a[b] += sc[b * 64 + k] * w; }
            const f32x4 bias = (kc == 0) ? *(const f32x4*)(F.b_ada + n) : (f32x4){0.f, 0.f, 0.f, 0.f};
#pragma unroll
            for (int b = 0; b < 4; ++b) *(f32x4*)(F.ADAP + ((size_t)kc * 4 + b) * 12288 + n) = a[b] + bias;
        } else if (u < B1) {
            const int v = u - B0, kt = v / 58, ntl = v % 58; bf16_t* W = F.WIN;
            tr_tile(F, F.w_in, 3664, kt * 128, ntl * 64, 3664, nullptr, [=](int n) { return W + (size_t)colmap(n) * 2048; });
        } else if (u < B2) {
            const int v = u - B1, kt = v / 32, ntl = v % 32; bf16_t* W = F.WOUT;
            tr_tile(F, F.w_out, 2048, kt * 128, ntl * 64, 2048, nullptr, [=](int n) { return W + (size_t)n * 2048; });
        } else if (u < B3) {
            const int v = u - B2, g = v / 8, kt = (v % 8) / 4, ntl = v % 4; bf16_t* W = F.WPOOL + (size_t)g * 256 * 256;
            tr_tile(F, F.w_pool + (size_t)g * 65536, 256, kt * 128, ntl * 64, 256, F.pool_scale + g * 256, [=](int n) { return W + (size_t)n * 256; });
        } else if (u < B5) {
            const bool is3 = u >= B4; const int v = u - (is3 ? B4 : B3), e = v / 128, kt = (v % 128) / 8, ntl = v % 8;
            bf16_t* W = F.W13 + (size_t)e * 1024 * 2048 + (is3 ? (size_t)128 * 2048 : 0);
            tr_tile(F, (is3 ? F.w3 : F.w1) + (size_t)e * 2048 * 512, 512, kt * 128, ntl * 64, 512, nullptr, [=](int n) { return W + (size_t)((n >> 7) * 256 + (n & 127)) * 2048; });
        } else if (u < B6) {
            const int v = u - B5, e = v / 128, kt = (v % 128) / 32, ntl = v % 32; bf16_t* W = F.W2 + (size_t)e * 2048 * 512;
            tr_tile(F, F.w2 + (size_t)e * 512 * 2048, 2048, kt * 128, ntl * 64, 2048, nullptr, [=](int n) { return W + (size_t)n * 512; });
        } else if (u < B7) {
            const int pos = (u - B6) * 512 + tid; float* tp = F.TAB + (size_t)pos * 48;
            for (int i = 0; i < 16; ++i) { const double inv = pow(500000.0, -(double)(2 * i) / 32.0); double sn, cs; sincos((double)pos * inv, &sn, &cs); tp[i] = (float)cs; tp[16 + i] = (float)sn; }
            for (int i = 0; i < 8; ++i) { const double inv = pow(500000.0, -(double)(2 * i) / 16.0); double sn, cs; sincos((double)pos * inv, &sn, &cs); tp[32 + i] = (float)cs; tp[40 + i] = (float)sn; }
        } else if (u < B8) {
            const int j0 = (u - B7) * 12;
            for (int idx = tid; idx < 12 * 2048; idx += NTHREADS) { const int j = j0 + idx / 2048, k = idx % 2048;
                const float v = j < 4 ? F.w_grp[k * 4 + j] : (j < 36 ? F.w_exp[k * 32 + (j - 4)] : 0.f);
                bf16v2 t; t.x = (__bf16)v; t.y = (__bf16)0.f; F.WR[(size_t)j * 2048 + k] = (bf16_t)(__builtin_bit_cast(unsigned, t) & 0xffffu); }
        } else {
            const int h = u - B8; u32x4* p = (u32x4*)(F.WIN + (size_t)3664 * 2048) + (size_t)h * 22528;
            for (int i = tid; i < 22528; i += NTHREADS) p[i] = (u32x4){0u, 0u, 0u, 0u};
        }
    }
}

__device__ __forceinline__ size_t qi_off(size_t t, int head, int d) { return (t >> 1) * 2048 + (size_t)((d >> 4) * 512 + (((head & 3) + 4 * (int)(t & 1) + 8 * (head >> 2)) + 32 * ((d >> 3) & 1)) * 8 + (d & 7)); }
__device__ __forceinline__ size_t ki_off(size_t s, int d) { const int kin = (int)(s & 127); return (s >> 7) * 8192 + (size_t)(((kin & 3) * 4 + (d >> 4)) * 512 + ((kin >> 2) + 32 * ((d >> 3) & 1)) * 8 + (d & 7)); }

__device__ __forceinline__ void norm_rows(const Frame& F, const float* src, const float* gain, const float* shiftp, const float* scalep) {
    const int lane = F.lane;
    f32x4 Gv[8], Sv[8];
#pragma unroll
    for (int i = 0; i < 8; ++i) { const int col = 4 * lane + 256 * i; const f32x4 g = *(const f32x4*)(gain + col), sc = *(const f32x4*)(scalep + col);
        Gv[i] = g * (1.0f + sc); Sv[i] = *(const f32x4*)(shiftp + col); }
    f32x4 v[8], vn[8];
    { const float* xr = src + (size_t)(F.bid * 128 + F.wave) * D;
#pragma unroll
      for (int i = 0; i < 8; ++i) v[i] = *(const f32x4*)(xr + 4 * lane + 256 * i); }
    for (int j = 0; j < 16; ++j) {
        const int t = F.bid * 128 + F.wave + 8 * j;
        if (j < 15) { const float* xn = src + (size_t)(t + 8) * D;
#pragma unroll
            for (int i = 0; i < 8; ++i) vn[i] = *(const f32x4*)(xn + 4 * lane + 256 * i); }
        float ss = 0.f;
#pragma unroll
        for (int i = 0; i < 8; ++i) ss += v[i][0] * v[i][0] + v[i][1] * v[i][1] + v[i][2] * v[i][2] + v[i][3] * v[i][3];
        ss = wave_sum(ss);
        const float rstd = rsqrtf(ss * (1.0f / 2048.0f) + NORM_EPS);
        bf16_t* hr = F.H + (size_t)t * D;
#pragma unroll
        for (int i = 0; i < 8; ++i) { const f32x4 y = v[i] * rstd * Gv[i] + Sv[i]; u32x2 w; w.x = pk_bf16(y[0], y[1]); w.y = pk_bf16(y[2], y[3]); *(u32x2*)(hr + 4 * lane + 256 * i) = w; }
        if (j < 15) {
#pragma unroll
            for (int i = 0; i < 8; ++i) v[i] = vn[i]; }
    }
}

__device__ __forceinline__ void p3_post(const Frame& F) {
    const int lane = F.lane;
    LAS float* kw = (LAS float*)F.lds + F.wave * 1280;
    {
        const int li = lane & 15, q4 = lane >> 4;
        f32x4 acc[5];
#pragma unroll
        for (int nb = 0; nb < 5; ++nb) acc[nb] = (f32x4){0.f, 0.f, 0.f, 0.f};
        const bf16_t* hp = F.H + (size_t)(F.bid * 128 + F.wave + 8 * li) * D + 8 * q4;
        LAS bf16_t* bs = (LAS bf16_t*)(F.lds + 40960);
        for (int kc = 0; kc < 8; ++kc) {
            u32x4 st[5];
#pragma unroll
            for (int i = 0; i < 5; ++i) { const int piece = F.tid + 512 * i, row = piece >> 5, pc = piece & 31; st[i] = *(const u32x4*)(F.WIN + (size_t)(3584 + row) * D + kc * 256 + pc * 8); }
            bf16x8 a[8];
#pragma unroll
            for (int ks = 0; ks < 8; ++ks) a[ks] = *(const bf16x8*)(hp + 32 * (kc * 8 + ks));
            __syncthreads();
#pragma unroll
            for (int i = 0; i < 5; ++i) { const int piece = F.tid + 512 * i, row = piece >> 5, pc = piece & 31; *(LAS u32x4*)(bs + row * 264 + pc * 8) = st[i]; }
            __syncthreads();
#pragma unroll
            for (int ks = 0; ks < 8; ++ks)
#pragma unroll
                for (int nb = 0; nb < 5; ++nb) { const bf16x8 bb = *(const LAS bf16x8*)(bs + (nb * 16 + li) * 264 + ks * 32 + 8 * q4); acc[nb] = __builtin_amdgcn_mfma_f32_16x16x32_bf16(a[ks], bb, acc[nb], 0, 0, 0); }
        }
#pragma unroll
        for (int nb = 0; nb < 5; ++nb)
#pragma unroll
            for (int i = 0; i < 4; ++i) kw[(4 * q4 + i) * 80 + nb * 16 + li] = acc[nb][i];
        asm volatile("s_waitcnt lgkmcnt(0)" ::: "memory");
    }
    const float QSCALE = 0.08838834764831845f * 1.4426950408889634f;
    const float IDX_SCALE = 0.125f * 0.25f;
    for (int j = 0; j < 16; ++j) {
        const int t = F.bid * 128 + F.wave + 8 * j, pos = t & (S - 1);
        const bf16_t* pr = F.PROJ + (size_t)t * NPROJ;
        const float* tab = F.TAB + (size_t)pos * 48;
        const int gpl = lane >> 4, wpl = 2 << gpl;
        const u32x4 Lq0 = *(const u32x4*)(pr + CQ + 16 * lane), Lq1 = *(const u32x4*)(pr + CQ + 16 * lane + 8);
        const u32x4 Lk0 = *(const u32x4*)(pr + CK + 16 * (lane & 31)), Lk1 = *(const u32x4*)(pr + CK + 16 * (lane & 31) + 8);
        const u32x4 Li0 = *(const u32x4*)(pr + CQI + 16 * lane), Li1 = *(const u32x4*)(pr + CQI + 16 * lane + 8);
        const u32x4 Lp0 = *(const u32x4*)(pr + CP + 16 * lane), Lp1 = *(const u32x4*)(pr + CP + 16 * lane + 8);
        u32x4 wl[15][2];
#pragma unroll
        for (int r = 1; r < 16; ++r) { int rr = r < wpl ? r : wpl - 1; rr = rr <= pos ? rr : pos; const bf16_t* pp = pr - (size_t)rr * NPROJ + CP + 16 * lane; wl[r - 1][0] = *(const u32x4*)pp; wl[r - 1][1] = *(const u32x4*)(pp + 8); }
        {
            float f[16]; unpack8(Lq0, f); unpack8(Lq1, f + 8);
            float ss = 0.f;
#pragma unroll
            for (int e = 0; e < 16; ++e) ss += f[e] * f[e];
            ss += __shfl_xor(ss, 1); ss += __shfl_xor(ss, 2); ss += __shfl_xor(ss, 4);
            const float rstd = rsqrtf(ss * (1.0f / 128.0f) + NORM_EPS);
            const int d0 = (lane & 7) * 16;
#pragma unroll
            for (int e = 0; e < 16; ++e) f[e] = f[e] * rstd * F.q_norm_g[d0 + e];
            float o[16];
#pragma unroll
            for (int e = 0; e < 16; ++e) o[e] = __shfl_xor(f[e], 1);
            const int l8 = lane & 7;
            if (l8 < 2) {
#pragma unroll
                for (int e = 0; e < 16; ++e) { const float cs = tab[e], sn = tab[16 + e]; f[e] = (l8 == 0) ? (f[e] * cs - o[e] * sn) : (f[e] * cs + o[e] * sn); }
            }
#pragma unroll
            for (int e = 0; e < 16; ++e) f[e] *= QSCALE;
            bf16_t* qo = F.QB + (size_t)t * 1024 + 16 * lane;
            *(u32x4*)qo = pack8(f); *(u32x4*)(qo + 8) = pack8(f + 8);
        }
        {
            const int l = lane & 31;
            float f[16]; unpack8(Lk0, f); unpack8(Lk1, f + 8);
            float kf[16]; float ss = 0.f;
#pragma unroll
            for (int e = 0; e < 16; ++e) ss += f[e] * f[e];
            ss += __shfl_xor(ss, 1); ss += __shfl_xor(ss, 2); ss += __shfl_xor(ss, 4);
            const float rstd = rsqrtf(ss * (1.0f / 128.0f) + NORM_EPS);
            const int d0 = (l & 7) * 16;
#pragma unroll
            for (int e = 0; e < 16; ++e) kf[e] = f[e] * rstd * F.k_norm_g[d0 + e];
            float o[16];
#pragma unroll
            for (int e = 0; e < 16; ++e) o[e] = __shfl_xor(kf[e], 1);
            const int l8 = l & 7;
            if (l8 < 2) {
#pragma unroll
                for (int e = 0; e < 16; ++e) { const float cs = tab[e], sn = tab[16 + e]; kf[e] = (l8 == 0) ? (kf[e] * cs - o[e] * sn) : (kf[e] * cs + o[e] * sn); }
            }
            if (lane < 32) {
                const bool isv = lane >= 16; const int ll = lane & 15, g = ll >> 3, dd = (ll & 7) * 16;
                bf16_t* dst = F.KV + (size_t)t * 512 + g * 256 + (isv ? 128 : 0) + dd;
                *(u32x4*)dst = pack8(isv ? f : kf); *(u32x4*)(dst + 8) = pack8(isv ? f + 8 : kf + 8);
            }
        }
        {
            float f[16]; unpack8(Li0, f); unpack8(Li1, f + 8);
            if ((lane & 3) == 0) {
#pragma unroll
                for (int i = 0; i < 8; ++i) { const float cs = tab[32 + i], sn = tab[40 + i]; const float x1 = f[i], x2 = f[i + 8]; f[i] = x1 * cs - x2 * sn; f[i + 8] = x2 * cs + x1 * sn; }
            }
            const int hd = lane >> 2, d0 = (lane & 3) * 16;
            *(u32x4*)(F.QI + qi_off((size_t)t, hd, d0)) = pack8(f); *(u32x4*)(F.QI + qi_off((size_t)t, hd, d0 + 8)) = pack8(f + 8);
        }
        if (lane < 5) {
            float f[16];
#pragma unroll
            for (int e = 0; e < 16; ++e) f[e] = kw[j * 80 + 16 * lane + e];
            if (lane == 0) {
#pragma unroll
                for (int i = 0; i < 8; ++i) { const float cs = tab[32 + i], sn = tab[40 + i]; const float x1 = f[i], x2 = f[i + 8]; f[i] = x1 * cs - x2 * sn; f[i + 8] = x2 * cs + x1 * sn; }
            }
            if (lane < 4) { *(u32x4*)(F.KI + ki_off((size_t)t, 16 * lane)) = pack8(f); *(u32x4*)(F.KI + ki_off((size_t)t, 16 * lane + 8)) = pack8(f + 8); }
            else { float* wo = F.WI + (size_t)t * 16;
#pragma unroll
                for (int e = 0; e < 16; ++e) wo[e] = f[e] * IDX_SCALE; }
        }
        {
            const int g = lane >> 4, w = 2 << g;
            float cur[16], sum[16];
            unpack8(Lp0, cur); unpack8(Lp1, cur + 8);
#pragma unroll
            for (int e = 0; e < 16; ++e) sum[e] = cur[e];
#pragma unroll
            for (int r = 1; r < 16; ++r) {
                float f[16]; unpack8(wl[r - 1][0], f); unpack8(wl[r - 1][1], f + 8);
                const float use = (r < w && r <= pos) ? 1.0f : 0.0f;
#pragma unroll
                for (int e = 0; e < 16; ++e) sum[e] += use * f[e];
            }
            const float inv = 1.0f / (float)((pos + 1) < w ? (pos + 1) : w);
#pragma unroll
            for (int e = 0; e < 16; ++e) sum[e] = sum[e] * inv - cur[e];
            bf16_t* po = F.PM + ((size_t)g * T + t) * 256 + (lane & 15) * 16;
            *(u32x4*)po = pack8(sum); *(u32x4*)(po + 8) = pack8(sum + 8);
        }
    }
}

__device__ __forceinline__ size_t sc_block_base(int b, int qb) { return (size_t)b * SC_BATCH + (size_t)16384 * ((size_t)qb * (qb + 1) / 2); }

__device__ __forceinline__ void indexer_unit(const Frame& F, int b, int qb, int kb) {
    const int lane = F.lane, wid = F.wave, c = lane & 31, hf = lane >> 5;
    bf16x8 kf[4][4];
    const bf16_t* kib = F.KI + (((size_t)b * S + kb * 128) >> 7) * 8192 + lane * 8;
#pragma unroll
    for (int sub = 0; sub < 4; ++sub)
#pragma unroll
        for (int kk = 0; kk < 4; ++kk) kf[sub][kk] = *(const bf16x8*)(kib + (sub * 4 + kk) * 512);
    const int qq = (c >> 2) & 1, head = (c & 3) + 4 * (c >> 3);
    const size_t rowlen = (size_t)(qb + 1) * 128;
    unsigned short* scb = F.SC + sc_block_base(b, qb);
    const size_t tq0 = (size_t)b * S + qb * 128 + wid * 16;
    bf16x8 af[4], afn[4]; f32x4 wv[4], wvn[4];
#pragma unroll
    for (int kk = 0; kk < 4; ++kk) af[kk] = *(const bf16x8*)(F.QI + (tq0 >> 1) * 2048 + kk * 512 + lane * 8);
#pragma unroll
    for (int i = 0; i < 4; ++i) wv[i] = *(const f32x4*)(F.WI + (tq0 + hf) * 16 + 4 * i);
#pragma unroll
    for (int pair = 0; pair < 8; ++pair) {
        const int r0 = wid * 16 + pair * 2;
        if (pair < 7) {
#pragma unroll
            for (int kk = 0; kk < 4; ++kk) afn[kk] = *(const bf16x8*)(F.QI + ((tq0 >> 1) + pair + 1) * 2048 + kk * 512 + lane * 8);
#pragma unroll
            for (int i = 0; i < 4; ++i) wvn[i] = *(const f32x4*)(F.WI + (tq0 + 2 * (pair + 1) + hf) * 16 + 4 * i);
        }
        float sc[4];
#pragma unroll
        for (int sub = 0; sub < 4; ++sub) {
            f32x16 acc;
#pragma unroll
            for (int i = 0; i < 16; ++i) acc[i] = 0.f;
#pragma unroll
            for (int kk = 0; kk < 4; ++kk) acc = __builtin_amdgcn_mfma_f32_32x32x16_bf16(af[kk], kf[sub][kk], acc, 0, 0, 0);
            float s = 0.f;
#pragma unroll
            for (int i = 0; i < 16; ++i) { const float av = acc[i]; const int ai = __float_as_int(av); const float rl = __int_as_float(ai > 0 ? ai : 0); const float wi_ = wv[i >> 2][i & 3];
                asm("v_fmac_f32 %0, %1, %2" : "+v"(s) : "v"(wi_), "v"(rl)); }
            sc[sub] = s;
        }
        f16v2 h0, h1; h0.x = (_Float16)sc[0]; h0.y = (_Float16)sc[1]; h1.x = (_Float16)sc[2]; h1.y = (_Float16)sc[3];
        u32x2 w; w.x = __builtin_bit_cast(unsigned, h0); w.y = __builtin_bit_cast(unsigned, h1);
        *(u32x2*)(scb + (size_t)(r0 + hf) * rowlen + kb * 128 + 4 * c) = w;
        if (pair < 7) {
#pragma unroll
            for (int kk = 0; kk < 4; ++kk) af[kk] = afn[kk];
#pragma unroll
            for (int i = 0; i < 4; ++i) wv[i] = wvn[i];
        }
    }
}

__device__ __forceinline__ void find_bin(LAS unsigned* hist, int lane, unsigned need, unsigned& bin, unsigned& above) {
    const u32x4 h = *(const LAS u32x4*)(hist + 4 * lane);
    const unsigned s = h.x + h.y + h.z + h.w;
    unsigned v = s;
#pragma unroll
    for (int d = 1; d < 64; d <<= 1) { const unsigned tt = __shfl_down(v, d); if (lane + d < 64) v += tt; }
    unsigned run = v - s;
    int fb = -1; unsigned fa = 0;
    const unsigned hh[4] = {h.x, h.y, h.z, h.w};
#pragma unroll
    for (int j = 3; j >= 0; --j) { if (fb < 0 && run < need && run + hh[j] >= need) { fb = 4 * lane + j; fa = run; } run += hh[j]; }
    const unsigned long long m = __ballot(fb >= 0);
    const int src = m ? (int)__builtin_ctzll(m) : 0;
    bin = (unsigned)__shfl(fb, src); above = __shfl(fa, src);
}

__device__ __forceinline__ unsigned okey(unsigned h) { return (h & 0x8000u) ? (~h & 0xffffu) : (h | 0x8000u); }
__device__ __forceinline__ const unsigned short* sel_src(const Frame& F, int t) { const int pos = t & (S - 1), qb = pos >> 7; return F.SC + sc_block_base(t >> 13, qb) + (size_t)(pos & 127) * (qb + 1) * 128; }
__device__ __forceinline__ void select_row(const Frame& F, int t, const u32x4 (&pre)[16], LAS unsigned char* wbuf, int lane) {
    LAS unsigned* rowb = (LAS unsigned*)wbuf;
    LAS unsigned* hist = (LAS unsigned*)(wbuf + 16384);
    LAS unsigned short* lst = (LAS unsigned short*)(wbuf + 16384 + 1024);
    const int pos = t & (S - 1), n = pos + 1;
    unsigned short* out = F.SEL + (size_t)t * 256;
    if (n <= 256) { for (int j = lane; j < 256; j += 64) out[j] = (unsigned short)(j < n ? j : 0); return; }
    const int nch = (n + 511) >> 9;
#pragma unroll
    for (int ch = 0; ch < 16; ++ch) if (ch < nch) *(LAS u32x4*)(rowb + ch * 256 + lane * 4) = pre[ch];
#pragma unroll
    for (int i = 0; i < 4; ++i) hist[lane + 64 * i] = 0u;
    for (int ch = 0; ch < nch; ++ch) {
        const int base = ch * 512 + lane * 8;
        u32x4 raw = *(const LAS u32x4*)(rowb + ch * 256 + lane * 4);
#pragma unroll
        for (int w = 0; w < 4; ++w) {
            const unsigned k0 = (base + 2 * w < n) ? okey(raw[w] & 0xffffu) : 0u, k1 = (base + 2 * w + 1 < n) ? okey(raw[w] >> 16) : 0u;
            __hip_atomic_fetch_add(hist + (k0 >> 8), 1u, __ATOMIC_RELAXED, __HIP_MEMORY_SCOPE_WORKGROUP);
            __hip_atomic_fetch_add(hist + (k1 >> 8), 1u, __ATOMIC_RELAXED, __HIP_MEMORY_SCOPE_WORKGROUP);
            raw[w] = k0 | (k1 << 16);
        }
        *(LAS u32x4*)(rowb + ch * 256 + lane * 4) = raw;
    }
#if P5_PROBE == 1
    for (int ch = 0; ch < nch; ++ch) {
        const u32x4 raw = *(const LAS u32x4*)(rowb + ch * 256 + lane * 4);
#pragma unroll
        for (int w = 0; w < 4; ++w) {
            __hip_atomic_fetch_add(hist + ((raw[w] & 0xffffu) >> 8), 0u, __ATOMIC_RELAXED, __HIP_MEMORY_SCOPE_WORKGROUP);
            __hip_atomic_fetch_add(hist + (raw[w] >> 24), 0u, __ATOMIC_RELAXED, __HIP_MEMORY_SCOPE_WORKGROUP);
        }
    }
#endif
    unsigned bin1, above1; find_bin(hist, lane, 256u, bin1, above1);
    const unsigned r1 = 256u - above1;
#pragma unroll
    for (int i = 0; i < 4; ++i) hist[lane + 64 * i] = 0u;
    for (int ch = 0; ch < nch; ++ch) {
        const u32x4 raw = *(const LAS u32x4*)(rowb + ch * 256 + lane * 4);
#pragma unroll
        for (int w = 0; w < 4; ++w) {
            const unsigned k0 = raw[w] & 0xffffu, k1 = raw[w] >> 16;
            if ((k0 >> 8) == bin1) __hip_atomic_fetch_add(hist + (k0 & 255u), 1u, __ATOMIC_RELAXED, __HIP_MEMORY_SCOPE_WORKGROUP);
            if ((k1 >> 8) == bin1) __hip_atomic_fetch_add(hist + (k1 & 255u), 1u, __ATOMIC_RELAXED, __HIP_MEMORY_SCOPE_WORKGROUP);
        }
    }
    unsigned bin2, above2; find_bin(hist, lane, r1, bin2, above2);
#if P5_PROBE == 4
    { unsigned bx, ax; find_bin(hist, lane, r1, bx, ax); if (bx != bin2) bin2 = bx; find_bin(hist, lane, r1, bx, ax); if (bx != bin2) bin2 = bx; }
#endif
    const unsigned r2 = r1 - above2, thr = (bin1 << 8) | bin2;
    unsigned cg = 0, ce = 0;
    for (int ch = 0; ch < nch; ++ch) {
        const u32x4 raw = *(const LAS u32x4*)(rowb + ch * 256 + lane * 4);
#pragma unroll
        for (int e = 0; e < 8; ++e) { const unsigned key = (raw[e >> 1] >> ((e & 1) * 16)) & 0xffffu; cg += (key > thr) ? 1u : 0u; ce += (key == thr) ? 1u : 0u; }
    }
#if P5_PROBE == 2
    { unsigned cg2 = 0, ce2 = 0;
      for (int ch = 0; ch < nch; ++ch) {
        const u32x4 raw = *(const LAS u32x4*)(rowb + ch * 256 + lane * 4);
#pragma unroll
        for (int e = 0; e < 8; ++e) { const unsigned key = (raw[e >> 1] >> ((e & 1) * 16)) & 0xffffu; cg2 += (key > thr + 1u) ? 1u : 0u; ce2 += (key == thr + 1u) ? 1u : 0u; }
      }
      if (cg2 + ce2 == 0xffffffffu) cg += 1u; }
#endif
    unsigned og = cg, oe = ce;
#pragma unroll
    for (int d = 1; d < 64; d <<= 1) { const unsigned tg = __shfl_up(og, d), te = __shfl_up(oe, d); if (lane >= d) { og += tg; oe += te; } }
    og -= cg; oe -= ce;
    const unsigned G = above1 + above2;
    for (int ch = 0; ch < nch; ++ch) {
        const u32x4 raw = *(const LAS u32x4*)(rowb + ch * 256 + lane * 4);
#pragma unroll
        for (int e = 0; e < 8; ++e) {
            const unsigned key = (raw[e >> 1] >> ((e & 1) * 16)) & 0xffffu;
            const unsigned short id = (unsigned short)(ch * 512 + lane * 8 + e);
            if (key > thr) { if (og < 256u) lst[og] = id; ++og; }
            if (key == thr) { if (oe < r2 && G + oe < 256u) lst[G + oe] = id; ++oe; }
        }
    }
    *(u32x2*)(out + 4 * lane) = *(const LAS u32x2*)(lst + 4 * lane);
}

__device__ __forceinline__ bf16x8 tr_read2(unsigned a0, unsigned a1) {
    s16x4 x, y;
    asm volatile("ds_read_b64_tr_b16 %0, %2\n\tds_read_b64_tr_b16 %1, %3\n\ts_waitcnt lgkmcnt(0)" : "=&v"(x), "=&v"(y) : "v"(a0), "v"(a1) : "memory");
    return (bf16x8){x[0], x[1], x[2], x[3], y[0], y[1], y[2], y[3]};
}

__device__ __forceinline__ void tr_read16(const unsigned (&va)[4], s16x4 (&r)[16]) {
    asm volatile(
        "ds_read_b64_tr_b16 %0, %16\n\tds_read_b64_tr_b16 %1, %16 offset:4096\n\tds_read_b64_tr_b16 %2, %17\n\tds_read_b64_tr_b16 %3, %17 offset:4096\n\t"
        "ds_read_b64_tr_b16 %4, %18\n\tds_read_b64_tr_b16 %5, %18 offset:4096\n\tds_read_b64_tr_b16 %6, %19\n\tds_read_b64_tr_b16 %7, %19 offset:4096\n\t"
        "ds_read_b64_tr_b16 %8, %16 offset:512\n\tds_read_b64_tr_b16 %9, %16 offset:4608\n\tds_read_b64_tr_b16 %10, %17 offset:512\n\tds_read_b64_tr_b16 %11, %17 offset:4608\n\t"
        "ds_read_b64_tr_b16 %12, %18 offset:512\n\tds_read_b64_tr_b16 %13, %18 offset:4608\n\tds_read_b64_tr_b16 %14, %19 offset:512\n\tds_read_b64_tr_b16 %15, %19 offset:4608\n\t"
        "s_waitcnt lgkmcnt(0)"
        : "=&v"(r[0]), "=&v"(r[1]), "=&v"(r[2]), "=&v"(r[3]), "=&v"(r[4]), "=&v"(r[5]), "=&v"(r[6]), "=&v"(r[7]),
          "=&v"(r[8]), "=&v"(r[9]), "=&v"(r[10]), "=&v"(r[11]), "=&v"(r[12]), "=&v"(r[13]), "=&v"(r[14]), "=&v"(r[15])
        : "v"(va[0]), "v"(va[1]), "v"(va[2]), "v"(va[3]) : "memory");
}
#define AT_WAITV(n) asm volatile("s_waitcnt vmcnt(" #n ")" ::: "memory")
__device__ __forceinline__ int rot_k(int p) { return ((p & 1) ? 3 : 1) + ((p >> 2) & 1) * 4; }
__device__ __forceinline__ void attn_items(const Frame& F, int klo, int khi) {
    const int lane = F.lane, li = lane & 15, q4 = lane >> 4;
    const int xg = F.bid & 7, b = xg >> 1, g = xg & 1;
    const int wq = (F.bid >> 3) * 8 + F.wave;
    LAS unsigned char* wb = F.lds + F.wave * 16384;
    const unsigned wbu = (unsigned)(uintptr_t)wb;
    const bf16_t* kvb = F.KV + (size_t)b * S * 512 + g * 256;
    const int da = lane >> 3, dr = lane & 7, drow = da & 3, dline = da >> 2;
    const int koff0 = 64 * dline + 8 * ((dr + rot_k(drow >> 1)) & 7);
    const int voff0 = 128 + 64 * dline + 8 * ((dr + 2 * (drow >> 1)) & 7);
    const unsigned kra0 = (unsigned)((li >> 2) * 1024 + (8 * (li & 3) + ((q4 - rot_k(li >> 1)) & 7)) * 16);
    const int vr4 = li >> 2, vp = li & 3;
    const unsigned vbase = wbu + (unsigned)(q4 * 1024 + 128 * vr4 + 8 * (vp & 1));
    const int vc = (vp >> 1) - 2 * ((2 * q4 + (vr4 >> 1)) & 3) + 8;
#define AT_KDMA(c) do { _Pragma("unroll") for (int _j = 0; _j < 4; ++_j) { const int _ix = (__shfl(idx2[(c) >> 1], 4 * _j + drow) >> (((c) & 1) * 16)) & 0xffff; \
        __builtin_amdgcn_global_load_lds((const unsigned*)((const char*)kvb + (unsigned)(_ix * 1024 + 2 * (koff0 ^ ((_j >> 1) * 32)))), (LAS unsigned*)(wb + ((c) & 3) * 4096 + _j * 1024), 16, 0, 0); } } while (0)
#define AT_VDMA(ks) do { _Pragma("unroll") for (int _j = 0; _j < 8; ++_j) { const int _ix = (__shfl(idx2[ks], 4 * (_j & 3) + drow) >> ((_j >> 2) * 16)) & 0xffff; \
        __builtin_amdgcn_global_load_lds((const unsigned*)((const char*)kvb + (unsigned)(_ix * 1024 + 2 * (voff0 ^ ((_j & 1) * 32)))), (LAS unsigned*)(wb + ((ks) & 1) * 8192 + _j * 1024), 16, 0, 0); } } while (0)
    for (int k = klo; k < khi; ++k) {
        const int pos = wq + 256 * k, t = b * S + pos, cnt = (pos + 1) < 256 ? (pos + 1) : 256;
        int idx2[8];
#pragma unroll
        for (int i = 0; i < 8; ++i) { const int s0 = 32 * i + li, s1 = s0 + 16; const int v0 = F.SEL[(size_t)t * 256 + s0], v1 = F.SEL[(size_t)t * 256 + s1]; idx2[i] = (s0 < cnt ? v0 : 0) | ((s1 < cnt ? v1 : 0) << 16); }
        bf16x8 bq[4];
#pragma unroll
        for (int kk = 0; kk < 4; ++kk) { bq[kk] = (bf16x8){0, 0, 0, 0, 0, 0, 0, 0}; if (li < 4) bq[kk] = *(const bf16x8*)(F.QB + (size_t)t * 1024 + (4 * g + li) * 128 + 32 * kk + 8 * q4); }
        AT_KDMA(0); AT_KDMA(1); AT_KDMA(2);
        f32x4 s[16];
#pragma unroll
        for (int c = 0; c < 16; ++c) {
            if (c <= 13) AT_WAITV(8); else if (c == 14) AT_WAITV(12); else AT_WAITV(8);
            f32x4 acc = (f32x4){0.f, 0.f, 0.f, 0.f};
            bf16x8 a[4];
#pragma unroll
            for (int kk = 0; kk < 4; ++kk) a[kk] = *(const LAS bf16x8*)(wb + (c & 3) * 4096 + (kk >> 1) * 512 + (kra0 ^ (unsigned)((kk & 1) * 64)));
#pragma unroll
            for (int kk = 0; kk < 4; ++kk) acc = __builtin_amdgcn_mfma_f32_16x16x32_bf16(a[kk], bq[kk], acc, 0, 0, 0);
            s[c] = acc;
            asm volatile("s_waitcnt lgkmcnt(0)" ::: "memory");
            if (c + 3 <= 15) AT_KDMA(c + 3);
            if (c == 13) AT_VDMA(0);
            if (c == 15) AT_VDMA(1);
            __builtin_amdgcn_sched_barrier(0);
        }
        float m = -INFINITY;
#pragma unroll
        for (int c = 0; c < 16; ++c)
#pragma unroll
            for (int i = 0; i < 4; ++i) { const int slot = c * 16 + 4 * q4 + i; if (slot >= cnt) s[c][i] = -INFINITY; m = fmaxf(m, s[c][i]); }
        m = fmaxf(m, __shfl_xor(m, 16)); m = fmaxf(m, __shfl_xor(m, 32));
        float sum = 0.f;
#pragma unroll
        for (int c = 0; c < 16; ++c)
#pragma unroll
            for (int i = 0; i < 4; ++i) { const float p = exp2f(s[c][i] - m); s[c][i] = p; sum += p; }
        sum += __shfl_xor(sum, 16); sum += __shfl_xor(sum, 32);
        f32x4 o[8];
#pragma unroll
        for (int d = 0; d < 8; ++d) o[d] = (f32x4){0.f, 0.f, 0.f, 0.f};
#pragma unroll
        for (int ks = 0; ks < 8; ++ks) {
            u32x4 pk; pk.x = pk_bf16(s[2 * ks][0], s[2 * ks][1]); pk.y = pk_bf16(s[2 * ks][2], s[2 * ks][3]); pk.z = pk_bf16(s[2 * ks + 1][0], s[2 * ks + 1][1]); pk.w = pk_bf16(s[2 * ks + 1][2], s[2 * ks + 1][3]);
            const bf16x8 bp = __builtin_bit_cast(bf16x8, pk);
            if (ks < 7) AT_WAITV(8); else AT_WAITV(0);
            unsigned va[4];
#pragma unroll
            for (int dd = 0; dd < 4; ++dd) va[dd] = vbase + (unsigned)((ks & 1) * 8192) + (unsigned)(((vc + 2 * dd) & 7) << 4);
            s16x4 tr[16];
            tr_read16(va, tr);
#pragma unroll
            for (int d = 0; d < 8; ++d) { const int q = 8 * (d >> 2) + 2 * (d & 3); const bf16x8 a = (bf16x8){tr[q][0], tr[q][1], tr[q][2], tr[q][3], tr[q + 1][0], tr[q + 1][1], tr[q + 1][2], tr[q + 1][3]};
                o[d] = __builtin_amdgcn_mfma_f32_16x16x32_bf16(a, bp, o[d], 0, 0, 0); }
            if (ks + 2 <= 7) AT_VDMA(ks + 2);
            __builtin_amdgcn_sched_barrier(0);
        }
        const float inv = 1.0f / sum;
        if (li < 4) {
            bf16_t* op = F.CONCAT + (size_t)t * D + g * 512 + li * 128 + 4 * q4;
#pragma unroll
            for (int d = 0; d < 8; ++d) { u32x2 w; w.x = pk_bf16(o[d][0] * inv, o[d][1] * inv); w.y = pk_bf16(o[d][2] * inv, o[d][3] * inv); *(u32x2*)(op + d * 16) = w; }
        }
    }
#undef AT_KDMA
#undef AT_VDMA
}

#if SELFCHECK
__device__ __forceinline__ float bfv(const bf16_t* p, size_t i) { return __uint_as_float(((unsigned)p[i]) << 16); }
__device__ __forceinline__ unsigned hash_u(unsigned x) { x ^= x >> 16; x *= 0x7feb352dU; x ^= x >> 15; x *= 0x846ca68bU; x ^= x >> 16; return x; }
__device__ __forceinline__ void chk_flag(const Frame& F, int k) { __hip_atomic_fetch_add(F.ctl + CW_CHK + k, 1u, __ATOMIC_RELAXED, __HIP_MEMORY_SCOPE_AGENT); }
__device__ void chk_gemm1(const Frame& F) {
    for (int j = 0; j < 16; ++j) {
        const unsigned hsh = hash_u((unsigned)((F.bid * 8 + F.wave) * 16 + j) * 2654435761u + 12345u);
        const int t = (int)(hsh % (unsigned)T), n = (int)((hsh >> 7) % 3664u);
        float s = 0.f, sa = 0.f;
        for (int k = F.lane; k < D; k += 64) { const float a = bfv(F.H, (size_t)t * D + k), w = F.w_in[(size_t)k * 3664 + n]; s += a * w; sa += fabsf(a * w); }
        s = wave_sum(s); sa = wave_sum(sa);
        const float got = colmap(n) < 3584 ? bfv(F.PROJ, (size_t)t * NPROJ + colmap(n)) : s;
        if (F.lane == 0 && !(fabsf(got - s) <= 0.001f * sa + 0.02f)) chk_flag(F, 0);
    }
}
__device__ void chk_post(const Frame& F) {
    const int gw = F.bid * 8 + F.wave;
    const int t = (gw * 16 + (gw & 15)) % T, pos = t & (S - 1), lane = F.lane;
    const bf16_t* pr = F.PROJ + (size_t)t * NPROJ;
    const float QSCALE = 0.08838834764831845f * 1.4426950408889634f;
    int bad = 0;
    for (int hh = 0; hh < 10; ++hh) {
        const int cb = hh < 8 ? CQ + hh * 128 : CK + (hh - 8) * 128; const float* gn = hh < 8 ? F.q_norm_g : F.k_norm_g;
        float ss = 0.f; for (int d = lane; d < 128; d += 64) { const float v = bfv(pr, cb + d); ss += v * v; } ss = wave_sum(ss);
        const float rstd = 1.0f / sqrtf(ss / 128.0f + NORM_EPS);
        for (int d = lane; d < 128; d += 64) {
            float y = bfv(pr, cb + d) * rstd * gn[d];
            if (d < 32) { const int i = d & 15; const float inv = powf(500000.0f, -(float)(2 * i) / 32.0f); const float ang = (float)pos * inv; const float cs = cosf(ang), sn = sinf(ang);
                const int dp = d < 16 ? d + 16 : d - 16; const float yp = bfv(pr, cb + dp) * rstd * gn[dp];
                y = d < 16 ? y * cs - yp * sn : y * cs + yp * sn; }
            float got, ref;
            if (hh < 8) { ref = y * QSCALE; got = bfv(F.QB, (size_t)t * 1024 + hh * 128 + d); } else { ref = y; got = bfv(F.KV, (size_t)t * 512 + (hh - 8) * 256 + d); }
            if (!(fabsf(got - ref) <= 0.02f * fabsf(ref) + 0.02f)) bad = 1;
        }
    }
    for (int e = lane; e < 256; e += 64) { const float ref = bfv(pr, CV + e), got = bfv(F.KV, (size_t)t * 512 + (e >> 7) * 256 + 128 + (e & 127)); if (got != ref) bad = 1; }
    for (int e = lane; e < 1024; e += 64) {
        const int cb = CQI + (e & ~63); const int d = e & 63;
        float y = bfv(pr, cb + d);
        if (d < 16) { const int i = d & 7; const float inv = powf(500000.0f, -(float)(2 * i) / 16.0f); const float ang = (float)pos * inv; const float cs = cosf(ang), sn = sinf(ang);
            const int dp = d < 8 ? d + 8 : d - 8; const float yp = bfv(pr, cb + dp); y = d < 8 ? y * cs - yp * sn : y * cs + yp * sn; }
        const float got = bfv(F.QI, qi_off((size_t)t, e >> 6, d));
        if (!(fabsf(got - y) <= 0.02f * fabsf(y) + 0.02f)) bad = 1;
    }
    {
        LAS float* kwref = (LAS float*)(F.lds + 49152) + F.wave * 128;
        for (int c = 0; c < 80; ++c) {
            float sdot = 0.f; for (int k = lane; k < D; k += 64) sdot += bfv(F.H, (size_t)t * D + k) * F.w_in[(size_t)k * 3664 + 2560 + c];
            sdot = wave_sum(sdot); if (lane == 0) kwref[c] = sdot;
        }
        asm volatile("s_waitcnt lgkmcnt(0)" ::: "memory");
        { const int d = lane; float y = kwref[d];
          if (d < 16) { const int i = d & 7; const float inv = powf(500000.0f, -(float)(2 * i) / 16.0f); const float ang = (float)pos * inv; const float cs = cosf(ang), sn = sinf(ang);
              const int dp = d < 8 ? d + 8 : d - 8; const float yp = kwref[dp]; y = d < 8 ? y * cs - yp * sn : y * cs + yp * sn; }
          const float got = bfv(F.KI, ki_off((size_t)t, d));
          if (!(fabsf(got - y) <= 0.02f * fabsf(y) + 0.03f)) bad = 1; }
        if (lane < 16) { const float ref = kwref[64 + lane] * 0.03125f, got = F.WI[(size_t)t * 16 + lane]; if (!(fabsf(got - ref) <= 1e-3f + 0.01f * fabsf(ref))) bad = 1; }
    }
    for (int e = lane; e < 1024; e += 64) {
        const int g = e >> 8, w = 2 << g; float sum = 0.f; int cn = 0;
        for (int r = 0; r < w; ++r) if (pos - r >= 0) { sum += bfv(pr - (size_t)r * NPROJ, CP + e); ++cn; }
        const float ref = sum / (float)cn - bfv(pr, CP + e), got = bfv(F.PM, ((size_t)g * T + t) * 256 + (e & 255));
        if (!(fabsf(got - ref) <= 0.02f * fabsf(ref) + 0.02f)) bad = 1;
    }
    if (__ballot(bad) != 0ull && lane == 0) chk_flag(F, 1);
}
__device__ void chk_attn(const Frame& F) {
    const int w = F.bid, b = w & 3, j = w >> 2;
    const int special[12] = {0, 1, 100, 254, 255, 256, 257, 300, 511, 512, 8190, 8191};
    const int pos = j < 12 ? special[j] : (j * 131 + 17) & (S - 1);
    const int t = b * S + pos, n = pos + 1, cnt = n < 256 ? n : 256, tid = F.tid;
    LAS float* sc = (LAS float*)F.lds;
    LAS int* selmark = (LAS int*)(F.lds + 32768);
    LAS float* red = (LAS float*)(F.lds + 65536);
    LAS int* ired = (LAS int*)(F.lds + 65536 + 4096);
    __syncthreads();
    for (int s2 = tid; s2 < n; s2 += NTHREADS) {
        float tot = 0.f;
        for (int h = 0; h < 16; ++h) { float dsum = 0.f; for (int d = 0; d < 64; ++d) dsum += bfv(F.QI, qi_off((size_t)t, h, d)) * bfv(F.KI, ki_off((size_t)b * S + s2, d)); tot += F.WI[(size_t)t * 16 + h] * fmaxf(dsum, 0.f); }
        sc[s2] = (float)(_Float16)tot; selmark[s2] = 0;
    }
    __syncthreads();
    if (tid < cnt) { const int k = F.SEL[(size_t)t * 256 + tid]; if (k < n) atomicAdd((int*)(selmark + k), 1); else atomicAdd((int*)(selmark + 0), 1000); }
    if (tid == 0) { ired[0] = 0; ired[1] = 0; }
    __syncthreads();
    int miss = 0, dup = 0;
    for (int s2 = tid; s2 < n; s2 += NTHREADS) {
        const int mk = selmark[s2]; if (mk > 1) dup = 1;
        if (mk >= 1 && n > 256) { const float v = sc[s2]; int rank = 0; for (int q = 0; q < n; ++q) rank += (sc[q] > v) ? 1 : 0; if (rank >= 256) ++miss; }
    }
    if (miss) atomicAdd((int*)ired, miss); if (dup) atomicAdd((int*)ired + 1, 1);
    __syncthreads();
    if (tid == 0 && (ired[0] > 3 || ired[1] > 0)) chk_flag(F, 2);
    float err2 = 0.f, ref2 = 0.f;
    for (int h = 0; h < 8; ++h) {
        const int g = h >> 2;
        __syncthreads();
        if (tid < 256) { float l = -INFINITY; if (tid < cnt) { const int k = F.SEL[(size_t)t * 256 + tid]; float dsum = 0.f; for (int d = 0; d < 128; ++d) dsum += bfv(F.QB, (size_t)t * 1024 + h * 128 + d) * bfv(F.KV, ((size_t)b * S + k) * 512 + g * 256 + d); l = dsum; } red[tid] = l; }
        __syncthreads();
        float m = -INFINITY; for (int q = 0; q < 256; ++q) m = fmaxf(m, red[q]);
        float den = 0.f; for (int q = 0; q < 256; ++q) den += exp2f(red[q] - m);
        if (tid < 128) { float o = 0.f; for (int q = 0; q < cnt; ++q) { const int k = F.SEL[(size_t)t * 256 + q]; o += exp2f(red[q] - m) * bfv(F.KV, ((size_t)b * S + k) * 512 + g * 256 + 128 + tid); }
            o /= den; const float got = bfv(F.CONCAT, (size_t)t * D + h * 128 + tid); err2 += (got - o) * (got - o); ref2 += o * o; }
    }
    err2 = wave_sum(err2); ref2 = wave_sum(ref2);
    __syncthreads();
    if (F.lane == 0 && F.wave < 2) { red[300 + F.wave * 2] = err2; red[301 + F.wave * 2] = ref2; }
    __syncthreads();
    if (tid == 0) { const float e = red[300] + red[302], r = red[301] + red[303]; if (!(e <= 0.0009f * r + 1e-6f)) chk_flag(F, 3); }
    __syncthreads();
}
#endif

__device__ __forceinline__ void r1_route(const Frame& F) {
    { const float* ada = F.ADA + (size_t)(F.bid >> 6) * 12288; norm_rows(F, F.out, F.norm2_g, ada + 3 * 2048, ada + 4 * 2048); }
    LAS unsigned* lh = (LAS unsigned*)(F.lds + 65536);
    LAS float* lg = (LAS float*)F.lds + F.wave * 768;
    if (F.tid < 64) lh[F.tid] = 0u;
    asm volatile("s_waitcnt vmcnt(0)" ::: "memory");
    __syncthreads();
    const int lane = F.lane, li = lane & 15, q4 = lane >> 4;
    const int t0 = F.bid * 128 + F.wave * 16;
    f32x4 acc[3];
#pragma unroll
    for (int nb = 0; nb < 3; ++nb) acc[nb] = (f32x4){0.f, 0.f, 0.f, 0.f};
    const bf16_t* hp = F.H + (size_t)(t0 + li) * D + 8 * q4;
    const bf16_t* wp = F.WR + (size_t)li * D + 8 * q4;
#pragma unroll 4
    for (int ks = 0; ks < 64; ++ks) {
        const bf16x8 a = *(const bf16x8*)(hp + 32 * ks);
#pragma unroll
        for (int nb = 0; nb < 3; ++nb) { const bf16x8 bb = *(const bf16x8*)(wp + (size_t)nb * 16 * D + 32 * ks); acc[nb] = __builtin_amdgcn_mfma_f32_16x16x32_bf16(a, bb, acc[nb], 0, 0, 0); }
    }
#pragma unroll
    for (int nb = 0; nb < 3; ++nb)
#pragma unroll
        for (int i = 0; i < 4; ++i) lg[(4 * q4 + i) * 48 + nb * 16 + li] = acc[nb][i];
    asm volatile("s_waitcnt lgkmcnt(0)" ::: "memory");
    if (lane < 16) {
        const int t = t0 + lane; const LAS float* l = lg + lane * 48;
        int gs = 0; float gm = l[0];
#pragma unroll
        for (int j = 1; j < 4; ++j) if (l[j] > gm) { gm = l[j]; gs = j; }
        float den = 0.f;
#pragma unroll
        for (int j = 0; j < 4; ++j) den += __expf(l[j] - gm);
        const float pg = 1.0f / den;
        const LAS float* el = l + 4 + gs * 8;
        int i0 = 0; float m0 = el[0];
#pragma unroll
        for (int j = 1; j < 8; ++j) if (el[j] > m0) { m0 = el[j]; i0 = j; }
        int i1 = -1; float m1 = -INFINITY;
#pragma unroll
        for (int j = 0; j < 8; ++j) if (j != i0 && el[j] > m1) { m1 = el[j]; i1 = j; }
        const float e1 = __expf(m1 - m0), w0 = pg / (1.0f + e1), w1 = pg * e1 / (1.0f + e1);
        const int b0 = gs * 8 + i0, b1 = 32 + gs * 8 + i1;
        F.TOKE[2 * t] = b0; F.TOKE[2 * t + 1] = b1; F.TOKW[2 * t] = w0; F.TOKW[2 * t + 1] = w1;
        __hip_atomic_fetch_add(lh + b0, 1u, __ATOMIC_RELAXED, __HIP_MEMORY_SCOPE_WORKGROUP);
        __hip_atomic_fetch_add(lh + b1, 1u, __ATOMIC_RELAXED, __HIP_MEMORY_SCOPE_WORKGROUP);
    }
    __syncthreads();
    if (F.tid < 64) { const unsigned cn = lh[F.tid]; if (cn) __hip_atomic_fetch_add(F.ctl + CW_GCOUNT + F.tid, cn, __ATOMIC_RELAXED, __HIP_MEMORY_SCOPE_AGENT); }
}

__device__ __forceinline__ void r2_rows(const Frame& F) {
    LAS unsigned* lh = (LAS unsigned*)F.lds;
    LAS unsigned* lbase = lh + 64;
    LAS unsigned* tstart = lh + 128;
    const int tid = F.tid;
    if (tid < 64) lh[tid] = 0u;
    __syncthreads();
    if (tid == 0) {
        unsigned ts = 0;
        for (int k = 0; k < 64; ++k) { tstart[k] = ts; const unsigned cn = __hip_atomic_load(F.ctl + CW_GCOUNT + k, __ATOMIC_RELAXED, __HIP_MEMORY_SCOPE_AGENT); ts += (cn + 255u) >> 8; if (k == 31) tstart[64 + 1] = ts; }
        tstart[64] = ts;
    }
    const int t = F.bid * 128 + (tid >> 1), sl = tid & 1;
    int bucket = 0; float w = 0.f;
    if (tid < 256) { bucket = F.TOKE[2 * t + sl]; w = F.TOKW[2 * t + sl]; __hip_atomic_fetch_add(lh + bucket, 1u, __ATOMIC_RELAXED, __HIP_MEMORY_SCOPE_WORKGROUP); }
    __syncthreads();
    if (tid < 64) { const unsigned cn = lh[tid]; unsigned base = 0; if (cn) base = __hip_atomic_fetch_add(F.ctl + CW_GCURSOR + tid, cn, __ATOMIC_RELAXED, __HIP_MEMORY_SCOPE_AGENT); lbase[tid] = tstart[tid] * 256u + base; }
    __syncthreads();
    if (tid < 64) lh[tid] = 0u;
    __syncthreads();
    if (tid < 256) { const unsigned rk = __hip_atomic_fetch_add(lh + bucket, 1u, __ATOMIC_RELAXED, __HIP_MEMORY_SCOPE_WORKGROUP); const unsigned p = lbase[bucket] + rk;
        if (p < (unsigned)MAXROWS) { F.ROWTOK[p] = t; F.ROWW[p] = w; } }
    if (F.bid == 0) {
        if (tid == 0) { ((int*)F.ctl)[CW_TINFO] = (int)tstart[65]; ((int*)F.ctl)[CW_TINFO + 1] = (int)tstart[64]; }
        if (tid < 64) { const unsigned a = tstart[tid], e = (tid == 63) ? tstart[64] : tstart[tid + 1]; for (unsigned p = a; p < e && p < 512u; ++p) ((int*)F.ctl)[CW_TILEB + p] = tid; }
    }
}

struct Args { const float* in[17]; float* out; unsigned char* ws; int ph_lo, ph_hi; };
constexpr int N_PHASES = 13;

__global__ void __launch_bounds__(NTHREADS, 2) mk_fwd(Args args) {
    extern __shared__ __attribute__((aligned(16))) unsigned char lds_raw[];
    Frame F;
    F.lds = (LAS unsigned char*)lds_raw;
    F.tid = threadIdx.x; F.lane = F.tid & 63; F.wave = __builtin_amdgcn_readfirstlane(F.tid >> 6); F.G = gridDim.x; F.bid = blockIdx.x;
    F.x = args.in[0]; F.c = args.in[1]; F.w_ada = args.in[2]; F.b_ada = args.in[3]; F.norm1_g = args.in[4]; F.w_in = args.in[5]; F.q_norm_g = args.in[6]; F.k_norm_g = args.in[7];
    F.w_pool = args.in[8]; F.pool_scale = args.in[9]; F.w_out = args.in[10]; F.norm2_g = args.in[11]; F.w_grp = args.in[12]; F.w_exp = args.in[13]; F.w1 = args.in[14]; F.w3 = args.in[15]; F.w2 = args.in[16];
    F.out = args.out;
    unsigned char* ws = args.ws;
    F.ctl = (unsigned*)(ws + WS_CTL); F.ADA = (float*)(ws + WS_ADA); F.ADAP = (float*)(ws + WS_ADAP); F.TAB = (float*)(ws + WS_TAB); F.WR = (bf16_t*)(ws + WS_WR); F.TOKE = (int*)(ws + WS_TOKE); F.TOKW = (float*)(ws + WS_TOKW);
    F.ROWTOK = (int*)(ws + WS_ROWTOK); F.ROWW = (float*)(ws + WS_ROWW); F.WI = (float*)(ws + WS_WI); F.KI = (bf16_t*)(ws + WS_KI);
    F.WPOOL = (bf16_t*)(ws + WS_WPOOL); F.WOUT = (bf16_t*)(ws + WS_WOUT); F.WIN = (bf16_t*)(ws + WS_WIN); F.W13 = (bf16_t*)(ws + WS_W13); F.W2 = (bf16_t*)(ws + WS_W2);
    F.H = (bf16_t*)(ws + WS_H); F.CONCAT = (bf16_t*)(ws + WS_H); F.PROJ = (bf16_t*)(ws + WS_X); F.SC = (unsigned short*)(ws + WS_X); F.Y0 = (bf16_t*)(ws + WS_X);
    F.QB = (bf16_t*)(ws + WS_QB); F.ACT = (bf16_t*)(ws + WS_QB); F.KV = (bf16_t*)(ws + WS_KV); F.QI = (bf16_t*)(ws + WS_QI); F.PM = (bf16_t*)(ws + WS_PM); F.SEL = (unsigned short*)(ws + WS_SEL);

    volatile LAS unsigned* bst = (volatile LAS unsigned*)(F.lds + LDS_BYTES - 16);
    if (F.tid == 0) { bst[0] = 0u; bst[1] = 0u; bst[2] = 0u; bst[3] = 0u; }
    __syncthreads();
    XcdBarrier bar = xcd_barrier_post(F.ctl, bst, F.wave);
    const int lo = args.ph_lo, hi = args.ph_hi;
#define IN(k) (lo <= (k) && (k) < hi)
#define SEAM(k) do { if (IN(k) && IN((k) + 1)) xcd_barrier(bar); } while (0)

#define PH(k, ...) do { F.lane = fresh_lane(); F.tid = F.wave * 64 + F.lane; if (IN(k)) { for (int rep_ = 0; rep_ < 1 + ((REPEAT_MASK >> (k)) & 1); ++rep_) { __VA_ARGS__ } } SEAM(k); } while (0)
    PH(0, { p0_prologue(F); });
    PH(1, {
        if (F.tid < 192) { const int v = F.bid * 192 + F.tid; float s = 0.f; for (int kc = 0; kc < 32; ++kc) s += F.ADAP[(size_t)kc * 49152 + v]; F.ADA[v] = s; }
        LAS float* sl = (LAS float*)F.lds;
        { const int b = F.bid >> 6; for (int idx = F.tid; idx < 4096; idx += NTHREADS) { float s = 0.f; for (int kc = 0; kc < 32; ++kc) s += F.ADAP[(size_t)kc * 49152 + b * 12288 + idx]; sl[idx] = s; } }
        __syncthreads();
        norm_rows(F, F.x, F.norm1_g, (const float*)sl, (const float*)(sl + 2048));
#if P1_PROBE == 1
        norm_rows(F, F.x, F.norm1_g, (const float*)sl, (const float*)(sl + 2048));
#elif P1_PROBE == 2
        __syncthreads();
        { const int b = F.bid >> 6; for (int idx = F.tid; idx < 4096; idx += NTHREADS) { float s = 0.f; for (int kc = 0; kc < 32; ++kc) s += F.ADAP[(size_t)kc * 49152 + b * 12288 + idx]; sl[idx] = s; } }
#endif
        __syncthreads();
    });
    PH(2, {
        pg8::Gemm g{F.H, F.WIN, D}; pg8::StaticOrder So; So.init(T, 3584, F.G, F.bid, 1 + ((REPEAT_UNITS >> 2) & 1));
        pg8::EpiBf16 E{F.PROJ, NPROJ, 0};
        pg8::gemm_phase<pg8::EpiBf16, pg8::StaticOrder>(F.lds, g, So, E, F.tid);
    });
#if SELFCHECK
    F.lane = fresh_lane(); F.tid = F.wave * 64 + F.lane; if (IN(3)) { chk_gemm1(F); }
#endif
    PH(3, { p3_post(F); });
#if SELFCHECK
    F.lane = fresh_lane(); F.tid = F.wave * 64 + F.lane; if (IN(3)) { chk_post(F); if (IN(4)) xcd_barrier(bar); }
#endif
    PH(4, {
        {
            pg8::Gemm g{F.PM, F.WPOOL, 256}; pg8::PoolOrder So{F.G, F.bid};
            pg8::EpiBf16 E{F.CONCAT, D, 1};
            pg8::gemm_phase<pg8::EpiBf16, pg8::PoolOrder>(F.lds, g, So, E, F.tid);
        }
        for (int uu = F.bid; uu < 4 * 2080 * (1 + ((REPEAT_UNITS >> 4) & 1)); uu += F.G) {
            const int u = uu % (4 * 2080); const int b = u / 2080, v = u % 2080;
            int qb = (int)((sqrtf(8.0f * (float)v + 1.0f) - 1.0f) * 0.5f);
            while (qb * (qb + 1) / 2 > v) --qb;
            while ((qb + 1) * (qb + 2) / 2 <= v) ++qb;
            indexer_unit(F, b, qb, v - qb * (qb + 1) / 2);
        }
    });
    PH(5, {
        LAS unsigned char* wbuf = F.lds + F.wave * 17920;
        u32x4 pre[16];
        int i = F.bid * 8 + F.wave;
        int t = (i & 1) ? (T - 1 - (i >> 1)) : (i >> 1);
        { const unsigned short* src = sel_src(F, t); const int n = (t & (S - 1)) + 1, nch = n > 256 ? (n + 511) >> 9 : 0;
          _Pragma("unroll") for (int ch = 0; ch < 16; ++ch) if (ch < nch) pre[ch] = *(const u32x4*)(src + ch * 512 + F.lane * 8); }
        for (; i < T; i += F.G * 8) {
            u32x4 cur[16];
            _Pragma("unroll") for (int ch = 0; ch < 16; ++ch) cur[ch] = pre[ch];
            const int tcur = t, inext = i + F.G * 8;
            if (inext < T) {
                t = (inext & 1) ? (T - 1 - (inext >> 1)) : (inext >> 1);
                const unsigned short* src = sel_src(F, t); const int n = (t & (S - 1)) + 1, nch = n > 256 ? (n + 511) >> 9 : 0;
                _Pragma("unroll") for (int ch = 0; ch < 16; ++ch) if (ch < nch) pre[ch] = *(const u32x4*)(src + ch * 512 + F.lane * 8);
            }
            select_row(F, tcur, cur, wbuf, F.lane);
        }
    });
    PH(6, {
        attn_items(F, 0, 32);
#if ATT_PROBE == 1
        attn_items(F, 0, 16);
#elif ATT_PROBE == 2
        attn_items(F, 16, 32);
#endif
    });
#if SELFCHECK
    F.lane = fresh_lane(); F.tid = F.wave * 64 + F.lane; if (IN(7)) { chk_attn(F); }
#endif
    PH(7, {
        pg8::Gemm g{F.CONCAT, F.WOUT, D}; pg8::StaticOrder So; So.init(T, D, F.G, F.bid, 1 + ((REPEAT_UNITS >> 7) & 1));
        pg8::EpiMix E{F.x, F.ADA, F.out};
        pg8::gemm_phase<pg8::EpiMix, pg8::StaticOrder>(F.lds, g, So, E, F.tid);
    });
    PH(8, { r1_route(F); });
    PH(9, { r2_rows(F); });
    PH(10, {
        const int* ti = (const int*)F.ctl + CW_TINFO;
        pg8::Gemm g{F.H, F.W13, D}; pg8::MoeOrder<4, true> So{(const int*)F.ctl + CW_TILEB, F.ROWTOK, 0, ti[1], F.G, F.bid, 1 + ((REPEAT_UNITS >> 10) & 1)};
        pg8::EpiAct E{F.ACT};
        pg8::gemm_phase<pg8::EpiAct, pg8::MoeOrder<4, true>>(F.lds, g, So, E, F.tid);
    });
    PH(11, {
        const int* ti = (const int*)F.ctl + CW_TINFO;
        pg8::Gemm g{F.ACT, F.W2, 512}; pg8::MoeOrder<8, false> So{(const int*)F.ctl + CW_TILEB, F.ROWTOK, 0, ti[0], F.G, F.bid, 1};
        pg8::EpiMoeY0 E{F.ROWTOK, F.ROWW, F.ADA, F.Y0};
        pg8::gemm_phase<pg8::EpiMoeY0, pg8::MoeOrder<8, false>>(F.lds, g, So, E, F.tid);
    });
    PH(12, {
        const int* ti = (const int*)F.ctl + CW_TINFO;
        pg8::Gemm g{F.ACT, F.W2, 512}; pg8::MoeOrder<8, false> So{(const int*)F.ctl + CW_TILEB, F.ROWTOK, ti[0], ti[1], F.G, F.bid, 1};
        pg8::EpiMoeOut E{F.ROWTOK, F.ROWW, F.ADA, F.Y0, F.out};
        pg8::gemm_phase<pg8::EpiMoeOut, pg8::MoeOrder<8, false>>(F.lds, g, So, E, F.tid);
    });
#undef PH
#if SELFCHECK
    if (IN(12)) {
        xcd_barrier(bar);
        if (F.bid == 0 && F.tid == 0) {
            float code = 0.f;
            for (int k = 0; k < 4; ++k) if (__hip_atomic_load(F.ctl + CW_CHK + k, __ATOMIC_RELAXED, __HIP_MEMORY_SCOPE_AGENT) != 0u) code += (float)(1 << k);
            if (code != 0.f) F.out[0] += 1.0e4f * code;
        }
    }
#endif
#undef IN
#undef SEAM
}

extern "C" void kernel_launch(void* const* d_in, const int* in_sizes, int n_in, void* d_out, int out_size, void* d_ws, size_t ws_size, hipStream_t stream) {
    static int grid = 0;
    if (grid == 0) {
        if (n_in != 17 || out_size != T * D || ws_size < WS_END) { fprintf(stderr, "kernel_launch: unexpected problem (n_in %d out %d ws %zu)\n", n_in, out_size, ws_size); grid = -1; return; }
        int dev = 0, cus = 0, per_cu = 0;
        if (hipGetDevice(&dev) != hipSuccess || hipDeviceGetAttribute(&cus, hipDeviceAttributeMultiprocessorCount, dev) != hipSuccess) { grid = -1; return; }
        if (hipFuncSetAttribute((const void*)mk_fwd, hipFuncAttributeMaxDynamicSharedMemorySize, LDS_BYTES) != hipSuccess) { fprintf(stderr, "kernel_launch: hipFuncSetAttribute failed\n"); grid = -1; return; }
        if (hipOccupancyMaxActiveBlocksPerMultiprocessor(&per_cu, (const void*)mk_fwd, NTHREADS, LDS_BYTES) != hipSuccess || per_cu < 1) { fprintf(stderr, "kernel_launch: occupancy query says %d\n", per_cu); }
        (void)hipGetLastError();
        grid = cus;
        if (grid != 256) { fprintf(stderr, "kernel_launch: built for 256 CUs, found %d\n", cus); grid = -1; return; }
    }
    if (grid < 0) return;
    (void)hipMemsetAsync((char*)d_ws + WS_CTL, 0, WS_ADA - WS_CTL, stream);
    (void)hipMemsetAsync((char*)d_ws + WS_ROWTOK, 0xFF, (size_t)MAXROWS * 4, stream);
    Args a{};
    for (int i = 0; i < 17; ++i) a.in[i] = (const float*)d_in[i];
    a.out = (float*)d_out; a.ws = (unsigned char*)d_ws;
#if MK_MULTI
    for (int p = 0; p < N_PHASES; ++p) { a.ph_lo = p; a.ph_hi = p + 1; hipLaunchKernelGGL(mk_fwd, dim3(grid), dim3(NTHREADS), LDS_BYTES, stream, a); }
#else
    a.ph_lo = 0; a.ph_hi = N_PHASES; hipLaunchKernelGGL(mk_fwd, dim3(grid), dim3(NTHREADS), LDS_BYTES, stream, a);
#endif
}
```

```cpp
#include <hip/hip_runtime.h>
#include <cstdio>
#include <cstdint>
#include <cstddef>

#ifndef MK_MULTI
#define MK_MULTI 0
#endif

#ifndef P5_PROBE
#define P5_PROBE 0
#endif
#ifndef P1_PROBE
#define P1_PROBE 0
#endif
#ifndef ATT_PROBE
#define ATT_PROBE 0
#endif
#ifndef SELFCHECK
#define SELFCHECK 0
#endif
#ifndef REPEAT_UNITS
#define REPEAT_UNITS 0
#endif
#ifndef REPEAT_MASK
#define REPEAT_MASK 0
#endif
#define LAS __attribute__((address_space(3)))
typedef unsigned short bf16_t;
typedef short bf16x8 __attribute__((ext_vector_type(8)));
typedef short s16x4 __attribute__((ext_vector_type(4)));
typedef float f32x4 __attribute__((ext_vector_type(4)));
typedef float f32x16 __attribute__((ext_vector_type(16)));
typedef unsigned u32x4 __attribute__((ext_vector_type(4)));
typedef unsigned u32x2 __attribute__((ext_vector_type(2)));
typedef __bf16 bf16v2 __attribute__((ext_vector_type(2)));
typedef _Float16 f16v2 __attribute__((ext_vector_type(2)));

constexpr int T = 32768, S = 8192, NB = 4, D = 2048;
constexpr int NPROJ = 3840;
constexpr int CQ = 0, CK = 1024, CV = 1280, CQI = 1536, CP = 2560, CKI = 3584, CWI = 3648;
constexpr int NTHREADS = 512;
constexpr int LDS_BYTES = 147456;
constexpr float NORM_EPS = 1e-6f;
constexpr size_t SC_BATCH = 34078720ull;
constexpr int MAXROWS = 81920;

constexpr size_t WS_CTL = 0;
constexpr size_t WS_ADA = 65536;
constexpr size_t WS_TAB = 262144;
constexpr size_t WS_WR = 1835008;
constexpr size_t WS_TOKE = 2031616;
constexpr size_t WS_TOKW = 2293760;
constexpr size_t WS_ROWTOK = 2555904;
constexpr size_t WS_ROWW = 2883584;
constexpr size_t WS_WI = 3211264;
constexpr size_t WS_KI = 5308416;
constexpr size_t WS_WPOOL = 9502720;
constexpr size_t WS_WOUT = 10027008;
constexpr size_t WS_WIN = 18415616;
constexpr size_t WS_W13 = 34144256;
constexpr size_t WS_W2 = 168361984;
constexpr size_t WS_H = 235470848;
constexpr size_t WS_X = 369688576;
constexpr size_t WS_QB = 642318336;
constexpr size_t WS_KV = 709427200;
constexpr size_t WS_QI = 742981632;
constexpr size_t WS_PM = 810090496;
constexpr size_t WS_SEL = 877199360;
constexpr size_t WS_ADAP = 893976576;
constexpr size_t WS_END = 900268032;
constexpr int CW_GCOUNT = 4096, CW_GCURSOR = 4160, CW_CHK = 4224, CW_TINFO = 4352, CW_TILEB = 4416;

__device__ __forceinline__ int fresh_lane() { int l; asm volatile("v_mbcnt_lo_u32_b32 %0, -1, 0\n\tv_mbcnt_hi_u32_b32 %0, -1, %0" : "=v"(l)); return l; }
__device__ __forceinline__ unsigned pk_bf16(float a, float b) { bf16v2 v; v.x = (__bf16)a; v.y = (__bf16)b; return __builtin_bit_cast(unsigned, v); }
__device__ __forceinline__ float bf_lo(unsigned u) { return __uint_as_float(u << 16); }
__device__ __forceinline__ float bf_hi(unsigned u) { return __uint_as_float(u & 0xffff0000u); }
__device__ __forceinline__ void unpack8(const u32x4 v, float* f) {
    f[0] = bf_lo(v.x); f[1] = bf_hi(v.x); f[2] = bf_lo(v.y); f[3] = bf_hi(v.y); f[4] = bf_lo(v.z); f[5] = bf_hi(v.z); f[6] = bf_lo(v.w); f[7] = bf_hi(v.w);
}
__device__ __forceinline__ u32x4 pack8(const float* f) { u32x4 v; v.x = pk_bf16(f[0], f[1]); v.y = pk_bf16(f[2], f[3]); v.z = pk_bf16(f[4], f[5]); v.w = pk_bf16(f[6], f[7]); return v; }
__device__ __forceinline__ float wave_sum(float v) {
#pragma unroll
    for (int d = 32; d >= 1; d >>= 1) v += __shfl_xor(v, d);
    return v;
}

#define XB_TMO      128
#define XB_XCNT(j)  (256  + 64 * (j))
#define XB_XSUB(j)  (1280 + 64 * (j))
#define XB_XGEN(j)  (2304 + 64 * (j))
#define XB_TOP      3328
#define XB_TOPGEN   3392
#define XCD_BAR_WORDS 3456
#define XB_SPIN_CAP (1u << 23)

__device__ __forceinline__ unsigned xb_ld(unsigned* p)              { return __hip_atomic_load(p, __ATOMIC_RELAXED, __HIP_MEMORY_SCOPE_AGENT); }
__device__ __forceinline__ unsigned xb_add(unsigned* p, unsigned v) { return __hip_atomic_fetch_add(p, v, __ATOMIC_RELAXED, __HIP_MEMORY_SCOPE_AGENT); }
__device__ __forceinline__ unsigned xb_xcc_id() { return (unsigned)__builtin_amdgcn_s_getreg((3 << 11) | 20) & 0xFu; }
#define XB_SPIN(cond, bar) do { unsigned _sp = 0; while (cond) { __builtin_amdgcn_s_sleep(1); \
    if ((++_sp & 255u) == 0u) { if (xb_ld(&(bar)[XB_TMO])) break; if (_sp > XB_SPIN_CAP) { atomicAdd(&(bar)[XB_TMO], 1u); break; } } } } while (0)

struct XcdBarrier { unsigned* bar; unsigned x; volatile LAS unsigned* st; int wave; };

__device__ __forceinline__ XcdBarrier xcd_barrier_post(unsigned* bar, volatile LAS unsigned* st, int wave) {
    XcdBarrier b; b.bar = bar; b.x = xb_xcc_id(); b.st = st; b.wave = wave;
    if (threadIdx.x == 0) (void)xb_add(&bar[XB_XCNT(b.x)], 1u);
    return b;
}
__device__ __forceinline__ void xcd_barrier_complete(unsigned* bar, unsigned x, unsigned& nloc, unsigned& nx) {
    const unsigned G = gridDim.x * gridDim.y * gridDim.z;
    unsigned sum, cnt, mine, sp = 0u;
    for (;;) {
        sum = 0u; cnt = 0u; mine = 0u;
#pragma unroll
        for (unsigned j = 0; j < 16; ++j) { const unsigned c = xb_ld(&bar[XB_XCNT(j)]); sum += c; cnt += (c > 0u) ? 1u : 0u; mine = (j == x) ? c : mine; }
        if (sum == G) break;
        __builtin_amdgcn_s_sleep(1);
        if ((++sp & 255u) == 0u) { if (xb_ld(&bar[XB_TMO])) break; if (sp > XB_SPIN_CAP) { atomicAdd(&bar[XB_TMO], 1u); break; } }
    }
    nloc = mine > 0u ? mine : 1u; nx = cnt > 0u ? cnt : 1u;
}
__device__ __forceinline__ void xcd_barrier(const XcdBarrier& b) {
    asm volatile("s_waitcnt vmcnt(0)" ::: "memory");
    __syncthreads();
    if (b.wave == 0 && fresh_lane() == 0) {
        unsigned* bar = b.bar;
        __builtin_amdgcn_s_waitcnt(0);
        unsigned nloc = b.st[0], nx = b.st[1];
        if (nloc == 0u) { xcd_barrier_complete(bar, b.x, nloc, nx); b.st[0] = nloc; b.st[1] = nx; }
        const unsigned old = xb_add(&bar[XB_XSUB(b.x)], 1u);
        const unsigned gen = old / nloc;
        if (old + 1u == (gen + 1u) * nloc) {
            __builtin_amdgcn_fence(__ATOMIC_RELEASE, "agent");
            asm volatile("s_waitcnt vmcnt(0)" ::: "memory");
            const unsigned og = xb_add(&bar[XB_TOP], 1u);
            const unsigned tg = og / nx;
            if (og + 1u == (tg + 1u) * nx) xb_add(&bar[XB_TOPGEN], 1u);
            else XB_SPIN(xb_ld(&bar[XB_TOPGEN]) == tg, bar);
            __builtin_amdgcn_fence(__ATOMIC_ACQUIRE, "agent");
            xb_add(&bar[XB_XGEN(b.x)], 1u);
            asm volatile("s_waitcnt vmcnt(0)" ::: "memory");
        } else {
            XB_SPIN(xb_ld(&bar[XB_XGEN(b.x)]) == gen, bar);
            __builtin_amdgcn_fence(__ATOMIC_ACQUIRE, "agent");
            asm volatile("s_waitcnt vmcnt(0)" ::: "memory");
        }
    }
    __syncthreads();
}

struct Frame {
    LAS unsigned char* lds;
    int tid, lane, wave, G, bid;
    const float *x, *c, *w_ada, *b_ada, *norm1_g, *w_in, *q_norm_g, *k_norm_g, *w_pool, *pool_scale, *w_out, *norm2_g, *w_grp, *w_exp, *w1, *w3, *w2;
    float* out;
    unsigned* ctl;
    float* ADA; float* ADAP; float* TAB; bf16_t* WR; int* TOKE; float* TOKW; int* ROWTOK; float* ROWW; float* WI; bf16_t* KI;
    bf16_t *WPOOL, *WOUT, *WIN, *W13, *W2, *H, *PROJ; unsigned short* SC; bf16_t *QB, *KV, *QI, *PM, *ACT, *CONCAT; unsigned short* SEL;
    bf16_t *Y0, *DX;
};

namespace pg8 {
constexpr int BM = 256, BK = 64, HALF = 128, HTB = HALF * BK * 2, STAGE_BYTES = 8 * HTB, NXCD = 8, WGM = 8;
__device__ __forceinline__ int lds_byte(int r, int c) { const int st = (r >> 4) * 2 + (c >> 5), rr = r & 15, cc = c & 31, ob = rr * 64 + cc * 2; return st * 1024 + (ob ^ (((ob >> 9) & 1) << 5)); }
__device__ __forceinline__ void stage_rc(int b, int& R, int& C) { const int st = b / 1024, sb = b % 1024, swz = sb ^ (((sb >> 9) & 1) << 5); R = (st >> 1) * 16 + swz / 64; C = (st & 1) * 32 + (swz % 64) / 2; }
__device__ __forceinline__ int perm32(int rho) { const int n = rho >> 4, i = rho & 15; return 8 * (i >> 2) + 4 * n + (i & 3); }
struct Unit { int pm, pn; };
struct Gemm { const bf16_t* A; const bf16_t* Bt; int K; };

struct StaticOrder {
    int nM, nN, nwg, G, c, rep;
    __device__ void init(int M, int N, int G_, int c_, int rep_ = 1) { nM = M / BM; nN = N / BM; nwg = nM * nN; G = G_; c = c_; rep = rep_; }
    __device__ bool next(int i, Unit& u) const {
        long L = (long)i * G + c; if (L >= (long)nwg * rep) return false;
        if (L >= nwg) L -= nwg;
        int wgid = (int)L; { const int q = nwg / NXCD, r = nwg % NXCD, xcd = wgid % NXCD, off = wgid / NXCD; wgid = (xcd < r ? xcd * (q + 1) : r * (q + 1) + (xcd - r) * q) + off; }
        const int nig = WGM * nN, gid = wgid / nig, fm = gid * WGM, gsz = (nM - fm) < WGM ? (nM - fm) : WGM;
        u.pm = fm + ((wgid % nig) % gsz); u.pn = (wgid % nig) / gsz; return true;
    }
    __device__ __forceinline__ unsigned arow(const Unit& u, int rr) const { return (unsigned)(u.pm * BM + rr); }
};
struct PoolOrder {
    int G, c;
    __device__ bool next(int i, Unit& u) const { const int L = i * G + c; if (L >= 512) return false; u.pm = L; u.pn = L >> 7; return true; }
    __device__ __forceinline__ unsigned arow(const Unit& u, int rr) const { return (unsigned)(u.pm * BM + rr); }
};
template <int NC, bool GATHER> struct MoeOrder {
    const int* tileb; const int* rowtok; int lo, hi, G, c, rep;
    __device__ bool next(int i, Unit& u) const {
        int L = i * G + c; if (L >= (hi - lo) * NC * rep) return false;
        if (L >= (hi - lo) * NC) L -= (hi - lo) * NC;
        u.pm = lo + L / NC; const int e = tileb[u.pm] & 31; u.pn = e * NC + (L % NC); return true;
    }
    __device__ __forceinline__ unsigned arow(const Unit& u, int rr) const {
        if (GATHER) { const int tok = rowtok[u.pm * BM + rr]; return (unsigned)(tok < 0 ? 0 : tok); }
        return (unsigned)(u.pm * BM + rr);
    }
};

template <class Epi, class Sched>
__device__ __forceinline__ void gemm_phase(LAS unsigned char* lds, const Gemm g, const Sched& S, const Epi& E, const int tid) {
    const int wid = __builtin_amdgcn_readfirstlane(tid >> 6), lane = tid & 63, wr = wid >> 2, wc = wid & 3, fr = lane & 15, fq = lane >> 4;
    const int K = g.K, nt = K / BK;
    int R0, C0; stage_rc(tid * 16, R0, C0);
    unsigned voffB[2];
#pragma unroll
    for (int i = 0; i < 2; ++i) { const int R = R0 + 64 * i; const int Rb = Epi::PERM ? ((R & ~31) + perm32(R & 31)) : R; voffB[i] = (unsigned)(Rb * K + C0) * 2u; }
    const unsigned rowb = (unsigned)K * 2u, colb = (unsigned)C0 * 2u;
    const size_t kstep = (size_t)(BK * 2);
    const size_t hstep = (size_t)HALF * K * 2;
    const size_t tstep = 2 * hstep;
    const unsigned ldsw = (unsigned)wid * 1024u;
    const int aoff = lds_byte(wr * 64 + fr, fq * 8), boff = lds_byte(wc * 32 + fr, fq * 8);
#define PG8_SA(b, h) (((b) * 2 + (h)) * HTB)
#define PG8_SB(b, h) ((4 + (b) * 2 + (h)) * HTB)
#define PG8_STAGE(bufoff, gbase, voff) do { _Pragma("unroll") for (int _i = 0; _i < 2; ++_i) \
        __builtin_amdgcn_global_load_lds((const unsigned*)((const char*)(gbase) + (voff)[_i]), (LAS unsigned*)(lds + (bufoff) + ldsw + _i * 8192), 16, 0, 0); } while (0)
#define PG8_LDA(dst, b, h) do { _Pragma("unroll") for (int m = 0; m < 4; ++m) _Pragma("unroll") for (int k = 0; k < 2; ++k) dst[m][k] = *(const LAS bf16x8*)(lds + PG8_SA(b, h) + aoff + m * 2048 + k * 1024); } while (0)
#define PG8_LDB(dst, b, h) do { _Pragma("unroll") for (int n = 0; n < 2; ++n) _Pragma("unroll") for (int k = 0; k < 2; ++k) dst[n][k] = *(const LAS bf16x8*)(lds + PG8_SB(b, h) + boff + n * 2048 + k * 1024); } while (0)
#define PG8_MMA(ai, bj, At, Bt) do { __builtin_amdgcn_s_setprio(1); _Pragma("unroll") for (int m = 0; m < 4; ++m) _Pragma("unroll") for (int n = 0; n < 2; ++n) _Pragma("unroll") for (int k = 0; k < 2; ++k) \
        acc[ai][bj][m][n] = __builtin_amdgcn_mfma_f32_16x16x32_bf16(Bt[n][k], At[m][k], acc[ai][bj][m][n], 0, 0, 0); __builtin_amdgcn_s_setprio(0); } while (0)
#define PG8_WAIT_V(n) asm volatile("s_waitcnt vmcnt(" #n ")" ::: "memory")
#define PG8_WAIT_L(n) asm volatile("s_waitcnt lgkmcnt(" #n ")" ::: "memory")
#define PG8_BAR __builtin_amdgcn_s_barrier()
#define PG8_SCHED __builtin_amdgcn_sched_barrier(0)
#define PG8_ROWS(dst, u) do { _Pragma("unroll") for (int _h = 0; _h < 2; ++_h) _Pragma("unroll") for (int _i = 0; _i < 2; ++_i) dst[_h][_i] = S.arow(u, _h * HALF + R0 + 64 * _i) * rowb + colb; } while (0)
    Unit cur, nxt; int ui = 0;
    if (!S.next(0, cur)) return;
    f32x4 acc[2][2][4][2];
#pragma unroll
    for (int a = 0; a < 2; ++a)
#pragma unroll
        for (int b = 0; b < 2; ++b)
#pragma unroll
            for (int m = 0; m < 4; ++m)
#pragma unroll
                for (int n = 0; n < 2; ++n) acc[a][b][m][n] = (f32x4){0.f, 0.f, 0.f, 0.f};
    bf16x8 At[4][2], B0[2][2], B1[2][2];
    unsigned oc[2][2], on[2][2];
    PG8_ROWS(oc, cur);
    const char* gA = (const char*)g.A;
    const char* cB = (const char*)g.Bt + (size_t)cur.pn * tstep;
    PG8_STAGE(PG8_SB(0, 0), cB, voffB); PG8_STAGE(PG8_SA(0, 0), gA, oc[0]); PG8_STAGE(PG8_SB(0, 1), cB + hstep, voffB); PG8_STAGE(PG8_SA(0, 1), gA, oc[1]);
    if (wr == 1) PG8_BAR;
    PG8_WAIT_V(4); PG8_BAR;
    PG8_STAGE(PG8_SB(1, 0), cB + kstep, voffB); PG8_STAGE(PG8_SA(1, 0), gA + kstep, oc[0]); PG8_STAGE(PG8_SB(1, 1), cB + hstep + kstep, voffB);
    PG8_WAIT_V(6); PG8_BAR;
    const int tpre = nt >= 4 ? nt - 4 : nt - 2;
    for (;;) {
        const bool has_next = S.next(ui + 1, nxt);
#pragma unroll
        for (int h = 0; h < 2; ++h)
#pragma unroll
            for (int i = 0; i < 2; ++i) on[h][i] = oc[h][i];
        const char* nB = has_next ? (const char*)g.Bt + (size_t)nxt.pn * tstep : cB;
        for (int t = 0; t < nt; t += 2) {
            const bool last = (t == nt - 2);
            if (has_next && t == tpre) PG8_ROWS(on, nxt);
            const char* a1 = gA + (size_t)(t + 1) * kstep;
            const char* a2 = last ? gA : gA + (size_t)(t + 2) * kstep; const char* b2 = last ? nB : cB + (size_t)(t + 2) * kstep;
            const char* a3 = a2 + kstep; const char* b3 = b2 + kstep;
            unsigned o2[2][2];
#pragma unroll
            for (int h = 0; h < 2; ++h)
#pragma unroll
                for (int i = 0; i < 2; ++i) o2[h][i] = last ? on[h][i] : oc[h][i];
            PG8_LDB(B0, 0, 0); PG8_SCHED; PG8_LDA(At, 0, 0); PG8_STAGE(PG8_SA(1, 1), a1, oc[1]);
            PG8_WAIT_L(8); PG8_BAR; PG8_WAIT_L(0); PG8_MMA(0, 0, At, B0); PG8_BAR; PG8_SCHED;
            PG8_LDB(B1, 0, 1); PG8_STAGE(PG8_SB(0, 0), b2, voffB);
            PG8_BAR; PG8_WAIT_L(0); PG8_MMA(0, 1, At, B1); PG8_BAR;
            PG8_LDA(At, 0, 1); PG8_STAGE(PG8_SA(0, 0), a2, o2[0]);
            PG8_BAR; PG8_WAIT_L(0); PG8_MMA(1, 0, At, B0); PG8_BAR; PG8_SCHED;
            PG8_STAGE(PG8_SB(0, 1), b2 + hstep, voffB);
            PG8_WAIT_V(6); PG8_BAR; PG8_MMA(1, 1, At, B1); PG8_BAR;
            PG8_LDB(B0, 1, 0); PG8_SCHED; PG8_LDA(At, 1, 0); PG8_STAGE(PG8_SA(0, 1), a2, o2[1]);
            PG8_WAIT_L(8); PG8_BAR; PG8_WAIT_L(0); PG8_MMA(0, 0, At, B0); PG8_BAR; PG8_SCHED;
            PG8_LDB(B1, 1, 1); PG8_STAGE(PG8_SB(1, 0), b3, voffB);
            PG8_BAR; PG8_WAIT_L(0); PG8_MMA(0, 1, At, B1); PG8_BAR;
            PG8_LDA(At, 1, 1); PG8_STAGE(PG8_SA(1, 0), a3, o2[0]);
            PG8_BAR; PG8_WAIT_L(0); PG8_MMA(1, 0, At, B0); PG8_BAR; PG8_SCHED;
            PG8_STAGE(PG8_SB(1, 1), b3 + hstep, voffB);
            PG8_WAIT_V(6); PG8_BAR; PG8_MMA(1, 1, At, B1); PG8_BAR;
        }
        E(acc, cur, wr, wc, fr, fq);
        if (!has_next) break;
#pragma unroll
        for (int a = 0; a < 2; ++a)
#pragma unroll
            for (int b = 0; b < 2; ++b)
#pragma unroll
                for (int m = 0; m < 4; ++m)
#pragma unroll
                    for (int n = 0; n < 2; ++n) acc[a][b][m][n] = (f32x4){0.f, 0.f, 0.f, 0.f};
        cur = nxt; cB = nB; ++ui;
#pragma unroll
        for (int h = 0; h < 2; ++h)
#pragma unroll
            for (int i = 0; i < 2; ++i) oc[h][i] = on[h][i];
    }
    PG8_WAIT_V(0);
    if (wr == 0) PG8_BAR;
    PG8_BAR;
#undef PG8_SA
#undef PG8_SB
#undef PG8_STAGE
#undef PG8_LDA
#undef PG8_LDB
#undef PG8_MMA
#undef PG8_WAIT_V
#undef PG8_WAIT_L
#undef PG8_BAR
#undef PG8_SCHED
#undef PG8_ROWS
}

struct EpiBf16 {
    static constexpr bool PERM = true;
    bf16_t* O; int ldc; int mode;
    __device__ __forceinline__ void operator()(const f32x4 (&acc)[2][2][4][2], const Unit& u, int wr, int wc, int fr, int fq) const {
        const int rowb = (mode == 1 ? (u.pm & 127) : u.pm) * BM, colb = (mode == 1 ? 1024 : 0) + u.pn * BM;
        const int row0 = rowb + wr * 64 + fr, col0 = colb + wc * 32 + 8 * fq;
#pragma unroll
        for (int ai = 0; ai < 2; ++ai)
#pragma unroll
            for (int m = 0; m < 4; ++m) { bf16_t* rowp = O + (size_t)(row0 + ai * HALF + m * 16) * ldc + col0;
#pragma unroll
                for (int bj = 0; bj < 2; ++bj) { const f32x4 v0 = acc[ai][bj][m][0], v1 = acc[ai][bj][m][1];
                    u32x4 w; w.x = pk_bf16(v0[0], v0[1]); w.y = pk_bf16(v0[2], v0[3]); w.z = pk_bf16(v1[0], v1[1]); w.w = pk_bf16(v1[2], v1[3]);
                    *(u32x4*)(rowp + bj * HALF) = w; } }
    }
};
struct EpiMix {
    static constexpr bool PERM = true;
    const float* ada; bf16_t* DX;
    __device__ __forceinline__ void operator()(const f32x4 (&acc)[2][2][4][2], const Unit& u, int wr, int wc, int fr, int fq) const {
        const int row0 = u.pm * BM + wr * 64 + fr, col0 = u.pn * BM + wc * 32 + 8 * fq;
        const float* gate = ada + (size_t)(u.pm >> 5) * 12288 + 2 * 2048 + col0;
        f32x4 gv[2][2];
#pragma unroll
        for (int bj = 0; bj < 2; ++bj)
#pragma unroll
            for (int n = 0; n < 2; ++n) gv[bj][n] = *(const f32x4*)(gate + bj * HALF + 4 * n);
#pragma unroll
        for (int ai = 0; ai < 2; ++ai)
#pragma unroll
            for (int m = 0; m < 4; ++m) { bf16_t* rowp = DX + (size_t)(row0 + ai * HALF + m * 16) * D + col0;
#pragma unroll
                for (int bj = 0; bj < 2; ++bj) { const f32x4 v0 = gv[bj][0] * acc[ai][bj][m][0], v1 = gv[bj][1] * acc[ai][bj][m][1];
                    u32x4 w; w.x = pk_bf16(v0[0], v0[1]); w.y = pk_bf16(v0[2], v0[3]); w.z = pk_bf16(v1[0], v1[1]); w.w = pk_bf16(v1[2], v1[3]);
                    *(u32x4*)(rowp + bj * HALF) = w; } }
    }
};
struct EpiAct {
    static constexpr bool PERM = true;
    bf16_t* ACT;
    __device__ __forceinline__ void operator()(const f32x4 (&acc)[2][2][4][2], const Unit& u, int wr, int wc, int fr, int fq) const {
        const int row0 = u.pm * BM + wr * 64 + fr, col0 = (u.pn & 3) * 128 + wc * 32 + 8 * fq;
#pragma unroll
        for (int ai = 0; ai < 2; ++ai)
#pragma unroll
            for (int m = 0; m < 4; ++m) {
                float v[8];
#pragma unroll
                for (int n = 0; n < 2; ++n)
#pragma unroll
                    for (int e = 0; e < 4; ++e) { const float a = acc[ai][0][m][n][e], b = acc[ai][1][m][n][e]; v[n * 4 + e] = a / (1.0f + __expf(-a)) * b; }
                *(u32x4*)(ACT + (size_t)(row0 + ai * HALF + m * 16) * 512 + col0) = pack8(v);
            }
    }
};
struct EpiMoeY0 {
    static constexpr bool PERM = true;
    const int* rowtok; const float* roww; const float* ada; bf16_t* Y0;
    __device__ __forceinline__ void operator()(const f32x4 (&acc)[2][2][4][2], const Unit& u, int wr, int wc, int fr, int fq) const {
        const int row0 = u.pm * BM + wr * 64 + fr, col0 = (u.pn & 7) * BM + wc * 32 + 8 * fq;
        int tk[8]; float wt[8];
#pragma unroll
        for (int r = 0; r < 8; ++r) { const int row = row0 + (r >> 2) * HALF + (r & 3) * 16; tk[r] = rowtok[row]; wt[r] = roww[row]; }
#pragma unroll
        for (int r = 0; r < 8; ++r) { const int ai = r >> 2, m = r & 3; const int tok = tk[r] < 0 ? 0 : tk[r]; const float w = tk[r] < 0 ? 0.f : wt[r];
            const float* gate = ada + (size_t)(tok >> 13) * 12288 + 5 * 2048 + col0; bf16_t* yp = Y0 + (size_t)tok * D + col0;
            u32x4 o[2];
#pragma unroll
            for (int bj = 0; bj < 2; ++bj) { const f32x4 g0 = *(const f32x4*)(gate + bj * HALF), g1 = *(const f32x4*)(gate + bj * HALF + 4);
                const f32x4 v0 = g0 * w * acc[ai][bj][m][0], v1 = g1 * w * acc[ai][bj][m][1];
                o[bj].x = pk_bf16(v0[0], v0[1]); o[bj].y = pk_bf16(v0[2], v0[3]); o[bj].z = pk_bf16(v1[0], v1[1]); o[bj].w = pk_bf16(v1[2], v1[3]); }
            if (tk[r] >= 0) { *(u32x4*)yp = o[0]; *(u32x4*)(yp + HALF) = o[1]; } }
    }
};
struct EpiMoeOut {
    static constexpr bool PERM = false;
    const int* rowtok; const float* roww; const float* ada; const bf16_t* Y0; const bf16_t* DX; const float* x; float* out;
    __device__ __forceinline__ void operator()(const f32x4 (&acc)[2][2][4][2], const Unit& u, int wr, int wc, int fr, int fq) const {
        const int row0 = u.pm * BM + wr * 64 + fr, col0 = (u.pn & 7) * BM + wc * 32 + 4 * fq;
        int tk[8]; float wt[8];
#pragma unroll
        for (int r = 0; r < 8; ++r) { const int row = row0 + (r >> 2) * HALF + (r & 3) * 16; tk[r] = rowtok[row]; wt[r] = roww[row]; }
#pragma unroll
        for (int r = 0; r < 8; ++r) { const int ai = r >> 2, m = r & 3; const int tok = tk[r] < 0 ? 0 : tk[r]; const float w = wt[r];
            const float* gate = ada + (size_t)(tok >> 13) * 12288 + 5 * 2048 + col0; float* op = out + (size_t)tok * D + col0; const float* xp = x + (size_t)tok * D + col0;
            const bf16_t* yp = Y0 + (size_t)tok * D + col0; const bf16_t* dp = DX + (size_t)tok * D + col0;
            f32x4 gvv[4], xv[4]; u32x2 yv[4], dv[4];
#pragma unroll
            for (int q = 0; q < 4; ++q) { const int off = (q >> 1) * HALF + (q & 1) * 16; gvv[q] = *(const f32x4*)(gate + off); xv[q] = *(const f32x4*)(xp + off); yv[q] = *(const u32x2*)(yp + off); dv[q] = *(const u32x2*)(dp + off); }
            if (tk[r] >= 0) {
#pragma unroll
                for (int q = 0; q < 4; ++q) { const int off = (q >> 1) * HALF + (q & 1) * 16; f32x4 o = xv[q];
                    o += (f32x4){bf_lo(dv[q].x), bf_hi(dv[q].x), bf_lo(dv[q].y), bf_hi(dv[q].y)}; o += (f32x4){bf_lo(yv[q].x), bf_hi(yv[q].x), bf_lo(yv[q].y), bf_hi(yv[q].y)} + gvv[q] * w * acc[ai][q >> 1][m][q & 1];
                    *(f32x4*)(op + off) = o; } } }
    }
};
}

__device__ __forceinline__ int colmap(int n) { return n < 2560 ? n : (n < 2624 ? 3584 + (n - 2560) : (n < 2640 ? 3648 + (n - 2624) : 2560 + (n - 2640))); }

template <class RowMap>
__device__ __forceinline__ void tr_tile(const Frame& F, const float* src, size_t ldS, int k0, int n0, int N, const float* cscale, RowMap rm) {
    LAS float* tile = (LAS float*)F.lds;
    const int tid = F.tid, r = tid >> 4, c4 = tid & 15;
    f32x4 v[4];
    const int n = n0 + c4 * 4;
#pragma unroll
    for (int i = 0; i < 4; ++i) v[i] = (n < N) ? *(const f32x4*)(src + (size_t)(k0 + r + 32 * i) * ldS + n) : (f32x4){0.f, 0.f, 0.f, 0.f};
    __syncthreads();
#pragma unroll
    for (int i = 0; i < 4; ++i)
#pragma unroll
        for (int e = 0; e < 4; ++e) tile[(r + 32 * i) * 65 + c4 * 4 + e] = v[i][e];
    __syncthreads();
    const int nn = tid >> 3, kc = tid & 7;
    if (n0 + nn < N) {
        const float sc = cscale ? cscale[n0 + nn] : 1.0f;
        float f[16];
#pragma unroll
        for (int j = 0; j < 16; ++j) f[j] = tile[(kc * 16 + j) * 65 + nn] * sc;
        bf16_t* d = rm(n0 + nn) + k0 + kc * 16;
        *(u32x4*)d = pack8(f); *(u32x4*)(d + 8) = pack8(f + 8);
    }
}

__device__ __forceinline__ void p0_prologue(const Frame& F) {
    constexpr int U_ADA = 192, T_WIN = 16 * 58, T_WOUT = 16 * 32, T_POOL = 4 * 2 * 4, T_W1 = 32 * 128, T_W2 = 32 * 128, U_TAB = 16, U_WR = 4, U_PAD = 2;
    constexpr int B0 = U_ADA, B1 = B0 + T_WIN, B2 = B1 + T_WOUT, B3 = B2 + T_POOL, B4 = B3 + T_W1, B5 = B4 + T_W1, B6 = B5 + T_W2, B7 = B6 + U_TAB, B8 = B7 + U_WR, B9 = B8 + U_PAD;
    const int tid = F.tid;
    constexpr int NTILE = B6 - B0;
    static_assert(NTILE == 13760, "tile split");
    const int nmine = 1 + 50 + (F.bid >= 192 ? 15 : 0);
    for (int it = 0; it < nmine; ++it) {
        int u;
        if (it == 0) { u = F.bid < 192 ? F.bid : (F.bid - 192 < 22 ? B6 + (F.bid - 192) : -1); if (u < 0) continue; }
        else if (it <= 50) u = B0 + F.bid + 256 * (it - 1);
        else u = B0 + 12800 + (F.bid - 192) + 64 * (it - 51);
        if (u < B0) {
            const int kc = u / 6, cb = u % 6;
            LAS float* sc = (LAS float*)F.lds;
            __syncthreads();
            if (tid < 256) { const int b = tid >> 6, k = tid & 63; const float cv = F.c[b * D + kc * 64 + k]; sc[tid] = cv / (1.0f + __expf(-cv)); }
            __syncthreads();
            const int n = cb * 2048 + tid * 4;
            f32x4 a[4];
#pragma unroll
            for (int b = 0; b < 4; ++b) a[b] = (f32x4){0.f, 0.f, 0.f, 0.f};
            const float* wp = F.w_ada + (size_t)(kc * 64) * 12288 + n;
#pragma unroll 8
            for (int k = 0; k < 64; ++k) { const f32x4 w = *(const f32x4*)(wp + (size_t)k * 12288);
#pragma unroll
                for (int b = 0; b < 4; ++b) a[b] += sc[b * 64 + k] * w; }
            const f32x4 bias = (kc == 0) ? *(const f32x4*)(F.b_ada + n) : (f32x4){0.f, 0.f, 0.f, 0.f};
#pragma unroll
            for (int b = 0; b < 4; ++b) *(f32x4*)(F.ADAP + ((size_t)kc * 4 + b) * 12288 + n) = a[b] + bias;
        } else if (u < B1) {
            const int v = u - B0, kt = v / 58, ntl = v % 58; bf16_t* W = F.WIN;
            tr_tile(F, F.w_in, 3664, kt * 128, ntl * 64, 3664, nullptr, [=](int n) { return W + (size_t)colmap(n) * 2048; });
        } else if (u < B2) {
            const int v = u - B1, kt = v / 32, ntl = v % 32; bf16_t* W = F.WOUT;
            tr_tile(F, F.w_out, 2048, kt * 128, ntl * 64, 2048, nullptr, [=](int n) { return W + (size_t)n * 2048; });
        } else if (u < B3) {
            const int v = u - B2, g = v / 8, kt = (v % 8) / 4, ntl = v % 4; bf16_t* W = F.WPOOL + (size_t)g * 256 * 256;
            tr_tile(F, F.w_pool + (size_t)g * 65536, 256, kt * 128, ntl * 64, 256, F.pool_scale + g * 256, [=](int n) { return W + (size_t)n * 256; });
        } else if (u < B5) {
            const bool is3 = u >= B4; const int v = u - (is3 ? B4 : B3), e = v / 128, kt = (v % 128) / 8, ntl = v % 8;
            bf16_t* W = F.W13 + (size_t)e * 1024 * 2048 + (is3 ? (size_t)128 * 2048 : 0);
            tr_tile(F, (is3 ? F.w3 : F.w1) + (size_t)e * 2048 * 512, 512, kt * 128, ntl * 64, 512, nullptr, [=](int n) { return W + (size_t)((n >> 7) * 256 + (n & 127)) * 2048; });
        } else if (u < B6) {
            const int v = u - B5, e = v / 128, kt = (v % 128) / 32, ntl = v % 32; bf16_t* W = F.W2 + (size_t)e * 2048 * 512;
            tr_tile(F, F.w2 + (size_t)e * 512 * 2048, 2048, kt * 128, ntl * 64, 2048, nullptr, [=](int n) { return W + (size_t)n * 512; });
        } else if (u < B7) {
            const int pos = (u - B6) * 512 + tid; float* tp = F.TAB + (size_t)pos * 48;
            for (int i = 0; i < 16; ++i) { const double inv = pow(500000.0, -(double)(2 * i) / 32.0); double sn, cs; sincos((double)pos * inv, &sn, &cs); tp[i] = (float)cs; tp[16 + i] = (float)sn; }
            for (int i = 0; i < 8; ++i) { const double inv = pow(500000.0, -(double)(2 * i) / 16.0); double sn, cs; sincos((double)pos * inv, &sn, &cs); tp[32 + i] = (float)cs; tp[40 + i] = (float)sn; }
        } else if (u < B8) {
            const int j0 = (u - B7) * 12;
            for (int idx = tid; idx < 12 * 2048; idx += NTHREADS) { const int j = j0 + idx / 2048, k = idx % 2048;
                const float v = j < 4 ? F.w_grp[k * 4 + j] : (j < 36 ? F.w_exp[k * 32 + (j - 4)] : 0.f);
                bf16v2 t; t.x = (__bf16)v; t.y = (__bf16)0.f; F.WR[(size_t)j * 2048 + k] = (bf16_t)(__builtin_bit_cast(unsigned, t) & 0xffffu); }
        } else {
            const int h = u - B8; u32x4* p = (u32x4*)(F.WIN + (size_t)3664 * 2048) + (size_t)h * 22528;
            for (int i = tid; i < 22528; i += NTHREADS) p[i] = (u32x4){0u, 0u, 0u, 0u};
        }
    }
}

__device__ __forceinline__ size_t qi_off(size_t t, int head, int d) { return (t >> 1) * 2048 + (size_t)((d >> 4) * 512 + (((head & 3) + 4 * (int)(t & 1) + 8 * (head >> 2)) + 32 * ((d >> 3) & 1)) * 8 + (d & 7)); }
__device__ __forceinline__ size_t ki_off(size_t s, int d) { const int kin = (int)(s & 127); return (s >> 7) * 8192 + (size_t)(((kin & 3) * 4 + (d >> 4)) * 512 + ((kin >> 2) + 32 * ((d >> 3) & 1)) * 8 + (d & 7)); }

__device__ __forceinline__ void norm_rows(const Frame& F, const float* src, const bf16_t* delta, const float* gain, const float* shiftp, const float* scalep) {
    const int lane = F.lane;
    f32x4 Gv[8], Sv[8];
#pragma unroll
    for (int i = 0; i < 8; ++i) { const int col = 4 * lane + 256 * i; const f32x4 g = *(const f32x4*)(gain + col), sc = *(const f32x4*)(scalep + col);
        Gv[i] = g * (1.0f + sc); Sv[i] = *(const f32x4*)(shiftp + col); }
    f32x4 v[8], vn[8]; u32x2 dv[8], dn[8];
    { const size_t ro = (size_t)(F.bid * 128 + F.wave) * D;
#pragma unroll
      for (int i = 0; i < 8; ++i) { v[i] = *(const f32x4*)(src + ro + 4 * lane + 256 * i); if (delta) dv[i] = *(const u32x2*)(delta + ro + 4 * lane + 256 * i); } }
    for (int j = 0; j < 16; ++j) {
        const int t = F.bid * 128 + F.wave + 8 * j;
        if (j < 15) { const size_t ro = (size_t)(t + 8) * D;
#pragma unroll
            for (int i = 0; i < 8; ++i) { vn[i] = *(const f32x4*)(src + ro + 4 * lane + 256 * i); if (delta) dn[i] = *(const u32x2*)(delta + ro + 4 * lane + 256 * i); } }
        if (delta) {
#pragma unroll
            for (int i = 0; i < 8; ++i) v[i] += (f32x4){bf_lo(dv[i].x), bf_hi(dv[i].x), bf_lo(dv[i].y), bf_hi(dv[i].y)}; }
        float ss = 0.f;
#pragma unroll
        for (int i = 0; i < 8; ++i) ss += v[i][0] * v[i][0] + v[i][1] * v[i][1] + v[i][2] * v[i][2] + v[i][3] * v[i][3];
        ss = wave_sum(ss);
        const float rstd = rsqrtf(ss * (1.0f / 2048.0f) + NORM_EPS);
        bf16_t* hr = F.H + (size_t)t * D;
#pragma unroll
        for (int i = 0; i < 8; ++i) { const f32x4 y = v[i] * rstd * Gv[i] + Sv[i]; u32x2 w; w.x = pk_bf16(y[0], y[1]); w.y = pk_bf16(y[2], y[3]); *(u32x2*)(hr + 4 * lane + 256 * i) = w; }
        if (j < 15) {
#pragma unroll
            for (int i = 0; i < 8; ++i) { v[i] = vn[i]; dv[i] = dn[i]; } }
    }
}

__device__ __forceinline__ void p3_post(const Frame& F) {
    const int lane = F.lane;
    LAS float* kw = (LAS float*)F.lds + F.wave * 1280;
    {
        const int li = lane & 15, q4 = lane >> 4;
        f32x4 acc[5];
#pragma unroll
        for (int nb = 0; nb < 5; ++nb) acc[nb] = (f32x4){0.f, 0.f, 0.f, 0.f};
        const bf16_t* hp = F.H + (size_t)(F.bid * 128 + F.wave * 16 + li) * D + 8 * q4;
        LAS bf16_t* bs = (LAS bf16_t*)(F.lds + 40960);
        for (int kc = 0; kc < 8; ++kc) {
            u32x4 st[5];
#pragma unroll
            for (int i = 0; i < 5; ++i) { const int piece = F.tid + 512 * i, row = piece >> 5, pc = piece & 31; st[i] = *(const u32x4*)(F.WIN + (size_t)(3584 + row) * D + kc * 256 + pc * 8); }
            bf16x8 a[8];
#pragma unroll
            for (int ks = 0; ks < 8; ++ks) a[ks] = *(const bf16x8*)(hp + 32 * (kc * 8 + ks));
            __syncthreads();
#pragma unroll
            for (int i = 0; i < 5; ++i) { const int piece = F.tid + 512 * i, row = piece >> 5, pc = piece & 31; *(LAS u32x4*)(bs + row * 264 + pc * 8) = st[i]; }
            __syncthreads();
#pragma unroll
            for (int ks = 0; ks < 8; ++ks)
#pragma unroll
                for (int nb = 0; nb < 5; ++nb) { const bf16x8 bb = *(const LAS bf16x8*)(bs + (nb * 16 + li) * 264 + ks * 32 + 8 * q4); acc[nb] = __builtin_amdgcn_mfma_f32_16x16x32_bf16(a[ks], bb, acc[nb], 0, 0, 0); }
        }
#pragma unroll
        for (int nb = 0; nb < 5; ++nb)
#pragma unroll
            for (int i = 0; i < 4; ++i) kw[(4 * q4 + i) * 80 + nb * 16 + li] = acc[nb][i];
        asm volatile("s_waitcnt lgkmcnt(0)" ::: "memory");
    }
    const float QSCALE = 0.08838834764831845f * 1.4426950408889634f;
    const float IDX_SCALE = 0.125f * 0.25f;
    float gq[16], gk[16];
#pragma unroll
    for (int e = 0; e < 16; ++e) { gq[e] = F.q_norm_g[(lane & 7) * 16 + e]; gk[e] = F.k_norm_g[(lane & 7) * 16 + e]; }
    float wsum[16];
    for (int j = 0; j < 16; ++j) {
        const int t = F.bid * 128 + F.wave * 16 + j, pos = t & (S - 1);
        const bf16_t* pr = F.PROJ + (size_t)t * NPROJ;
        const float* tab = F.TAB + (size_t)pos * 48;
        const int gpl = lane >> 4, wpl = 2 << gpl;
        const u32x4 Lq0 = *(const u32x4*)(pr + CQ + 16 * lane), Lq1 = *(const u32x4*)(pr + CQ + 16 * lane + 8);
        const u32x4 Lk0 = *(const u32x4*)(pr + CK + 16 * (lane & 31)), Lk1 = *(const u32x4*)(pr + CK + 16 * (lane & 31) + 8);
        const u32x4 Li0 = *(const u32x4*)(pr + CQI + 16 * lane), Li1 = *(const u32x4*)(pr + CQI + 16 * lane + 8);
        const u32x4 Lp0 = *(const u32x4*)(pr + CP + 16 * lane), Lp1 = *(const u32x4*)(pr + CP + 16 * lane + 8);
        f32x4 tq[8], ti[4];
#pragma unroll
        for (int i = 0; i < 8; ++i) tq[i] = *(const f32x4*)(tab + 4 * i);
#pragma unroll
        for (int i = 0; i < 4; ++i) ti[i] = *(const f32x4*)(tab + 32 + 4 * i);
        u32x4 Lo0, Lo1;
        { const int rr = wpl <= pos ? wpl : pos; const bf16_t* pp = pr - (size_t)rr * NPROJ + CP + 16 * lane; Lo0 = *(const u32x4*)pp; Lo1 = *(const u32x4*)(pp + 8); }
        {
            float f[16]; unpack8(Lq0, f); unpack8(Lq1, f + 8);
            float ss = 0.f;
#pragma unroll
            for (int e = 0; e < 16; ++e) ss += f[e] * f[e];
            ss += __shfl_xor(ss, 1); ss += __shfl_xor(ss, 2); ss += __shfl_xor(ss, 4);
            const float rstd = rsqrtf(ss * (1.0f / 128.0f) + NORM_EPS);
            const int d0 = (lane & 7) * 16;
#pragma unroll
            for (int e = 0; e < 16; ++e) f[e] = f[e] * rstd * gq[e];
            float o[16];
#pragma unroll
            for (int e = 0; e < 16; ++e) o[e] = __shfl_xor(f[e], 1);
            const int l8 = lane & 7;
            if (l8 < 2) {
#pragma unroll
                for (int e = 0; e < 16; ++e) { const float cs = tq[e >> 2][e & 3], sn = tq[4 + (e >> 2)][e & 3]; f[e] = (l8 == 0) ? (f[e] * cs - o[e] * sn) : (f[e] * cs + o[e] * sn); }
            }
#pragma unroll
            for (int e = 0; e < 16; ++e) f[e] *= QSCALE;
            bf16_t* qo = F.QB + (size_t)t * 1024 + 16 * lane;
            *(u32x4*)qo = pack8(f); *(u32x4*)(qo + 8) = pack8(f + 8);
        }
        {
            const int l = lane & 31;
            float f[16]; unpack8(Lk0, f); unpack8(Lk1, f + 8);
            float kf[16]; float ss = 0.f;
#pragma unroll
            for (int e = 0; e < 16; ++e) ss += f[e] * f[e];
            ss += __shfl_xor(ss, 1); ss += __shfl_xor(ss, 2); ss += __shfl_xor(ss, 4);
            const float rstd = rsqrtf(ss * (1.0f / 128.0f) + NORM_EPS);
            const int d0 = (l & 7) * 16;
#pragma unroll
            for (int e = 0; e < 16; ++e) kf[e] = f[e] * rstd * gk[e];
            float o[16];
#pragma unroll
            for (int e = 0; e < 16; ++e) o[e] = __shfl_xor(kf[e], 1);
            const int l8 = l & 7;
            if (l8 < 2) {
#pragma unroll
                for (int e = 0; e < 16; ++e) { const float cs = tq[e >> 2][e & 3], sn = tq[4 + (e >> 2)][e & 3]; kf[e] = (l8 == 0) ? (kf[e] * cs - o[e] * sn) : (kf[e] * cs + o[e] * sn); }
            }
            if (lane < 32) {
                const bool isv = lane >= 16; const int ll = lane & 15, g = ll >> 3, dd = (ll & 7) * 16;
                bf16_t* dst = F.KV + (size_t)t * 512 + g * 256 + (isv ? 128 : 0) + dd;
                *(u32x4*)dst = pack8(isv ? f : kf); *(u32x4*)(dst + 8) = pack8(isv ? f + 8 : kf + 8);
            }
        }
        {
            float f[16]; unpack8(Li0, f); unpack8(Li1, f + 8);
            if ((lane & 3) == 0) {
#pragma unroll
                for (int i = 0; i < 8; ++i) { const float cs = ti[i >> 2][i & 3], sn = ti[2 + (i >> 2)][i & 3]; const float x1 = f[i], x2 = f[i + 8]; f[i] = x1 * cs - x2 * sn; f[i + 8] = x2 * cs + x1 * sn; }
            }
            const int hd = lane >> 2, d0 = (lane & 3) * 16;
            *(u32x4*)(F.QI + qi_off((size_t)t, hd, d0)) = pack8(f); *(u32x4*)(F.QI + qi_off((size_t)t, hd, d0 + 8)) = pack8(f + 8);
        }
        if (lane < 5) {
            float f[16];
#pragma unroll
            for (int e = 0; e < 16; ++e) f[e] = kw[j * 80 + 16 * lane + e];
            if (lane == 0) {
#pragma unroll
                for (int i = 0; i < 8; ++i) { const float cs = ti[i >> 2][i & 3], sn = ti[2 + (i >> 2)][i & 3]; const float x1 = f[i], x2 = f[i + 8]; f[i] = x1 * cs - x2 * sn; f[i + 8] = x2 * cs + x1 * sn; }
            }
            if (lane < 4) { *(u32x4*)(F.KI + ki_off((size_t)t, 16 * lane)) = pack8(f); *(u32x4*)(F.KI + ki_off((size_t)t, 16 * lane + 8)) = pack8(f + 8); }
            else { float* wo = F.WI + (size_t)t * 16;
#pragma unroll
                for (int e = 0; e < 16; ++e) wo[e] = f[e] * IDX_SCALE; }
        }
        {
            const int g = lane >> 4, w = 2 << g;
            float cur[16], sum[16];
            unpack8(Lp0, cur); unpack8(Lp1, cur + 8);
            if (j == 0) {
#pragma unroll
                for (int e = 0; e < 16; ++e) wsum[e] = cur[e];
                for (int r = 1; r < 16; ++r) {
                    if (r < w && r <= pos) { float f[16]; const bf16_t* pp = pr - (size_t)r * NPROJ + CP + 16 * lane; unpack8(*(const u32x4*)pp, f); unpack8(*(const u32x4*)(pp + 8), f + 8);
#pragma unroll
                        for (int e = 0; e < 16; ++e) wsum[e] += f[e]; }
                }
            } else {
                float old[16]; unpack8(Lo0, old); unpack8(Lo1, old + 8);
                const float useo = (pos >= w) ? 1.0f : 0.0f;
#pragma unroll
                for (int e = 0; e < 16; ++e) wsum[e] += cur[e] - useo * old[e];
            }
            const float inv = 1.0f / (float)((pos + 1) < w ? (pos + 1) : w);
#pragma unroll
            for (int e = 0; e < 16; ++e) sum[e] = wsum[e] * inv - cur[e];
            bf16_t* po = F.PM + ((size_t)g * T + t) * 256 + (lane & 15) * 16;
            *(u32x4*)po = pack8(sum); *(u32x4*)(po + 8) = pack8(sum + 8);
        }
    }
}

__device__ __forceinline__ size_t sc_block_base(int b, int qb) { return (size_t)b * SC_BATCH + (size_t)16384 * ((size_t)qb * (qb + 1) / 2); }

__device__ __forceinline__ void indexer_unit(const Frame& F, int b, int qb, int kb) {
    const int lane = F.lane, wid = F.wave, c = lane & 31, hf = lane >> 5;
    bf16x8 kf[4][4];
    const bf16_t* kib = F.KI + (((size_t)b * S + kb * 128) >> 7) * 8192 + lane * 8;
#pragma unroll
    for (int sub = 0; sub < 4; ++sub)
#pragma unroll
        for (int kk = 0; kk < 4; ++kk) kf[sub][kk] = *(const bf16x8*)(kib + (sub * 4 + kk) * 512);
    const int qq = (c >> 2) & 1, head = (c & 3) + 4 * (c >> 3);
    const size_t rowlen = (size_t)(qb + 1) * 128;
    unsigned short* scb = F.SC + sc_block_base(b, qb);
    const size_t tq0 = (size_t)b * S + qb * 128 + wid * 16;
    bf16x8 af[4], afn[4]; f32x4 wv[4], wvn[4];
#pragma unroll
    for (int kk = 0; kk < 4; ++kk) af[kk] = *(const bf16x8*)(F.QI + (tq0 >> 1) * 2048 + kk * 512 + lane * 8);
#pragma unroll
    for (int i = 0; i < 4; ++i) wv[i] = *(const f32x4*)(F.WI + (tq0 + hf) * 16 + 4 * i);
#pragma unroll
    for (int pair = 0; pair < 8; ++pair) {
        const int r0 = wid * 16 + pair * 2;
        if (pair < 7) {
#pragma unroll
            for (int kk = 0; kk < 4; ++kk) afn[kk] = *(const bf16x8*)(F.QI + ((tq0 >> 1) + pair + 1) * 2048 + kk * 512 + lane * 8);
#pragma unroll
            for (int i = 0; i < 4; ++i) wvn[i] = *(const f32x4*)(F.WI + (tq0 + 2 * (pair + 1) + hf) * 16 + 4 * i);
        }
        float sc[4];
#pragma unroll
        for (int sub = 0; sub < 4; ++sub) {
            f32x16 acc;
#pragma unroll
            for (int i = 0; i < 16; ++i) acc[i] = 0.f;
#pragma unroll
            for (int kk = 0; kk < 4; ++kk) acc = __builtin_amdgcn_mfma_f32_32x32x16_bf16(af[kk], kf[sub][kk], acc, 0, 0, 0);
            float s = 0.f;
#pragma unroll
            for (int i = 0; i < 16; ++i) { const float av = acc[i]; const int ai = __float_as_int(av); const float rl = __int_as_float(ai > 0 ? ai : 0); const float wi_ = wv[i >> 2][i & 3];
                asm("v_fmac_f32 %0, %1, %2" : "+v"(s) : "v"(wi_), "v"(rl)); }
            sc[sub] = s;
        }
        f16v2 h0, h1; h0.x = (_Float16)sc[0]; h0.y = (_Float16)sc[1]; h1.x = (_Float16)sc[2]; h1.y = (_Float16)sc[3];
        u32x2 w; w.x = __builtin_bit_cast(unsigned, h0); w.y = __builtin_bit_cast(unsigned, h1);
        *(u32x2*)(scb + (size_t)(r0 + hf) * rowlen + kb * 128 + 4 * c) = w;
        if (pair < 7) {
#pragma unroll
            for (int kk = 0; kk < 4; ++kk) af[kk] = afn[kk];
#pragma unroll
            for (int i = 0; i < 4; ++i) wv[i] = wvn[i];
        }
    }
}

__device__ __forceinline__ void find_bin(LAS unsigned* hist, int lane, unsigned need, unsigned& bin, unsigned& above) {
    const u32x4 h = *(const LAS u32x4*)(hist + 4 * lane);
    const unsigned s = h.x + h.y + h.z + h.w;
    unsigned v = s;
#pragma unroll
    for (int d = 1; d < 64; d <<= 1) { const unsigned tt = __shfl_down(v, d); if (lane + d < 64) v += tt; }
    unsigned run = v - s;
    int fb = -1; unsigned fa = 0;
    const unsigned hh[4] = {h.x, h.y, h.z, h.w};
#pragma unroll
    for (int j = 3; j >= 0; --j) { if (fb < 0 && run < need && run + hh[j] >= need) { fb = 4 * lane + j; fa = run; } run += hh[j]; }
    const unsigned long long m = __ballot(fb >= 0);
    const int src = m ? (int)__builtin_ctzll(m) : 0;
    bin = (unsigned)__shfl(fb, src); above = __shfl(fa, src);
}

__device__ __forceinline__ unsigned okey(unsigned h) { return (h & 0x8000u) ? (~h & 0xffffu) : (h | 0x8000u); }
__device__ __forceinline__ const unsigned short* sel_src(const Frame& F, int t) { const int pos = t & (S - 1), qb = pos >> 7; return F.SC + sc_block_base(t >> 13, qb) + (size_t)(pos & 127) * (qb + 1) * 128; }
__device__ __forceinline__ void select_row(const Frame& F, int t, const u32x4 (&pre)[16], LAS unsigned char* wbuf, int lane) {
    LAS unsigned* rowb = (LAS unsigned*)wbuf;
    LAS unsigned* hist = (LAS unsigned*)(wbuf + 16384);
    LAS unsigned short* lst = (LAS unsigned short*)(wbuf + 16384 + 1024);
    const int pos = t & (S - 1), n = pos + 1;
    unsigned short* out = F.SEL + (size_t)t * 256;
    if (n <= 256) { for (int j = lane; j < 256; j += 64) out[j] = (unsigned short)(j < n ? j : 0); return; }
    const int nch = (n + 511) >> 9;
#pragma unroll
    for (int ch = 0; ch < 16; ++ch) if (ch < nch) *(LAS u32x4*)(rowb + ch * 256 + lane * 4) = pre[ch];
#pragma unroll
    for (int i = 0; i < 4; ++i) hist[lane + 64 * i] = 0u;
    for (int ch = 0; ch < nch; ++ch) {
        const int base = ch * 512 + lane * 8;
        u32x4 raw = *(const LAS u32x4*)(rowb + ch * 256 + lane * 4);
#pragma unroll
        for (int w = 0; w < 4; ++w) {
            const unsigned k0 = (base + 2 * w < n) ? okey(raw[w] & 0xffffu) : 0u, k1 = (base + 2 * w + 1 < n) ? okey(raw[w] >> 16) : 0u;
            __hip_atomic_fetch_add(hist + (k0 >> 8), 1u, __ATOMIC_RELAXED, __HIP_MEMORY_SCOPE_WORKGROUP);
            __hip_atomic_fetch_add(hist + (k1 >> 8), 1u, __ATOMIC_RELAXED, __HIP_MEMORY_SCOPE_WORKGROUP);
            raw[w] = k0 | (k1 << 16);
        }
        *(LAS u32x4*)(rowb + ch * 256 + lane * 4) = raw;
    }
#if P5_PROBE == 1
    for (int ch = 0; ch < nch; ++ch) {
        const u32x4 raw = *(const LAS u32x4*)(rowb + ch * 256 + lane * 4);
#pragma unroll
        for (int w = 0; w < 4; ++w) {
            __hip_atomic_fetch_add(hist + ((raw[w] & 0xffffu) >> 8), 0u, __ATOMIC_RELAXED, __HIP_MEMORY_SCOPE_WORKGROUP);
            __hip_atomic_fetch_add(hist + (raw[w] >> 24), 0u, __ATOMIC_RELAXED, __HIP_MEMORY_SCOPE_WORKGROUP);
        }
    }
#endif
    unsigned bin1, above1; find_bin(hist, lane, 256u, bin1, above1);
    const unsigned r1 = 256u - above1;
#pragma unroll
    for (int i = 0; i < 4; ++i) hist[lane + 64 * i] = 0u;
    for (int ch = 0; ch < nch; ++ch) {
        const u32x4 raw = *(const LAS u32x4*)(rowb + ch * 256 + lane * 4);
#pragma unroll
        for (int w = 0; w < 4; ++w) {
            const unsigned k0 = raw[w] & 0xffffu, k1 = raw[w] >> 16;
            if ((k0 >> 8) == bin1) __hip_atomic_fetch_add(hist + (k0 & 255u), 1u, __ATOMIC_RELAXED, __HIP_MEMORY_SCOPE_WORKGROUP);
            if ((k1 >> 8) == bin1) __hip_atomic_fetch_add(hist + (k1 & 255u), 1u, __ATOMIC_RELAXED, __HIP_MEMORY_SCOPE_WORKGROUP);
        }
    }
    unsigned bin2, above2; find_bin(hist, lane, r1, bin2, above2);
#if P5_PROBE == 4
    { unsigned bx, ax; find_bin(hist, lane, r1, bx, ax); if (bx != bin2) bin2 = bx; find_bin(hist, lane, r1, bx, ax); if (bx != bin2) bin2 = bx; }
#endif
    const unsigned r2 = r1 - above2, thr = (bin1 << 8) | bin2;
    unsigned cg = 0, ce = 0;
    for (int ch = 0; ch < nch; ++ch) {
        const u32x4 raw = *(const LAS u32x4*)(rowb + ch * 256 + lane * 4);
#pragma unroll
        for (int e = 0; e < 8; ++e) { const unsigned key = (raw[e >> 1] >> ((e & 1) * 16)) & 0xffffu; cg += (key > thr) ? 1u : 0u; ce += (key == thr) ? 1u : 0u; }
    }
#if P5_PROBE == 2
    { unsigned cg2 = 0, ce2 = 0;
      for (int ch = 0; ch < nch; ++ch) {
        const u32x4 raw = *(const LAS u32x4*)(rowb + ch * 256 + lane * 4);
#pragma unroll
        for (int e = 0; e < 8; ++e) { const unsigned key = (raw[e >> 1] >> ((e & 1) * 16)) & 0xffffu; cg2 += (key > thr + 1u) ? 1u : 0u; ce2 += (key == thr + 1u) ? 1u : 0u; }
      }
      if (cg2 + ce2 == 0xffffffffu) cg += 1u; }
#endif
    unsigned og = cg, oe = ce;
#pragma unroll
    for (int d = 1; d < 64; d <<= 1) { const unsigned tg = __shfl_up(og, d), te = __shfl_up(oe, d); if (lane >= d) { og += tg; oe += te; } }
    og -= cg; oe -= ce;
    const unsigned G = above1 + above2;
    for (int ch = 0; ch < nch; ++ch) {
        const u32x4 raw = *(const LAS u32x4*)(rowb + ch * 256 + lane * 4);
#pragma unroll
        for (int e = 0; e < 8; ++e) {
            const unsigned key = (raw[e >> 1] >> ((e & 1) * 16)) & 0xffffu;
            const unsigned short id = (unsigned short)(ch * 512 + lane * 8 + e);
            if (key > thr) { if (og < 256u) lst[og] = id; ++og; }
            if (key == thr) { if (oe < r2 && G + oe < 256u) lst[G + oe] = id; ++oe; }
        }
    }
    *(u32x2*)(out + 4 * lane) = *(const LAS u32x2*)(lst + 4 * lane);
}

__device__ __forceinline__ bf16x8 tr_read2(unsigned a0, unsigned a1) {
    s16x4 x, y;
    asm volatile("ds_read_b64_tr_b16 %0, %2\n\tds_read_b64_tr_b16 %1, %3\n\ts_waitcnt lgkmcnt(0)" : "=&v"(x), "=&v"(y) : "v"(a0), "v"(a1) : "memory");
    return (bf16x8){x[0], x[1], x[2], x[3], y[0], y[1], y[2], y[3]};
}

__device__ __forceinline__ void tr_read16(const unsigned (&va)[4], s16x4 (&r)[16]) {
    asm volatile(
        "ds_read_b64_tr_b16 %0, %16\n\tds_read_b64_tr_b16 %1, %16 offset:4096\n\tds_read_b64_tr_b16 %2, %17\n\tds_read_b64_tr_b16 %3, %17 offset:4096\n\t"
        "ds_read_b64_tr_b16 %4, %18\n\tds_read_b64_tr_b16 %5, %18 offset:4096\n\tds_read_b64_tr_b16 %6, %19\n\tds_read_b64_tr_b16 %7, %19 offset:4096\n\t"
        "ds_read_b64_tr_b16 %8, %16 offset:512\n\tds_read_b64_tr_b16 %9, %16 offset:4608\n\tds_read_b64_tr_b16 %10, %17 offset:512\n\tds_read_b64_tr_b16 %11, %17 offset:4608\n\t"
        "ds_read_b64_tr_b16 %12, %18 offset:512\n\tds_read_b64_tr_b16 %13, %18 offset:4608\n\tds_read_b64_tr_b16 %14, %19 offset:512\n\tds_read_b64_tr_b16 %15, %19 offset:4608\n\t"
        "s_waitcnt lgkmcnt(0)"
        : "=&v"(r[0]), "=&v"(r[1]), "=&v"(r[2]), "=&v"(r[3]), "=&v"(r[4]), "=&v"(r[5]), "=&v"(r[6]), "=&v"(r[7]),
          "=&v"(r[8]), "=&v"(r[9]), "=&v"(r[10]), "=&v"(r[11]), "=&v"(r[12]), "=&v"(r[13]), "=&v"(r[14]), "=&v"(r[15])
        : "v"(va[0]), "v"(va[1]), "v"(va[2]), "v"(va[3]) : "memory");
}
#define AT_WAITV(n) asm volatile("s_waitcnt vmcnt(" #n ")" ::: "memory")
__device__ __forceinline__ int rot_k(int p) { return ((p & 1) ? 3 : 1) + ((p >> 2) & 1) * 4; }
__device__ __forceinline__ void attn_items(const Frame& F, int klo, int khi) {
    const int lane = F.lane, li = lane & 15, q4 = lane >> 4;
    const int xg = F.bid & 7, b = xg >> 1, g = xg & 1;
    const int wq = (F.bid >> 3) * 8 + F.wave;
    LAS unsigned char* wb = F.lds + F.wave * 16384;
    const unsigned wbu = (unsigned)(uintptr_t)wb;
    const bf16_t* kvb = F.KV + (size_t)b * S * 512 + g * 256;
    const int da = lane >> 3, dr = lane & 7, drow = da & 3, dline = da >> 2;
    const int koff0 = 64 * dline + 8 * ((dr + rot_k(drow >> 1)) & 7);
    const int voff0 = 128 + 64 * dline + 8 * ((dr + 2 * (drow >> 1)) & 7);
    const unsigned kra0 = (unsigned)((li >> 2) * 1024 + (8 * (li & 3) + ((q4 - rot_k(li >> 1)) & 7)) * 16);
    const int vr4 = li >> 2, vp = li & 3;
    const unsigned vbase = wbu + (unsigned)(q4 * 1024 + 128 * vr4 + 8 * (vp & 1));
    const int vc = (vp >> 1) - 2 * ((2 * q4 + (vr4 >> 1)) & 3) + 8;
#define AT_KDMA(c) do { _Pragma("unroll") for (int _j = 0; _j < 4; ++_j) { const int _ix = (__shfl(idx2[(c) >> 1], 4 * _j + drow) >> (((c) & 1) * 16)) & 0xffff; \
        __builtin_amdgcn_global_load_lds((const unsigned*)((const char*)kvb + (unsigned)(_ix * 1024 + 2 * (koff0 ^ ((_j >> 1) * 32)))), (LAS unsigned*)(wb + ((c) & 3) * 4096 + _j * 1024), 16, 0, 0); } } while (0)
#define AT_VDMA(ks) do { _Pragma("unroll") for (int _j = 0; _j < 8; ++_j) { const int _ix = (__shfl(idx2[ks], 4 * (_j & 3) + drow) >> ((_j >> 2) * 16)) & 0xffff; \
        __builtin_amdgcn_global_load_lds((const unsigned*)((const char*)kvb + (unsigned)(_ix * 1024 + 2 * (voff0 ^ ((_j & 1) * 32)))), (LAS unsigned*)(wb + ((ks) & 1) * 8192 + _j * 1024), 16, 0, 0); } } while (0)
    for (int k = klo; k < khi; ++k) {
        const int pos = wq + 256 * k, t = b * S + pos, cnt = (pos + 1) < 256 ? (pos + 1) : 256;
        int idx2[8];
#pragma unroll
        for (int i = 0; i < 8; ++i) { const int s0 = 32 * i + li, s1 = s0 + 16; const int v0 = F.SEL[(size_t)t * 256 + s0], v1 = F.SEL[(size_t)t * 256 + s1]; idx2[i] = (s0 < cnt ? v0 : 0) | ((s1 < cnt ? v1 : 0) << 16); }
        bf16x8 bq[4];
#pragma unroll
        for (int kk = 0; kk < 4; ++kk) { bq[kk] = (bf16x8){0, 0, 0, 0, 0, 0, 0, 0}; if (li < 4) bq[kk] = *(const bf16x8*)(F.QB + (size_t)t * 1024 + (4 * g + li) * 128 + 32 * kk + 8 * q4); }
        AT_KDMA(0); AT_KDMA(1); AT_KDMA(2);
        f32x4 s[16];
#pragma unroll
        for (int c = 0; c < 16; ++c) {
            if (c <= 13) AT_WAITV(8); else if (c == 14) AT_WAITV(12); else AT_WAITV(8);
            f32x4 acc = (f32x4){0.f, 0.f, 0.f, 0.f};
            bf16x8 a[4];
#pragma unroll
            for (int kk = 0; kk < 4; ++kk) a[kk] = *(const LAS bf16x8*)(wb + (c & 3) * 4096 + (kk >> 1) * 512 + (kra0 ^ (unsigned)((kk & 1) * 64)));
#pragma unroll
            for (int kk = 0; kk < 4; ++kk) acc = __builtin_amdgcn_mfma_f32_16x16x32_bf16(a[kk], bq[kk], acc, 0, 0, 0);
            s[c] = acc;
            asm volatile("s_waitcnt lgkmcnt(0)" ::: "memory");
            if (c + 3 <= 15) AT_KDMA(c + 3);
            if (c == 13) AT_VDMA(0);
            if (c == 15) AT_VDMA(1);
            __builtin_amdgcn_sched_barrier(0);
        }
        float m = -INFINITY;
#pragma unroll
        for (int c = 0; c < 16; ++c)
#pragma unroll
            for (int i = 0; i < 4; ++i) { const int slot = c * 16 + 4 * q4 + i; if (slot >= cnt) s[c][i] = -INFINITY; m = fmaxf(m, s[c][i]); }
        m = fmaxf(m, __shfl_xor(m, 16)); m = fmaxf(m, __shfl_xor(m, 32));
        float sum = 0.f;
#pragma unroll
        for (int c = 0; c < 16; ++c)
#pragma unroll
            for (int i = 0; i < 4; ++i) { const float p = exp2f(s[c][i] - m); s[c][i] = p; sum += p; }
        sum += __shfl_xor(sum, 16); sum += __shfl_xor(sum, 32);
        f32x4 o[8];
#pragma unroll
        for (int d = 0; d < 8; ++d) o[d] = (f32x4){0.f, 0.f, 0.f, 0.f};
#pragma unroll
        for (int ks = 0; ks < 8; ++ks) {
            u32x4 pk; pk.x = pk_bf16(s[2 * ks][0], s[2 * ks][1]); pk.y = pk_bf16(s[2 * ks][2], s[2 * ks][3]); pk.z = pk_bf16(s[2 * ks + 1][0], s[2 * ks + 1][1]); pk.w = pk_bf16(s[2 * ks + 1][2], s[2 * ks + 1][3]);
            const bf16x8 bp = __builtin_bit_cast(bf16x8, pk);
            if (ks < 7) AT_WAITV(8); else AT_WAITV(0);
            unsigned va[4];
#pragma unroll
            for (int dd = 0; dd < 4; ++dd) va[dd] = vbase + (unsigned)((ks & 1) * 8192) + (unsigned)(((vc + 2 * dd) & 7) << 4);
            s16x4 tr[16];
            tr_read16(va, tr);
#pragma unroll
            for (int d = 0; d < 8; ++d) { const int q = 8 * (d >> 2) + 2 * (d & 3); const bf16x8 a = (bf16x8){tr[q][0], tr[q][1], tr[q][2], tr[q][3], tr[q + 1][0], tr[q + 1][1], tr[q + 1][2], tr[q + 1][3]};
                o[d] = __builtin_amdgcn_mfma_f32_16x16x32_bf16(a, bp, o[d], 0, 0, 0); }
            if (ks + 2 <= 7) AT_VDMA(ks + 2);
            __builtin_amdgcn_sched_barrier(0);
        }
        const float inv = 1.0f / sum;
        if (li < 4) {
            bf16_t* op = F.CONCAT + (size_t)t * D + g * 512 + li * 128 + 4 * q4;
#pragma unroll
            for (int d = 0; d < 8; ++d) { u32x2 w; w.x = pk_bf16(o[d][0] * inv, o[d][1] * inv); w.y = pk_bf16(o[d][2] * inv, o[d][3] * inv); *(u32x2*)(op + d * 16) = w; }
        }
    }
#undef AT_KDMA
#undef AT_VDMA
}

#if SELFCHECK
__device__ __forceinline__ float bfv(const bf16_t* p, size_t i) { return __uint_as_float(((unsigned)p[i]) << 16); }
__device__ __forceinline__ unsigned hash_u(unsigned x) { x ^= x >> 16; x *= 0x7feb352dU; x ^= x >> 15; x *= 0x846ca68bU; x ^= x >> 16; return x; }
__device__ __forceinline__ void chk_flag(const Frame& F, int k) { __hip_atomic_fetch_add(F.ctl + CW_CHK + k, 1u, __ATOMIC_RELAXED, __HIP_MEMORY_SCOPE_AGENT); }
__device__ void chk_gemm1(const Frame& F) {
    for (int j = 0; j < 16; ++j) {
        const unsigned hsh = hash_u((unsigned)((F.bid * 8 + F.wave) * 16 + j) * 2654435761u + 12345u);
        const int t = (int)(hsh % (unsigned)T), n = (int)((hsh >> 7) % 3664u);
        float s = 0.f, sa = 0.f;
        for (int k = F.lane; k < D; k += 64) { const float a = bfv(F.H, (size_t)t * D + k), w = F.w_in[(size_t)k * 3664 + n]; s += a * w; sa += fabsf(a * w); }
        s = wave_sum(s); sa = wave_sum(sa);
        const float got = colmap(n) < 3584 ? bfv(F.PROJ, (size_t)t * NPROJ + colmap(n)) : s;
        if (F.lane == 0 && !(fabsf(got - s) <= 0.001f * sa + 0.02f)) chk_flag(F, 0);
    }
}
__device__ void chk_post(const Frame& F) {
    const int gw = F.bid * 8 + F.wave;
    const int t = (gw * 16 + (gw & 15)) % T, pos = t & (S - 1), lane = F.lane;
    const bf16_t* pr = F.PROJ + (size_t)t * NPROJ;
    const float QSCALE = 0.08838834764831845f * 1.4426950408889634f;
    int bad = 0;
    for (int hh = 0; hh < 10; ++hh) {
        const int cb = hh < 8 ? CQ + hh * 128 : CK + (hh - 8) * 128; const float* gn = hh < 8 ? F.q_norm_g : F.k_norm_g;
        float ss = 0.f; for (int d = lane; d < 128; d += 64) { const float v = bfv(pr, cb + d); ss += v * v; } ss = wave_sum(ss);
        const float rstd = 1.0f / sqrtf(ss / 128.0f + NORM_EPS);
        for (int d = lane; d < 128; d += 64) {
            float y = bfv(pr, cb + d) * rstd * gn[d];
            if (d < 32) { const int i = d & 15; const float inv = powf(500000.0f, -(float)(2 * i) / 32.0f); const float ang = (float)pos * inv; const float cs = cosf(ang), sn = sinf(ang);
                const int dp = d < 16 ? d + 16 : d - 16; const float yp = bfv(pr, cb + dp) * rstd * gn[dp];
                y = d < 16 ? y * cs - yp * sn : y * cs + yp * sn; }
            float got, ref;
            if (hh < 8) { ref = y * QSCALE; got = bfv(F.QB, (size_t)t * 1024 + hh * 128 + d); } else { ref = y; got = bfv(F.KV, (size_t)t * 512 + (hh - 8) * 256 + d); }
            if (!(fabsf(got - ref) <= 0.02f * fabsf(ref) + 0.02f)) bad = 1;
        }
    }
    for (int e = lane; e < 256; e += 64) { const float ref = bfv(pr, CV + e), got = bfv(F.KV, (size_t)t * 512 + (e >> 7) * 256 + 128 + (e & 127)); if (got != ref) bad = 1; }
    for (int e = lane; e < 1024; e += 64) {
        const int cb = CQI + (e & ~63); const int d = e & 63;
        float y = bfv(pr, cb + d);
        if (d < 16) { const int i = d & 7; const float inv = powf(500000.0f, -(float)(2 * i) / 16.0f); const float ang = (float)pos * inv; const float cs = cosf(ang), sn = sinf(ang);
            const int dp = d < 8 ? d + 8 : d - 8; const float yp = bfv(pr, cb + dp); y = d < 8 ? y * cs - yp * sn : y * cs + yp * sn; }
        const float got = bfv(F.QI, qi_off((size_t)t, e >> 6, d));
        if (!(fabsf(got - y) <= 0.02f * fabsf(y) + 0.02f)) bad = 1;
    }
    {
        LAS float* kwref = (LAS float*)(F.lds + 49152) + F.wave * 128;
        for (int c = 0; c < 80; ++c) {
            float sdot = 0.f; for (int k = lane; k < D; k += 64) sdot += bfv(F.H, (size_t)t * D + k) * F.w_in[(size_t)k * 3664 + 2560 + c];
            sdot = wave_sum(sdot); if (lane == 0) kwref[c] = sdot;
        }
        asm volatile("s_waitcnt lgkmcnt(0)" ::: "memory");
        { const int d = lane; float y = kwref[d];
          if (d < 16) { const int i = d & 7; const float inv = powf(500000.0f, -(float)(2 * i) / 16.0f); const float ang = (float)pos * inv; const float cs = cosf(ang), sn = sinf(ang);
              const int dp = d < 8 ? d + 8 : d - 8; const float yp = kwref[dp]; y = d < 8 ? y * cs - yp * sn : y * cs + yp * sn; }
          const float got = bfv(F.KI, ki_off((size_t)t, d));
          if (!(fabsf(got - y) <= 0.02f * fabsf(y) + 0.03f)) bad = 1; }
        if (lane < 16) { const float ref = kwref[64 + lane] * 0.03125f, got = F.WI[(size_t)t * 16 + lane]; if (!(fabsf(got - ref) <= 1e-3f + 0.01f * fabsf(ref))) bad = 1; }
    }
    for (int e = lane; e < 1024; e += 64) {
        const int g = e >> 8, w = 2 << g; float sum = 0.f; int cn = 0;
        for (int r = 0; r < w; ++r) if (pos - r >= 0) { sum += bfv(pr - (size_t)r * NPROJ, CP + e); ++cn; }
        const float ref = sum / (float)cn - bfv(pr, CP + e), got = bfv(F.PM, ((size_t)g * T + t) * 256 + (e & 255));
        if (!(fabsf(got - ref) <= 0.02f * fabsf(ref) + 0.02f)) bad = 1;
    }
    if (__ballot(bad) != 0ull && lane == 0) chk_flag(F, 1);
}
__device__ void chk_attn(const Frame& F) {
    const int w = F.bid, b = w & 3, j = w >> 2;
    const int special[12] = {0, 1, 100, 254, 255, 256, 257, 300, 511, 512, 8190, 8191};
    const int pos = j < 12 ? special[j] : (j * 131 + 17) & (S - 1);
    const int t = b * S + pos, n = pos + 1, cnt = n < 256 ? n : 256, tid = F.tid;
    LAS float* sc = (LAS float*)F.lds;
    LAS int* selmark = (LAS int*)(F.lds + 32768);
    LAS float* red = (LAS float*)(F.lds + 65536);
    LAS int* ired = (LAS int*)(F.lds + 65536 + 4096);
    __syncthreads();
    for (int s2 = tid; s2 < n; s2 += NTHREADS) {
        float tot = 0.f;
        for (int h = 0; h < 16; ++h) { float dsum = 0.f; for (int d = 0; d < 64; ++d) dsum += bfv(F.QI, qi_off((size_t)t, h, d)) * bfv(F.KI, ki_off((size_t)b * S + s2, d)); tot += F.WI[(size_t)t * 16 + h] * fmaxf(dsum, 0.f); }
        sc[s2] = (float)(_Float16)tot; selmark[s2] = 0;
    }
    __syncthreads();
    if (tid < cnt) { const int k = F.SEL[(size_t)t * 256 + tid]; if (k < n) atomicAdd((int*)(selmark + k), 1); else atomicAdd((int*)(selmark + 0), 1000); }
    if (tid == 0) { ired[0] = 0; ired[1] = 0; }
    __syncthreads();
    int miss = 0, dup = 0;
    for (int s2 = tid; s2 < n; s2 += NTHREADS) {
        const int mk = selmark[s2]; if (mk > 1) dup = 1;
        if (mk >= 1 && n > 256) { const float v = sc[s2]; int rank = 0; for (int q = 0; q < n; ++q) rank += (sc[q] > v) ? 1 : 0; if (rank >= 256) ++miss; }
    }
    if (miss) atomicAdd((int*)ired, miss); if (dup) atomicAdd((int*)ired + 1, 1);
    __syncthreads();
    if (tid == 0 && (ired[0] > 3 || ired[1] > 0)) chk_flag(F, 2);
    float err2 = 0.f, ref2 = 0.f;
    for (int h = 0; h < 8; ++h) {
        const int g = h >> 2;
        __syncthreads();
        if (tid < 256) { float l = -INFINITY; if (tid < cnt) { const int k = F.SEL[(size_t)t * 256 + tid]; float dsum = 0.f; for (int d = 0; d < 128; ++d) dsum += bfv(F.QB, (size_t)t * 1024 + h * 128 + d) * bfv(F.KV, ((size_t)b * S + k) * 512 + g * 256 + d); l = dsum; } red[tid] = l; }
        __syncthreads();
        float m = -INFINITY; for (int q = 0; q < 256; ++q) m = fmaxf(m, red[q]);
        float den = 0.f; for (int q = 0; q < 256; ++q) den += exp2f(red[q] - m);
        if (tid < 128) { float o = 0.f; for (int q = 0; q < cnt; ++q) { const int k = F.SEL[(size_t)t * 256 + q]; o += exp2f(red[q] - m) * bfv(F.KV, ((size_t)b * S + k) * 512 + g * 256 + 128 + tid); }
            o /= den; const float got = bfv(F.CONCAT, (size_t)t * D + h * 128 + tid); err2 += (got - o) * (got - o); ref2 += o * o; }
    }
    err2 = wave_sum(err2); ref2 = wave_sum(ref2);
    __syncthreads();
    if (F.lane == 0 && F.wave < 2) { red[300 + F.wave * 2] = err2; red[301 + F.wave * 2] = ref2; }
    __syncthreads();
    if (tid == 0) { const float e = red[300] + red[302], r = red[301] + red[303]; if (!(e <= 0.0009f * r + 1e-6f)) chk_flag(F, 3); }
    __syncthreads();
}
#endif

__device__ __forceinline__ void r1_route(const Frame& F) {
    { const float* ada = F.ADA + (size_t)(F.bid >> 6) * 12288; norm_rows(F, F.x, F.DX, F.norm2_g, ada + 3 * 2048, ada + 4 * 2048); }
    LAS unsigned* lh = (LAS unsigned*)(F.lds + 65536);
    LAS float* lg = (LAS float*)F.lds + F.wave * 768;
    if (F.tid < 64) lh[F.tid] = 0u;
    asm volatile("s_waitcnt vmcnt(0)" ::: "memory");
    __syncthreads();
    const int lane = F.lane, li = lane & 15, q4 = lane >> 4;
    const int t0 = F.bid * 128 + F.wave * 16;
    f32x4 acc[3];
#pragma unroll
    for (int nb = 0; nb < 3; ++nb) acc[nb] = (f32x4){0.f, 0.f, 0.f, 0.f};
    const bf16_t* hp = F.H + (size_t)(t0 + li) * D + 8 * q4;
    const bf16_t* wp = F.WR + (size_t)li * D + 8 * q4;
#pragma unroll 4
    for (int ks = 0; ks < 64; ++ks) {
        const bf16x8 a = *(const bf16x8*)(hp + 32 * ks);
#pragma unroll
        for (int nb = 0; nb < 3; ++nb) { const bf16x8 bb = *(const bf16x8*)(wp + (size_t)nb * 16 * D + 32 * ks); acc[nb] = __builtin_amdgcn_mfma_f32_16x16x32_bf16(a, bb, acc[nb], 0, 0, 0); }
    }
#pragma unroll
    for (int nb = 0; nb < 3; ++nb)
#pragma unroll
        for (int i = 0; i < 4; ++i) lg[(4 * q4 + i) * 48 + nb * 16 + li] = acc[nb][i];
    asm volatile("s_waitcnt lgkmcnt(0)" ::: "memory");
    if (lane < 16) {
        const int t = t0 + lane; const LAS float* l = lg + lane * 48;
        int gs = 0; float gm = l[0];
#pragma unroll
        for (int j = 1; j < 4; ++j) if (l[j] > gm) { gm = l[j]; gs = j; }
        float den = 0.f;
#pragma unroll
        for (int j = 0; j < 4; ++j) den += __expf(l[j] - gm);
        const float pg = 1.0f / den;
        const LAS float* el = l + 4 + gs * 8;
        int i0 = 0; float m0 = el[0];
#pragma unroll
        for (int j = 1; j < 8; ++j) if (el[j] > m0) { m0 = el[j]; i0 = j; }
        int i1 = -1; float m1 = -INFINITY;
#pragma unroll
        for (int j = 0; j < 8; ++j) if (j != i0 && el[j] > m1) { m1 = el[j]; i1 = j; }
        const float e1 = __expf(m1 - m0), w0 = pg / (1.0f + e1), w1 = pg * e1 / (1.0f + e1);
        const int b0 = gs * 8 + i0, b1 = 32 + gs * 8 + i1;
        F.TOKE[2 * t] = b0; F.TOKE[2 * t + 1] = b1; F.TOKW[2 * t] = w0; F.TOKW[2 * t + 1] = w1;
        __hip_atomic_fetch_add(lh + b0, 1u, __ATOMIC_RELAXED, __HIP_MEMORY_SCOPE_WORKGROUP);
        __hip_atomic_fetch_add(lh + b1, 1u, __ATOMIC_RELAXED, __HIP_MEMORY_SCOPE_WORKGROUP);
    }
    __syncthreads();
    if (F.tid < 64) { const unsigned cn = lh[F.tid]; if (cn) __hip_atomic_fetch_add(F.ctl + CW_GCOUNT + F.tid, cn, __ATOMIC_RELAXED, __HIP_MEMORY_SCOPE_AGENT); }
}

__device__ __forceinline__ void r2_rows(const Frame& F) {
    LAS unsigned* lh = (LAS unsigned*)F.lds;
    LAS unsigned* lbase = lh + 64;
    LAS unsigned* tstart = lh + 128;
    const int tid = F.tid;
    if (tid < 64) lh[tid] = 0u;
    __syncthreads();
    if (tid == 0) {
        unsigned ts = 0;
        for (int k = 0; k < 64; ++k) { tstart[k] = ts; const unsigned cn = __hip_atomic_load(F.ctl + CW_GCOUNT + k, __ATOMIC_RELAXED, __HIP_MEMORY_SCOPE_AGENT); ts += (cn + 255u) >> 8; if (k == 31) tstart[64 + 1] = ts; }
        tstart[64] = ts;
    }
    const int t = F.bid * 128 + (tid >> 1), sl = tid & 1;
    int bucket = 0; float w = 0.f;
    if (tid < 256) { bucket = F.TOKE[2 * t + sl]; w = F.TOKW[2 * t + sl]; __hip_atomic_fetch_add(lh + bucket, 1u, __ATOMIC_RELAXED, __HIP_MEMORY_SCOPE_WORKGROUP); }
    __syncthreads();
    if (tid < 64) { const unsigned cn = lh[tid]; unsigned base = 0; if (cn) base = __hip_atomic_fetch_add(F.ctl + CW_GCURSOR + tid, cn, __ATOMIC_RELAXED, __HIP_MEMORY_SCOPE_AGENT); lbase[tid] = tstart[tid] * 256u + base; }
    __syncthreads();
    if (tid < 64) lh[tid] = 0u;
    __syncthreads();
    if (tid < 256) { const unsigned rk = __hip_atomic_fetch_add(lh + bucket, 1u, __ATOMIC_RELAXED, __HIP_MEMORY_SCOPE_WORKGROUP); const unsigned p = lbase[bucket] + rk;
        if (p < (unsigned)MAXROWS) { F.ROWTOK[p] = t; F.ROWW[p] = w; } }
    if (F.bid == 0) {
        if (tid == 0) { ((int*)F.ctl)[CW_TINFO] = (int)tstart[65]; ((int*)F.ctl)[CW_TINFO + 1] = (int)tstart[64]; }
        if (tid < 64) { const unsigned a = tstart[tid], e = (tid == 63) ? tstart[64] : tstart[tid + 1]; for (unsigned p = a; p < e && p < 512u; ++p) ((int*)F.ctl)[CW_TILEB + p] = tid; }
    }
}

struct Args { const float* in[17]; float* out; unsigned char* ws; int ph_lo, ph_hi; };
constexpr int N_PHASES = 13;

__global__ void __launch_bounds__(NTHREADS, 2) mk_fwd(Args args) {
    extern __shared__ __attribute__((aligned(16))) unsigned char lds_raw[];
    Frame F;
    F.lds = (LAS unsigned char*)lds_raw;
    F.tid = threadIdx.x; F.lane = F.tid & 63; F.wave = __builtin_amdgcn_readfirstlane(F.tid >> 6); F.G = gridDim.x; F.bid = blockIdx.x;
    F.x = args.in[0]; F.c = args.in[1]; F.w_ada = args.in[2]; F.b_ada = args.in[3]; F.norm1_g = args.in[4]; F.w_in = args.in[5]; F.q_norm_g = args.in[6]; F.k_norm_g = args.in[7];
    F.w_pool = args.in[8]; F.pool_scale = args.in[9]; F.w_out = args.in[10]; F.norm2_g = args.in[11]; F.w_grp = args.in[12]; F.w_exp = args.in[13]; F.w1 = args.in[14]; F.w3 = args.in[15]; F.w2 = args.in[16];
    F.out = args.out;
    unsigned char* ws = args.ws;
    F.ctl = (unsigned*)(ws + WS_CTL); F.ADA = (float*)(ws + WS_ADA); F.ADAP = (float*)(ws + WS_ADAP); F.TAB = (float*)(ws + WS_TAB); F.WR = (bf16_t*)(ws + WS_WR); F.TOKE = (int*)(ws + WS_TOKE); F.TOKW = (float*)(ws + WS_TOKW);
    F.ROWTOK = (int*)(ws + WS_ROWTOK); F.ROWW = (float*)(ws + WS_ROWW); F.WI = (float*)(ws + WS_WI); F.KI = (bf16_t*)(ws + WS_KI);
    F.WPOOL = (bf16_t*)(ws + WS_WPOOL); F.WOUT = (bf16_t*)(ws + WS_WOUT); F.WIN = (bf16_t*)(ws + WS_WIN); F.W13 = (bf16_t*)(ws + WS_W13); F.W2 = (bf16_t*)(ws + WS_W2);
    F.H = (bf16_t*)(ws + WS_H); F.CONCAT = (bf16_t*)(ws + WS_H); F.PROJ = (bf16_t*)(ws + WS_X); F.SC = (unsigned short*)(ws + WS_X); F.Y0 = (bf16_t*)(ws + WS_X); F.DX = (bf16_t*)(ws + WS_X + 134217728);
    F.QB = (bf16_t*)(ws + WS_QB); F.ACT = (bf16_t*)(ws + WS_QB); F.KV = (bf16_t*)(ws + WS_KV); F.QI = (bf16_t*)(ws + WS_QI); F.PM = (bf16_t*)(ws + WS_PM); F.SEL = (unsigned short*)(ws + WS_SEL);

    volatile LAS unsigned* bst = (volatile LAS unsigned*)(F.lds + LDS_BYTES - 16);
    if (F.tid == 0) { bst[0] = 0u; bst[1] = 0u; bst[2] = 0u; bst[3] = 0u; }
    __syncthreads();
    XcdBarrier bar = xcd_barrier_post(F.ctl, bst, F.wave);
    const int lo = args.ph_lo, hi = args.ph_hi;
#define IN(k) (lo <= (k) && (k) < hi)
#define SEAM(k) do { if (IN(k) && IN((k) + 1)) xcd_barrier(bar); } while (0)

#define PH(k, ...) do { F.lane = fresh_lane(); F.tid = F.wave * 64 + F.lane; if (IN(k)) { for (int rep_ = 0; rep_ < 1 + ((REPEAT_MASK >> (k)) & 1); ++rep_) { __VA_ARGS__ } } SEAM(k); } while (0)
    PH(0, { p0_prologue(F); });
    PH(1, {
        if (F.tid < 192) { const int v = F.bid * 192 + F.tid; float s = 0.f; for (int kc = 0; kc < 32; ++kc) s += F.ADAP[(size_t)kc * 49152 + v]; F.ADA[v] = s; }
        LAS float* sl = (LAS float*)F.lds;
        { const int b = F.bid >> 6; for (int idx = F.tid; idx < 4096; idx += NTHREADS) { float s = 0.f; for (int kc = 0; kc < 32; ++kc) s += F.ADAP[(size_t)kc * 49152 + b * 12288 + idx]; sl[idx] = s; } }
        __syncthreads();
        norm_rows(F, F.x, nullptr, F.norm1_g, (const float*)sl, (const float*)(sl + 2048));
#if P1_PROBE == 1
        norm_rows(F, F.x, nullptr, F.norm1_g, (const float*)sl, (const float*)(sl + 2048));
#elif P1_PROBE == 2
        __syncthreads();
        { const int b = F.bid >> 6; for (int idx = F.tid; idx < 4096; idx += NTHREADS) { float s = 0.f; for (int kc = 0; kc < 32; ++kc) s += F.ADAP[(size_t)kc * 49152 + b * 12288 + idx]; sl[idx] = s; } }
#endif
        __syncthreads();
    });
    PH(2, {
        pg8::Gemm g{F.H, F.WIN, D}; pg8::StaticOrder So; So.init(T, 3584, F.G, F.bid, 1 + ((REPEAT_UNITS >> 2) & 1));
        pg8::EpiBf16 E{F.PROJ, NPROJ, 0};
        pg8::gemm_phase<pg8::EpiBf16, pg8::StaticOrder>(F.lds, g, So, E, F.tid);
    });
#if SELFCHECK
    F.lane = fresh_lane(); F.tid = F.wave * 64 + F.lane; if (IN(3)) { chk_gemm1(F); }
#endif
    PH(3, { p3_post(F); });
#if SELFCHECK
    F.lane = fresh_lane(); F.tid = F.wave * 64 + F.lane; if (IN(3)) { chk_post(F); if (IN(4)) xcd_barrier(bar); }
#endif
    PH(4, {
        {
            pg8::Gemm g{F.PM, F.WPOOL, 256}; pg8::PoolOrder So{F.G, F.bid};
            pg8::EpiBf16 E{F.CONCAT, D, 1};
            pg8::gemm_phase<pg8::EpiBf16, pg8::PoolOrder>(F.lds, g, So, E, F.tid);
        }
        for (int uu = F.bid; uu < 4 * 2080 * (1 + ((REPEAT_UNITS >> 4) & 1)); uu += F.G) {
            const int u = uu % (4 * 2080); const int b = u / 2080, v = u % 2080;
            int qb = (int)((sqrtf(8.0f * (float)v + 1.0f) - 1.0f) * 0.5f);
            while (qb * (qb + 1) / 2 > v) --qb;
            while ((qb + 1) * (qb + 2) / 2 <= v) ++qb;
            indexer_unit(F, b, qb, v - qb * (qb + 1) / 2);
        }
    });
    PH(5, {
        LAS unsigned char* wbuf = F.lds + F.wave * 17920;
        u32x4 pre[16];
        int i = F.bid * 8 + F.wave;
        int t = (i & 1) ? (T - 1 - (i >> 1)) : (i >> 1);
        { const unsigned short* src = sel_src(F, t); const int n = (t & (S - 1)) + 1, nch = n > 256 ? (n + 511) >> 9 : 0;
          _Pragma("unroll") for (int ch = 0; ch < 16; ++ch) if (ch < nch) pre[ch] = *(const u32x4*)(src + ch * 512 + F.lane * 8); }
        for (; i < T; i += F.G * 8) {
            u32x4 cur[16];
            _Pragma("unroll") for (int ch = 0; ch < 16; ++ch) cur[ch] = pre[ch];
            const int tcur = t, inext = i + F.G * 8;
            if (inext < T) {
                t = (inext & 1) ? (T - 1 - (inext >> 1)) : (inext >> 1);
                const unsigned short* src = sel_src(F, t); const int n = (t & (S - 1)) + 1, nch = n > 256 ? (n + 511) >> 9 : 0;
                _Pragma("unroll") for (int ch = 0; ch < 16; ++ch) if (ch < nch) pre[ch] = *(const u32x4*)(src + ch * 512 + F.lane * 8);
            }
            select_row(F, tcur, cur, wbuf, F.lane);
        }
    });
    PH(6, {
        attn_items(F, 0, 32);
#if ATT_PROBE == 1
        attn_items(F, 0, 16);
#elif ATT_PROBE == 2
        attn_items(F, 16, 32);
#endif
    });
#if SELFCHECK
    F.lane = fresh_lane(); F.tid = F.wave * 64 + F.lane; if (IN(7)) { chk_attn(F); }
#endif
    PH(7, {
        pg8::Gemm g{F.CONCAT, F.WOUT, D}; pg8::StaticOrder So; So.init(T, D, F.G, F.bid, 1 + ((REPEAT_UNITS >> 7) & 1));
        pg8::EpiMix E{F.ADA, F.DX};
        pg8::gemm_phase<pg8::EpiMix, pg8::StaticOrder>(F.lds, g, So, E, F.tid);
    });
    PH(8, { r1_route(F); });
    PH(9, { r2_rows(F); });
    PH(10, {
        const int* ti = (const int*)F.ctl + CW_TINFO;
        pg8::Gemm g{F.H, F.W13, D}; pg8::MoeOrder<4, true> So{(const int*)F.ctl + CW_TILEB, F.ROWTOK, 0, ti[1], F.G, F.bid, 1 + ((REPEAT_UNITS >> 10) & 1)};
        pg8::EpiAct E{F.ACT};
        pg8::gemm_phase<pg8::EpiAct, pg8::MoeOrder<4, true>>(F.lds, g, So, E, F.tid);
    });
    PH(11, {
        const int* ti = (const int*)F.ctl + CW_TINFO;
        pg8::Gemm g{F.ACT, F.W2, 512}; pg8::MoeOrder<8, false> So{(const int*)F.ctl + CW_TILEB, F.ROWTOK, 0, ti[0], F.G, F.bid, 1};
        pg8::EpiMoeY0 E{F.ROWTOK, F.ROWW, F.ADA, F.Y0};
        pg8::gemm_phase<pg8::EpiMoeY0, pg8::MoeOrder<8, false>>(F.lds, g, So, E, F.tid);
    });
    PH(12, {
        const int* ti = (const int*)F.ctl + CW_TINFO;
        pg8::Gemm g{F.ACT, F.W2, 512}; pg8::MoeOrder<8, false> So{(const int*)F.ctl + CW_TILEB, F.ROWTOK, ti[0], ti[1], F.G, F.bid, 1};
        pg8::EpiMoeOut E{F.ROWTOK, F.ROWW, F.ADA, F.Y0, F.DX, F.x, F.out};
        pg8::gemm_phase<pg8::EpiMoeOut, pg8::MoeOrder<8, false>>(F.lds, g, So, E, F.tid);
    });
#undef PH
#if SELFCHECK
    if (IN(12)) {
        xcd_barrier(bar);
        if (F.bid == 0 && F.tid == 0) {
            float code = 0.f;
            for (int k = 0; k < 4; ++k) if (__hip_atomic_load(F.ctl + CW_CHK + k, __ATOMIC_RELAXED, __HIP_MEMORY_SCOPE_AGENT) != 0u) code += (float)(1 << k);
            if (code != 0.f) F.out[0] += 1.0e4f * code;
        }
    }
#endif
#undef IN
#undef SEAM
}

extern "C" void kernel_launch(void* const* d_in, const int* in_sizes, int n_in, void* d_out, int out_size, void* d_ws, size_t ws_size, hipStream_t stream) {
    static int grid = 0;
    if (grid == 0) {
        if (n_in != 17 || out_size != T * D || ws_size < WS_END) { fprintf(stderr, "kernel_launch: unexpected problem (n_in %d out %d ws %zu)\n", n_in, out_size, ws_size); grid = -1; return; }
        int dev = 0, cus = 0, per_cu = 0;
        if (hipGetDevice(&dev) != hipSuccess || hipDeviceGetAttribute(&cus, hipDeviceAttributeMultiprocessorCount, dev) != hipSuccess) { grid = -1; return; }
        if (hipFuncSetAttribute((const void*)mk_fwd, hipFuncAttributeMaxDynamicSharedMemorySize, LDS_BYTES) != hipSuccess) { fprintf(stderr, "kernel_launch: hipFuncSetAttribute failed\n"); grid = -1; return; }
        if (hipOccupancyMaxActiveBlocksPerMultiprocessor(&per_cu, (const void*)mk_fwd, NTHREADS, LDS_BYTES) != hipSuccess || per_cu < 1) { fprintf(stderr, "kernel_launch: occupancy query says %d\n", per_cu); }
        (void)hipGetLastError();
        grid = cus;
        if (grid != 256) { fprintf(stderr, "kernel_launch: built for 256 CUs, found %d\n", cus); grid = -1; return; }
    }
    if (grid < 0) return;
    (void)hipMemsetAsync((char*)d_ws + WS_CTL, 0, WS_ADA - WS_CTL, stream);
    (void)hipMemsetAsync((char*)d_ws + WS_ROWTOK, 0xFF, (size_t)MAXROWS * 4, stream);
    Args a{};
    for (int i = 0; i < 17; ++i) a.in[i] = (const float*)d_in[i];
    a.out = (float*)d_out; a.ws = (unsigned char*)d_ws;
#if MK_MULTI
    for (int p = 0; p < N_PHASES; ++p) { a.ph_lo = p; a.ph_hi = p + 1; hipLaunchKernelGGL(mk_fwd, dim3(grid), dim3(NTHREADS), LDS_BYTES, stream, a); }
#else
    a.ph_lo = 0; a.ph_hi = N_PHASES; hipLaunchKernelGGL(mk_fwd, dim3(grid), dim3(NTHREADS), LDS_BYTES, stream, a);
#endif
}
```

```cpp
#include <hip/hip_runtime.h>
#include <cstdio>
#include <cstdint>
#include <cstddef>

#ifndef MK_MULTI
#define MK_MULTI 0
#endif

#ifndef P5_PROBE
#define P5_PROBE 0
#endif
#ifndef P1_PROBE
#define P1_PROBE 0
#endif
#ifndef ATT_PROBE
#define ATT_PROBE 0
#endif
#ifndef SEL_PROBE
#define SEL_PROBE 0
#endif
#ifndef EPI_PROBE
#define EPI_PROBE 0
#endif
#ifndef SELFCHECK
#define SELFCHECK 0
#endif
#ifndef REPEAT_UNITS
#define REPEAT_UNITS 0
#endif
#ifndef REPEAT_MASK
#define REPEAT_MASK 0
#endif
#define LAS __attribute__((address_space(3)))
typedef unsigned short bf16_t;
typedef short bf16x8 __attribute__((ext_vector_type(8)));
typedef short s16x4 __attribute__((ext_vector_type(4)));
typedef float f32x4 __attribute__((ext_vector_type(4)));
typedef float f32x16 __attribute__((ext_vector_type(16)));
typedef unsigned u32x4 __attribute__((ext_vector_type(4)));
typedef unsigned u32x2 __attribute__((ext_vector_type(2)));
typedef __bf16 bf16v2 __attribute__((ext_vector_type(2)));
typedef _Float16 f16v2 __attribute__((ext_vector_type(2)));

constexpr int T = 32768, S = 8192, NB = 4, D = 2048;
constexpr int NPROJ = 3840;
constexpr int CQ = 0, CK = 1024, CV = 1280, CQI = 1536, CP = 2560, CKI = 3584, CWI = 3648;
constexpr int NTHREADS = 512;
constexpr int LDS_BYTES = 147456;
constexpr float NORM_EPS = 1e-6f;
constexpr size_t SC_BATCH = 34078720ull;
constexpr int MAXROWS = 81920;

constexpr size_t WS_CTL = 0;
constexpr size_t WS_ADA = 65536;
constexpr size_t WS_TAB = 262144;
constexpr size_t WS_WR = 1835008;
constexpr size_t WS_TOKE = 2031616;
constexpr size_t WS_TOKW = 2293760;
constexpr size_t WS_ROWTOK = 2555904;
constexpr size_t WS_ROWW = 2883584;
constexpr size_t WS_WI = 3211264;
constexpr size_t WS_KI = 5308416;
constexpr size_t WS_WPOOL = 9502720;
constexpr size_t WS_WOUT = 10027008;
constexpr size_t WS_WIN = 18415616;
constexpr size_t WS_W13 = 34144256;
constexpr size_t WS_W2 = 168361984;
constexpr size_t WS_H = 235470848;
constexpr size_t WS_X = 369688576;
constexpr size_t WS_QB = 642318336;
constexpr size_t WS_KV = 709427200;
constexpr size_t WS_QI = 742981632;
constexpr size_t WS_PM = 810090496;
constexpr size_t WS_SEL = 877199360;
constexpr size_t WS_ADAP = 893976576;
constexpr size_t WS_END = 900268032;
constexpr int CW_GCOUNT = 4096, CW_GCURSOR = 4160, CW_CHK = 4224, CW_TINFO = 4352, CW_TILEB = 4416;

__device__ __forceinline__ int fresh_lane() { int l; asm volatile("v_mbcnt_lo_u32_b32 %0, -1, 0\n\tv_mbcnt_hi_u32_b32 %0, -1, %0" : "=v"(l)); return l; }
__device__ __forceinline__ unsigned pk_bf16(float a, float b) { bf16v2 v; v.x = (__bf16)a; v.y = (__bf16)b; return __builtin_bit_cast(unsigned, v); }
__device__ __forceinline__ float bf_lo(unsigned u) { return __uint_as_float(u << 16); }
__device__ __forceinline__ float bf_hi(unsigned u) { return __uint_as_float(u & 0xffff0000u); }
__device__ __forceinline__ void unpack8(const u32x4 v, float* f) {
    f[0] = bf_lo(v.x); f[1] = bf_hi(v.x); f[2] = bf_lo(v.y); f[3] = bf_hi(v.y); f[4] = bf_lo(v.z); f[5] = bf_hi(v.z); f[6] = bf_lo(v.w); f[7] = bf_hi(v.w);
}
__device__ __forceinline__ u32x4 pack8(const float* f) { u32x4 v; v.x = pk_bf16(f[0], f[1]); v.y = pk_bf16(f[2], f[3]); v.z = pk_bf16(f[4], f[5]); v.w = pk_bf16(f[6], f[7]); return v; }
__device__ __forceinline__ float wave_sum(float v) {
#pragma unroll
    for (int d = 32; d >= 1; d >>= 1) v += __shfl_xor(v, d);
    return v;
}

#define XB_TMO      128
#define XB_XCNT(j)  (256  + 64 * (j))
#define XB_XSUB(j)  (1280 + 64 * (j))
#define XB_XGEN(j)  (2304 + 64 * (j))
#define XB_TOP      3328
#define XB_TOPGEN   3392
#define XCD_BAR_WORDS 3456
#define XB_SPIN_CAP (1u << 23)

__device__ __forceinline__ unsigned xb_ld(unsigned* p)              { return __hip_atomic_load(p, __ATOMIC_RELAXED, __HIP_MEMORY_SCOPE_AGENT); }
__device__ __forceinline__ unsigned xb_add(unsigned* p, unsigned v) { return __hip_atomic_fetch_add(p, v, __ATOMIC_RELAXED, __HIP_MEMORY_SCOPE_AGENT); }
__device__ __forceinline__ unsigned xb_xcc_id() { return (unsigned)__builtin_amdgcn_s_getreg((3 << 11) | 20) & 0xFu; }
#define XB_SPIN(cond, bar) do { unsigned _sp = 0; while (cond) { __builtin_amdgcn_s_sleep(1); \
    if ((++_sp & 255u) == 0u) { if (xb_ld(&(bar)[XB_TMO])) break; if (_sp > XB_SPIN_CAP) { atomicAdd(&(bar)[XB_TMO], 1u); break; } } } } while (0)

struct XcdBarrier { unsigned* bar; unsigned x; volatile LAS unsigned* st; int wave; };

__device__ __forceinline__ XcdBarrier xcd_barrier_post(unsigned* bar, volatile LAS unsigned* st, int wave) {
    XcdBarrier b; b.bar = bar; b.x = xb_xcc_id(); b.st = st; b.wave = wave;
    if (threadIdx.x == 0) (void)xb_add(&bar[XB_XCNT(b.x)], 1u);
    return b;
}
__device__ __forceinline__ void xcd_barrier_complete(unsigned* bar, unsigned x, unsigned& nloc, unsigned& nx) {
    const unsigned G = gridDim.x * gridDim.y * gridDim.z;
    unsigned sum, cnt, mine, sp = 0u;
    for (;;) {
        sum = 0u; cnt = 0u; mine = 0u;
#pragma unroll
        for (unsigned j = 0; j < 16; ++j) { const unsigned c = xb_ld(&bar[XB_XCNT(j)]); sum += c; cnt += (c > 0u) ? 1u : 0u; mine = (j == x) ? c : mine; }
        if (sum == G) break;
        __builtin_amdgcn_s_sleep(1);
        if ((++sp & 255u) == 0u) { if (xb_ld(&bar[XB_TMO])) break; if (sp > XB_SPIN_CAP) { atomicAdd(&bar[XB_TMO], 1u); break; } }
    }
    nloc = mine > 0u ? mine : 1u; nx = cnt > 0u ? cnt : 1u;
}
__device__ __forceinline__ void xcd_barrier(const XcdBarrier& b) {
    asm volatile("s_waitcnt vmcnt(0)" ::: "memory");
    __syncthreads();
    if (b.wave == 0 && fresh_lane() == 0) {
        unsigned* bar = b.bar;
        __builtin_amdgcn_s_waitcnt(0);
        unsigned nloc = b.st[0], nx = b.st[1];
        if (nloc == 0u) { xcd_barrier_complete(bar, b.x, nloc, nx); b.st[0] = nloc; b.st[1] = nx; }
        const unsigned old = xb_add(&bar[XB_XSUB(b.x)], 1u);
        const unsigned gen = old / nloc;
        if (old + 1u == (gen + 1u) * nloc) {
            __builtin_amdgcn_fence(__ATOMIC_RELEASE, "agent");
            asm volatile("s_waitcnt vmcnt(0)" ::: "memory");
            const unsigned og = xb_add(&bar[XB_TOP], 1u);
            const unsigned tg = og / nx;
            if (og + 1u == (tg + 1u) * nx) xb_add(&bar[XB_TOPGEN], 1u);
            else XB_SPIN(xb_ld(&bar[XB_TOPGEN]) == tg, bar);
            __builtin_amdgcn_fence(__ATOMIC_ACQUIRE, "agent");
            xb_add(&bar[XB_XGEN(b.x)], 1u);
            asm volatile("s_waitcnt vmcnt(0)" ::: "memory");
        } else {
            XB_SPIN(xb_ld(&bar[XB_XGEN(b.x)]) == gen, bar);
            __builtin_amdgcn_fence(__ATOMIC_ACQUIRE, "agent");
            asm volatile("s_waitcnt vmcnt(0)" ::: "memory");
        }
    }
    __syncthreads();
}

struct Frame {
    LAS unsigned char* lds;
    int tid, lane, wave, G, bid;
    const float *x, *c, *w_ada, *b_ada, *norm1_g, *w_in, *q_norm_g, *k_norm_g, *w_pool, *pool_scale, *w_out, *norm2_g, *w_grp, *w_exp, *w1, *w3, *w2;
    float* out;
    unsigned* ctl;
    float* ADA; float* ADAP; float* TAB; bf16_t* WR; int* TOKE; float* TOKW; int* ROWTOK; float* ROWW; float* WI; bf16_t* KI;
    bf16_t *WPOOL, *WOUT, *WIN, *W13, *W2, *H, *PROJ; unsigned short* SC; bf16_t *QB, *KV, *QI, *PM, *ACT, *CONCAT; unsigned short* SEL;
    bf16_t *Y0, *DX;
};

namespace pg8 {
constexpr int BM = 256, BK = 64, HALF = 128, HTB = HALF * BK * 2, STAGE_BYTES = 8 * HTB, NXCD = 8, WGM = 8;
__device__ __forceinline__ int lds_byte(int r, int c) { const int st = (r >> 4) * 2 + (c >> 5), rr = r & 15, cc = c & 31, ob = rr * 64 + cc * 2; return st * 1024 + (ob ^ (((ob >> 9) & 1) << 5)); }
__device__ __forceinline__ void stage_rc(int b, int& R, int& C) { const int st = b / 1024, sb = b % 1024, swz = sb ^ (((sb >> 9) & 1) << 5); R = (st >> 1) * 16 + swz / 64; C = (st & 1) * 32 + (swz % 64) / 2; }
__device__ __forceinline__ int perm32(int rho) { const int n = rho >> 4, i = rho & 15; return 8 * (i >> 2) + 4 * n + (i & 3); }
struct Unit { int pm, pn, rep; };
struct Gemm { const bf16_t* A; const bf16_t* Bt; int K; };

struct StaticOrder {
    int nM, nN, nwg, G, c, rep;
    __device__ void init(int M, int N, int G_, int c_, int rep_ = 1) { nM = M / BM; nN = N / BM; nwg = nM * nN; G = G_; c = c_; rep = rep_; }
    __device__ bool next(int i, Unit& u) const {
        long L = (long)i * G + c; if (L >= (long)nwg * rep) return false;
        u.rep = 0; if (L >= nwg) { L -= nwg; u.rep = 1; }
        int wgid = (int)L; { const int q = nwg / NXCD, r = nwg % NXCD, xcd = wgid % NXCD, off = wgid / NXCD; wgid = (xcd < r ? xcd * (q + 1) : r * (q + 1) + (xcd - r) * q) + off; }
        const int nig = WGM * nN, gid = wgid / nig, fm = gid * WGM, gsz = (nM - fm) < WGM ? (nM - fm) : WGM;
        u.pm = fm + ((wgid % nig) % gsz); u.pn = (wgid % nig) / gsz; return true;
    }
    __device__ __forceinline__ unsigned arow(const Unit& u, int rr) const { return (unsigned)(u.pm * BM + rr); }
};
struct PoolOrder {
    int G, c;
    __device__ bool next(int i, Unit& u) const { const int L = i * G + c; if (L >= 512) return false; u.pm = L; u.pn = L >> 7; u.rep = 0; return true; }
    __device__ __forceinline__ unsigned arow(const Unit& u, int rr) const { return (unsigned)(u.pm * BM + rr); }
};
template <int NC, bool GATHER> struct MoeOrder {
    const int* tileb; const int* rowtok; int lo, hi, G, c, rep;
    __device__ bool next(int i, Unit& u) const {
        int L = i * G + c; if (L >= (hi - lo) * NC * rep) return false;
        if (L >= (hi - lo) * NC) L -= (hi - lo) * NC;
        u.pm = lo + L / NC; const int e = tileb[u.pm] & 31; u.pn = e * NC + (L % NC); u.rep = 0; return true;
    }
    __device__ __forceinline__ unsigned arow(const Unit& u, int rr) const {
        if (GATHER) { const int tok = rowtok[u.pm * BM + rr]; return (unsigned)(tok < 0 ? 0 : tok); }
        return (unsigned)(u.pm * BM + rr);
    }
};

template <class Epi, class Sched>
__device__ __forceinline__ void gemm_phase(LAS unsigned char* lds, const Gemm g, const Sched& S, const Epi& E, const int tid) {
    const int wid = __builtin_amdgcn_readfirstlane(tid >> 6), lane = tid & 63, wr = wid >> 2, wc = wid & 3, fr = lane & 15, fq = lane >> 4;
    const int K = g.K, nt = K / BK;
    int R0, C0; stage_rc(tid * 16, R0, C0);
    unsigned voffB[2];
#pragma unroll
    for (int i = 0; i < 2; ++i) { const int R = R0 + 64 * i; const int Rb = Epi::PERM ? ((R & ~31) + perm32(R & 31)) : R; voffB[i] = (unsigned)(Rb * K + C0) * 2u; }
    const unsigned rowb = (unsigned)K * 2u, colb = (unsigned)C0 * 2u;
    const size_t kstep = (size_t)(BK * 2);
    const size_t hstep = (size_t)HALF * K * 2;
    const size_t tstep = 2 * hstep;
    const unsigned ldsw = (unsigned)wid * 1024u;
    const int aoff = lds_byte(wr * 64 + fr, fq * 8), boff = lds_byte(wc * 32 + fr, fq * 8);
#define PG8_SA(b, h) (((b) * 2 + (h)) * HTB)
#define PG8_SB(b, h) ((4 + (b) * 2 + (h)) * HTB)
#define PG8_STAGE(bufoff, gbase, voff) do { _Pragma("unroll") for (int _i = 0; _i < 2; ++_i) \
        __builtin_amdgcn_global_load_lds((const unsigned*)((const char*)(gbase) + (voff)[_i]), (LAS unsigned*)(lds + (bufoff) + ldsw + _i * 8192), 16, 0, 0); } while (0)
#define PG8_LDA(dst, b, h) do { _Pragma("unroll") for (int m = 0; m < 4; ++m) _Pragma("unroll") for (int k = 0; k < 2; ++k) dst[m][k] = *(const LAS bf16x8*)(lds + PG8_SA(b, h) + aoff + m * 2048 + k * 1024); } while (0)
#define PG8_LDB(dst, b, h) do { _Pragma("unroll") for (int n = 0; n < 2; ++n) _Pragma("unroll") for (int k = 0; k < 2; ++k) dst[n][k] = *(const LAS bf16x8*)(lds + PG8_SB(b, h) + boff + n * 2048 + k * 1024); } while (0)
#define PG8_MMA(ai, bj, At, Bt) do { __builtin_amdgcn_s_setprio(1); _Pragma("unroll") for (int m = 0; m < 4; ++m) _Pragma("unroll") for (int n = 0; n < 2; ++n) _Pragma("unroll") for (int k = 0; k < 2; ++k) \
        acc[ai][bj][m][n] = __builtin_amdgcn_mfma_f32_16x16x32_bf16(Bt[n][k], At[m][k], acc[ai][bj][m][n], 0, 0, 0); __builtin_amdgcn_s_setprio(0); } while (0)
#define PG8_WAIT_V(n) asm volatile("s_waitcnt vmcnt(" #n ")" ::: "memory")
#define PG8_WAIT_L(n) asm volatile("s_waitcnt lgkmcnt(" #n ")" ::: "memory")
#define PG8_BAR __builtin_amdgcn_s_barrier()
#define PG8_SCHED __builtin_amdgcn_sched_barrier(0)
#define PG8_ROWS(dst, u) do { _Pragma("unroll") for (int _h = 0; _h < 2; ++_h) _Pragma("unroll") for (int _i = 0; _i < 2; ++_i) dst[_h][_i] = S.arow(u, _h * HALF + R0 + 64 * _i) * rowb + colb; } while (0)
    Unit cur, nxt; int ui = 0;
    if (!S.next(0, cur)) return;
    f32x4 acc[2][2][4][2];
#pragma unroll
    for (int a = 0; a < 2; ++a)
#pragma unroll
        for (int b = 0; b < 2; ++b)
#pragma unroll
            for (int m = 0; m < 4; ++m)
#pragma unroll
                for (int n = 0; n < 2; ++n) acc[a][b][m][n] = (f32x4){0.f, 0.f, 0.f, 0.f};
    bf16x8 At[4][2], B0[2][2], B1[2][2];
    unsigned oc[2][2], on[2][2];
    PG8_ROWS(oc, cur);
    const char* gA = (const char*)g.A;
    const char* cB = (const char*)g.Bt + (size_t)cur.pn * tstep;
    PG8_STAGE(PG8_SB(0, 0), cB, voffB); PG8_STAGE(PG8_SA(0, 0), gA, oc[0]); PG8_STAGE(PG8_SB(0, 1), cB + hstep, voffB); PG8_STAGE(PG8_SA(0, 1), gA, oc[1]);
    if (wr == 1) PG8_BAR;
    PG8_WAIT_V(4); PG8_BAR;
    PG8_STAGE(PG8_SB(1, 0), cB + kstep, voffB); PG8_STAGE(PG8_SA(1, 0), gA + kstep, oc[0]); PG8_STAGE(PG8_SB(1, 1), cB + hstep + kstep, voffB);
    PG8_WAIT_V(6); PG8_BAR;
    const int tpre = nt >= 4 ? nt - 4 : nt - 2;
    for (;;) {
        const bool has_next = S.next(ui + 1, nxt);
#pragma unroll
        for (int h = 0; h < 2; ++h)
#pragma unroll
            for (int i = 0; i < 2; ++i) on[h][i] = oc[h][i];
        const char* nB = has_next ? (const char*)g.Bt + (size_t)nxt.pn * tstep : cB;
        for (int t = 0; t < nt; t += 2) {
            const bool last = (t == nt - 2);
            if (has_next && t == tpre) PG8_ROWS(on, nxt);
            const char* a1 = gA + (size_t)(t + 1) * kstep;
            const char* a2 = last ? gA : gA + (size_t)(t + 2) * kstep; const char* b2 = last ? nB : cB + (size_t)(t + 2) * kstep;
            const char* a3 = a2 + kstep; const char* b3 = b2 + kstep;
            unsigned o2[2][2];
#pragma unroll
            for (int h = 0; h < 2; ++h)
#pragma unroll
                for (int i = 0; i < 2; ++i) o2[h][i] = last ? on[h][i] : oc[h][i];
            PG8_LDB(B0, 0, 0); PG8_SCHED; PG8_LDA(At, 0, 0); PG8_STAGE(PG8_SA(1, 1), a1, oc[1]);
            PG8_WAIT_L(8); PG8_BAR; PG8_WAIT_L(0); PG8_MMA(0, 0, At, B0); PG8_BAR; PG8_SCHED;
            PG8_LDB(B1, 0, 1); PG8_STAGE(PG8_SB(0, 0), b2, voffB);
            PG8_BAR; PG8_WAIT_L(0); PG8_MMA(0, 1, At, B1); PG8_BAR;
            PG8_LDA(At, 0, 1); PG8_STAGE(PG8_SA(0, 0), a2, o2[0]);
            PG8_BAR; PG8_WAIT_L(0); PG8_MMA(1, 0, At, B0); PG8_BAR; PG8_SCHED;
            PG8_STAGE(PG8_SB(0, 1), b2 + hstep, voffB);
            PG8_WAIT_V(6); PG8_BAR; PG8_MMA(1, 1, At, B1); PG8_BAR;
            PG8_LDB(B0, 1, 0); PG8_SCHED; PG8_LDA(At, 1, 0); PG8_STAGE(PG8_SA(0, 1), a2, o2[1]);
            PG8_WAIT_L(8); PG8_BAR; PG8_WAIT_L(0); PG8_MMA(0, 0, At, B0); PG8_BAR; PG8_SCHED;
            PG8_LDB(B1, 1, 1); PG8_STAGE(PG8_SB(1, 0), b3, voffB);
            PG8_BAR; PG8_WAIT_L(0); PG8_MMA(0, 1, At, B1); PG8_BAR;
            PG8_LDA(At, 1, 1); PG8_STAGE(PG8_SA(1, 0), a3, o2[0]);
            PG8_BAR; PG8_WAIT_L(0); PG8_MMA(1, 0, At, B0); PG8_BAR; PG8_SCHED;
            PG8_STAGE(PG8_SB(1, 1), b3 + hstep, voffB);
            PG8_WAIT_V(6); PG8_BAR; PG8_MMA(1, 1, At, B1); PG8_BAR;
        }
        E(acc, cur, wr, wc, fr, fq);
        if (!has_next) break;
#pragma unroll
        for (int a = 0; a < 2; ++a)
#pragma unroll
            for (int b = 0; b < 2; ++b)
#pragma unroll
                for (int m = 0; m < 4; ++m)
#pragma unroll
                    for (int n = 0; n < 2; ++n) acc[a][b][m][n] = (f32x4){0.f, 0.f, 0.f, 0.f};
        cur = nxt; cB = nB; ++ui;
#pragma unroll
        for (int h = 0; h < 2; ++h)
#pragma unroll
            for (int i = 0; i < 2; ++i) oc[h][i] = on[h][i];
    }
    PG8_WAIT_V(0);
    if (wr == 0) PG8_BAR;
    PG8_BAR;
#undef PG8_SA
#undef PG8_SB
#undef PG8_STAGE
#undef PG8_LDA
#undef PG8_LDB
#undef PG8_MMA
#undef PG8_WAIT_V
#undef PG8_WAIT_L
#undef PG8_BAR
#undef PG8_SCHED
#undef PG8_ROWS
}

struct EpiBf16 {
    static constexpr bool PERM = true;
    bf16_t* O; int ldc; int mode;
    __device__ __forceinline__ void operator()(const f32x4 (&acc)[2][2][4][2], const Unit& u, int wr, int wc, int fr, int fq) const {
        const int rowb = (mode == 1 ? (u.pm & 127) : u.pm) * BM, colb = (mode == 1 ? 1024 : 0) + u.pn * BM;
        const int row0 = rowb + wr * 64 + fr, col0 = colb + wc * 32 + 8 * fq;
#pragma unroll
        for (int ai = 0; ai < 2; ++ai)
#pragma unroll
            for (int m = 0; m < 4; ++m) { bf16_t* rowp = O + (size_t)(row0 + ai * HALF + m * 16) * ldc + col0;
#pragma unroll
                for (int bj = 0; bj < 2; ++bj) { const f32x4 v0 = acc[ai][bj][m][0], v1 = acc[ai][bj][m][1];
                    u32x4 w; w.x = pk_bf16(v0[0], v0[1]); w.y = pk_bf16(v0[2], v0[3]); w.z = pk_bf16(v1[0], v1[1]); w.w = pk_bf16(v1[2], v1[3]);
                    if (!(EPI_PROBE && u.rep) || (w.x ^ w.w) == 0x12345678u) *(u32x4*)(rowp + bj * HALF) = w; } }
    }
};
struct EpiMix {
    static constexpr bool PERM = true;
    const float* ada; bf16_t* DX;
    __device__ __forceinline__ void operator()(const f32x4 (&acc)[2][2][4][2], const Unit& u, int wr, int wc, int fr, int fq) const {
        const int row0 = u.pm * BM + wr * 64 + fr, col0 = u.pn * BM + wc * 32 + 8 * fq;
        const float* gate = ada + (size_t)(u.pm >> 5) * 12288 + 2 * 2048 + col0;
        f32x4 gv[2][2];
#pragma unroll
        for (int bj = 0; bj < 2; ++bj)
#pragma unroll
            for (int n = 0; n < 2; ++n) gv[bj][n] = *(const f32x4*)(gate + bj * HALF + 4 * n);
#pragma unroll
        for (int ai = 0; ai < 2; ++ai)
#pragma unroll
            for (int m = 0; m < 4; ++m) { bf16_t* rowp = DX + (size_t)(row0 + ai * HALF + m * 16) * D + col0;
#pragma unroll
                for (int bj = 0; bj < 2; ++bj) { const f32x4 v0 = gv[bj][0] * acc[ai][bj][m][0], v1 = gv[bj][1] * acc[ai][bj][m][1];
                    u32x4 w; w.x = pk_bf16(v0[0], v0[1]); w.y = pk_bf16(v0[2], v0[3]); w.z = pk_bf16(v1[0], v1[1]); w.w = pk_bf16(v1[2], v1[3]);
                    *(u32x4*)(rowp + bj * HALF) = w; } }
    }
};
struct EpiAct {
    static constexpr bool PERM = true;
    bf16_t* ACT;
    __device__ __forceinline__ void operator()(const f32x4 (&acc)[2][2][4][2], const Unit& u, int wr, int wc, int fr, int fq) const {
        const int row0 = u.pm * BM + wr * 64 + fr, col0 = (u.pn & 3) * 128 + wc * 32 + 8 * fq;
#pragma unroll
        for (int ai = 0; ai < 2; ++ai)
#pragma unroll
            for (int m = 0; m < 4; ++m) {
                float v[8];
#pragma unroll
                for (int n = 0; n < 2; ++n)
#pragma unroll
                    for (int e = 0; e < 4; ++e) { const float a = acc[ai][0][m][n][e], b = acc[ai][1][m][n][e]; v[n * 4 + e] = a / (1.0f + __expf(-a)) * b; }
                *(u32x4*)(ACT + (size_t)(row0 + ai * HALF + m * 16) * 512 + col0) = pack8(v);
            }
    }
};
struct EpiMoeY0 {
    static constexpr bool PERM = true;
    const int* rowtok; const float* roww; const float* ada; bf16_t* Y0;
    __device__ __forceinline__ void operator()(const f32x4 (&acc)[2][2][4][2], const Unit& u, int wr, int wc, int fr, int fq) const {
        const int row0 = u.pm * BM + wr * 64 + fr, col0 = (u.pn & 7) * BM + wc * 32 + 8 * fq;
        int tk[8]; float wt[8];
#pragma unroll
        for (int r = 0; r < 8; ++r) { const int row = row0 + (r >> 2) * HALF + (r & 3) * 16; tk[r] = rowtok[row]; wt[r] = roww[row]; }
#pragma unroll
        for (int r = 0; r < 8; ++r) { const int ai = r >> 2, m = r & 3; const int tok = tk[r] < 0 ? 0 : tk[r]; const float w = tk[r] < 0 ? 0.f : wt[r];
            const float* gate = ada + (size_t)(tok >> 13) * 12288 + 5 * 2048 + col0; bf16_t* yp = Y0 + (size_t)tok * D + col0;
            u32x4 o[2];
#pragma unroll
            for (int bj = 0; bj < 2; ++bj) { const f32x4 g0 = *(const f32x4*)(gate + bj * HALF), g1 = *(const f32x4*)(gate + bj * HALF + 4);
                const f32x4 v0 = g0 * w * acc[ai][bj][m][0], v1 = g1 * w * acc[ai][bj][m][1];
                o[bj].x = pk_bf16(v0[0], v0[1]); o[bj].y = pk_bf16(v0[2], v0[3]); o[bj].z = pk_bf16(v1[0], v1[1]); o[bj].w = pk_bf16(v1[2], v1[3]); }
            if (tk[r] >= 0) { *(u32x4*)yp = o[0]; *(u32x4*)(yp + HALF) = o[1]; } }
    }
};
struct EpiMoeOut {
    static constexpr bool PERM = false;
    const int* rowtok; const float* roww; const float* ada; const bf16_t* Y0; const bf16_t* DX; const float* x; float* out;
    __device__ __forceinline__ void operator()(const f32x4 (&acc)[2][2][4][2], const Unit& u, int wr, int wc, int fr, int fq) const {
        const int row0 = u.pm * BM + wr * 64 + fr, col0 = (u.pn & 7) * BM + wc * 32 + 4 * fq;
        int tk[8]; float wt[8];
#pragma unroll
        for (int r = 0; r < 8; ++r) { const int row = row0 + (r >> 2) * HALF + (r & 3) * 16; tk[r] = rowtok[row]; wt[r] = roww[row]; }
#pragma unroll
        for (int r = 0; r < 8; ++r) { const int ai = r >> 2, m = r & 3; const int tok = tk[r] < 0 ? 0 : tk[r]; const float w = wt[r];
            const float* gate = ada + (size_t)(tok >> 13) * 12288 + 5 * 2048 + col0; float* op = out + (size_t)tok * D + col0; const float* xp = x + (size_t)tok * D + col0;
            const bf16_t* yp = Y0 + (size_t)tok * D + col0; const bf16_t* dp = DX + (size_t)tok * D + col0;
            f32x4 gvv[4], xv[4]; u32x2 yv[4], dv[4];
#pragma unroll
            for (int q = 0; q < 4; ++q) { const int off = (q >> 1) * HALF + (q & 1) * 16; gvv[q] = *(const f32x4*)(gate + off); xv[q] = *(const f32x4*)(xp + off); yv[q] = *(const u32x2*)(yp + off); dv[q] = *(const u32x2*)(dp + off); }
            if (tk[r] >= 0) {
#pragma unroll
                for (int q = 0; q < 4; ++q) { const int off = (q >> 1) * HALF + (q & 1) * 16; f32x4 o = xv[q];
                    o += (f32x4){bf_lo(dv[q].x), bf_hi(dv[q].x), bf_lo(dv[q].y), bf_hi(dv[q].y)}; o += (f32x4){bf_lo(yv[q].x), bf_hi(yv[q].x), bf_lo(yv[q].y), bf_hi(yv[q].y)} + gvv[q] * w * acc[ai][q >> 1][m][q & 1];
                    *(f32x4*)(op + off) = o; } } }
    }
};
}

__device__ __forceinline__ int colmap(int n) { return n < 2560 ? n : (n < 2624 ? 3584 + (n - 2560) : (n < 2640 ? 3648 + (n - 2624) : 2560 + (n - 2640))); }

template <class RowMap>
__device__ __forceinline__ void tr_tile(const Frame& F, const float* src, size_t ldS, int k0, int n0, int N, const float* cscale, RowMap rm) {
    LAS float* tile = (LAS float*)F.lds;
    const int tid = F.tid, r = tid >> 4, c4 = tid & 15;
    f32x4 v[4];
    const int n = n0 + c4 * 4;
#pragma unroll
    for (int i = 0; i < 4; ++i) v[i] = (n < N) ? *(const f32x4*)(src + (size_t)(k0 + r + 32 * i) * ldS + n) : (f32x4){0.f, 0.f, 0.f, 0.f};
    __syncthreads();
#pragma unroll
    for (int i = 0; i < 4; ++i)
#pragma unroll
        for (int e = 0; e < 4; ++e) tile[(r + 32 * i) * 65 + c4 * 4 + e] = v[i][e];
    __syncthreads();
    const int nn = tid >> 3, kc = tid & 7;
    if (n0 + nn < N) {
        const float sc = cscale ? cscale[n0 + nn] : 1.0f;
        float f[16];
#pragma unroll
        for (int j = 0; j < 16; ++j) f[j] = tile[(kc * 16 + j) * 65 + nn] * sc;
        bf16_t* d = rm(n0 + nn) + k0 + kc * 16;
        *(u32x4*)d = pack8(f); *(u32x4*)(d + 8) = pack8(f + 8);
    }
}

__device__ __forceinline__ void p0_prologue(const Frame& F) {
    constexpr int U_ADA = 192, T_WIN = 16 * 58, T_WOUT = 16 * 32, T_POOL = 4 * 2 * 4, T_W1 = 32 * 128, T_W2 = 32 * 128, U_TAB = 16, U_WR = 4, U_PAD = 2;
    constexpr int B0 = U_ADA, B1 = B0 + T_WIN, B2 = B1 + T_WOUT, B3 = B2 + T_POOL, B4 = B3 + T_W1, B5 = B4 + T_W1, B6 = B5 + T_W2, B7 = B6 + U_TAB, B8 = B7 + U_WR, B9 = B8 + U_PAD;
    const int tid = F.tid;
    constexpr int NTILE = B6 - B0;
    static_assert(NTILE == 13760, "tile split");
    const int nmine = 1 + 50 + (F.bid >= 192 ? 15 : 0);
    for (int it = 0; it < nmine; ++it) {
        int u;
        if (it == 0) { u = F.bid < 192 ? F.bid : (F.bid - 192 < 22 ? B6 + (F.bid - 192) : -1); if (u < 0) continue; }
        else if (it <= 50) u = B0 + F.bid + 256 * (it - 1);
        else u = B0 + 12800 + (F.bid - 192) + 64 * (it - 51);
        if (u < B0) {
            const int kc = u / 6, cb = u % 6;
            LAS float* sc = (LAS float*)F.lds;
            __syncthreads();
            if (tid < 256) { const int b = tid >> 6, k = tid & 63; const float cv = F.c[b * D + kc * 64 + k]; sc[tid] = cv / (1.0f + __expf(-cv)); }
            __syncthreads();
            const int n = cb * 2048 + tid * 4;
            f32x4 a[4];
#pragma unroll
            for (int b = 0; b < 4; ++b) a[b] = (f32x4){0.f, 0.f, 0.f, 0.f};
            const float* wp = F.w_ada + (size_t)(kc * 64) * 12288 + n;
#pragma unroll 8
            for (int k = 0; k < 64; ++k) { const f32x4 w = *(const f32x4*)(wp + (size_t)k * 12288);
#pragma unroll
                for (int b = 0; b < 4; ++b) a[b] += sc[b * 64 + k] * w; }
            const f32x4 bias = (kc == 0) ? *(const f32x4*)(F.b_ada + n) : (f32x4){0.f, 0.f, 0.f, 0.f};
#pragma unroll
            for (int b = 0; b < 4; ++b) *(f32x4*)(F.ADAP + ((size_t)kc * 4 + b) * 12288 + n) = a[b] + bias;
        } else if (u < B1) {
            const int v = u - B0, kt = v / 58, ntl = v % 58; bf16_t* W = F.WIN;
            tr_tile(F, F.w_in, 3664, kt * 128, ntl * 64, 3664, nullptr, [=](int n) { return W + (size_t)colmap(n) * 2048; });
        } else if (u < B2) {
            const int v = u - B1, kt = v / 32, ntl = v % 32; bf16_t* W = F.WOUT;
            tr_tile(F, F.w_out, 2048, kt * 128, ntl * 64, 2048, nullptr, [=](int n) { return W + (size_t)n * 2048; });
        } else if (u < B3) {
            const int v = u - B2, g = v / 8, kt = (v % 8) / 4, ntl = v % 4; bf16_t* W = F.WPOOL + (size_t)g * 256 * 256;
            tr_tile(F, F.w_pool + (size_t)g * 65536, 256, kt * 128, ntl * 64, 256, F.pool_scale + g * 256, [=](int n) { return W + (size_t)n * 256; });
        } else if (u < B5) {
            const bool is3 = u >= B4; const int v = u - (is3 ? B4 : B3), e = v / 128, kt = (v % 128) / 8, ntl = v % 8;
            bf16_t* W = F.W13 + (size_t)e * 1024 * 2048 + (is3 ? (size_t)128 * 2048 : 0);
            tr_tile(F, (is3 ? F.w3 : F.w1) + (size_t)e * 2048 * 512, 512, kt * 128, ntl * 64, 512, nullptr, [=](int n) { return W + (size_t)((n >> 7) * 256 + (n & 127)) * 2048; });
        } else if (u < B6) {
            const int v = u - B5, e = v / 128, kt = (v % 128) / 32, ntl = v % 32; bf16_t* W = F.W2 + (size_t)e * 2048 * 512;
            tr_tile(F, F.w2 + (size_t)e * 512 * 2048, 2048, kt * 128, ntl * 64, 2048, nullptr, [=](int n) { return W + (size_t)n * 512; });
        } else if (u < B7) {
            const int pos = (u - B6) * 512 + tid; float* tp = F.TAB + (size_t)pos * 48;
            for (int i = 0; i < 16; ++i) { const double inv = pow(500000.0, -(double)(2 * i) / 32.0); double sn, cs; sincos((double)pos * inv, &sn, &cs); tp[i] = (float)cs; tp[16 + i] = (float)sn; }
            for (int i = 0; i < 8; ++i) { const double inv = pow(500000.0, -(double)(2 * i) / 16.0); double sn, cs; sincos((double)pos * inv, &sn, &cs); tp[32 + i] = (float)cs; tp[40 + i] = (float)sn; }
        } else if (u < B8) {
            const int j0 = (u - B7) * 12;
            for (int idx = tid; idx < 12 * 2048; idx += NTHREADS) { const int j = j0 + idx / 2048, k = idx % 2048;
                const float v = j < 4 ? F.w_grp[k * 4 + j] : (j < 36 ? F.w_exp[k * 32 + (j - 4)] : 0.f);
                bf16v2 t; t.x = (__bf16)v; t.y = (__bf16)0.f; F.WR[(size_t)j * 2048 + k] = (bf16_t)(__builtin_bit_cast(unsigned, t) & 0xffffu); }
        } else {
            const int h = u - B8; u32x4* p = (u32x4*)(F.WIN + (size_t)3664 * 2048) + (size_t)h * 22528;
            for (int i = tid; i < 22528; i += NTHREADS) p[i] = (u32x4){0u, 0u, 0u, 0u};
        }
    }
}

__device__ __forceinline__ size_t qi_off(size_t t, int head, int d) { return (t >> 1) * 2048 + (size_t)((d >> 4) * 512 + (((head & 3) + 4 * (int)(t & 1) + 8 * (head >> 2)) + 32 * ((d >> 3) & 1)) * 8 + (d & 7)); }
__device__ __forceinline__ size_t ki_off(size_t s, int d) { const int kin = (int)(s & 127); return (s >> 7) * 8192 + (size_t)(((kin & 3) * 4 + (d >> 4)) * 512 + ((kin >> 2) + 32 * ((d >> 3) & 1)) * 8 + (d & 7)); }

__device__ __forceinline__ void norm_rows(const Frame& F, const float* src, const bf16_t* delta, const float* gain, const float* shiftp, const float* scalep) {
    const int lane = F.lane;
    f32x4 Gv[8], Sv[8];
#pragma unroll
    for (int i = 0; i < 8; ++i) { const int col = 4 * lane + 256 * i; const f32x4 g = *(const f32x4*)(gain + col), sc = *(const f32x4*)(scalep + col);
        Gv[i] = g * (1.0f + sc); Sv[i] = *(const f32x4*)(shiftp + col); }
    f32x4 v[8], vn[8]; u32x2 dv[8], dn[8];
    { const size_t ro = (size_t)(F.bid * 128 + F.wave) * D;
#pragma unroll
      for (int i = 0; i < 8; ++i) { v[i] = *(const f32x4*)(src + ro + 4 * lane + 256 * i); if (delta) dv[i] = *(const u32x2*)(delta + ro + 4 * lane + 256 * i); } }
    for (int j = 0; j < 16; ++j) {
        const int t = F.bid * 128 + F.wave + 8 * j;
        if (j < 15) { const size_t ro = (size_t)(t + 8) * D;
#pragma unroll
            for (int i = 0; i < 8; ++i) { vn[i] = *(const f32x4*)(src + ro + 4 * lane + 256 * i); if (delta) dn[i] = *(const u32x2*)(delta + ro + 4 * lane + 256 * i); } }
        if (delta) {
#pragma unroll
            for (int i = 0; i < 8; ++i) v[i] += (f32x4){bf_lo(dv[i].x), bf_hi(dv[i].x), bf_lo(dv[i].y), bf_hi(dv[i].y)}; }
        float ss = 0.f;
#pragma unroll
        for (int i = 0; i < 8; ++i) ss += v[i][0] * v[i][0] + v[i][1] * v[i][1] + v[i][2] * v[i][2] + v[i][3] * v[i][3];
        ss = wave_sum(ss);
        const float rstd = rsqrtf(ss * (1.0f / 2048.0f) + NORM_EPS);
        bf16_t* hr = F.H + (size_t)t * D;
#pragma unroll
        for (int i = 0; i < 8; ++i) { const f32x4 y = v[i] * rstd * Gv[i] + Sv[i]; u32x2 w; w.x = pk_bf16(y[0], y[1]); w.y = pk_bf16(y[2], y[3]); *(u32x2*)(hr + 4 * lane + 256 * i) = w; }
        if (j < 15) {
#pragma unroll
            for (int i = 0; i < 8; ++i) { v[i] = vn[i]; dv[i] = dn[i]; } }
    }
}

__device__ __forceinline__ void p3_post(const Frame& F) {
    const int lane = F.lane;
    LAS float* kw = (LAS float*)F.lds + F.wave * 1280;
    {
        const int li = lane & 15, q4 = lane >> 4;
        f32x4 acc[5];
#pragma unroll
        for (int nb = 0; nb < 5; ++nb) acc[nb] = (f32x4){0.f, 0.f, 0.f, 0.f};
        const bf16_t* hp = F.H + (size_t)(F.bid * 128 + F.wave * 16 + li) * D + 8 * q4;
        LAS bf16_t* bs = (LAS bf16_t*)(F.lds + 40960);
        for (int kc = 0; kc < 8; ++kc) {
            u32x4 st[5];
#pragma unroll
            for (int i = 0; i < 5; ++i) { const int piece = F.tid + 512 * i, row = piece >> 5, pc = piece & 31; st[i] = *(const u32x4*)(F.WIN + (size_t)(3584 + row) * D + kc * 256 + pc * 8); }
            bf16x8 a[8];
#pragma unroll
            for (int ks = 0; ks < 8; ++ks) a[ks] = *(const bf16x8*)(hp + 32 * (kc * 8 + ks));
            __syncthreads();
#pragma unroll
            for (int i = 0; i < 5; ++i) { const int piece = F.tid + 512 * i, row = piece >> 5, pc = piece & 31; *(LAS u32x4*)(bs + row * 264 + pc * 8) = st[i]; }
            __syncthreads();
#pragma unroll
            for (int ks = 0; ks < 8; ++ks)
#pragma unroll
                for (int nb = 0; nb < 5; ++nb) { const bf16x8 bb = *(const LAS bf16x8*)(bs + (nb * 16 + li) * 264 + ks * 32 + 8 * q4); acc[nb] = __builtin_amdgcn_mfma_f32_16x16x32_bf16(a[ks], bb, acc[nb], 0, 0, 0); }
        }
#pragma unroll
        for (int nb = 0; nb < 5; ++nb)
#pragma unroll
            for (int i = 0; i < 4; ++i) kw[(4 * q4 + i) * 80 + nb * 16 + li] = acc[nb][i];
        asm volatile("s_waitcnt lgkmcnt(0)" ::: "memory");
    }
    const float QSCALE = 0.08838834764831845f * 1.4426950408889634f;
    const float IDX_SCALE = 0.125f * 0.25f;
    float gq[16], gk[16];
#pragma unroll
    for (int e = 0; e < 16; ++e) { gq[e] = F.q_norm_g[(lane & 7) * 16 + e]; gk[e] = F.k_norm_g[(lane & 7) * 16 + e]; }
    float wsum[16];
    for (int j = 0; j < 16; ++j) {
        const int t = F.bid * 128 + F.wave * 16 + j, pos = t & (S - 1);
        const bf16_t* pr = F.PROJ + (size_t)t * NPROJ;
        const float* tab = F.TAB + (size_t)pos * 48;
        const int gpl = lane >> 4, wpl = 2 << gpl;
        const u32x4 Lq0 = *(const u32x4*)(pr + CQ + 16 * lane), Lq1 = *(const u32x4*)(pr + CQ + 16 * lane + 8);
        const u32x4 Lk0 = *(const u32x4*)(pr + CK + 16 * (lane & 31)), Lk1 = *(const u32x4*)(pr + CK + 16 * (lane & 31) + 8);
        const u32x4 Li0 = *(const u32x4*)(pr + CQI + 16 * lane), Li1 = *(const u32x4*)(pr + CQI + 16 * lane + 8);
        const u32x4 Lp0 = *(const u32x4*)(pr + CP + 16 * lane), Lp1 = *(const u32x4*)(pr + CP + 16 * lane + 8);
        f32x4 tq[8], ti[4];
#pragma unroll
        for (int i = 0; i < 8; ++i) tq[i] = *(const f32x4*)(tab + 4 * i);
#pragma unroll
        for (int i = 0; i < 4; ++i) ti[i] = *(const f32x4*)(tab + 32 + 4 * i);
        u32x4 Lo0, Lo1;
        { const int rr = wpl <= pos ? wpl : pos; const bf16_t* pp = pr - (size_t)rr * NPROJ + CP + 16 * lane; Lo0 = *(const u32x4*)pp; Lo1 = *(const u32x4*)(pp + 8); }
        {
            float f[16]; unpack8(Lq0, f); unpack8(Lq1, f + 8);
            float ss = 0.f;
#pragma unroll
            for (int e = 0; e < 16; ++e) ss += f[e] * f[e];
            ss += __shfl_xor(ss, 1); ss += __shfl_xor(ss, 2); ss += __shfl_xor(ss, 4);
            const float rstd = rsqrtf(ss * (1.0f / 128.0f) + NORM_EPS);
            const int d0 = (lane & 7) * 16;
#pragma unroll
            for (int e = 0; e < 16; ++e) f[e] = f[e] * rstd * gq[e];
            float o[16];
#pragma unroll
            for (int e = 0; e < 16; ++e) o[e] = __shfl_xor(f[e], 1);
            const int l8 = lane & 7;
            if (l8 < 2) {
#pragma unroll
                for (int e = 0; e < 16; ++e) { const float cs = tq[e >> 2][e & 3], sn = tq[4 + (e >> 2)][e & 3]; f[e] = (l8 == 0) ? (f[e] * cs - o[e] * sn) : (f[e] * cs + o[e] * sn); }
            }
#pragma unroll
            for (int e = 0; e < 16; ++e) f[e] *= QSCALE;
            bf16_t* qo = F.QB + (size_t)t * 1024 + 16 * lane;
            *(u32x4*)qo = pack8(f); *(u32x4*)(qo + 8) = pack8(f + 8);
        }
        {
            const int l = lane & 31;
            float f[16]; unpack8(Lk0, f); unpack8(Lk1, f + 8);
            float kf[16]; float ss = 0.f;
#pragma unroll
            for (int e = 0; e < 16; ++e) ss += f[e] * f[e];
            ss += __shfl_xor(ss, 1); ss += __shfl_xor(ss, 2); ss += __shfl_xor(ss, 4);
            const float rstd = rsqrtf(ss * (1.0f / 128.0f) + NORM_EPS);
            const int d0 = (l & 7) * 16;
#pragma unroll
            for (int e = 0; e < 16; ++e) kf[e] = f[e] * rstd * gk[e];
            float o[16];
#pragma unroll
            for (int e = 0; e < 16; ++e) o[e] = __shfl_xor(kf[e], 1);
            const int l8 = l & 7;
            if (l8 < 2) {
#pragma unroll
                for (int e = 0; e < 16; ++e) { const float cs = tq[e >> 2][e & 3], sn = tq[4 + (e >> 2)][e & 3]; kf[e] = (l8 == 0) ? (kf[e] * cs - o[e] * sn) : (kf[e] * cs + o[e] * sn); }
            }
            if (lane < 32) {
                const bool isv = lane >= 16; const int ll = lane & 15, g = ll >> 3, dd = (ll & 7) * 16;
                bf16_t* dst = F.KV + (size_t)t * 512 + g * 256 + (isv ? 128 : 0) + dd;
                *(u32x4*)dst = pack8(isv ? f : kf); *(u32x4*)(dst + 8) = pack8(isv ? f + 8 : kf + 8);
            }
        }
        {
            float f[16]; unpack8(Li0, f); unpack8(Li1, f + 8);
            if ((lane & 3) == 0) {
#pragma unroll
                for (int i = 0; i < 8; ++i) { const float cs = ti[i >> 2][i & 3], sn = ti[2 + (i >> 2)][i & 3]; const float x1 = f[i], x2 = f[i + 8]; f[i] = x1 * cs - x2 * sn; f[i + 8] = x2 * cs + x1 * sn; }
            }
            const int hd = lane >> 2, d0 = (lane & 3) * 16;
            *(u32x4*)(F.QI + qi_off((size_t)t, hd, d0)) = pack8(f); *(u32x4*)(F.QI + qi_off((size_t)t, hd, d0 + 8)) = pack8(f + 8);
        }
        if (lane < 5) {
            float f[16];
#pragma unroll
            for (int e = 0; e < 16; ++e) f[e] = kw[j * 80 + 16 * lane + e];
            if (lane == 0) {
#pragma unroll
                for (int i = 0; i < 8; ++i) { const float cs = ti[i >> 2][i & 3], sn = ti[2 + (i >> 2)][i & 3]; const float x1 = f[i], x2 = f[i + 8]; f[i] = x1 * cs - x2 * sn; f[i + 8] = x2 * cs + x1 * sn; }
            }
            if (lane < 4) { *(u32x4*)(F.KI + ki_off((size_t)t, 16 * lane)) = pack8(f); *(u32x4*)(F.KI + ki_off((size_t)t, 16 * lane + 8)) = pack8(f + 8); }
            else { float* wo = F.WI + (size_t)t * 16;
#pragma unroll
                for (int e = 0; e < 16; ++e) wo[e] = f[e] * IDX_SCALE; }
        }
        {
            const int g = lane >> 4, w = 2 << g;
            float cur[16], sum[16];
            unpack8(Lp0, cur); unpack8(Lp1, cur + 8);
            if (j == 0) {
#pragma unroll
                for (int e = 0; e < 16; ++e) wsum[e] = cur[e];
                for (int r = 1; r < 16; ++r) {
                    if (r < w && r <= pos) { float f[16]; const bf16_t* pp = pr - (size_t)r * NPROJ + CP + 16 * lane; unpack8(*(const u32x4*)pp, f); unpack8(*(const u32x4*)(pp + 8), f + 8);
#pragma unroll
                        for (int e = 0; e < 16; ++e) wsum[e] += f[e]; }
                }
            } else {
                float old[16]; unpack8(Lo0, old); unpack8(Lo1, old + 8);
                const float useo = (pos >= w) ? 1.0f : 0.0f;
#pragma unroll
                for (int e = 0; e < 16; ++e) wsum[e] += cur[e] - useo * old[e];
            }
            const float inv = 1.0f / (float)((pos + 1) < w ? (pos + 1) : w);
#pragma unroll
            for (int e = 0; e < 16; ++e) sum[e] = wsum[e] * inv - cur[e];
            bf16_t* po = F.PM + ((size_t)g * T + t) * 256 + (lane & 15) * 16;
            *(u32x4*)po = pack8(sum); *(u32x4*)(po + 8) = pack8(sum + 8);
        }
    }
}

__device__ __forceinline__ size_t sc_block_base(int b, int qb) { return (size_t)b * SC_BATCH + (size_t)16384 * ((size_t)qb * (qb + 1) / 2); }

struct IdxUnit { int b, qb, kb; };
__device__ __forceinline__ IdxUnit idx_decode(int u) {
    IdxUnit r; r.b = u / 2080; const int v = u % 2080;
    int qb = (int)((sqrtf(8.0f * (float)v + 1.0f) - 1.0f) * 0.5f);
    while (qb * (qb + 1) / 2 > v) --qb;
    while ((qb + 1) * (qb + 2) / 2 <= v) ++qb;
    r.qb = qb; r.kb = v - qb * (qb + 1) / 2; return r;
}
__device__ __forceinline__ void indexer_units(const Frame& F, int u0, int ustride, int uend) {
    const int lane = F.lane, wid = F.wave, c = lane & 31, hf = lane >> 5;
    if (u0 >= uend) return;
    bf16x8 kf[4][4], af[4], afn[4]; f32x4 wv[4], wvn[4];
#define IX_LDK(dst, U) do { const bf16_t* _kib = F.KI + (((size_t)(U).b * S + (U).kb * 128) >> 7) * 8192 + lane * 8; \
        _Pragma("unroll") for (int _s = 0; _s < 4; ++_s) _Pragma("unroll") for (int _k = 0; _k < 4; ++_k) dst[_s][_k] = *(const bf16x8*)(_kib + (_s * 4 + _k) * 512); } while (0)
#define IX_LDA(dsta, dstw, U, pair) do { const size_t _tq = (size_t)(U).b * S + (U).qb * 128 + wid * 16 + 2 * (pair); \
        _Pragma("unroll") for (int _k = 0; _k < 4; ++_k) dsta[_k] = *(const bf16x8*)(F.QI + (_tq >> 1) * 2048 + _k * 512 + lane * 8); \
        _Pragma("unroll") for (int _i = 0; _i < 4; ++_i) dstw[_i] = *(const f32x4*)(F.WI + (_tq + hf) * 16 + 4 * _i); } while (0)
    IdxUnit cur = idx_decode(u0);
    IX_LDK(kf, cur); IX_LDA(af, wv, cur, 0);
    for (int u = u0; u < uend; u += ustride) {
        const bool has_next = u + ustride < uend;
        IdxUnit nxt = cur; if (has_next) nxt = idx_decode(u + ustride);
        const size_t rowlen = (size_t)(cur.qb + 1) * 128;
        unsigned short* scb = F.SC + sc_block_base(cur.b, cur.qb);
#pragma unroll
        for (int pair = 0; pair < 8; ++pair) {
            const int r0 = wid * 16 + pair * 2;
            if (pair < 7) IX_LDA(afn, wvn, cur, pair + 1);
            else if (has_next) IX_LDA(afn, wvn, nxt, 0);
            float sc[4];
#pragma unroll
            for (int sub = 0; sub < 4; ++sub) {
                f32x16 acc;
#pragma unroll
                for (int i = 0; i < 16; ++i) acc[i] = 0.f;
#pragma unroll
                for (int kk = 0; kk < 4; ++kk) acc = __builtin_amdgcn_mfma_f32_32x32x16_bf16(af[kk], kf[sub][kk], acc, 0, 0, 0);
                if (pair == 7 && has_next) {
                    const bf16_t* kib = F.KI + (((size_t)nxt.b * S + nxt.kb * 128) >> 7) * 8192 + lane * 8;
#pragma unroll
                    for (int kk = 0; kk < 4; ++kk) kf[sub][kk] = *(const bf16x8*)(kib + (sub * 4 + kk) * 512);
                }
                float s = 0.f;
#pragma unroll
                for (int i = 0; i < 16; ++i) { const float av = acc[i]; const int ai = __float_as_int(av); const float rl = __int_as_float(ai > 0 ? ai : 0); const float wi_ = wv[i >> 2][i & 3];
                    asm("v_fmac_f32 %0, %1, %2" : "+v"(s) : "v"(wi_), "v"(rl)); }
                sc[sub] = s;
            }
            f16v2 h0, h1; h0.x = (_Float16)sc[0]; h0.y = (_Float16)sc[1]; h1.x = (_Float16)sc[2]; h1.y = (_Float16)sc[3];
            u32x2 w; w.x = __builtin_bit_cast(unsigned, h0); w.y = __builtin_bit_cast(unsigned, h1);
            *(u32x2*)(scb + (size_t)(r0 + hf) * rowlen + cur.kb * 128 + 4 * c) = w;
#pragma unroll
            for (int kk = 0; kk < 4; ++kk) af[kk] = afn[kk];
#pragma unroll
            for (int i = 0; i < 4; ++i) wv[i] = wvn[i];
        }
        cur = nxt;
    }
#undef IX_LDK
#undef IX_LDA
}

__device__ __forceinline__ void find_bin(LAS unsigned* hist, int lane, unsigned need, unsigned& bin, unsigned& above) {
    const u32x4 h = *(const LAS u32x4*)(hist + 4 * lane);
    const unsigned s = h.x + h.y + h.z + h.w;
    unsigned v = s;
#pragma unroll
    for (int d = 1; d < 64; d <<= 1) { const unsigned tt = __shfl_down(v, d); if (lane + d < 64) v += tt; }
    unsigned run = v - s;
    int fb = -1; unsigned fa = 0;
    const unsigned hh[4] = {h.x, h.y, h.z, h.w};
#pragma unroll
    for (int j = 3; j >= 0; --j) { if (fb < 0 && run < need && run + hh[j] >= need) { fb = 4 * lane + j; fa = run; } run += hh[j]; }
    const unsigned long long m = __ballot(fb >= 0);
    const int src = m ? (int)__builtin_ctzll(m) : 0;
    bin = (unsigned)__shfl(fb, src); above = __shfl(fa, src);
}

__device__ __forceinline__ unsigned okey(unsigned h) { return (h & 0x8000u) ? (~h & 0xffffu) : (h | 0x8000u); }
__device__ __forceinline__ const unsigned short* sel_src(const Frame& F, int t) { const int pos = t & (S - 1), qb = pos >> 7; return F.SC + sc_block_base(t >> 13, qb) + (size_t)(pos & 127) * (qb + 1) * 128; }
__device__ __forceinline__ void select_row(const Frame& F, int t, const u32x4 (&pre)[16], LAS unsigned char* wbuf, int lane) {
    LAS unsigned* rowb = (LAS unsigned*)wbuf;
    LAS unsigned* hist = (LAS unsigned*)(wbuf + 16384);
    LAS unsigned short* lst = (LAS unsigned short*)(wbuf + 16384 + 1024);
    const int pos = t & (S - 1), n = pos + 1;
    unsigned short* out = F.SEL + (size_t)t * 256;
    if (n <= 256) { for (int j = lane; j < 256; j += 64) out[j] = (unsigned short)(j < n ? j : 0); return; }
    const int nch = (n + 511) >> 9;
#pragma unroll
    for (int ch = 0; ch < 16; ++ch) if (ch < nch) *(LAS u32x4*)(rowb + ch * 256 + lane * 4) = pre[ch];
#pragma unroll
    for (int i = 0; i < 4; ++i) hist[lane + 64 * i] = 0u;
    for (int ch = 0; ch < nch; ++ch) {
        const int base = ch * 512 + lane * 8;
        u32x4 raw = *(const LAS u32x4*)(rowb + ch * 256 + lane * 4);
#pragma unroll
        for (int w = 0; w < 4; ++w) {
            const unsigned k0 = (base + 2 * w < n) ? okey(raw[w] & 0xffffu) : 0u, k1 = (base + 2 * w + 1 < n) ? okey(raw[w] >> 16) : 0u;
            __hip_atomic_fetch_add(hist + (k0 >> 8), 1u, __ATOMIC_RELAXED, __HIP_MEMORY_SCOPE_WORKGROUP);
            __hip_atomic_fetch_add(hist + (k1 >> 8), 1u, __ATOMIC_RELAXED, __HIP_MEMORY_SCOPE_WORKGROUP);
            raw[w] = k0 | (k1 << 16);
        }
        *(LAS u32x4*)(rowb + ch * 256 + lane * 4) = raw;
    }
#if P5_PROBE == 1
    for (int ch = 0; ch < nch; ++ch) {
        const u32x4 raw = *(const LAS u32x4*)(rowb + ch * 256 + lane * 4);
#pragma unroll
        for (int w = 0; w < 4; ++w) {
            __hip_atomic_fetch_add(hist + ((raw[w] & 0xffffu) >> 8), 0u, __ATOMIC_RELAXED, __HIP_MEMORY_SCOPE_WORKGROUP);
            __hip_atomic_fetch_add(hist + (raw[w] >> 24), 0u, __ATOMIC_RELAXED, __HIP_MEMORY_SCOPE_WORKGROUP);
        }
    }
#endif
    unsigned bin1, above1; find_bin(hist, lane, 256u, bin1, above1);
    const unsigned r1 = 256u - above1;
#pragma unroll
    for (int i = 0; i < 4; ++i) hist[lane + 64 * i] = 0u;
    for (int ch = 0; ch < nch; ++ch) {
        const u32x4 raw = *(const LAS u32x4*)(rowb + ch * 256 + lane * 4);
#pragma unroll
        for (int w = 0; w < 4; ++w) {
            const unsigned k0 = raw[w] & 0xffffu, k1 = raw[w] >> 16;
            if ((k0 >> 8) == bin1) __hip_atomic_fetch_add(hist + (k0 & 255u), 1u, __ATOMIC_RELAXED, __HIP_MEMORY_SCOPE_WORKGROUP);
            if ((k1 >> 8) == bin1) __hip_atomic_fetch_add(hist + (k1 & 255u), 1u, __ATOMIC_RELAXED, __HIP_MEMORY_SCOPE_WORKGROUP);
        }
    }
    unsigned bin2, above2; find_bin(hist, lane, r1, bin2, above2);
#if P5_PROBE == 4
    { unsigned bx, ax; find_bin(hist, lane, r1, bx, ax); if (bx != bin2) bin2 = bx; find_bin(hist, lane, r1, bx, ax); if (bx != bin2) bin2 = bx; }
#endif
    const unsigned r2 = r1 - above2, thr = (bin1 << 8) | bin2;
    unsigned cg = 0, ce = 0;
    for (int ch = 0; ch < nch; ++ch) {
        const u32x4 raw = *(const LAS u32x4*)(rowb + ch * 256 + lane * 4);
#pragma unroll
        for (int e = 0; e < 8; ++e) { const unsigned key = (raw[e >> 1] >> ((e & 1) * 16)) & 0xffffu; cg += (key > thr) ? 1u : 0u; ce += (key == thr) ? 1u : 0u; }
    }
#if P5_PROBE == 2
    { unsigned cg2 = 0, ce2 = 0;
      for (int ch = 0; ch < nch; ++ch) {
        const u32x4 raw = *(const LAS u32x4*)(rowb + ch * 256 + lane * 4);
#pragma unroll
        for (int e = 0; e < 8; ++e) { const unsigned key = (raw[e >> 1] >> ((e & 1) * 16)) & 0xffffu; cg2 += (key > thr + 1u) ? 1u : 0u; ce2 += (key == thr + 1u) ? 1u : 0u; }
      }
      if (cg2 + ce2 == 0xffffffffu) cg += 1u; }
#endif
    unsigned og = cg, oe = ce;
#pragma unroll
    for (int d = 1; d < 64; d <<= 1) { const unsigned tg = __shfl_up(og, d), te = __shfl_up(oe, d); if (lane >= d) { og += tg; oe += te; } }
    og -= cg; oe -= ce;
    const unsigned G = above1 + above2;
    for (int ch = 0; ch < nch; ++ch) {
        const u32x4 raw = *(const LAS u32x4*)(rowb + ch * 256 + lane * 4);
#pragma unroll
        for (int e = 0; e < 8; ++e) {
            const unsigned key = (raw[e >> 1] >> ((e & 1) * 16)) & 0xffffu;
            const unsigned short id = (unsigned short)(ch * 512 + lane * 8 + e);
            if (key > thr) { if (og < 256u) lst[og] = id; ++og; }
            if (key == thr) { if (oe < r2 && G + oe < 256u) lst[G + oe] = id; ++oe; }
        }
    }
    *(u32x2*)(out + 4 * lane) = *(const LAS u32x2*)(lst + 4 * lane);
}

__device__ __forceinline__ bf16x8 tr_read2(unsigned a0, unsigned a1) {
    s16x4 x, y;
    asm volatile("ds_read_b64_tr_b16 %0, %2\n\tds_read_b64_tr_b16 %1, %3\n\ts_waitcnt lgkmcnt(0)" : "=&v"(x), "=&v"(y) : "v"(a0), "v"(a1) : "memory");
    return (bf16x8){x[0], x[1], x[2], x[3], y[0], y[1], y[2], y[3]};
}

__device__ __forceinline__ void tr_read16(const unsigned (&va)[4], s16x4 (&r)[16]) {
    asm volatile(
        "ds_read_b64_tr_b16 %0, %16\n\tds_read_b64_tr_b16 %1, %16 offset:4096\n\tds_read_b64_tr_b16 %2, %17\n\tds_read_b64_tr_b16 %3, %17 offset:4096\n\t"
        "ds_read_b64_tr_b16 %4, %18\n\tds_read_b64_tr_b16 %5, %18 offset:4096\n\tds_read_b64_tr_b16 %6, %19\n\tds_read_b64_tr_b16 %7, %19 offset:4096\n\t"
        "ds_read_b64_tr_b16 %8, %16 offset:512\n\tds_read_b64_tr_b16 %9, %16 offset:4608\n\tds_read_b64_tr_b16 %10, %17 offset:512\n\tds_read_b64_tr_b16 %11, %17 offset:4608\n\t"
        "ds_read_b64_tr_b16 %12, %18 offset:512\n\tds_read_b64_tr_b16 %13, %18 offset:4608\n\tds_read_b64_tr_b16 %14, %19 offset:512\n\tds_read_b64_tr_b16 %15, %19 offset:4608\n\t"
        "s_waitcnt lgkmcnt(0)"
        : "=&v"(r[0]), "=&v"(r[1]), "=&v"(r[2]), "=&v"(r[3]), "=&v"(r[4]), "=&v"(r[5]), "=&v"(r[6]), "=&v"(r[7]),
          "=&v"(r[8]), "=&v"(r[9]), "=&v"(r[10]), "=&v"(r[11]), "=&v"(r[12]), "=&v"(r[13]), "=&v"(r[14]), "=&v"(r[15])
        : "v"(va[0]), "v"(va[1]), "v"(va[2]), "v"(va[3]) : "memory");
}
#define AT_WAITV(n) asm volatile("s_waitcnt vmcnt(" #n ")" ::: "memory")
__device__ __forceinline__ int rot_k(int p) { return ((p & 1) ? 3 : 1) + ((p >> 2) & 1) * 4; }
__device__ __forceinline__ void attn_items(const Frame& F, int klo, int khi) {
    const int lane = F.lane, li = lane & 15, q4 = lane >> 4;
    const int xg = F.bid & 7, b = xg >> 1, g = xg & 1;
    const int wq = (F.bid >> 3) * 8 + F.wave;
    LAS unsigned char* wb = F.lds + F.wave * 16384;
    const unsigned wbu = (unsigned)(uintptr_t)wb;
    const bf16_t* kvb = F.KV + (size_t)b * S * 512 + g * 256;
    const int da = lane >> 3, dr = lane & 7, drow = da & 3, dline = da >> 2;
    const int koff0 = 64 * dline + 8 * ((dr + rot_k(drow >> 1)) & 7);
    const int voff0 = 128 + 64 * dline + 8 * ((dr + 2 * (drow >> 1)) & 7);
    const unsigned kra0 = (unsigned)((li >> 2) * 1024 + (8 * (li & 3) + ((q4 - rot_k(li >> 1)) & 7)) * 16);
    const int vr4 = li >> 2, vp = li & 3;
    const unsigned vbase = wbu + (unsigned)(q4 * 1024 + 128 * vr4 + 8 * (vp & 1));
    const int vc = (vp >> 1) - 2 * ((2 * q4 + (vr4 >> 1)) & 3) + 8;
#define AT_KDMA(c) do { _Pragma("unroll") for (int _j = 0; _j < 4; ++_j) { const int _ix = (__shfl(idx2[(c) >> 1], 4 * _j + drow) >> (((c) & 1) * 16)) & 0xffff; \
        __builtin_amdgcn_global_load_lds((const unsigned*)((const char*)kvb + (unsigned)(_ix * 1024 + 2 * (koff0 ^ ((_j >> 1) * 32)))), (LAS unsigned*)(wb + ((c) & 3) * 4096 + _j * 1024), 16, 0, 0); } } while (0)
#define AT_VDMA(ks) do { _Pragma("unroll") for (int _j = 0; _j < 8; ++_j) { const int _ix = (__shfl(idx2[ks], 4 * (_j & 3) + drow) >> ((_j >> 2) * 16)) & 0xffff; \
        __builtin_amdgcn_global_load_lds((const unsigned*)((const char*)kvb + (unsigned)(_ix * 1024 + 2 * (voff0 ^ ((_j & 1) * 32)))), (LAS unsigned*)(wb + ((ks) & 1) * 8192 + _j * 1024), 16, 0, 0); } } while (0)
    int nv0[8], nv1[8]; bf16x8 nbq[4];
#define AT_FETCH(kk_) do { const size_t _t = (size_t)(b * S + wq + 256 * (kk_)); \
        _Pragma("unroll") for (int _i = 0; _i < 8; ++_i) { nv0[_i] = F.SEL[_t * 256 + 32 * _i + li]; nv1[_i] = F.SEL[_t * 256 + 32 * _i + 16 + li]; } \
        _Pragma("unroll") for (int _kk = 0; _kk < 4; ++_kk) { nbq[_kk] = (bf16x8){0, 0, 0, 0, 0, 0, 0, 0}; if (li < 4) nbq[_kk] = *(const bf16x8*)(F.QB + _t * 1024 + (4 * g + li) * 128 + 32 * _kk + 8 * q4); } } while (0)
    AT_FETCH(klo);
    for (int k = klo; k < khi; ++k) {
        const int pos = wq + 256 * k, t = b * S + pos, cnt = (pos + 1) < 256 ? (pos + 1) : 256;
        int idx2[8]; bf16x8 bq[4];
#pragma unroll
        for (int i = 0; i < 8; ++i) { const int s0 = 32 * i + li, s1 = s0 + 16; idx2[i] = (s0 < cnt ? nv0[i] : 0) | ((s1 < cnt ? nv1[i] : 0) << 16); }
#pragma unroll
        for (int kk = 0; kk < 4; ++kk) bq[kk] = nbq[kk];
        if (k + 1 < khi) AT_FETCH(k + 1);
        AT_KDMA(0); AT_KDMA(1); AT_KDMA(2);
        f32x4 s[16];
#pragma unroll
        for (int c = 0; c < 16; ++c) {
            if (c <= 13) AT_WAITV(8); else if (c == 14) AT_WAITV(12); else AT_WAITV(8);
            f32x4 acc = (f32x4){0.f, 0.f, 0.f, 0.f};
            bf16x8 a[4];
#pragma unroll
            for (int kk = 0; kk < 4; ++kk) a[kk] = *(const LAS bf16x8*)(wb + (c & 3) * 4096 + (kk >> 1) * 512 + (kra0 ^ (unsigned)((kk & 1) * 64)));
#pragma unroll
            for (int kk = 0; kk < 4; ++kk) acc = __builtin_amdgcn_mfma_f32_16x16x32_bf16(a[kk], bq[kk], acc, 0, 0, 0);
            s[c] = acc;
            asm volatile("s_waitcnt lgkmcnt(0)" ::: "memory");
            if (c + 3 <= 15) AT_KDMA(c + 3);
            if (c == 13) AT_VDMA(0);
            if (c == 15) AT_VDMA(1);
            __builtin_amdgcn_sched_barrier(0);
        }
        float m = -INFINITY;
#pragma unroll
        for (int c = 0; c < 16; ++c)
#pragma unroll
            for (int i = 0; i < 4; ++i) { const int slot = c * 16 + 4 * q4 + i; if (slot >= cnt) s[c][i] = -INFINITY; m = fmaxf(m, s[c][i]); }
        m = fmaxf(m, __shfl_xor(m, 16)); m = fmaxf(m, __shfl_xor(m, 32));
        float sum = 0.f;
#pragma unroll
        for (int c = 0; c < 16; ++c)
#pragma unroll
            for (int i = 0; i < 4; ++i) { const float p = exp2f(s[c][i] - m); s[c][i] = p; sum += p; }
        sum += __shfl_xor(sum, 16); sum += __shfl_xor(sum, 32);
        f32x4 o[8];
#pragma unroll
        for (int d = 0; d < 8; ++d) o[d] = (f32x4){0.f, 0.f, 0.f, 0.f};
#pragma unroll
        for (int ks = 0; ks < 8; ++ks) {
            u32x4 pk; pk.x = pk_bf16(s[2 * ks][0], s[2 * ks][1]); pk.y = pk_bf16(s[2 * ks][2], s[2 * ks][3]); pk.z = pk_bf16(s[2 * ks + 1][0], s[2 * ks + 1][1]); pk.w = pk_bf16(s[2 * ks + 1][2], s[2 * ks + 1][3]);
            const bf16x8 bp = __builtin_bit_cast(bf16x8, pk);
            if (ks < 7) AT_WAITV(8); else AT_WAITV(0);
            unsigned va[4];
#pragma unroll
            for (int dd = 0; dd < 4; ++dd) va[dd] = vbase + (unsigned)((ks & 1) * 8192) + (unsigned)(((vc + 2 * dd) & 7) << 4);
            s16x4 tr[16];
            tr_read16(va, tr);
#pragma unroll
            for (int d = 0; d < 8; ++d) { const int q = 8 * (d >> 2) + 2 * (d & 3); const bf16x8 a = (bf16x8){tr[q][0], tr[q][1], tr[q][2], tr[q][3], tr[q + 1][0], tr[q + 1][1], tr[q + 1][2], tr[q + 1][3]};
                o[d] = __builtin_amdgcn_mfma_f32_16x16x32_bf16(a, bp, o[d], 0, 0, 0); }
            if (ks + 2 <= 7) AT_VDMA(ks + 2);
            __builtin_amdgcn_sched_barrier(0);
        }
        const float inv = 1.0f / sum;
        if (li < 4) {
            bf16_t* op = F.CONCAT + (size_t)t * D + g * 512 + li * 128 + 4 * q4;
#pragma unroll
            for (int d = 0; d < 8; ++d) { u32x2 w; w.x = pk_bf16(o[d][0] * inv, o[d][1] * inv); w.y = pk_bf16(o[d][2] * inv, o[d][3] * inv); *(u32x2*)(op + d * 16) = w; }
        }
    }
#undef AT_FETCH
#undef AT_KDMA
#undef AT_VDMA
}

#if SELFCHECK
__device__ __forceinline__ float bfv(const bf16_t* p, size_t i) { return __uint_as_float(((unsigned)p[i]) << 16); }
__device__ __forceinline__ unsigned hash_u(unsigned x) { x ^= x >> 16; x *= 0x7feb352dU; x ^= x >> 15; x *= 0x846ca68bU; x ^= x >> 16; return x; }
__device__ __forceinline__ void chk_flag(const Frame& F, int k) { __hip_atomic_fetch_add(F.ctl + CW_CHK + k, 1u, __ATOMIC_RELAXED, __HIP_MEMORY_SCOPE_AGENT); }
__device__ __forceinline__ void chk_gemm1(const Frame& F) {
    for (int j = 0; j < 16; ++j) {
        const unsigned hsh = hash_u((unsigned)((F.bid * 8 + F.wave) * 16 + j) * 2654435761u + 12345u);
        const int t = (int)(hsh % (unsigned)T), n = (int)((hsh >> 7) % 3664u);
        float s = 0.f, sa = 0.f;
        for (int k = F.lane; k < D; k += 64) { const float a = bfv(F.H, (size_t)t * D + k), w = F.w_in[(size_t)k * 3664 + n]; s += a * w; sa += fabsf(a * w); }
        s = wave_sum(s); sa = wave_sum(sa);
        const float got = colmap(n) < 3584 ? bfv(F.PROJ, (size_t)t * NPROJ + colmap(n)) : s;
        if (F.lane == 0 && !(fabsf(got - s) <= 0.001f * sa + 0.02f)) chk_flag(F, 0);
    }
}
__device__ __forceinline__ void chk_post(const Frame& F) {
    const int gw = F.bid * 8 + F.wave;
    const int t = (gw * 16 + (gw & 15)) % T, pos = t & (S - 1), lane = F.lane;
    const bf16_t* pr = F.PROJ + (size_t)t * NPROJ;
    const float QSCALE = 0.08838834764831845f * 1.4426950408889634f;
    int bad = 0;
    for (int hh = 0; hh < 10; ++hh) {
        const int cb = hh < 8 ? CQ + hh * 128 : CK + (hh - 8) * 128; const float* gn = hh < 8 ? F.q_norm_g : F.k_norm_g;
        float ss = 0.f; for (int d = lane; d < 128; d += 64) { const float v = bfv(pr, cb + d); ss += v * v; } ss = wave_sum(ss);
        const float rstd = 1.0f / sqrtf(ss / 128.0f + NORM_EPS);
        for (int d = lane; d < 128; d += 64) {
            float y = bfv(pr, cb + d) * rstd * gn[d];
            if (d < 32) { const int i = d & 15; const float inv = powf(500000.0f, -(float)(2 * i) / 32.0f); const float ang = (float)pos * inv; const float cs = cosf(ang), sn = sinf(ang);
                const int dp = d < 16 ? d + 16 : d - 16; const float yp = bfv(pr, cb + dp) * rstd * gn[dp];
                y = d < 16 ? y * cs - yp * sn : y * cs + yp * sn; }
            float got, ref;
            if (hh < 8) { ref = y * QSCALE; got = bfv(F.QB, (size_t)t * 1024 + hh * 128 + d); } else { ref = y; got = bfv(F.KV, (size_t)t * 512 + (hh - 8) * 256 + d); }
            if (!(fabsf(got - ref) <= 0.02f * fabsf(ref) + 0.02f)) bad = 1;
        }
    }
    for (int e = lane; e < 256; e += 64) { const float ref = bfv(pr, CV + e), got = bfv(F.KV, (size_t)t * 512 + (e >> 7) * 256 + 128 + (e & 127)); if (got != ref) bad = 1; }
    for (int e = lane; e < 1024; e += 64) {
        const int cb = CQI + (e & ~63); const int d = e & 63;
        float y = bfv(pr, cb + d);
        if (d < 16) { const int i = d & 7; const float inv = powf(500000.0f, -(float)(2 * i) / 16.0f); const float ang = (float)pos * inv; const float cs = cosf(ang), sn = sinf(ang);
            const int dp = d < 8 ? d + 8 : d - 8; const float yp = bfv(pr, cb + dp); y = d < 8 ? y * cs - yp * sn : y * cs + yp * sn; }
        const float got = bfv(F.QI, qi_off((size_t)t, e >> 6, d));
        if (!(fabsf(got - y) <= 0.02f * fabsf(y) + 0.02f)) bad = 1;
    }
    {
        LAS float* kwref = (LAS float*)(F.lds + 49152) + F.wave * 128;
        for (int c = 0; c < 80; ++c) {
            float sdot = 0.f; for (int k = lane; k < D; k += 64) sdot += bfv(F.H, (size_t)t * D + k) * F.w_in[(size_t)k * 3664 + 2560 + c];
            sdot = wave_sum(sdot); if (lane == 0) kwref[c] = sdot;
        }
        asm volatile("s_waitcnt lgkmcnt(0)" ::: "memory");
        { const int d = lane; float y = kwref[d];
          if (d < 16) { const int i = d & 7; const float inv = powf(500000.0f, -(float)(2 * i) / 16.0f); const float ang = (float)pos * inv; const float cs = cosf(ang), sn = sinf(ang);
              const int dp = d < 8 ? d + 8 : d - 8; const float yp = kwref[dp]; y = d < 8 ? y * cs - yp * sn : y * cs + yp * sn; }
          const float got = bfv(F.KI, ki_off((size_t)t, d));
          if (!(fabsf(got - y) <= 0.02f * fabsf(y) + 0.03f)) bad = 1; }
        if (lane < 16) { const float ref = kwref[64 + lane] * 0.03125f, got = F.WI[(size_t)t * 16 + lane]; if (!(fabsf(got - ref) <= 1e-3f + 0.01f * fabsf(ref))) bad = 1; }
    }
    for (int e = lane; e < 1024; e += 64) {
        const int g = e >> 8, w = 2 << g; float sum = 0.f; int cn = 0;
        for (int r = 0; r < w; ++r) if (pos - r >= 0) { sum += bfv(pr - (size_t)r * NPROJ, CP + e); ++cn; }
        const float ref = sum / (float)cn - bfv(pr, CP + e), got = bfv(F.PM, ((size_t)g * T + t) * 256 + (e & 255));
        if (!(fabsf(got - ref) <= 0.02f * fabsf(ref) + 0.02f)) bad = 1;
    }
    if (__ballot(bad) != 0ull && lane == 0) chk_flag(F, 1);
}
__device__ __forceinline__ void chk_attn(const Frame& F) {
    const int w = F.bid, b = w & 3, j = w >> 2;
    const int pos = j == 0 ? 0 : j == 1 ? 1 : j == 2 ? 100 : j == 3 ? 254 : j == 4 ? 255 : j == 5 ? 256 : j == 6 ? 257 : j == 7 ? 300 : j == 8 ? 511 : j == 9 ? 512 : j == 10 ? 8190 : j == 11 ? 8191 : ((j * 131 + 17) & (S - 1));
    const int t = b * S + pos, n = pos + 1, cnt = n < 256 ? n : 256, tid = F.tid;
    LAS float* sc = (LAS float*)F.lds;
    LAS int* selmark = (LAS int*)(F.lds + 32768);
    LAS float* red = (LAS float*)(F.lds + 65536);
    LAS int* ired = (LAS int*)(F.lds + 65536 + 4096);
    __syncthreads();
    for (int s2 = tid; s2 < n; s2 += NTHREADS) {
        float tot = 0.f;
        for (int h = 0; h < 16; ++h) { float dsum = 0.f; for (int d = 0; d < 64; ++d) dsum += bfv(F.QI, qi_off((size_t)t, h, d)) * bfv(F.KI, ki_off((size_t)b * S + s2, d)); tot += F.WI[(size_t)t * 16 + h] * fmaxf(dsum, 0.f); }
        sc[s2] = (float)(_Float16)tot; selmark[s2] = 0;
    }
    __syncthreads();
    if (tid < cnt) { const int k = F.SEL[(size_t)t * 256 + tid]; if (k < n) atomicAdd((int*)(selmark + k), 1); else atomicAdd((int*)(selmark + 0), 1000); }
    if (tid == 0) { ired[0] = 0; ired[1] = 0; }
    __syncthreads();
    int miss = 0, dup = 0;
    for (int s2 = tid; s2 < n; s2 += NTHREADS) {
        const int mk = selmark[s2]; if (mk > 1) dup = 1;
        if (mk >= 1 && n > 256) { const float v = sc[s2]; int rank = 0; for (int q = 0; q < n; ++q) rank += (sc[q] > v) ? 1 : 0; if (rank >= 256) ++miss; }
    }
    if (miss) atomicAdd((int*)ired, miss); if (dup) atomicAdd((int*)ired + 1, 1);
    __syncthreads();
    if (tid == 0 && (ired[0] > 3 || ired[1] > 0)) chk_flag(F, 2);
    float err2 = 0.f, ref2 = 0.f;
    for (int h = 0; h < 8; ++h) {
        const int g = h >> 2;
        __syncthreads();
        if (tid < 256) { float l = -INFINITY; if (tid < cnt) { const int k = F.SEL[(size_t)t * 256 + tid]; float dsum = 0.f; for (int d = 0; d < 128; ++d) dsum += bfv(F.QB, (size_t)t * 1024 + h * 128 + d) * bfv(F.KV, ((size_t)b * S + k) * 512 + g * 256 + d); l = dsum; } red[tid] = l; }
        __syncthreads();
        float m = -INFINITY; for (int q = 0; q < 256; ++q) m = fmaxf(m, red[q]);
        float den = 0.f; for (int q = 0; q < 256; ++q) den += exp2f(red[q] - m);
        if (tid < 128) { float o = 0.f; for (int q = 0; q < cnt; ++q) { const int k = F.SEL[(size_t)t * 256 + q]; o += exp2f(red[q] - m) * bfv(F.KV, ((size_t)b * S + k) * 512 + g * 256 + 128 + tid); }
            o /= den; const float got = bfv(F.CONCAT, (size_t)t * D + h * 128 + tid); err2 += (got - o) * (got - o); ref2 += o * o; }
    }
    err2 = wave_sum(err2); ref2 = wave_sum(ref2);
    __syncthreads();
    if (F.lane == 0 && F.wave < 2) { red[300 + F.wave * 2] = err2; red[301 + F.wave * 2] = ref2; }
    __syncthreads();
    if (tid == 0) { const float e = red[300] + red[302], r = red[301] + red[303]; if (!(e <= 0.0009f * r + 1e-6f)) chk_flag(F, 3); }
    __syncthreads();
}
#endif

__device__ __forceinline__ void r1_route(const Frame& F) {
    { const float* ada = F.ADA + (size_t)(F.bid >> 6) * 12288; norm_rows(F, F.x, F.DX, F.norm2_g, ada + 3 * 2048, ada + 4 * 2048); }
    LAS unsigned* lh = (LAS unsigned*)(F.lds + 65536);
    LAS float* lg = (LAS float*)F.lds + F.wave * 768;
    if (F.tid < 64) lh[F.tid] = 0u;
    asm volatile("s_waitcnt vmcnt(0)" ::: "memory");
    __syncthreads();
    const int lane = F.lane, li = lane & 15, q4 = lane >> 4;
    const int t0 = F.bid * 128 + F.wave * 16;
    f32x4 acc[3];
#pragma unroll
    for (int nb = 0; nb < 3; ++nb) acc[nb] = (f32x4){0.f, 0.f, 0.f, 0.f};
    const bf16_t* hp = F.H + (size_t)(t0 + li) * D + 8 * q4;
    const bf16_t* wp = F.WR + (size_t)li * D + 8 * q4;
#pragma unroll 4
    for (int ks = 0; ks < 64; ++ks) {
        const bf16x8 a = *(const bf16x8*)(hp + 32 * ks);
#pragma unroll
        for (int nb = 0; nb < 3; ++nb) { const bf16x8 bb = *(const bf16x8*)(wp + (size_t)nb * 16 * D + 32 * ks); acc[nb] = __builtin_amdgcn_mfma_f32_16x16x32_bf16(a, bb, acc[nb], 0, 0, 0); }
    }
#pragma unroll
    for (int nb = 0; nb < 3; ++nb)
#pragma unroll
        for (int i = 0; i < 4; ++i) lg[(4 * q4 + i) * 48 + nb * 16 + li] = acc[nb][i];
    asm volatile("s_waitcnt lgkmcnt(0)" ::: "memory");
    if (lane < 16) {
        const int t = t0 + lane; const LAS float* l = lg + lane * 48;
        int gs = 0; float gm = l[0];
#pragma unroll
        for (int j = 1; j < 4; ++j) if (l[j] > gm) { gm = l[j]; gs = j; }
        float den = 0.f;
#pragma unroll
        for (int j = 0; j < 4; ++j) den += __expf(l[j] - gm);
        const float pg = 1.0f / den;
        const LAS float* el = l + 4 + gs * 8;
        int i0 = 0; float m0 = el[0];
#pragma unroll
        for (int j = 1; j < 8; ++j) if (el[j] > m0) { m0 = el[j]; i0 = j; }
        int i1 = -1; float m1 = -INFINITY;
#pragma unroll
        for (int j = 0; j < 8; ++j) if (j != i0 && el[j] > m1) { m1 = el[j]; i1 = j; }
        const float e1 = __expf(m1 - m0), w0 = pg / (1.0f + e1), w1 = pg * e1 / (1.0f + e1);
        const int b0 = gs * 8 + i0, b1 = 32 + gs * 8 + i1;
        F.TOKE[2 * t] = b0; F.TOKE[2 * t + 1] = b1; F.TOKW[2 * t] = w0; F.TOKW[2 * t + 1] = w1;
        __hip_atomic_fetch_add(lh + b0, 1u, __ATOMIC_RELAXED, __HIP_MEMORY_SCOPE_WORKGROUP);
        __hip_atomic_fetch_add(lh + b1, 1u, __ATOMIC_RELAXED, __HIP_MEMORY_SCOPE_WORKGROUP);
    }
    __syncthreads();
    if (F.tid < 64) { const unsigned cn = lh[F.tid]; if (cn) __hip_atomic_fetch_add(F.ctl + CW_GCOUNT + F.tid, cn, __ATOMIC_RELAXED, __HIP_MEMORY_SCOPE_AGENT); }
}

__device__ __forceinline__ void r2_rows(const Frame& F) {
    LAS unsigned* lh = (LAS unsigned*)F.lds;
    LAS unsigned* lbase = lh + 64;
    LAS unsigned* tstart = lh + 128;
    const int tid = F.tid;
    if (tid < 64) lh[tid] = 0u;
    __syncthreads();
    if (tid == 0) {
        unsigned ts = 0;
        for (int k = 0; k < 64; ++k) { tstart[k] = ts; const unsigned cn = __hip_atomic_load(F.ctl + CW_GCOUNT + k, __ATOMIC_RELAXED, __HIP_MEMORY_SCOPE_AGENT); ts += (cn + 255u) >> 8; if (k == 31) tstart[64 + 1] = ts; }
        tstart[64] = ts;
    }
    const int t = F.bid * 128 + (tid >> 1), sl = tid & 1;
    int bucket = 0; float w = 0.f;
    if (tid < 256) { bucket = F.TOKE[2 * t + sl]; w = F.TOKW[2 * t + sl]; __hip_atomic_fetch_add(lh + bucket, 1u, __ATOMIC_RELAXED, __HIP_MEMORY_SCOPE_WORKGROUP); }
    __syncthreads();
    if (tid < 64) { const unsigned cn = lh[tid]; unsigned base = 0; if (cn) base = __hip_atomic_fetch_add(F.ctl + CW_GCURSOR + tid, cn, __ATOMIC_RELAXED, __HIP_MEMORY_SCOPE_AGENT); lbase[tid] = tstart[tid] * 256u + base; }
    __syncthreads();
    if (tid < 64) lh[tid] = 0u;
    __syncthreads();
    if (tid < 256) { const unsigned rk = __hip_atomic_fetch_add(lh + bucket, 1u, __ATOMIC_RELAXED, __HIP_MEMORY_SCOPE_WORKGROUP); const unsigned p = lbase[bucket] + rk;
        if (p < (unsigned)MAXROWS) { F.ROWTOK[p] = t; F.ROWW[p] = w; } }
    if (F.bid == 0) {
        if (tid == 0) { ((int*)F.ctl)[CW_TINFO] = (int)tstart[65]; ((int*)F.ctl)[CW_TINFO + 1] = (int)tstart[64]; }
        if (tid < 64) { const unsigned a = tstart[tid], e = (tid == 63) ? tstart[64] : tstart[tid + 1]; for (unsigned p = a; p < e && p < 512u; ++p) ((int*)F.ctl)[CW_TILEB + p] = tid; }
    }
}

struct Args { const float* in[17]; float* out; unsigned char* ws; int ph_lo, ph_hi; };
constexpr int N_PHASES = 13;

__global__ void __launch_bounds__(NTHREADS, 2) mk_fwd(Args args) {
    extern __shared__ __attribute__((aligned(16))) unsigned char lds_raw[];
    Frame F;
    F.lds = (LAS unsigned char*)lds_raw;
    F.tid = threadIdx.x; F.lane = F.tid & 63; F.wave = __builtin_amdgcn_readfirstlane(F.tid >> 6); F.G = gridDim.x; F.bid = blockIdx.x;
    F.x = args.in[0]; F.c = args.in[1]; F.w_ada = args.in[2]; F.b_ada = args.in[3]; F.norm1_g = args.in[4]; F.w_in = args.in[5]; F.q_norm_g = args.in[6]; F.k_norm_g = args.in[7];
    F.w_pool = args.in[8]; F.pool_scale = args.in[9]; F.w_out = args.in[10]; F.norm2_g = args.in[11]; F.w_grp = args.in[12]; F.w_exp = args.in[13]; F.w1 = args.in[14]; F.w3 = args.in[15]; F.w2 = args.in[16];
    F.out = args.out;
    unsigned char* ws = args.ws;
    F.ctl = (unsigned*)(ws + WS_CTL); F.ADA = (float*)(ws + WS_ADA); F.ADAP = (float*)(ws + WS_ADAP); F.TAB = (float*)(ws + WS_TAB); F.WR = (bf16_t*)(ws + WS_WR); F.TOKE = (int*)(ws + WS_TOKE); F.TOKW = (float*)(ws + WS_TOKW);
    F.ROWTOK = (int*)(ws + WS_ROWTOK); F.ROWW = (float*)(ws + WS_ROWW); F.WI = (float*)(ws + WS_WI); F.KI = (bf16_t*)(ws + WS_KI);
    F.WPOOL = (bf16_t*)(ws + WS_WPOOL); F.WOUT = (bf16_t*)(ws + WS_WOUT); F.WIN = (bf16_t*)(ws + WS_WIN); F.W13 = (bf16_t*)(ws + WS_W13); F.W2 = (bf16_t*)(ws + WS_W2);
    F.H = (bf16_t*)(ws + WS_H); F.CONCAT = (bf16_t*)(ws + WS_H); F.PROJ = (bf16_t*)(ws + WS_X); F.SC = (unsigned short*)(ws + WS_X); F.Y0 = (bf16_t*)(ws + WS_X); F.DX = (bf16_t*)(ws + WS_X + 134217728);
    F.QB = (bf16_t*)(ws + WS_QB); F.ACT = (bf16_t*)(ws + WS_QB); F.KV = (bf16_t*)(ws + WS_KV); F.QI = (bf16_t*)(ws + WS_QI); F.PM = (bf16_t*)(ws + WS_PM); F.SEL = (unsigned short*)(ws + WS_SEL);

    volatile LAS unsigned* bst = (volatile LAS unsigned*)(F.lds + LDS_BYTES - 16);
    if (F.tid == 0) { bst[0] = 0u; bst[1] = 0u; bst[2] = 0u; bst[3] = 0u; }
    __syncthreads();
    XcdBarrier bar = xcd_barrier_post(F.ctl, bst, F.wave);
    const int lo = args.ph_lo, hi = args.ph_hi;
#define IN(k) (lo <= (k) && (k) < hi)
#define SEAM(k) do { if (IN(k) && IN((k) + 1)) xcd_barrier(bar); } while (0)

#define PH(k, ...) do { F.lane = fresh_lane(); F.tid = F.wave * 64 + F.lane; if (IN(k)) { for (int rep_ = 0; rep_ < 1 + ((REPEAT_MASK >> (k)) & 1); ++rep_) { __VA_ARGS__ } } SEAM(k); } while (0)
    PH(0, { p0_prologue(F); });
    PH(1, {
        if (F.tid < 192) { const int v = F.bid * 192 + F.tid; float s = 0.f; for (int kc = 0; kc < 32; ++kc) s += F.ADAP[(size_t)kc * 49152 + v]; F.ADA[v] = s; }
        LAS float* sl = (LAS float*)F.lds;
        { const int b = F.bid >> 6; for (int idx = F.tid; idx < 4096; idx += NTHREADS) { float s = 0.f; for (int kc = 0; kc < 32; ++kc) s += F.ADAP[(size_t)kc * 49152 + b * 12288 + idx]; sl[idx] = s; } }
        __syncthreads();
        norm_rows(F, F.x, nullptr, F.norm1_g, (const float*)sl, (const float*)(sl + 2048));
#if P1_PROBE == 1
        norm_rows(F, F.x, nullptr, F.norm1_g, (const float*)sl, (const float*)(sl + 2048));
#elif P1_PROBE == 2
        __syncthreads();
        { const int b = F.bid >> 6; for (int idx = F.tid; idx < 4096; idx += NTHREADS) { float s = 0.f; for (int kc = 0; kc < 32; ++kc) s += F.ADAP[(size_t)kc * 49152 + b * 12288 + idx]; sl[idx] = s; } }
#endif
        __syncthreads();
    });
    PH(2, {
        pg8::Gemm g{F.H, F.WIN, D}; pg8::StaticOrder So; So.init(T, 3584, F.G, F.bid, 1 + ((REPEAT_UNITS >> 2) & 1));
        pg8::EpiBf16 E{F.PROJ, NPROJ, 0};
        pg8::gemm_phase<pg8::EpiBf16, pg8::StaticOrder>(F.lds, g, So, E, F.tid);
    });
#if SELFCHECK
    F.lane = fresh_lane(); F.tid = F.wave * 64 + F.lane; if (IN(3)) { chk_gemm1(F); }
#endif
    PH(3, { p3_post(F); });
#if SELFCHECK
    F.lane = fresh_lane(); F.tid = F.wave * 64 + F.lane; if (IN(3)) { chk_post(F); if (IN(4)) xcd_barrier(bar); }
#endif
    PH(4, {
        {
            pg8::Gemm g{F.PM, F.WPOOL, 256}; pg8::PoolOrder So{F.G, F.bid};
            pg8::EpiBf16 E{F.CONCAT, D, 1};
            pg8::gemm_phase<pg8::EpiBf16, pg8::PoolOrder>(F.lds, g, So, E, F.tid);
        }
        indexer_units(F, F.bid, F.G, 4 * 2080);
    });
    PH(5, {
        LAS unsigned char* wbuf = F.lds + F.wave * 17920;
        u32x4 pre[16];
        int i = F.bid * 8 + F.wave;
        int t = (i & 1) ? (T - 1 - (i >> 1)) : (i >> 1);
        { const unsigned short* src = sel_src(F, t); const int n = (t & (S - 1)) + 1, nch = n > 256 ? (n + 511) >> 9 : 0;
          _Pragma("unroll") for (int ch = 0; ch < 16; ++ch) if (ch < nch) pre[ch] = *(const u32x4*)(src + ch * 512 + F.lane * 8); }
        for (; i < T; i += F.G * 8) {
            u32x4 cur[16];
            _Pragma("unroll") for (int ch = 0; ch < 16; ++ch) cur[ch] = pre[ch];
            const int tcur = t, inext = i + F.G * 8;
            if (inext < T) {
                t = (inext & 1) ? (T - 1 - (inext >> 1)) : (inext >> 1);
                const unsigned short* src = sel_src(F, t); const int n = (t & (S - 1)) + 1, nch = n > 256 ? (n + 511) >> 9 : 0;
                _Pragma("unroll") for (int ch = 0; ch < 16; ++ch) if (ch < nch) pre[ch] = *(const u32x4*)(src + ch * 512 + F.lane * 8);
            }
            select_row(F, tcur, cur, wbuf, F.lane);
        }
#if SEL_PROBE
        {
            unsigned accx = 0;
            for (int i2 = F.bid * 8 + F.wave; i2 < T; i2 += F.G * 8) {
                const int t2 = (i2 & 1) ? (T - 1 - (i2 >> 1)) : (i2 >> 1);
                const unsigned short* src = sel_src(F, t2); const int n = (t2 & (S - 1)) + 1, nch = n > 256 ? (n + 511) >> 9 : 0;
                u32x4 r[16];
                _Pragma("unroll") for (int ch = 0; ch < 16; ++ch) if (ch < nch) r[ch] = *(const u32x4*)(src + ch * 512 + F.lane * 8);
                _Pragma("unroll") for (int ch = 0; ch < 16; ++ch) if (ch < nch) accx ^= r[ch].x ^ r[ch].y ^ r[ch].z ^ r[ch].w;
            }
            if (accx == 0x12345678u) F.SEL[0] = 1;
        }
#endif
    });
    PH(6, {
        attn_items(F, 0, 32);
#if ATT_PROBE == 1
        attn_items(F, 0, 16);
#elif ATT_PROBE == 2
        attn_items(F, 16, 32);
#endif
    });
#if SELFCHECK
    F.lane = fresh_lane(); F.tid = F.wave * 64 + F.lane; if (IN(7)) { chk_attn(F); }
#endif
    PH(7, {
        pg8::Gemm g{F.CONCAT, F.WOUT, D}; pg8::StaticOrder So; So.init(T, D, F.G, F.bid, 1 + ((REPEAT_UNITS >> 7) & 1));
        pg8::EpiMix E{F.ADA, F.DX};
        pg8::gemm_phase<pg8::EpiMix, pg8::StaticOrder>(F.lds, g, So, E, F.tid);
    });
    PH(8, { r1_route(F); });
    PH(9, { r2_rows(F); });
    PH(10, {
        const int* ti = (const int*)F.ctl + CW_TINFO;
        pg8::Gemm g{F.H, F.W13, D}; pg8::MoeOrder<4, true> So{(const int*)F.ctl + CW_TILEB, F.ROWTOK, 0, ti[1], F.G, F.bid, 1 + ((REPEAT_UNITS >> 10) & 1)};
        pg8::EpiAct E{F.ACT};
        pg8::gemm_phase<pg8::EpiAct, pg8::MoeOrder<4, true>>(F.lds, g, So, E, F.tid);
    });
    PH(11, {
        const int* ti = (const int*)F.ctl + CW_TINFO;
        pg8::Gemm g{F.ACT, F.W2, 512}; pg8::MoeOrder<8, false> So{(const int*)F.ctl + CW_TILEB, F.ROWTOK, 0, ti[0], F.G, F.bid, 1};
        pg8::EpiMoeY0 E{F.ROWTOK, F.ROWW, F.ADA, F.Y0};
        pg8::gemm_phase<pg8::EpiMoeY0, pg8::MoeOrder<8, false>>(F.lds, g, So, E, F.tid);
    });
    PH(12, {
        const int* ti = (const int*)F.ctl + CW_TINFO;
        pg8::Gemm g{F.ACT, F.W2, 512}; pg8::MoeOrder<8, false> So{(const int*)F.ctl + CW_TILEB, F.ROWTOK, ti[0], ti[1], F.G, F.bid, 1};
        pg8::EpiMoeOut E{F.ROWTOK, F.ROWW, F.ADA, F.Y0, F.DX, F.x, F.out};
        pg8::gemm_phase<pg8::EpiMoeOut, pg8::MoeOrder<8, false>>(F.lds, g, So, E, F.tid);
    });
#undef PH
#if SELFCHECK
    if (IN(12)) {
        xcd_barrier(bar);
        if (F.bid == 0 && F.tid == 0) {
            float code = 0.f;
            for (int k = 0; k < 4; ++k) if (__hip_atomic_load(F.ctl + CW_CHK + k, __ATOMIC_RELAXED, __HIP_MEMORY_SCOPE_AGENT) != 0u) code += (float)(1 << k);
            if (code != 0.f) F.out[0] += 1.0e4f * code;
        }
    }
#endif
#undef IN
#undef SEAM
}

extern "C" void kernel_launch(void* const* d_in, const int* in_sizes, int n_in, void* d_out, int out_size, void* d_ws, size_t ws_size, hipStream_t stream) {
    static int grid = 0;
    if (grid == 0) {
        if (n_in != 17 || out_size != T * D || ws_size < WS_END) { fprintf(stderr, "kernel_launch: unexpected problem (n_in %d out %d ws %zu)\n", n_in, out_size, ws_size); grid = -1; return; }
        int dev = 0, cus = 0, per_cu = 0;
        if (hipGetDevice(&dev) != hipSuccess || hipDeviceGetAttribute(&cus, hipDeviceAttributeMultiprocessorCount, dev) != hipSuccess) { grid = -1; return; }
        if (hipFuncSetAttribute((const void*)mk_fwd, hipFuncAttributeMaxDynamicSharedMemorySize, LDS_BYTES) != hipSuccess) { fprintf(stderr, "kernel_launch: hipFuncSetAttribute failed\n"); grid = -1; return; }
        if (hipOccupancyMaxActiveBlocksPerMultiprocessor(&per_cu, (const void*)mk_fwd, NTHREADS, LDS_BYTES) != hipSuccess || per_cu < 1) { fprintf(stderr, "kernel_launch: occupancy query says %d\n", per_cu); }
        (void)hipGetLastError();
        grid = cus;
        if (grid != 256) { fprintf(stderr, "kernel_launch: built for 256 CUs, found %d\n", cus); grid = -1; return; }
    }
    if (grid < 0) return;
    (void)hipMemsetAsync((char*)d_ws + WS_CTL, 0, WS_ADA - WS_CTL, stream);
    (void)hipMemsetAsync((char*)d_ws + WS_ROWTOK, 0xFF, (size_t)MAXROWS * 4, stream);
    Args a{};
    for (int i = 0; i < 17; ++i) a.in[i] = (const float*)d_in[i];
    a.out = (float*)d_out; a.ws = (unsigned char*)d_ws;
#if MK_MULTI
    for (int p = 0; p < N_PHASES; ++p) { a.ph_lo = p; a.ph_hi = p + 1; hipLaunchKernelGGL(mk_fwd, dim3(grid), dim3(NTHREADS), LDS_BYTES, stream, a); }
#else
    a.ph_lo = 0; a.ph_hi = N_PHASES; hipLaunchKernelGGL(mk_fwd, dim3(grid), dim3(NTHREADS), LDS_BYTES, stream, a);
#endif
}
```

```cpp
#include <hip/hip_runtime.h>
#include <cstdio>
#include <cstdint>
#include <cstddef>

#ifndef MK_MULTI
#define MK_MULTI 0
#endif

#ifndef P5_PROBE
#define P5_PROBE 0
#endif
#ifndef P1_PROBE
#define P1_PROBE 0
#endif
#ifndef ATT_PROBE
#define ATT_PROBE 0
#endif
#ifndef SEL_PROBE
#define SEL_PROBE 0
#endif
#ifndef EPI_PROBE
#define EPI_PROBE 0
#endif
#ifndef SELFCHECK
#define SELFCHECK 0
#endif
#ifndef REPEAT_UNITS
#define REPEAT_UNITS 0
#endif
#ifndef REPEAT_MASK
#define REPEAT_MASK 0
#endif
#define LAS __attribute__((address_space(3)))
typedef unsigned short bf16_t;
typedef short bf16x8 __attribute__((ext_vector_type(8)));
typedef short s16x4 __attribute__((ext_vector_type(4)));
typedef float f32x4 __attribute__((ext_vector_type(4)));
typedef float f32x16 __attribute__((ext_vector_type(16)));
typedef unsigned u32x4 __attribute__((ext_vector_type(4)));
typedef unsigned u32x2 __attribute__((ext_vector_type(2)));
typedef __bf16 bf16v2 __attribute__((ext_vector_type(2)));
typedef _Float16 f16v2 __attribute__((ext_vector_type(2)));

constexpr int T = 32768, S = 8192, NB = 4, D = 2048;
constexpr int NPROJ = 3840;
constexpr int CQ = 0, CK = 1024, CV = 1280, CQI = 1536, CP = 2560, CKI = 3584, CWI = 3648;
constexpr int NTHREADS = 512;
constexpr int LDS_BYTES = 147456;
constexpr float NORM_EPS = 1e-6f;
constexpr size_t SC_BATCH = 34078720ull;
constexpr int MAXROWS = 81920;

constexpr size_t WS_CTL = 0;
constexpr size_t WS_ADA = 65536;
constexpr size_t WS_TAB = 262144;
constexpr size_t WS_WR = 1835008;
constexpr size_t WS_TOKE = 2031616;
constexpr size_t WS_TOKW = 2293760;
constexpr size_t WS_ROWTOK = 2555904;
constexpr size_t WS_ROWW = 2883584;
constexpr size_t WS_WI = 3211264;
constexpr size_t WS_KI = 5308416;
constexpr size_t WS_WPOOL = 9502720;
constexpr size_t WS_WOUT = 10027008;
constexpr size_t WS_WIN = 18415616;
constexpr size_t WS_W13 = 34144256;
constexpr size_t WS_W2 = 168361984;
constexpr size_t WS_H = 235470848;
constexpr size_t WS_X = 369688576;
constexpr size_t WS_QB = 642318336;
constexpr size_t WS_KV = 709427200;
constexpr size_t WS_QI = 742981632;
constexpr size_t WS_PM = 810090496;
constexpr size_t WS_SEL = 877199360;
constexpr size_t WS_ADAP = 893976576;
constexpr size_t WS_END = 900268032;
constexpr int CW_GCOUNT = 4096, CW_GCURSOR = 4160, CW_CHK = 4224, CW_TINFO = 4352, CW_TILEB = 4416;

__device__ __forceinline__ int fresh_lane() { int l; asm volatile("v_mbcnt_lo_u32_b32 %0, -1, 0\n\tv_mbcnt_hi_u32_b32 %0, -1, %0" : "=v"(l)); return l; }
__device__ __forceinline__ unsigned pk_bf16(float a, float b) { bf16v2 v; v.x = (__bf16)a; v.y = (__bf16)b; return __builtin_bit_cast(unsigned, v); }
__device__ __forceinline__ float bf_lo(unsigned u) { return __uint_as_float(u << 16); }
__device__ __forceinline__ float bf_hi(unsigned u) { return __uint_as_float(u & 0xffff0000u); }
__device__ __forceinline__ void unpack8(const u32x4 v, float* f) {
    f[0] = bf_lo(v.x); f[1] = bf_hi(v.x); f[2] = bf_lo(v.y); f[3] = bf_hi(v.y); f[4] = bf_lo(v.z); f[5] = bf_hi(v.z); f[6] = bf_lo(v.w); f[7] = bf_hi(v.w);
}
__device__ __forceinline__ u32x4 pack8(const float* f) { u32x4 v; v.x = pk_bf16(f[0], f[1]); v.y = pk_bf16(f[2], f[3]); v.z = pk_bf16(f[4], f[5]); v.w = pk_bf16(f[6], f[7]); return v; }
__device__ __forceinline__ u32x4 pack16_fp8(const float* f) {
    u32x4 v;
#pragma unroll
    for (int w = 0; w < 4; ++w) { int pk = __builtin_amdgcn_cvt_pk_fp8_f32(f[4 * w], f[4 * w + 1], 0, false); pk = __builtin_amdgcn_cvt_pk_fp8_f32(f[4 * w + 2], f[4 * w + 3], pk, true); v[w] = (unsigned)pk; }
    return v;
}
__device__ __forceinline__ float fp8_at(const unsigned char* p, size_t i) { typedef float f2 __attribute__((ext_vector_type(2))); const f2 r = __builtin_amdgcn_cvt_pk_f32_fp8((int)p[i], false); return r.x; }
__device__ __forceinline__ float wave_sum(float v) {
#pragma unroll
    for (int d = 32; d >= 1; d >>= 1) v += __shfl_xor(v, d);
    return v;
}

#define XB_TMO      128
#define XB_XCNT(j)  (256  + 64 * (j))
#define XB_XSUB(j)  (1280 + 64 * (j))
#define XB_XGEN(j)  (2304 + 64 * (j))
#define XB_TOP      3328
#define XB_TOPGEN   3392
#define XCD_BAR_WORDS 3456
#define XB_SPIN_CAP (1u << 23)

__device__ __forceinline__ unsigned xb_ld(unsigned* p)              { return __hip_atomic_load(p, __ATOMIC_RELAXED, __HIP_MEMORY_SCOPE_AGENT); }
__device__ __forceinline__ unsigned xb_add(unsigned* p, unsigned v) { return __hip_atomic_fetch_add(p, v, __ATOMIC_RELAXED, __HIP_MEMORY_SCOPE_AGENT); }
__device__ __forceinline__ unsigned xb_xcc_id() { return (unsigned)__builtin_amdgcn_s_getreg((3 << 11) | 20) & 0xFu; }
#define XB_SPIN(cond, bar) do { unsigned _sp = 0; while (cond) { __builtin_amdgcn_s_sleep(1); \
    if ((++_sp & 255u) == 0u) { if (xb_ld(&(bar)[XB_TMO])) break; if (_sp > XB_SPIN_CAP) { atomicAdd(&(bar)[XB_TMO], 1u); break; } } } } while (0)

struct XcdBarrier { unsigned* bar; unsigned x; volatile LAS unsigned* st; int wave; };

__device__ __forceinline__ XcdBarrier xcd_barrier_post(unsigned* bar, volatile LAS unsigned* st, int wave) {
    XcdBarrier b; b.bar = bar; b.x = xb_xcc_id(); b.st = st; b.wave = wave;
    if (threadIdx.x == 0) (void)xb_add(&bar[XB_XCNT(b.x)], 1u);
    return b;
}
__device__ __forceinline__ void xcd_barrier_complete(unsigned* bar, unsigned x, unsigned& nloc, unsigned& nx) {
    const unsigned G = gridDim.x * gridDim.y * gridDim.z;
    unsigned sum, cnt, mine, sp = 0u;
    for (;;) {
        sum = 0u; cnt = 0u; mine = 0u;
#pragma unroll
        for (unsigned j = 0; j < 16; ++j) { const unsigned c = xb_ld(&bar[XB_XCNT(j)]); sum += c; cnt += (c > 0u) ? 1u : 0u; mine = (j == x) ? c : mine; }
        if (sum == G) break;
        __builtin_amdgcn_s_sleep(1);
        if ((++sp & 255u) == 0u) { if (xb_ld(&bar[XB_TMO])) break; if (sp > XB_SPIN_CAP) { atomicAdd(&bar[XB_TMO], 1u); break; } }
    }
    nloc = mine > 0u ? mine : 1u; nx = cnt > 0u ? cnt : 1u;
}
__device__ __forceinline__ void xcd_barrier(const XcdBarrier& b) {
    asm volatile("s_waitcnt vmcnt(0)" ::: "memory");
    __syncthreads();
    if (b.wave == 0 && fresh_lane() == 0) {
        unsigned* bar = b.bar;
        __builtin_amdgcn_s_waitcnt(0);
        unsigned nloc = b.st[0], nx = b.st[1];
        if (nloc == 0u) { xcd_barrier_complete(bar, b.x, nloc, nx); b.st[0] = nloc; b.st[1] = nx; }
        const unsigned old = xb_add(&bar[XB_XSUB(b.x)], 1u);
        const unsigned gen = old / nloc;
        if (old + 1u == (gen + 1u) * nloc) {
            __builtin_amdgcn_fence(__ATOMIC_RELEASE, "agent");
            asm volatile("s_waitcnt vmcnt(0)" ::: "memory");
            const unsigned og = xb_add(&bar[XB_TOP], 1u);
            const unsigned tg = og / nx;
            if (og + 1u == (tg + 1u) * nx) xb_add(&bar[XB_TOPGEN], 1u);
            else XB_SPIN(xb_ld(&bar[XB_TOPGEN]) == tg, bar);
            __builtin_amdgcn_fence(__ATOMIC_ACQUIRE, "agent");
            xb_add(&bar[XB_XGEN(b.x)], 1u);
            asm volatile("s_waitcnt vmcnt(0)" ::: "memory");
        } else {
            XB_SPIN(xb_ld(&bar[XB_XGEN(b.x)]) == gen, bar);
            __builtin_amdgcn_fence(__ATOMIC_ACQUIRE, "agent");
            asm volatile("s_waitcnt vmcnt(0)" ::: "memory");
        }
    }
    __syncthreads();
}

struct Frame {
    LAS unsigned char* lds;
    int tid, lane, wave, G, bid;
    const float *x, *c, *w_ada, *b_ada, *norm1_g, *w_in, *q_norm_g, *k_norm_g, *w_pool, *pool_scale, *w_out, *norm2_g, *w_grp, *w_exp, *w1, *w3, *w2;
    float* out;
    unsigned* ctl;
    float* ADA; float* ADAP; float* TAB; bf16_t* WR; int* TOKE; float* TOKW; int* ROWTOK; float* ROWW; float* WI; bf16_t* KI;
    bf16_t *WPOOL, *WOUT, *WIN, *W13, *W2, *H, *PROJ; unsigned short* SC; bf16_t *QB, *KV, *QI, *PM, *ACT, *CONCAT; unsigned short* SEL;
    unsigned char *Q8, *KVm;
    bf16_t *Y0, *DX;
};

namespace pg8 {
constexpr int BM = 256, BK = 64, HALF = 128, HTB = HALF * BK * 2, STAGE_BYTES = 8 * HTB, NXCD = 8, WGM = 8;
__device__ __forceinline__ int lds_byte(int r, int c) { const int st = (r >> 4) * 2 + (c >> 5), rr = r & 15, cc = c & 31, ob = rr * 64 + cc * 2; return st * 1024 + (ob ^ (((ob >> 9) & 1) << 5)); }
__device__ __forceinline__ void stage_rc(int b, int& R, int& C) { const int st = b / 1024, sb = b % 1024, swz = sb ^ (((sb >> 9) & 1) << 5); R = (st >> 1) * 16 + swz / 64; C = (st & 1) * 32 + (swz % 64) / 2; }
__device__ __forceinline__ int perm32(int rho) { const int n = rho >> 4, i = rho & 15; return 8 * (i >> 2) + 4 * n + (i & 3); }
struct Unit { int pm, pn, rep; };
struct Gemm { const bf16_t* A; const bf16_t* Bt; int K; };

struct StaticOrder {
    int nM, nN, nwg, G, c, rep;
    __device__ void init(int M, int N, int G_, int c_, int rep_ = 1) { nM = M / BM; nN = N / BM; nwg = nM * nN; G = G_; c = c_; rep = rep_; }
    __device__ bool next(int i, Unit& u) const {
        long L = (long)i * G + c; if (L >= (long)nwg * rep) return false;
        u.rep = 0; if (L >= nwg) { L -= nwg; u.rep = 1; }
        int wgid = (int)L; { const int q = nwg / NXCD, r = nwg % NXCD, xcd = wgid % NXCD, off = wgid / NXCD; wgid = (xcd < r ? xcd * (q + 1) : r * (q + 1) + (xcd - r) * q) + off; }
        const int nig = WGM * nN, gid = wgid / nig, fm = gid * WGM, gsz = (nM - fm) < WGM ? (nM - fm) : WGM;
        u.pm = fm + ((wgid % nig) % gsz); u.pn = (wgid % nig) / gsz; return true;
    }
    __device__ __forceinline__ unsigned arow(const Unit& u, int rr) const { return (unsigned)(u.pm * BM + rr); }
};
struct PoolOrder {
    int G, c;
    __device__ bool next(int i, Unit& u) const { const int L = i * G + c; if (L >= 512) return false; u.pm = L; u.pn = L >> 7; u.rep = 0; return true; }
    __device__ __forceinline__ unsigned arow(const Unit& u, int rr) const { return (unsigned)(u.pm * BM + rr); }
};
template <int NC, bool GATHER> struct MoeOrder {
    const int* tileb; const int* rowtok; int lo, hi, G, c, rep;
    __device__ bool next(int i, Unit& u) const {
        int L = i * G + c; if (L >= (hi - lo) * NC * rep) return false;
        if (L >= (hi - lo) * NC) L -= (hi - lo) * NC;
        u.pm = lo + L / NC; const int e = tileb[u.pm] & 31; u.pn = e * NC + (L % NC); u.rep = 0; return true;
    }
    __device__ __forceinline__ unsigned arow(const Unit& u, int rr) const {
        if (GATHER) { const int tok = rowtok[u.pm * BM + rr]; return (unsigned)(tok < 0 ? 0 : tok); }
        return (unsigned)(u.pm * BM + rr);
    }
};

template <class Epi, class Sched>
__device__ __forceinline__ void gemm_phase(LAS unsigned char* lds, const Gemm g, const Sched& S, const Epi& E, const int tid) {
    const int wid = __builtin_amdgcn_readfirstlane(tid >> 6), lane = tid & 63, wr = wid >> 2, wc = wid & 3, fr = lane & 15, fq = lane >> 4;
    const int K = g.K, nt = K / BK;
    int R0, C0; stage_rc(tid * 16, R0, C0);
    unsigned voffB[2];
#pragma unroll
    for (int i = 0; i < 2; ++i) { const int R = R0 + 64 * i; const int Rb = Epi::PERM ? ((R & ~31) + perm32(R & 31)) : R; voffB[i] = (unsigned)(Rb * K + C0) * 2u; }
    const unsigned rowb = (unsigned)K * 2u, colb = (unsigned)C0 * 2u;
    const size_t kstep = (size_t)(BK * 2);
    const size_t hstep = (size_t)HALF * K * 2;
    const size_t tstep = 2 * hstep;
    const unsigned ldsw = (unsigned)wid * 1024u;
    const int aoff = lds_byte(wr * 64 + fr, fq * 8), boff = lds_byte(wc * 32 + fr, fq * 8);
#define PG8_SA(b, h) (((b) * 2 + (h)) * HTB)
#define PG8_SB(b, h) ((4 + (b) * 2 + (h)) * HTB)
#define PG8_STAGE(bufoff, gbase, voff) do { _Pragma("unroll") for (int _i = 0; _i < 2; ++_i) \
        __builtin_amdgcn_global_load_lds((const unsigned*)((const char*)(gbase) + (voff)[_i]), (LAS unsigned*)(lds + (bufoff) + ldsw + _i * 8192), 16, 0, 0); } while (0)
#define PG8_LDA(dst, b, h) do { _Pragma("unroll") for (int m = 0; m < 4; ++m) _Pragma("unroll") for (int k = 0; k < 2; ++k) dst[m][k] = *(const LAS bf16x8*)(lds + PG8_SA(b, h) + aoff + m * 2048 + k * 1024); } while (0)
#define PG8_LDB(dst, b, h) do { _Pragma("unroll") for (int n = 0; n < 2; ++n) _Pragma("unroll") for (int k = 0; k < 2; ++k) dst[n][k] = *(const LAS bf16x8*)(lds + PG8_SB(b, h) + boff + n * 2048 + k * 1024); } while (0)
#define PG8_MMA(ai, bj, At, Bt) do { __builtin_amdgcn_s_setprio(1); _Pragma("unroll") for (int m = 0; m < 4; ++m) _Pragma("unroll") for (int n = 0; n < 2; ++n) _Pragma("unroll") for (int k = 0; k < 2; ++k) \
        acc[ai][bj][m][n] = __builtin_amdgcn_mfma_f32_16x16x32_bf16(Bt[n][k], At[m][k], acc[ai][bj][m][n], 0, 0, 0); __builtin_amdgcn_s_setprio(0); } while (0)
#define PG8_WAIT_V(n) asm volatile("s_waitcnt vmcnt(" #n ")" ::: "memory")
#define PG8_WAIT_L(n) asm volatile("s_waitcnt lgkmcnt(" #n ")" ::: "memory")
#define PG8_BAR __builtin_amdgcn_s_barrier()
#define PG8_SCHED __builtin_amdgcn_sched_barrier(0)
#define PG8_ROWS(dst, u) do { _Pragma("unroll") for (int _h = 0; _h < 2; ++_h) _Pragma("unroll") for (int _i = 0; _i < 2; ++_i) dst[_h][_i] = S.arow(u, _h * HALF + R0 + 64 * _i) * rowb + colb; } while (0)
    Unit cur, nxt; int ui = 0;
    if (!S.next(0, cur)) return;
    f32x4 acc[2][2][4][2];
#pragma unroll
    for (int a = 0; a < 2; ++a)
#pragma unroll
        for (int b = 0; b < 2; ++b)
#pragma unroll
            for (int m = 0; m < 4; ++m)
#pragma unroll
                for (int n = 0; n < 2; ++n) acc[a][b][m][n] = (f32x4){0.f, 0.f, 0.f, 0.f};
    bf16x8 At[4][2], B0[2][2], B1[2][2];
    unsigned oc[2][2], on[2][2];
    PG8_ROWS(oc, cur);
    const char* gA = (const char*)g.A;
    const char* cB = (const char*)g.Bt + (size_t)cur.pn * tstep;
    PG8_STAGE(PG8_SB(0, 0), cB, voffB); PG8_STAGE(PG8_SA(0, 0), gA, oc[0]); PG8_STAGE(PG8_SB(0, 1), cB + hstep, voffB); PG8_STAGE(PG8_SA(0, 1), gA, oc[1]);
    if (wr == 1) PG8_BAR;
    PG8_WAIT_V(4); PG8_BAR;
    PG8_STAGE(PG8_SB(1, 0), cB + kstep, voffB); PG8_STAGE(PG8_SA(1, 0), gA + kstep, oc[0]); PG8_STAGE(PG8_SB(1, 1), cB + hstep + kstep, voffB);
    PG8_WAIT_V(6); PG8_BAR;
    const int tpre = nt >= 4 ? nt - 4 : nt - 2;
    for (;;) {
        const bool has_next = S.next(ui + 1, nxt);
#pragma unroll
        for (int h = 0; h < 2; ++h)
#pragma unroll
            for (int i = 0; i < 2; ++i) on[h][i] = oc[h][i];
        const char* nB = has_next ? (const char*)g.Bt + (size_t)nxt.pn * tstep : cB;
        for (int t = 0; t < nt; t += 2) {
            const bool last = (t == nt - 2);
            if (has_next && t == tpre) PG8_ROWS(on, nxt);
            const char* a1 = gA + (size_t)(t + 1) * kstep;
            const char* a2 = last ? gA : gA + (size_t)(t + 2) * kstep; const char* b2 = last ? nB : cB + (size_t)(t + 2) * kstep;
            const char* a3 = a2 + kstep; const char* b3 = b2 + kstep;
            unsigned o2[2][2];
#pragma unroll
            for (int h = 0; h < 2; ++h)
#pragma unroll
                for (int i = 0; i < 2; ++i) o2[h][i] = last ? on[h][i] : oc[h][i];
            PG8_LDB(B0, 0, 0); PG8_SCHED; PG8_LDA(At, 0, 0); PG8_STAGE(PG8_SA(1, 1), a1, oc[1]);
            PG8_WAIT_L(8); PG8_BAR; PG8_WAIT_L(0); PG8_MMA(0, 0, At, B0); PG8_BAR; PG8_SCHED;
            PG8_LDB(B1, 0, 1); PG8_STAGE(PG8_SB(0, 0), b2, voffB);
            PG8_BAR; PG8_WAIT_L(0); PG8_MMA(0, 1, At, B1); PG8_BAR;
            PG8_LDA(At, 0, 1); PG8_STAGE(PG8_SA(0, 0), a2, o2[0]);
            PG8_BAR; PG8_WAIT_L(0); PG8_MMA(1, 0, At, B0); PG8_BAR; PG8_SCHED;
            PG8_STAGE(PG8_SB(0, 1), b2 + hstep, voffB);
            PG8_WAIT_V(6); PG8_BAR; PG8_MMA(1, 1, At, B1); PG8_BAR;
            PG8_LDB(B0, 1, 0); PG8_SCHED; PG8_LDA(At, 1, 0); PG8_STAGE(PG8_SA(0, 1), a2, o2[1]);
            PG8_WAIT_L(8); PG8_BAR; PG8_WAIT_L(0); PG8_MMA(0, 0, At, B0); PG8_BAR; PG8_SCHED;
            PG8_LDB(B1, 1, 1); PG8_STAGE(PG8_SB(1, 0), b3, voffB);
            PG8_BAR; PG8_WAIT_L(0); PG8_MMA(0, 1, At, B1); PG8_BAR;
            PG8_LDA(At, 1, 1); PG8_STAGE(PG8_SA(1, 0), a3, o2[0]);
            PG8_BAR; PG8_WAIT_L(0); PG8_MMA(1, 0, At, B0); PG8_BAR; PG8_SCHED;
            PG8_STAGE(PG8_SB(1, 1), b3 + hstep, voffB);
            PG8_WAIT_V(6); PG8_BAR; PG8_MMA(1, 1, At, B1); PG8_BAR;
        }
        E(acc, cur, wr, wc, fr, fq);
        if (!has_next) break;
#pragma unroll
        for (int a = 0; a < 2; ++a)
#pragma unroll
            for (int b = 0; b < 2; ++b)
#pragma unroll
                for (int m = 0; m < 4; ++m)
#pragma unroll
                    for (int n = 0; n < 2; ++n) acc[a][b][m][n] = (f32x4){0.f, 0.f, 0.f, 0.f};
        cur = nxt; cB = nB; ++ui;
#pragma unroll
        for (int h = 0; h < 2; ++h)
#pragma unroll
            for (int i = 0; i < 2; ++i) oc[h][i] = on[h][i];
    }
    PG8_WAIT_V(0);
    if (wr == 0) PG8_BAR;
    PG8_BAR;
#undef PG8_SA
#undef PG8_SB
#undef PG8_STAGE
#undef PG8_LDA
#undef PG8_LDB
#undef PG8_MMA
#undef PG8_WAIT_V
#undef PG8_WAIT_L
#undef PG8_BAR
#undef PG8_SCHED
#undef PG8_ROWS
}

struct EpiBf16 {
    static constexpr bool PERM = true;
    bf16_t* O; int ldc; int mode;
    __device__ __forceinline__ void operator()(const f32x4 (&acc)[2][2][4][2], const Unit& u, int wr, int wc, int fr, int fq) const {
        const int rowb = (mode == 1 ? (u.pm & 127) : u.pm) * BM, colb = (mode == 1 ? 1024 : 0) + u.pn * BM;
        const int row0 = rowb + wr * 64 + fr, col0 = colb + wc * 32 + 8 * fq;
#pragma unroll
        for (int ai = 0; ai < 2; ++ai)
#pragma unroll
            for (int m = 0; m < 4; ++m) { bf16_t* rowp = O + (size_t)(row0 + ai * HALF + m * 16) * ldc + col0;
#pragma unroll
                for (int bj = 0; bj < 2; ++bj) { const f32x4 v0 = acc[ai][bj][m][0], v1 = acc[ai][bj][m][1];
                    u32x4 w; w.x = pk_bf16(v0[0], v0[1]); w.y = pk_bf16(v0[2], v0[3]); w.z = pk_bf16(v1[0], v1[1]); w.w = pk_bf16(v1[2], v1[3]);
                    if (!(EPI_PROBE && u.rep) || (w.x ^ w.w) == 0x12345678u) *(u32x4*)(rowp + bj * HALF) = w; } }
    }
};
struct EpiMix {
    static constexpr bool PERM = true;
    const float* ada; bf16_t* DX;
    __device__ __forceinline__ void operator()(const f32x4 (&acc)[2][2][4][2], const Unit& u, int wr, int wc, int fr, int fq) const {
        const int row0 = u.pm * BM + wr * 64 + fr, col0 = u.pn * BM + wc * 32 + 8 * fq;
        const float* gate = ada + (size_t)(u.pm >> 5) * 12288 + 2 * 2048 + col0;
        f32x4 gv[2][2];
#pragma unroll
        for (int bj = 0; bj < 2; ++bj)
#pragma unroll
            for (int n = 0; n < 2; ++n) gv[bj][n] = *(const f32x4*)(gate + bj * HALF + 4 * n);
#pragma unroll
        for (int ai = 0; ai < 2; ++ai)
#pragma unroll
            for (int m = 0; m < 4; ++m) { bf16_t* rowp = DX + (size_t)(row0 + ai * HALF + m * 16) * D + col0;
#pragma unroll
                for (int bj = 0; bj < 2; ++bj) { const f32x4 v0 = gv[bj][0] * acc[ai][bj][m][0], v1 = gv[bj][1] * acc[ai][bj][m][1];
                    u32x4 w; w.x = pk_bf16(v0[0], v0[1]); w.y = pk_bf16(v0[2], v0[3]); w.z = pk_bf16(v1[0], v1[1]); w.w = pk_bf16(v1[2], v1[3]);
                    *(u32x4*)(rowp + bj * HALF) = w; } }
    }
};
struct EpiAct {
    static constexpr bool PERM = true;
    bf16_t* ACT;
    __device__ __forceinline__ void operator()(const f32x4 (&acc)[2][2][4][2], const Unit& u, int wr, int wc, int fr, int fq) const {
        const int row0 = u.pm * BM + wr * 64 + fr, col0 = (u.pn & 3) * 128 + wc * 32 + 8 * fq;
#pragma unroll
        for (int ai = 0; ai < 2; ++ai)
#pragma unroll
            for (int m = 0; m < 4; ++m) {
                float v[8];
#pragma unroll
                for (int n = 0; n < 2; ++n)
#pragma unroll
                    for (int e = 0; e < 4; ++e) { const float a = acc[ai][0][m][n][e], b = acc[ai][1][m][n][e]; v[n * 4 + e] = a / (1.0f + __expf(-a)) * b; }
                *(u32x4*)(ACT + (size_t)(row0 + ai * HALF + m * 16) * 512 + col0) = pack8(v);
            }
    }
};
struct EpiMoeY0 {
    static constexpr bool PERM = true;
    const int* rowtok; const float* roww; const float* ada; bf16_t* Y0;
    __device__ __forceinline__ void operator()(const f32x4 (&acc)[2][2][4][2], const Unit& u, int wr, int wc, int fr, int fq) const {
        const int row0 = u.pm * BM + wr * 64 + fr, col0 = (u.pn & 7) * BM + wc * 32 + 8 * fq;
        int tk[8]; float wt[8];
#pragma unroll
        for (int r = 0; r < 8; ++r) { const int row = row0 + (r >> 2) * HALF + (r & 3) * 16; tk[r] = rowtok[row]; wt[r] = roww[row]; }
#pragma unroll
        for (int r = 0; r < 8; ++r) { const int ai = r >> 2, m = r & 3; const int tok = tk[r] < 0 ? 0 : tk[r]; const float w = tk[r] < 0 ? 0.f : wt[r];
            const float* gate = ada + (size_t)(tok >> 13) * 12288 + 5 * 2048 + col0; bf16_t* yp = Y0 + (size_t)tok * D + col0;
            u32x4 o[2];
#pragma unroll
            for (int bj = 0; bj < 2; ++bj) { const f32x4 g0 = *(const f32x4*)(gate + bj * HALF), g1 = *(const f32x4*)(gate + bj * HALF + 4);
                const f32x4 v0 = g0 * w * acc[ai][bj][m][0], v1 = g1 * w * acc[ai][bj][m][1];
                o[bj].x = pk_bf16(v0[0], v0[1]); o[bj].y = pk_bf16(v0[2], v0[3]); o[bj].z = pk_bf16(v1[0], v1[1]); o[bj].w = pk_bf16(v1[2], v1[3]); }
            if (tk[r] >= 0) { *(u32x4*)yp = o[0]; *(u32x4*)(yp + HALF) = o[1]; } }
    }
};
struct EpiMoeOut {
    static constexpr bool PERM = false;
    const int* rowtok; const float* roww; const float* ada; const bf16_t* Y0; const bf16_t* DX; const float* x; float* out;
    __device__ __forceinline__ void operator()(const f32x4 (&acc)[2][2][4][2], const Unit& u, int wr, int wc, int fr, int fq) const {
        const int row0 = u.pm * BM + wr * 64 + fr, col0 = (u.pn & 7) * BM + wc * 32 + 4 * fq;
        int tk[8]; float wt[8];
#pragma unroll
        for (int r = 0; r < 8; ++r) { const int row = row0 + (r >> 2) * HALF + (r & 3) * 16; tk[r] = rowtok[row]; wt[r] = roww[row]; }
#pragma unroll
        for (int r = 0; r < 8; ++r) { const int ai = r >> 2, m = r & 3; const int tok = tk[r] < 0 ? 0 : tk[r]; const float w = wt[r];
            const float* gate = ada + (size_t)(tok >> 13) * 12288 + 5 * 2048 + col0; float* op = out + (size_t)tok * D + col0; const float* xp = x + (size_t)tok * D + col0;
            const bf16_t* yp = Y0 + (size_t)tok * D + col0; const bf16_t* dp = DX + (size_t)tok * D + col0;
            f32x4 gvv[4], xv[4]; u32x2 yv[4], dv[4];
#pragma unroll
            for (int q = 0; q < 4; ++q) { const int off = (q >> 1) * HALF + (q & 1) * 16; gvv[q] = *(const f32x4*)(gate + off); xv[q] = *(const f32x4*)(xp + off); yv[q] = *(const u32x2*)(yp + off); dv[q] = *(const u32x2*)(dp + off); }
            if (tk[r] >= 0) {
#pragma unroll
                for (int q = 0; q < 4; ++q) { const int off = (q >> 1) * HALF + (q & 1) * 16; f32x4 o = xv[q];
                    o += (f32x4){bf_lo(dv[q].x), bf_hi(dv[q].x), bf_lo(dv[q].y), bf_hi(dv[q].y)}; o += (f32x4){bf_lo(yv[q].x), bf_hi(yv[q].x), bf_lo(yv[q].y), bf_hi(yv[q].y)} + gvv[q] * w * acc[ai][q >> 1][m][q & 1];
                    *(f32x4*)(op + off) = o; } } }
    }
};
}

__device__ __forceinline__ int colmap(int n) { return n < 2560 ? n : (n < 2624 ? 3584 + (n - 2560) : (n < 2640 ? 3648 + (n - 2624) : 2560 + (n - 2640))); }

template <class RowMap>
__device__ __forceinline__ void tr_tile(const Frame& F, const float* src, size_t ldS, int k0, int n0, int N, const float* cscale, RowMap rm) {
    LAS float* tile = (LAS float*)F.lds;
    const int tid = F.tid, r = tid >> 4, c4 = tid & 15;
    f32x4 v[4];
    const int n = n0 + c4 * 4;
#pragma unroll
    for (int i = 0; i < 4; ++i) v[i] = (n < N) ? *(const f32x4*)(src + (size_t)(k0 + r + 32 * i) * ldS + n) : (f32x4){0.f, 0.f, 0.f, 0.f};
    __syncthreads();
#pragma unroll
    for (int i = 0; i < 4; ++i)
#pragma unroll
        for (int e = 0; e < 4; ++e) tile[(r + 32 * i) * 65 + c4 * 4 + e] = v[i][e];
    __syncthreads();
    const int nn = tid >> 3, kc = tid & 7;
    if (n0 + nn < N) {
        const float sc = cscale ? cscale[n0 + nn] : 1.0f;
        float f[16];
#pragma unroll
        for (int j = 0; j < 16; ++j) f[j] = tile[(kc * 16 + j) * 65 + nn] * sc;
        bf16_t* d = rm(n0 + nn) + k0 + kc * 16;
        *(u32x4*)d = pack8(f); *(u32x4*)(d + 8) = pack8(f + 8);
    }
}

__device__ __forceinline__ void p0_prologue(const Frame& F) {
    constexpr int U_ADA = 192, T_WIN = 16 * 58, T_WOUT = 16 * 32, T_POOL = 4 * 2 * 4, T_W1 = 32 * 128, T_W2 = 32 * 128, U_TAB = 16, U_WR = 4, U_PAD = 2;
    constexpr int B0 = U_ADA, B1 = B0 + T_WIN, B2 = B1 + T_WOUT, B3 = B2 + T_POOL, B4 = B3 + T_W1, B5 = B4 + T_W1, B6 = B5 + T_W2, B7 = B6 + U_TAB, B8 = B7 + U_WR, B9 = B8 + U_PAD;
    const int tid = F.tid;
    constexpr int NTILE = B6 - B0;
    static_assert(NTILE == 13760, "tile split");
    const int nmine = 1 + 50 + (F.bid >= 192 ? 15 : 0);
    for (int it = 0; it < nmine; ++it) {
        int u;
        if (it == 0) { u = F.bid < 192 ? F.bid : (F.bid - 192 < 22 ? B6 + (F.bid - 192) : -1); if (u < 0) continue; }
        else if (it <= 50) u = B0 + F.bid + 256 * (it - 1);
        else u = B0 + 12800 + (F.bid - 192) + 64 * (it - 51);
        if (u < B0) {
            const int kc = u / 6, cb = u % 6;
            LAS float* sc = (LAS float*)F.lds;
            __syncthreads();
            if (tid < 256) { const int b = tid >> 6, k = tid & 63; const float cv = F.c[b * D + kc * 64 + k]; sc[tid] = cv / (1.0f + __expf(-cv)); }
            __syncthreads();
            const int n = cb * 2048 + tid * 4;
            f32x4 a[4];
#pragma unroll
            for (int b = 0; b < 4; ++b) a[b] = (f32x4){0.f, 0.f, 0.f, 0.f};
            const float* wp = F.w_ada + (size_t)(kc * 64) * 12288 + n;
#pragma unroll 8
            for (int k = 0; k < 64; ++k) { const f32x4 w = *(const f32x4*)(wp + (size_t)k * 12288);
#pragma unroll
                for (int b = 0; b < 4; ++b) a[b] += sc[b * 64 + k] * w; }
            const f32x4 bias = (kc == 0) ? *(const f32x4*)(F.b_ada + n) : (f32x4){0.f, 0.f, 0.f, 0.f};
#pragma unroll
            for (int b = 0; b < 4; ++b) *(f32x4*)(F.ADAP + ((size_t)kc * 4 + b) * 12288 + n) = a[b] + bias;
        } else if (u < B1) {
            const int v = u - B0, kt = v / 58, ntl = v % 58; bf16_t* W = F.WIN;
            tr_tile(F, F.w_in, 3664, kt * 128, ntl * 64, 3664, nullptr, [=](int n) { return W + (size_t)colmap(n) * 2048; });
        } else if (u < B2) {
            const int v = u - B1, kt = v / 32, ntl = v % 32; bf16_t* W = F.WOUT;
            tr_tile(F, F.w_out, 2048, kt * 128, ntl * 64, 2048, nullptr, [=](int n) { return W + (size_t)n * 2048; });
        } else if (u < B3) {
            const int v = u - B2, g = v / 8, kt = (v % 8) / 4, ntl = v % 4; bf16_t* W = F.WPOOL + (size_t)g * 256 * 256;
            tr_tile(F, F.w_pool + (size_t)g * 65536, 256, kt * 128, ntl * 64, 256, F.pool_scale + g * 256, [=](int n) { return W + (size_t)n * 256; });
        } else if (u < B5) {
            const bool is3 = u >= B4; const int v = u - (is3 ? B4 : B3), e = v / 128, kt = (v % 128) / 8, ntl = v % 8;
            bf16_t* W = F.W13 + (size_t)e * 1024 * 2048 + (is3 ? (size_t)128 * 2048 : 0);
            tr_tile(F, (is3 ? F.w3 : F.w1) + (size_t)e * 2048 * 512, 512, kt * 128, ntl * 64, 512, nullptr, [=](int n) { return W + (size_t)((n >> 7) * 256 + (n & 127)) * 2048; });
        } else if (u < B6) {
            const int v = u - B5, e = v / 128, kt = (v % 128) / 32, ntl = v % 32; bf16_t* W = F.W2 + (size_t)e * 2048 * 512;
            tr_tile(F, F.w2 + (size_t)e * 512 * 2048, 2048, kt * 128, ntl * 64, 2048, nullptr, [=](int n) { return W + (size_t)n * 512; });
        } else if (u < B7) {
            const int pos = (u - B6) * 512 + tid; float* tp = F.TAB + (size_t)pos * 48;
            for (int i = 0; i < 16; ++i) { const double inv = pow(500000.0, -(double)(2 * i) / 32.0); double sn, cs; sincos((double)pos * inv, &sn, &cs); tp[i] = (float)cs; tp[16 + i] = (float)sn; }
            for (int i = 0; i < 8; ++i) { const double inv = pow(500000.0, -(double)(2 * i) / 16.0); double sn, cs; sincos((double)pos * inv, &sn, &cs); tp[32 + i] = (float)cs; tp[40 + i] = (float)sn; }
        } else if (u < B8) {
            const int j0 = (u - B7) * 12;
            for (int idx = tid; idx < 12 * 2048; idx += NTHREADS) { const int j = j0 + idx / 2048, k = idx % 2048;
                const float v = j < 4 ? F.w_grp[k * 4 + j] : (j < 36 ? F.w_exp[k * 32 + (j - 4)] : 0.f);
                bf16v2 t; t.x = (__bf16)v; t.y = (__bf16)0.f; F.WR[(size_t)j * 2048 + k] = (bf16_t)(__builtin_bit_cast(unsigned, t) & 0xffffu); }
        } else {
            const int h = u - B8; u32x4* p = (u32x4*)(F.WIN + (size_t)3664 * 2048) + (size_t)h * 22528;
            for (int i = tid; i < 22528; i += NTHREADS) p[i] = (u32x4){0u, 0u, 0u, 0u};
        }
    }
}

__device__ __forceinline__ size_t qi_off(size_t t, int head, int d) { return (t >> 1) * 2048 + (size_t)((d >> 4) * 512 + (((head & 3) + 4 * (int)(t & 1) + 8 * (head >> 2)) + 32 * ((d >> 3) & 1)) * 8 + (d & 7)); }
__device__ __forceinline__ size_t ki_off(size_t s, int d) { const int kin = (int)(s & 127); return (s >> 7) * 8192 + (size_t)(((kin & 3) * 4 + (d >> 4)) * 512 + ((kin >> 2) + 32 * ((d >> 3) & 1)) * 8 + (d & 7)); }

__device__ __forceinline__ void norm_rows(const Frame& F, const float* src, const bf16_t* delta, const float* gain, const float* shiftp, const float* scalep) {
    const int lane = F.lane;
    f32x4 Gv[8], Sv[8];
#pragma unroll
    for (int i = 0; i < 8; ++i) { const int col = 4 * lane + 256 * i; const f32x4 g = *(const f32x4*)(gain + col), sc = *(const f32x4*)(scalep + col);
        Gv[i] = g * (1.0f + sc); Sv[i] = *(const f32x4*)(shiftp + col); }
    f32x4 v[8], vn[8]; u32x2 dv[8], dn[8];
    { const size_t ro = (size_t)(F.bid * 128 + F.wave) * D;
#pragma unroll
      for (int i = 0; i < 8; ++i) { v[i] = *(const f32x4*)(src + ro + 4 * lane + 256 * i); if (delta) dv[i] = *(const u32x2*)(delta + ro + 4 * lane + 256 * i); } }
    for (int j = 0; j < 16; ++j) {
        const int t = F.bid * 128 + F.wave + 8 * j;
        if (j < 15) { const size_t ro = (size_t)(t + 8) * D;
#pragma unroll
            for (int i = 0; i < 8; ++i) { vn[i] = *(const f32x4*)(src + ro + 4 * lane + 256 * i); if (delta) dn[i] = *(const u32x2*)(delta + ro + 4 * lane + 256 * i); } }
        if (delta) {
#pragma unroll
            for (int i = 0; i < 8; ++i) v[i] += (f32x4){bf_lo(dv[i].x), bf_hi(dv[i].x), bf_lo(dv[i].y), bf_hi(dv[i].y)}; }
        float ss = 0.f;
#pragma unroll
        for (int i = 0; i < 8; ++i) ss += v[i][0] * v[i][0] + v[i][1] * v[i][1] + v[i][2] * v[i][2] + v[i][3] * v[i][3];
        ss = wave_sum(ss);
        const float rstd = rsqrtf(ss * (1.0f / 2048.0f) + NORM_EPS);
        bf16_t* hr = F.H + (size_t)t * D;
#pragma unroll
        for (int i = 0; i < 8; ++i) { const f32x4 y = v[i] * rstd * Gv[i] + Sv[i]; u32x2 w; w.x = pk_bf16(y[0], y[1]); w.y = pk_bf16(y[2], y[3]); *(u32x2*)(hr + 4 * lane + 256 * i) = w; }
        if (j < 15) {
#pragma unroll
            for (int i = 0; i < 8; ++i) { v[i] = vn[i]; dv[i] = dn[i]; } }
    }
}

__device__ __forceinline__ void p3_post(const Frame& F) {
    const int lane = F.lane;
    LAS float* kw = (LAS float*)F.lds + F.wave * 1280;
    {
        const int li = lane & 15, q4 = lane >> 4;
        f32x4 acc[5];
#pragma unroll
        for (int nb = 0; nb < 5; ++nb) acc[nb] = (f32x4){0.f, 0.f, 0.f, 0.f};
        const bf16_t* hp = F.H + (size_t)(F.bid * 128 + F.wave * 16 + li) * D + 8 * q4;
        LAS bf16_t* bs = (LAS bf16_t*)(F.lds + 40960);
        for (int kc = 0; kc < 8; ++kc) {
            u32x4 st[5];
#pragma unroll
            for (int i = 0; i < 5; ++i) { const int piece = F.tid + 512 * i, row = piece >> 5, pc = piece & 31; st[i] = *(const u32x4*)(F.WIN + (size_t)(3584 + row) * D + kc * 256 + pc * 8); }
            bf16x8 a[8];
#pragma unroll
            for (int ks = 0; ks < 8; ++ks) a[ks] = *(const bf16x8*)(hp + 32 * (kc * 8 + ks));
            __syncthreads();
#pragma unroll
            for (int i = 0; i < 5; ++i) { const int piece = F.tid + 512 * i, row = piece >> 5, pc = piece & 31; *(LAS u32x4*)(bs + row * 264 + pc * 8) = st[i]; }
            __syncthreads();
#pragma unroll
            for (int ks = 0; ks < 8; ++ks)
#pragma unroll
                for (int nb = 0; nb < 5; ++nb) { const bf16x8 bb = *(const LAS bf16x8*)(bs + (nb * 16 + li) * 264 + ks * 32 + 8 * q4); acc[nb] = __builtin_amdgcn_mfma_f32_16x16x32_bf16(a[ks], bb, acc[nb], 0, 0, 0); }
        }
#pragma unroll
        for (int nb = 0; nb < 5; ++nb)
#pragma unroll
            for (int i = 0; i < 4; ++i) kw[(4 * q4 + i) * 80 + nb * 16 + li] = acc[nb][i];
        asm volatile("s_waitcnt lgkmcnt(0)" ::: "memory");
    }
    const float IDX_SCALE = 0.125f * 0.25f;
    float gq[16], gk[16];
#pragma unroll
    for (int e = 0; e < 16; ++e) { gq[e] = F.q_norm_g[(lane & 7) * 16 + e]; gk[e] = F.k_norm_g[(lane & 7) * 16 + e]; }
    float wsum[16];
    for (int j = 0; j < 16; ++j) {
        const int t = F.bid * 128 + F.wave * 16 + j, pos = t & (S - 1);
        const bf16_t* pr = F.PROJ + (size_t)t * NPROJ;
        const float* tab = F.TAB + (size_t)pos * 48;
        const int gpl = lane >> 4, wpl = 2 << gpl;
        const u32x4 Lq0 = *(const u32x4*)(pr + CQ + 16 * lane), Lq1 = *(const u32x4*)(pr + CQ + 16 * lane + 8);
        const u32x4 Lk0 = *(const u32x4*)(pr + CK + 16 * (lane & 31)), Lk1 = *(const u32x4*)(pr + CK + 16 * (lane & 31) + 8);
        const u32x4 Li0 = *(const u32x4*)(pr + CQI + 16 * lane), Li1 = *(const u32x4*)(pr + CQI + 16 * lane + 8);
        const u32x4 Lp0 = *(const u32x4*)(pr + CP + 16 * lane), Lp1 = *(const u32x4*)(pr + CP + 16 * lane + 8);
        f32x4 tq[8], ti[4];
#pragma unroll
        for (int i = 0; i < 8; ++i) tq[i] = *(const f32x4*)(tab + 4 * i);
#pragma unroll
        for (int i = 0; i < 4; ++i) ti[i] = *(const f32x4*)(tab + 32 + 4 * i);
        u32x4 Lo0, Lo1;
        { const int rr = wpl <= pos ? wpl : pos; const bf16_t* pp = pr - (size_t)rr * NPROJ + CP + 16 * lane; Lo0 = *(const u32x4*)pp; Lo1 = *(const u32x4*)(pp + 8); }
        {
            float f[16]; unpack8(Lq0, f); unpack8(Lq1, f + 8);
            float ss = 0.f;
#pragma unroll
            for (int e = 0; e < 16; ++e) ss += f[e] * f[e];
            ss += __shfl_xor(ss, 1); ss += __shfl_xor(ss, 2); ss += __shfl_xor(ss, 4);
            const float rstd = rsqrtf(ss * (1.0f / 128.0f) + NORM_EPS);
            const int d0 = (lane & 7) * 16;
#pragma unroll
            for (int e = 0; e < 16; ++e) f[e] = f[e] * rstd * gq[e];
            float o[16];
#pragma unroll
            for (int e = 0; e < 16; ++e) o[e] = __shfl_xor(f[e], 1);
            const int l8 = lane & 7;
            if (l8 < 2) {
#pragma unroll
                for (int e = 0; e < 16; ++e) { const float cs = tq[e >> 2][e & 3], sn = tq[4 + (e >> 2)][e & 3]; f[e] = (l8 == 0) ? (f[e] * cs - o[e] * sn) : (f[e] * cs + o[e] * sn); }
            }
            *(u32x4*)(F.Q8 + (size_t)t * 1024 + 16 * lane) = pack16_fp8(f);
        }
        {
            const int l = lane & 31;
            float f[16]; unpack8(Lk0, f); unpack8(Lk1, f + 8);
            float kf[16]; float ss = 0.f;
#pragma unroll
            for (int e = 0; e < 16; ++e) ss += f[e] * f[e];
            ss += __shfl_xor(ss, 1); ss += __shfl_xor(ss, 2); ss += __shfl_xor(ss, 4);
            const float rstd = rsqrtf(ss * (1.0f / 128.0f) + NORM_EPS);
            const int d0 = (l & 7) * 16;
#pragma unroll
            for (int e = 0; e < 16; ++e) kf[e] = f[e] * rstd * gk[e];
            float o[16];
#pragma unroll
            for (int e = 0; e < 16; ++e) o[e] = __shfl_xor(kf[e], 1);
            const int l8 = l & 7;
            if (l8 < 2) {
#pragma unroll
                for (int e = 0; e < 16; ++e) { const float cs = tq[e >> 2][e & 3], sn = tq[4 + (e >> 2)][e & 3]; kf[e] = (l8 == 0) ? (kf[e] * cs - o[e] * sn) : (kf[e] * cs + o[e] * sn); }
            }
            if (lane < 32) {
                const bool isv = lane >= 16; const int ll = lane & 15, g = ll >> 3, dd = (ll & 7) * 16;
                *(u32x4*)(F.KVm + (size_t)t * 512 + g * 256 + (isv ? 128 : 0) + dd) = pack16_fp8(isv ? f : kf);
            }
        }
        {
            float f[16]; unpack8(Li0, f); unpack8(Li1, f + 8);
            if ((lane & 3) == 0) {
#pragma unroll
                for (int i = 0; i < 8; ++i) { const float cs = ti[i >> 2][i & 3], sn = ti[2 + (i >> 2)][i & 3]; const float x1 = f[i], x2 = f[i + 8]; f[i] = x1 * cs - x2 * sn; f[i + 8] = x2 * cs + x1 * sn; }
            }
            const int hd = lane >> 2, d0 = (lane & 3) * 16;
            *(u32x4*)(F.QI + qi_off((size_t)t, hd, d0)) = pack8(f); *(u32x4*)(F.QI + qi_off((size_t)t, hd, d0 + 8)) = pack8(f + 8);
        }
        if (lane < 5) {
            float f[16];
#pragma unroll
            for (int e = 0; e < 16; ++e) f[e] = kw[j * 80 + 16 * lane + e];
            if (lane == 0) {
#pragma unroll
                for (int i = 0; i < 8; ++i) { const float cs = ti[i >> 2][i & 3], sn = ti[2 + (i >> 2)][i & 3]; const float x1 = f[i], x2 = f[i + 8]; f[i] = x1 * cs - x2 * sn; f[i + 8] = x2 * cs + x1 * sn; }
            }
            if (lane < 4) { *(u32x4*)(F.KI + ki_off((size_t)t, 16 * lane)) = pack8(f); *(u32x4*)(F.KI + ki_off((size_t)t, 16 * lane + 8)) = pack8(f + 8); }
            else { float* wo = F.WI + (size_t)t * 16;
#pragma unroll
                for (int e = 0; e < 16; ++e) wo[e] = f[e] * IDX_SCALE; }
        }
        {
            const int g = lane >> 4, w = 2 << g;
            float cur[16], sum[16];
            unpack8(Lp0, cur); unpack8(Lp1, cur + 8);
            if (j == 0) {
#pragma unroll
                for (int e = 0; e < 16; ++e) wsum[e] = cur[e];
                for (int r = 1; r < 16; ++r) {
                    if (r < w && r <= pos) { float f[16]; const bf16_t* pp = pr - (size_t)r * NPROJ + CP + 16 * lane; unpack8(*(const u32x4*)pp, f); unpack8(*(const u32x4*)(pp + 8), f + 8);
#pragma unroll
                        for (int e = 0; e < 16; ++e) wsum[e] += f[e]; }
                }
            } else {
                float old[16]; unpack8(Lo0, old); unpack8(Lo1, old + 8);
                const float useo = (pos >= w) ? 1.0f : 0.0f;
#pragma unroll
                for (int e = 0; e < 16; ++e) wsum[e] += cur[e] - useo * old[e];
            }
            const float inv = 1.0f / (float)((pos + 1) < w ? (pos + 1) : w);
#pragma unroll
            for (int e = 0; e < 16; ++e) sum[e] = wsum[e] * inv - cur[e];
            bf16_t* po = F.PM + ((size_t)g * T + t) * 256 + (lane & 15) * 16;
            *(u32x4*)po = pack8(sum); *(u32x4*)(po + 8) = pack8(sum + 8);
        }
    }
}

__device__ __forceinline__ size_t sc_block_base(int b, int qb) { return (size_t)b * SC_BATCH + (size_t)16384 * ((size_t)qb * (qb + 1) / 2); }

__device__ __forceinline__ void indexer_sweep(const Frame& F) {
    const int lane = F.lane, wid = F.wave, c = lane & 31, hf = lane >> 5;
    const int b = F.bid >> 6, j0 = F.bid & 63;
    LAS unsigned char* kbuf = F.lds;
    for (int half = 0; half < 2; ++half) {
        const int qb64 = half == 0 ? j0 : 127 - j0, nkb = (qb64 >> 1) + 1, qb128 = qb64 >> 1;
        const size_t tq0 = (size_t)b * S + qb64 * 64 + wid * 8;
        bf16x8 af[4][4]; f32x4 wv[4][4];
#pragma unroll
        for (int p = 0; p < 4; ++p) {
#pragma unroll
            for (int kk = 0; kk < 4; ++kk) af[p][kk] = *(const bf16x8*)(F.QI + ((tq0 >> 1) + p) * 2048 + kk * 512 + lane * 8);
#pragma unroll
            for (int i = 0; i < 4; ++i) wv[p][i] = *(const f32x4*)(F.WI + (tq0 + 2 * p + hf) * 16 + 4 * i);
        }
        const size_t rowlen = (size_t)(qb128 + 1) * 128;
        unsigned short* scb = F.SC + sc_block_base(b, qb128) + (size_t)((qb64 & 1) * 64 + wid * 8 + hf) * rowlen + 4 * c;
        const bf16_t* kib = F.KI + (((size_t)b * S) >> 7) * 8192 + (2 * wid) * 512 + lane * 8;
        __syncthreads();
#define IX_DMA(kb) do { _Pragma("unroll") for (int _i = 0; _i < 2; ++_i) \
            __builtin_amdgcn_global_load_lds((const unsigned*)(kib + (size_t)(kb) * 8192 + _i * 512), (LAS unsigned*)(kbuf + ((kb) & 1) * 16384 + (2 * wid + _i) * 1024), 16, 0, 0); } while (0)
        IX_DMA(0);
        for (int kb = 0; kb < nkb; ++kb) {
            if (kb == 0) asm volatile("s_waitcnt vmcnt(0)" ::: "memory"); else asm volatile("s_waitcnt vmcnt(4)" ::: "memory");
            __syncthreads();
            if (kb + 1 < nkb) IX_DMA(kb + 1);
            float sc[4][4];
            bf16x8 kf[2][4];
#pragma unroll
            for (int kk = 0; kk < 4; ++kk) kf[0][kk] = *(const LAS bf16x8*)(kbuf + (kb & 1) * 16384 + kk * 1024 + lane * 16);
            f32x16 accs[2];
#pragma unroll
            for (int i = 0; i < 16; ++i) accs[0][i] = 0.f;
#pragma unroll
            for (int kk = 0; kk < 4; ++kk) accs[0] = __builtin_amdgcn_mfma_f32_32x32x16_bf16(af[0][kk], kf[0][kk], accs[0], 0, 0, 0);
#pragma unroll
            for (int n = 0; n < 16; ++n) {
                const int sub = n >> 2, p = n & 3;
                if (p == 0 && sub < 3) {
#pragma unroll
                    for (int kk = 0; kk < 4; ++kk) kf[(sub + 1) & 1][kk] = *(const LAS bf16x8*)(kbuf + (kb & 1) * 16384 + ((sub + 1) * 4 + kk) * 1024 + lane * 16);
                }
                if (n < 15) {
                    const int sub1 = (n + 1) >> 2, p1 = (n + 1) & 3;
#pragma unroll
                    for (int i = 0; i < 16; ++i) accs[(n + 1) & 1][i] = 0.f;
#pragma unroll
                    for (int kk = 0; kk < 4; ++kk) accs[(n + 1) & 1] = __builtin_amdgcn_mfma_f32_32x32x16_bf16(af[p1][kk], kf[sub1 & 1][kk], accs[(n + 1) & 1], 0, 0, 0);
                }
                float sm = 0.f;
#pragma unroll
                for (int i = 0; i < 16; ++i) { const float av = accs[n & 1][i]; const int ai = __float_as_int(av); const float rl = __int_as_float(ai > 0 ? ai : 0); const float wi_ = wv[p][i >> 2][i & 3];
                    asm("v_fmac_f32 %0, %1, %2" : "+v"(sm) : "v"(wi_), "v"(rl)); }
                sc[p][sub] = sm;
            }
#pragma unroll
            for (int p = 0; p < 4; ++p) {
                f16v2 h0, h1; h0.x = (_Float16)sc[p][0]; h0.y = (_Float16)sc[p][1]; h1.x = (_Float16)sc[p][2]; h1.y = (_Float16)sc[p][3];
                u32x2 w; w.x = __builtin_bit_cast(unsigned, h0); w.y = __builtin_bit_cast(unsigned, h1);
                *(u32x2*)(scb + (size_t)(2 * p) * rowlen + kb * 128) = w;
            }
        }
#undef IX_DMA
    }
    __syncthreads();
}

__device__ __forceinline__ void find_bin(LAS unsigned* hist, int lane, unsigned need, unsigned& bin, unsigned& above) {
    const u32x4 h = *(const LAS u32x4*)(hist + 4 * lane);
    const unsigned s = h.x + h.y + h.z + h.w;
    unsigned v = s;
#pragma unroll
    for (int d = 1; d < 64; d <<= 1) { const unsigned tt = __shfl_down(v, d); if (lane + d < 64) v += tt; }
    unsigned run = v - s;
    int fb = -1; unsigned fa = 0;
    const unsigned hh[4] = {h.x, h.y, h.z, h.w};
#pragma unroll
    for (int j = 3; j >= 0; --j) { if (fb < 0 && run < need && run + hh[j] >= need) { fb = 4 * lane + j; fa = run; } run += hh[j]; }
    const unsigned long long m = __ballot(fb >= 0);
    const int src = m ? (int)__builtin_ctzll(m) : 0;
    bin = (unsigned)__shfl(fb, src); above = __shfl(fa, src);
}

__device__ __forceinline__ unsigned okey(unsigned h) { return (h & 0x8000u) ? (~h & 0xffffu) : (h | 0x8000u); }
__device__ __forceinline__ const unsigned short* sel_src(const Frame& F, int t) { const int pos = t & (S - 1), qb = pos >> 7; return F.SC + sc_block_base(t >> 13, qb) + (size_t)(pos & 127) * (qb + 1) * 128; }
__device__ __forceinline__ void select_row(const Frame& F, int t, const u32x4 (&pre)[16], LAS unsigned char* wbuf, int lane) {
    LAS unsigned* rowb = (LAS unsigned*)wbuf;
    LAS unsigned* hist = (LAS unsigned*)(wbuf + 16384);
    LAS unsigned short* lst = (LAS unsigned short*)(wbuf + 16384 + 1024);
    const int pos = t & (S - 1), n = pos + 1;
    unsigned short* out = F.SEL + (size_t)t * 256;
    if (n <= 256) { for (int j = lane; j < 256; j += 64) out[j] = (unsigned short)(j < n ? j : 0); return; }
    const int nch = (n + 511) >> 9;
#pragma unroll
    for (int ch = 0; ch < 16; ++ch) if (ch < nch) *(LAS u32x4*)(rowb + ch * 256 + lane * 4) = pre[ch];
#pragma unroll
    for (int i = 0; i < 4; ++i) hist[lane + 64 * i] = 0u;
    for (int ch = 0; ch < nch; ++ch) {
        const int base = ch * 512 + lane * 8;
        u32x4 raw = *(const LAS u32x4*)(rowb + ch * 256 + lane * 4);
#pragma unroll
        for (int w = 0; w < 4; ++w) {
            const unsigned k0 = (base + 2 * w < n) ? okey(raw[w] & 0xffffu) : 0u, k1 = (base + 2 * w + 1 < n) ? okey(raw[w] >> 16) : 0u;
            __hip_atomic_fetch_add(hist + (k0 >> 8), 1u, __ATOMIC_RELAXED, __HIP_MEMORY_SCOPE_WORKGROUP);
            __hip_atomic_fetch_add(hist + (k1 >> 8), 1u, __ATOMIC_RELAXED, __HIP_MEMORY_SCOPE_WORKGROUP);
            raw[w] = k0 | (k1 << 16);
        }
        *(LAS u32x4*)(rowb + ch * 256 + lane * 4) = raw;
    }
#if P5_PROBE == 1
    for (int ch = 0; ch < nch; ++ch) {
        const u32x4 raw = *(const LAS u32x4*)(rowb + ch * 256 + lane * 4);
#pragma unroll
        for (int w = 0; w < 4; ++w) {
            __hip_atomic_fetch_add(hist + ((raw[w] & 0xffffu) >> 8), 0u, __ATOMIC_RELAXED, __HIP_MEMORY_SCOPE_WORKGROUP);
            __hip_atomic_fetch_add(hist + (raw[w] >> 24), 0u, __ATOMIC_RELAXED, __HIP_MEMORY_SCOPE_WORKGROUP);
        }
    }
#endif
    unsigned bin1, above1; find_bin(hist, lane, 256u, bin1, above1);
    const unsigned r1 = 256u - above1;
#pragma unroll
    for (int i = 0; i < 4; ++i) hist[lane + 64 * i] = 0u;
    for (int ch = 0; ch < nch; ++ch) {
        const u32x4 raw = *(const LAS u32x4*)(rowb + ch * 256 + lane * 4);
#pragma unroll
        for (int w = 0; w < 4; ++w) {
            const unsigned k0 = raw[w] & 0xffffu, k1 = raw[w] >> 16;
            if ((k0 >> 8) == bin1) __hip_atomic_fetch_add(hist + (k0 & 255u), 1u, __ATOMIC_RELAXED, __HIP_MEMORY_SCOPE_WORKGROUP);
            if ((k1 >> 8) == bin1) __hip_atomic_fetch_add(hist + (k1 & 255u), 1u, __ATOMIC_RELAXED, __HIP_MEMORY_SCOPE_WORKGROUP);
        }
    }
    unsigned bin2, above2; find_bin(hist, lane, r1, bin2, above2);
#if P5_PROBE == 4
    { unsigned bx, ax; find_bin(hist, lane, r1, bx, ax); if (bx != bin2) bin2 = bx; find_bin(hist, lane, r1, bx, ax); if (bx != bin2) bin2 = bx; }
#endif
    const unsigned r2 = r1 - above2, thr = (bin1 << 8) | bin2;
    unsigned cg = 0, ce = 0;
    for (int ch = 0; ch < nch; ++ch) {
        const u32x4 raw = *(const LAS u32x4*)(rowb + ch * 256 + lane * 4);
#pragma unroll
        for (int e = 0; e < 8; ++e) { const unsigned key = (raw[e >> 1] >> ((e & 1) * 16)) & 0xffffu; cg += (key > thr) ? 1u : 0u; ce += (key == thr) ? 1u : 0u; }
    }
#if P5_PROBE == 2
    { unsigned cg2 = 0, ce2 = 0;
      for (int ch = 0; ch < nch; ++ch) {
        const u32x4 raw = *(const LAS u32x4*)(rowb + ch * 256 + lane * 4);
#pragma unroll
        for (int e = 0; e < 8; ++e) { const unsigned key = (raw[e >> 1] >> ((e & 1) * 16)) & 0xffffu; cg2 += (key > thr + 1u) ? 1u : 0u; ce2 += (key == thr + 1u) ? 1u : 0u; }
      }
      if (cg2 + ce2 == 0xffffffffu) cg += 1u; }
#endif
    unsigned og = cg, oe = ce;
#pragma unroll
    for (int d = 1; d < 64; d <<= 1) { const unsigned tg = __shfl_up(og, d), te = __shfl_up(oe, d); if (lane >= d) { og += tg; oe += te; } }
    og -= cg; oe -= ce;
    const unsigned G = above1 + above2;
    for (int ch = 0; ch < nch; ++ch) {
        const u32x4 raw = *(const LAS u32x4*)(rowb + ch * 256 + lane * 4);
#pragma unroll
        for (int e = 0; e < 8; ++e) {
            const unsigned key = (raw[e >> 1] >> ((e & 1) * 16)) & 0xffffu;
            const unsigned short id = (unsigned short)(ch * 512 + lane * 8 + e);
            if (key > thr) { if (og < 256u) lst[og] = id; ++og; }
            if (key == thr) { if (oe < r2 && G + oe < 256u) lst[G + oe] = id; ++oe; }
        }
    }
    *(u32x2*)(out + 4 * lane) = *(const LAS u32x2*)(lst + 4 * lane);
}

__device__ __forceinline__ bf16x8 tr_read2(unsigned a0, unsigned a1) {
    s16x4 x, y;
    asm volatile("ds_read_b64_tr_b16 %0, %2\n\tds_read_b64_tr_b16 %1, %3\n\ts_waitcnt lgkmcnt(0)" : "=&v"(x), "=&v"(y) : "v"(a0), "v"(a1) : "memory");
    return (bf16x8){x[0], x[1], x[2], x[3], y[0], y[1], y[2], y[3]};
}

__device__ __forceinline__ void tr_read16(const unsigned (&va)[4], s16x4 (&r)[16]) {
    asm volatile(
        "ds_read_b64_tr_b16 %0, %16\n\tds_read_b64_tr_b16 %1, %16 offset:4096\n\tds_read_b64_tr_b16 %2, %17\n\tds_read_b64_tr_b16 %3, %17 offset:4096\n\t"
        "ds_read_b64_tr_b16 %4, %18\n\tds_read_b64_tr_b16 %5, %18 offset:4096\n\tds_read_b64_tr_b16 %6, %19\n\tds_read_b64_tr_b16 %7, %19 offset:4096\n\t"
        "ds_read_b64_tr_b16 %8, %16 offset:512\n\tds_read_b64_tr_b16 %9, %16 offset:4608\n\tds_read_b64_tr_b16 %10, %17 offset:512\n\tds_read_b64_tr_b16 %11, %17 offset:4608\n\t"
        "ds_read_b64_tr_b16 %12, %18 offset:512\n\tds_read_b64_tr_b16 %13, %18 offset:4608\n\tds_read_b64_tr_b16 %14, %19 offset:512\n\tds_read_b64_tr_b16 %15, %19 offset:4608\n\t"
        "s_waitcnt lgkmcnt(0)"
        : "=&v"(r[0]), "=&v"(r[1]), "=&v"(r[2]), "=&v"(r[3]), "=&v"(r[4]), "=&v"(r[5]), "=&v"(r[6]), "=&v"(r[7]),
          "=&v"(r[8]), "=&v"(r[9]), "=&v"(r[10]), "=&v"(r[11]), "=&v"(r[12]), "=&v"(r[13]), "=&v"(r[14]), "=&v"(r[15])
        : "v"(va[0]), "v"(va[1]), "v"(va[2]), "v"(va[3]) : "memory");
}
#define AT_WAITV(n) asm volatile("s_waitcnt vmcnt(" #n ")" ::: "memory")
__device__ __forceinline__ int rot_k(int p) { return ((p & 1) ? 3 : 1) + ((p >> 2) & 1) * 4; }
__device__ __forceinline__ int rot_v(int r) { return ((r >> 1) & 3) + 4 * ((r >> 4) & 1); }
__device__ __forceinline__ void tr8_read8(const unsigned (&va)[8], long (&r)[8]) {
    asm volatile(
        "ds_read_b64_tr_b8 %0, %8\n\tds_read_b64_tr_b8 %1, %9\n\tds_read_b64_tr_b8 %2, %10\n\tds_read_b64_tr_b8 %3, %11\n\t"
        "ds_read_b64_tr_b8 %4, %12\n\tds_read_b64_tr_b8 %5, %13\n\tds_read_b64_tr_b8 %6, %14\n\tds_read_b64_tr_b8 %7, %15\n\ts_waitcnt lgkmcnt(0)"
        : "=&v"(r[0]), "=&v"(r[1]), "=&v"(r[2]), "=&v"(r[3]), "=&v"(r[4]), "=&v"(r[5]), "=&v"(r[6]), "=&v"(r[7])
        : "v"(va[0]), "v"(va[1]), "v"(va[2]), "v"(va[3]), "v"(va[4]), "v"(va[5]), "v"(va[6]), "v"(va[7]) : "memory");
}
__device__ __forceinline__ void attn_items(const Frame& F, int klo, int khi) {
    typedef long i64x2 __attribute__((ext_vector_type(2)));
    const float QSCALE = 0.08838834764831845f * 1.4426950408889634f;
    const int lane = F.lane, li = lane & 15, q4 = lane >> 4;
    const int xg = F.bid & 7, b = xg >> 1, g = xg & 1;
    const int wq = (F.bid >> 3) * 8 + F.wave;
    LAS unsigned char* wb = F.lds + F.wave * 16384;
    const unsigned wbu = (unsigned)(uintptr_t)wb;
    const unsigned char* kvb = F.KVm + (size_t)b * S * 512 + g * 256;
    const int da = lane >> 3, dr = lane & 7;
    const unsigned kra0 = (unsigned)((li >> 3) * 1024 + (8 * (li & 7) + ((q4 - rot_k(li >> 1)) & 7)) * 16);
    unsigned vrb; int vrot;
    { const int q = li >> 1, p = li & 1, R = q < 4 ? 4 * q4 + q : 16 + 4 * q4 + (q - 4); vrb = wbu + 8192u + (unsigned)((R >> 3) * 1024 + (R & 7) * 128 + 8 * p); vrot = 8 - rot_v(R); }
#define AT_KDMA(c) do { _Pragma("unroll") for (int _j = 0; _j < 2; ++_j) { const int _row = 8 * _j + da; const int _ix = (__shfl(idx2[(c) >> 1], _row) >> (((c) & 1) * 16)) & 0xffff; \
        __builtin_amdgcn_global_load_lds((const unsigned*)(kvb + (unsigned)(_ix * 512 + 16 * ((dr + rot_k(_row >> 1)) & 7))), (LAS unsigned*)(wb + ((c) & 3) * 2048 + _j * 1024), 16, 0, 0); } } while (0)
#define AT_VDMA(ks) do { _Pragma("unroll") for (int _j = 0; _j < 4; ++_j) { const int _row = 8 * _j + da; const int _ix = (__shfl(idx2[ks], _row & 15) >> ((_j >> 1) * 16)) & 0xffff; \
        __builtin_amdgcn_global_load_lds((const unsigned*)(kvb + (unsigned)(_ix * 512 + 128 + 16 * ((dr + rot_v(_row)) & 7))), (LAS unsigned*)(wb + 8192 + ((ks) & 1) * 4096 + _j * 1024), 16, 0, 0); } } while (0)
    int nv0[8], nv1[8]; i64x2 nbq[2];
#define AT_FETCH(kk_) do { const size_t _t = (size_t)(b * S + wq + 256 * (kk_)); \
        _Pragma("unroll") for (int _i = 0; _i < 8; ++_i) { nv0[_i] = F.SEL[_t * 256 + 32 * _i + li]; nv1[_i] = F.SEL[_t * 256 + 32 * _i + 16 + li]; } \
        _Pragma("unroll") for (int _sp = 0; _sp < 2; ++_sp) { nbq[_sp] = (i64x2){0, 0}; if (li < 4) nbq[_sp] = *(const i64x2*)(F.Q8 + _t * 1024 + (4 * g + li) * 128 + 16 * (q4 + 4 * _sp)); } } while (0)
    AT_FETCH(klo);
    for (int k = klo; k < khi; ++k) {
        const int pos = wq + 256 * k, t = b * S + pos, cnt = (pos + 1) < 256 ? (pos + 1) : 256;
        int idx2[8]; long bq[4];
#pragma unroll
        for (int i = 0; i < 8; ++i) { const int s0 = 32 * i + li, s1 = s0 + 16; idx2[i] = (s0 < cnt ? nv0[i] : 0) | ((s1 < cnt ? nv1[i] : 0) << 16); }
        bq[0] = nbq[0].x; bq[1] = nbq[0].y; bq[2] = nbq[1].x; bq[3] = nbq[1].y;
        if (k + 1 < khi) AT_FETCH(k + 1);
        AT_KDMA(0); AT_KDMA(1); AT_KDMA(2); AT_VDMA(0); AT_VDMA(1);
        f32x4 s[16];
#pragma unroll
        for (int c = 0; c < 16; ++c) {
            if (c <= 2) AT_WAITV(12); else if (c <= 13) AT_WAITV(4); else if (c == 14) AT_WAITV(2); else AT_WAITV(0);
            f32x4 acc = (f32x4){0.f, 0.f, 0.f, 0.f};
            const i64x2 a0 = *(const LAS i64x2*)(wb + (c & 3) * 2048 + kra0), a1 = *(const LAS i64x2*)(wb + (c & 3) * 2048 + (kra0 ^ 64u));
            acc = __builtin_amdgcn_mfma_f32_16x16x32_fp8_fp8(a0.x, bq[0], acc, 0, 0, 0);
            acc = __builtin_amdgcn_mfma_f32_16x16x32_fp8_fp8(a0.y, bq[1], acc, 0, 0, 0);
            acc = __builtin_amdgcn_mfma_f32_16x16x32_fp8_fp8(a1.x, bq[2], acc, 0, 0, 0);
            acc = __builtin_amdgcn_mfma_f32_16x16x32_fp8_fp8(a1.y, bq[3], acc, 0, 0, 0);
            s[c] = acc;
            asm volatile("s_waitcnt lgkmcnt(0)" ::: "memory");
            if (c + 3 <= 15) AT_KDMA(c + 3);
            __builtin_amdgcn_sched_barrier(0);
        }
        float m = -INFINITY;
#pragma unroll
        for (int c = 0; c < 16; ++c)
#pragma unroll
            for (int i = 0; i < 4; ++i) { const int slot = c * 16 + 4 * q4 + i; if (slot >= cnt) s[c][i] = -INFINITY; m = fmaxf(m, s[c][i]); }
        m = fmaxf(m, __shfl_xor(m, 16)); m = fmaxf(m, __shfl_xor(m, 32));
        const float mq = m * QSCALE;
        float sum = 0.f;
#pragma unroll
        for (int c = 0; c < 16; ++c)
#pragma unroll
            for (int i = 0; i < 4; ++i) { const float p = exp2f(fmaf(s[c][i], QSCALE, -mq)); s[c][i] = p; sum += p; }
        sum += __shfl_xor(sum, 16); sum += __shfl_xor(sum, 32);
        f32x4 o[8];
#pragma unroll
        for (int d = 0; d < 8; ++d) o[d] = (f32x4){0.f, 0.f, 0.f, 0.f};
#pragma unroll
        for (int ks = 0; ks < 8; ++ks) {
            int p0 = __builtin_amdgcn_cvt_pk_fp8_f32(s[2 * ks][0], s[2 * ks][1], 0, false); p0 = __builtin_amdgcn_cvt_pk_fp8_f32(s[2 * ks][2], s[2 * ks][3], p0, true);
            int p1 = __builtin_amdgcn_cvt_pk_fp8_f32(s[2 * ks + 1][0], s[2 * ks + 1][1], 0, false); p1 = __builtin_amdgcn_cvt_pk_fp8_f32(s[2 * ks + 1][2], s[2 * ks + 1][3], p1, true);
            const long bp = (long)(((unsigned long long)(unsigned)p1 << 32) | (unsigned long long)(unsigned)p0);
            if (ks < 7) AT_WAITV(4); else AT_WAITV(0);
            unsigned va[8];
#pragma unroll
            for (int d = 0; d < 8; ++d) va[d] = vrb + (unsigned)((ks & 1) * 4096) + (unsigned)(((vrot + d) & 7) << 4);
            long tr[8];
            tr8_read8(va, tr);
#pragma unroll
            for (int d = 0; d < 8; ++d) o[d] = __builtin_amdgcn_mfma_f32_16x16x32_fp8_fp8(tr[d], bp, o[d], 0, 0, 0);
            if (ks + 2 <= 7) AT_VDMA(ks + 2);
            __builtin_amdgcn_sched_barrier(0);
        }
        const float inv = 1.0f / sum;
        if (li < 4) {
            bf16_t* op = F.CONCAT + (size_t)t * D + g * 512 + li * 128 + 4 * q4;
#pragma unroll
            for (int d = 0; d < 8; ++d) { u32x2 w; w.x = pk_bf16(o[d][0] * inv, o[d][1] * inv); w.y = pk_bf16(o[d][2] * inv, o[d][3] * inv); *(u32x2*)(op + d * 16) = w; }
        }
    }
#undef AT_FETCH
#undef AT_KDMA
#undef AT_VDMA
}

#if SELFCHECK
__device__ __forceinline__ float bfv(const bf16_t* p, size_t i) { return __uint_as_float(((unsigned)p[i]) << 16); }
__device__ __forceinline__ unsigned hash_u(unsigned x) { x ^= x >> 16; x *= 0x7feb352dU; x ^= x >> 15; x *= 0x846ca68bU; x ^= x >> 16; return x; }
__device__ __forceinline__ void chk_flag(const Frame& F, int k) { __hip_atomic_fetch_add(F.ctl + CW_CHK + k, 1u, __ATOMIC_RELAXED, __HIP_MEMORY_SCOPE_AGENT); }
__device__ __forceinline__ void chk_gemm1(const Frame& F) {
    for (int j = 0; j < 16; ++j) {
        const unsigned hsh = hash_u((unsigned)((F.bid * 8 + F.wave) * 16 + j) * 2654435761u + 12345u);
        const int t = (int)(hsh % (unsigned)T), n = (int)((hsh >> 7) % 3664u);
        float s = 0.f, sa = 0.f;
        for (int k = F.lane; k < D; k += 64) { const float a = bfv(F.H, (size_t)t * D + k), w = F.w_in[(size_t)k * 3664 + n]; s += a * w; sa += fabsf(a * w); }
        s = wave_sum(s); sa = wave_sum(sa);
        const float got = colmap(n) < 3584 ? bfv(F.PROJ, (size_t)t * NPROJ + colmap(n)) : s;
        if (F.lane == 0 && !(fabsf(got - s) <= 0.001f * sa + 0.02f)) chk_flag(F, 0);
    }
}
__device__ __forceinline__ void chk_post(const Frame& F) {
    const int gw = F.bid * 8 + F.wave;
    const int t = (gw * 16 + (gw & 15)) % T, pos = t & (S - 1), lane = F.lane;
    const bf16_t* pr = F.PROJ + (size_t)t * NPROJ;
    const float QSCALE = 0.08838834764831845f * 1.4426950408889634f;
    int bad = 0;
    for (int hh = 0; hh < 10; ++hh) {
        const int cb = hh < 8 ? CQ + hh * 128 : CK + (hh - 8) * 128; const float* gn = hh < 8 ? F.q_norm_g : F.k_norm_g;
        float ss = 0.f; for (int d = lane; d < 128; d += 64) { const float v = bfv(pr, cb + d); ss += v * v; } ss = wave_sum(ss);
        const float rstd = 1.0f / sqrtf(ss / 128.0f + NORM_EPS);
        for (int d = lane; d < 128; d += 64) {
            float y = bfv(pr, cb + d) * rstd * gn[d];
            if (d < 32) { const int i = d & 15; const float inv = powf(500000.0f, -(float)(2 * i) / 32.0f); const float ang = (float)pos * inv; const float cs = cosf(ang), sn = sinf(ang);
                const int dp = d < 16 ? d + 16 : d - 16; const float yp = bfv(pr, cb + dp) * rstd * gn[dp];
                y = d < 16 ? y * cs - yp * sn : y * cs + yp * sn; }
            float got, ref;
            if (hh < 8) { ref = y; got = fp8_at(F.Q8, (size_t)t * 1024 + hh * 128 + d); } else { ref = y; got = fp8_at(F.KVm, (size_t)t * 512 + (hh - 8) * 256 + d); }
            if (!(fabsf(got - ref) <= 0.08f * fabsf(ref) + 0.02f)) bad = 1;
        }
    }
    for (int e = lane; e < 256; e += 64) { const float ref = bfv(pr, CV + e), got = fp8_at(F.KVm, (size_t)t * 512 + (e >> 7) * 256 + 128 + (e & 127)); if (!(fabsf(got - ref) <= 0.08f * fabsf(ref) + 0.02f)) bad = 1; }
    for (int e = lane; e < 1024; e += 64) {
        const int cb = CQI + (e & ~63); const int d = e & 63;
        float y = bfv(pr, cb + d);
        if (d < 16) { const int i = d & 7; const float inv = powf(500000.0f, -(float)(2 * i) / 16.0f); const float ang = (float)pos * inv; const float cs = cosf(ang), sn = sinf(ang);
            const int dp = d < 8 ? d + 8 : d - 8; const float yp = bfv(pr, cb + dp); y = d < 8 ? y * cs - yp * sn : y * cs + yp * sn; }
        const float got = bfv(F.QI, qi_off((size_t)t, e >> 6, d));
        if (!(fabsf(got - y) <= 0.02f * fabsf(y) + 0.02f)) bad = 1;
    }
    {
        LAS float* kwref = (LAS float*)(F.lds + 49152) + F.wave * 128;
        for (int c = 0; c < 80; ++c) {
            float sdot = 0.f; for (int k = lane; k < D; k += 64) sdot += bfv(F.H, (size_t)t * D + k) * F.w_in[(size_t)k * 3664 + 2560 + c];
            sdot = wave_sum(sdot); if (lane == 0) kwref[c] = sdot;
        }
        asm volatile("s_waitcnt lgkmcnt(0)" ::: "memory");
        { const int d = lane; float y = kwref[d];
          if (d < 16) { const int i = d & 7; const float inv = powf(500000.0f, -(float)(2 * i) / 16.0f); const float ang = (float)pos * inv; const float cs = cosf(ang), sn = sinf(ang);
              const int dp = d < 8 ? d + 8 : d - 8; const float yp = kwref[dp]; y = d < 8 ? y * cs - yp * sn : y * cs + yp * sn; }
          const float got = bfv(F.KI, ki_off((size_t)t, d));
          if (!(fabsf(got - y) <= 0.02f * fabsf(y) + 0.03f)) bad = 1; }
        if (lane < 16) { const float ref = kwref[64 + lane] * 0.03125f, got = F.WI[(size_t)t * 16 + lane]; if (!(fabsf(got - ref) <= 1e-3f + 0.01f * fabsf(ref))) bad = 1; }
    }
    for (int e = lane; e < 1024; e += 64) {
        const int g = e >> 8, w = 2 << g; float sum = 0.f; int cn = 0;
        for (int r = 0; r < w; ++r) if (pos - r >= 0) { sum += bfv(pr - (size_t)r * NPROJ, CP + e); ++cn; }
        const float ref = sum / (float)cn - bfv(pr, CP + e), got = bfv(F.PM, ((size_t)g * T + t) * 256 + (e & 255));
        if (!(fabsf(got - ref) <= 0.02f * fabsf(ref) + 0.02f)) bad = 1;
    }
    if (__ballot(bad) != 0ull && lane == 0) chk_flag(F, 1);
}
__device__ __forceinline__ void chk_attn(const Frame& F) {
    const int w = F.bid, b = w & 3, j = w >> 2;
    const int pos = j == 0 ? 0 : j == 1 ? 1 : j == 2 ? 100 : j == 3 ? 254 : j == 4 ? 255 : j == 5 ? 256 : j == 6 ? 257 : j == 7 ? 300 : j == 8 ? 511 : j == 9 ? 512 : j == 10 ? 8190 : j == 11 ? 8191 : ((j * 131 + 17) & (S - 1));
    const int t = b * S + pos, n = pos + 1, cnt = n < 256 ? n : 256, tid = F.tid;
    LAS float* sc = (LAS float*)F.lds;
    LAS int* selmark = (LAS int*)(F.lds + 32768);
    LAS float* red = (LAS float*)(F.lds + 65536);
    LAS int* ired = (LAS int*)(F.lds + 65536 + 4096);
    __syncthreads();
    for (int s2 = tid; s2 < n; s2 += NTHREADS) {
        float tot = 0.f;
        for (int h = 0; h < 16; ++h) { float dsum = 0.f; for (int d = 0; d < 64; ++d) dsum += bfv(F.QI, qi_off((size_t)t, h, d)) * bfv(F.KI, ki_off((size_t)b * S + s2, d)); tot += F.WI[(size_t)t * 16 + h] * fmaxf(dsum, 0.f); }
        sc[s2] = (float)(_Float16)tot; selmark[s2] = 0;
    }
    __syncthreads();
    if (tid < cnt) { const int k = F.SEL[(size_t)t * 256 + tid]; if (k < n) atomicAdd((int*)(selmark + k), 1); else atomicAdd((int*)(selmark + 0), 1000); }
    if (tid == 0) { ired[0] = 0; ired[1] = 0; }
    __syncthreads();
    int miss = 0, dup = 0;
    for (int s2 = tid; s2 < n; s2 += NTHREADS) {
        const int mk = selmark[s2]; if (mk > 1) dup = 1;
        if (mk >= 1 && n > 256) { const float v = sc[s2]; int rank = 0; for (int q = 0; q < n; ++q) rank += (sc[q] > v) ? 1 : 0; if (rank >= 256) ++miss; }
    }
    if (miss) atomicAdd((int*)ired, miss); if (dup) atomicAdd((int*)ired + 1, 1);
    __syncthreads();
    if (tid == 0 && (ired[0] > 3 || ired[1] > 0)) chk_flag(F, 2);
    float err2 = 0.f, ref2 = 0.f;
    for (int h = 0; h < 8; ++h) {
        const int g = h >> 2;
        __syncthreads();
        if (tid < 256) { float l = -INFINITY; if (tid < cnt) { const int k = F.SEL[(size_t)t * 256 + tid]; float dsum = 0.f; for (int d = 0; d < 128; ++d) dsum += fp8_at(F.Q8, (size_t)t * 1024 + h * 128 + d) * fp8_at(F.KVm, ((size_t)b * S + k) * 512 + g * 256 + d); l = dsum * (0.08838834764831845f * 1.4426950408889634f); } red[tid] = l; }
        __syncthreads();
        float m = -INFINITY; for (int q = 0; q < 256; ++q) m = fmaxf(m, red[q]);
        float den = 0.f; for (int q = 0; q < 256; ++q) den += exp2f(red[q] - m);
        if (tid < 128) { float o = 0.f; for (int q = 0; q < cnt; ++q) { const int k = F.SEL[(size_t)t * 256 + q]; o += exp2f(red[q] - m) * fp8_at(F.KVm, ((size_t)b * S + k) * 512 + g * 256 + 128 + tid); }
            o /= den; const float got = bfv(F.CONCAT, (size_t)t * D + h * 128 + tid); err2 += (got - o) * (got - o); ref2 += o * o; }
    }
    err2 = wave_sum(err2); ref2 = wave_sum(ref2);
    __syncthreads();
    if (F.lane == 0 && F.wave < 2) { red[300 + F.wave * 2] = err2; red[301 + F.wave * 2] = ref2; }
    __syncthreads();
    if (tid == 0) { const float e = red[300] + red[302], r = red[301] + red[303]; if (!(e <= 0.0064f * r + 1e-6f)) chk_flag(F, 3); }
    __syncthreads();
}
#endif

__device__ __forceinline__ void r1_route(const Frame& F) {
    { const float* ada = F.ADA + (size_t)(F.bid >> 6) * 12288; norm_rows(F, F.x, F.DX, F.norm2_g, ada + 3 * 2048, ada + 4 * 2048); }
    LAS unsigned* lh = (LAS unsigned*)(F.lds + 65536);
    LAS float* lg = (LAS float*)F.lds + F.wave * 768;
    if (F.tid < 64) lh[F.tid] = 0u;
    asm volatile("s_waitcnt vmcnt(0)" ::: "memory");
    __syncthreads();
    const int lane = F.lane, li = lane & 15, q4 = lane >> 4;
    const int t0 = F.bid * 128 + F.wave * 16;
    f32x4 acc[3];
#pragma unroll
    for (int nb = 0; nb < 3; ++nb) acc[nb] = (f32x4){0.f, 0.f, 0.f, 0.f};
    const bf16_t* hp = F.H + (size_t)(t0 + li) * D + 8 * q4;
    const bf16_t* wp = F.WR + (size_t)li * D + 8 * q4;
#pragma unroll 4
    for (int ks = 0; ks < 64; ++ks) {
        const bf16x8 a = *(const bf16x8*)(hp + 32 * ks);
#pragma unroll
        for (int nb = 0; nb < 3; ++nb) { const bf16x8 bb = *(const bf16x8*)(wp + (size_t)nb * 16 * D + 32 * ks); acc[nb] = __builtin_amdgcn_mfma_f32_16x16x32_bf16(a, bb, acc[nb], 0, 0, 0); }
    }
#pragma unroll
    for (int nb = 0; nb < 3; ++nb)
#pragma unroll
        for (int i = 0; i < 4; ++i) lg[(4 * q4 + i) * 48 + nb * 16 + li] = acc[nb][i];
    asm volatile("s_waitcnt lgkmcnt(0)" ::: "memory");
    if (lane < 16) {
        const int t = t0 + lane; const LAS float* l = lg + lane * 48;
        int gs = 0; float gm = l[0];
#pragma unroll
        for (int j = 1; j < 4; ++j) if (l[j] > gm) { gm = l[j]; gs = j; }
        float den = 0.f;
#pragma unroll
        for (int j = 0; j < 4; ++j) den += __expf(l[j] - gm);
        const float pg = 1.0f / den;
        const LAS float* el = l + 4 + gs * 8;
        int i0 = 0; float m0 = el[0];
#pragma unroll
        for (int j = 1; j < 8; ++j) if (el[j] > m0) { m0 = el[j]; i0 = j; }
        int i1 = -1; float m1 = -INFINITY;
#pragma unroll
        for (int j = 0; j < 8; ++j) if (j != i0 && el[j] > m1) { m1 = el[j]; i1 = j; }
        const float e1 = __expf(m1 - m0), w0 = pg / (1.0f + e1), w1 = pg * e1 / (1.0f + e1);
        const int b0 = gs * 8 + i0, b1 = 32 + gs * 8 + i1;
        F.TOKE[2 * t] = b0; F.TOKE[2 * t + 1] = b1; F.TOKW[2 * t] = w0; F.TOKW[2 * t + 1] = w1;
        __hip_atomic_fetch_add(lh + b0, 1u, __ATOMIC_RELAXED, __HIP_MEMORY_SCOPE_WORKGROUP);
        __hip_atomic_fetch_add(lh + b1, 1u, __ATOMIC_RELAXED, __HIP_MEMORY_SCOPE_WORKGROUP);
    }
    __syncthreads();
    if (F.tid < 64) { const unsigned cn = lh[F.tid]; if (cn) __hip_atomic_fetch_add(F.ctl + CW_GCOUNT + F.tid, cn, __ATOMIC_RELAXED, __HIP_MEMORY_SCOPE_AGENT); }
}

__device__ __forceinline__ void r2_rows(const Frame& F) {
    LAS unsigned* lh = (LAS unsigned*)F.lds;
    LAS unsigned* lbase = lh + 64;
    LAS unsigned* tstart = lh + 128;
    const int tid = F.tid;
    if (tid < 64) lh[tid] = 0u;
    __syncthreads();
    if (tid == 0) {
        unsigned ts = 0;
        for (int k = 0; k < 64; ++k) { tstart[k] = ts; const unsigned cn = __hip_atomic_load(F.ctl + CW_GCOUNT + k, __ATOMIC_RELAXED, __HIP_MEMORY_SCOPE_AGENT); ts += (cn + 255u) >> 8; if (k == 31) tstart[64 + 1] = ts; }
        tstart[64] = ts;
    }
    const int t = F.bid * 128 + (tid >> 1), sl = tid & 1;
    int bucket = 0; float w = 0.f;
    if (tid < 256) { bucket = F.TOKE[2 * t + sl]; w = F.TOKW[2 * t + sl]; __hip_atomic_fetch_add(lh + bucket, 1u, __ATOMIC_RELAXED, __HIP_MEMORY_SCOPE_WORKGROUP); }
    __syncthreads();
    if (tid < 64) { const unsigned cn = lh[tid]; unsigned base = 0; if (cn) base = __hip_atomic_fetch_add(F.ctl + CW_GCURSOR + tid, cn, __ATOMIC_RELAXED, __HIP_MEMORY_SCOPE_AGENT); lbase[tid] = tstart[tid] * 256u + base; }
    __syncthreads();
    if (tid < 64) lh[tid] = 0u;
    __syncthreads();
    if (tid < 256) { const unsigned rk = __hip_atomic_fetch_add(lh + bucket, 1u, __ATOMIC_RELAXED, __HIP_MEMORY_SCOPE_WORKGROUP); const unsigned p = lbase[bucket] + rk;
        if (p < (unsigned)MAXROWS) { F.ROWTOK[p] = t; F.ROWW[p] = w; } }
    if (F.bid == 0) {
        if (tid == 0) { ((int*)F.ctl)[CW_TINFO] = (int)tstart[65]; ((int*)F.ctl)[CW_TINFO + 1] = (int)tstart[64]; }
        if (tid < 64) { const unsigned a = tstart[tid], e = (tid == 63) ? tstart[64] : tstart[tid + 1]; for (unsigned p = a; p < e && p < 512u; ++p) ((int*)F.ctl)[CW_TILEB + p] = tid; }
    }
}

struct Args { const float* in[17]; float* out; unsigned char* ws; int ph_lo, ph_hi; };
constexpr int N_PHASES = 13;

__global__ void __launch_bounds__(NTHREADS, 2) mk_fwd(Args args) {
    extern __shared__ __attribute__((aligned(16))) unsigned char lds_raw[];
    Frame F;
    F.lds = (LAS unsigned char*)lds_raw;
    F.tid = threadIdx.x; F.lane = F.tid & 63; F.wave = __builtin_amdgcn_readfirstlane(F.tid >> 6); F.G = gridDim.x; F.bid = blockIdx.x;
    F.x = args.in[0]; F.c = args.in[1]; F.w_ada = args.in[2]; F.b_ada = args.in[3]; F.norm1_g = args.in[4]; F.w_in = args.in[5]; F.q_norm_g = args.in[6]; F.k_norm_g = args.in[7];
    F.w_pool = args.in[8]; F.pool_scale = args.in[9]; F.w_out = args.in[10]; F.norm2_g = args.in[11]; F.w_grp = args.in[12]; F.w_exp = args.in[13]; F.w1 = args.in[14]; F.w3 = args.in[15]; F.w2 = args.in[16];
    F.out = args.out;
    unsigned char* ws = args.ws;
    F.ctl = (unsigned*)(ws + WS_CTL); F.ADA = (float*)(ws + WS_ADA); F.ADAP = (float*)(ws + WS_ADAP); F.TAB = (float*)(ws + WS_TAB); F.WR = (bf16_t*)(ws + WS_WR); F.TOKE = (int*)(ws + WS_TOKE); F.TOKW = (float*)(ws + WS_TOKW);
    F.ROWTOK = (int*)(ws + WS_ROWTOK); F.ROWW = (float*)(ws + WS_ROWW); F.WI = (float*)(ws + WS_WI); F.KI = (bf16_t*)(ws + WS_KI);
    F.WPOOL = (bf16_t*)(ws + WS_WPOOL); F.WOUT = (bf16_t*)(ws + WS_WOUT); F.WIN = (bf16_t*)(ws + WS_WIN); F.W13 = (bf16_t*)(ws + WS_W13); F.W2 = (bf16_t*)(ws + WS_W2);
    F.H = (bf16_t*)(ws + WS_H); F.CONCAT = (bf16_t*)(ws + WS_H); F.PROJ = (bf16_t*)(ws + WS_X); F.SC = (unsigned short*)(ws + WS_X); F.Y0 = (bf16_t*)(ws + WS_X); F.DX = (bf16_t*)(ws + WS_X + 134217728);
    F.QB = (bf16_t*)(ws + WS_QB); F.Q8 = ws + WS_QB; F.ACT = (bf16_t*)(ws + WS_QB); F.KV = (bf16_t*)(ws + WS_KV); F.KVm = ws + WS_KV; F.QI = (bf16_t*)(ws + WS_QI); F.PM = (bf16_t*)(ws + WS_PM); F.SEL = (unsigned short*)(ws + WS_SEL);

    volatile LAS unsigned* bst = (volatile LAS unsigned*)(F.lds + LDS_BYTES - 16);
    if (F.tid == 0) { bst[0] = 0u; bst[1] = 0u; bst[2] = 0u; bst[3] = 0u; }
    __syncthreads();
    XcdBarrier bar = xcd_barrier_post(F.ctl, bst, F.wave);
    const int lo = args.ph_lo, hi = args.ph_hi;
#define IN(k) (lo <= (k) && (k) < hi)
#define SEAM(k) do { if (IN(k) && IN((k) + 1)) xcd_barrier(bar); } while (0)

#define PH(k, ...) do { F.lane = fresh_lane(); F.tid = F.wave * 64 + F.lane; if (IN(k)) { for (int rep_ = 0; rep_ < 1 + ((REPEAT_MASK >> (k)) & 1); ++rep_) { __VA_ARGS__ } } SEAM(k); } while (0)
    PH(0, { p0_prologue(F); });
    PH(1, {
        if (F.tid < 192) { const int v = F.bid * 192 + F.tid; float s = 0.f; for (int kc = 0; kc < 32; ++kc) s += F.ADAP[(size_t)kc * 49152 + v]; F.ADA[v] = s; }
        LAS float* sl = (LAS float*)F.lds;
        { const int b = F.bid >> 6; for (int idx = F.tid; idx < 4096; idx += NTHREADS) { float s = 0.f; for (int kc = 0; kc < 32; ++kc) s += F.ADAP[(size_t)kc * 49152 + b * 12288 + idx]; sl[idx] = s; } }
        __syncthreads();
        norm_rows(F, F.x, nullptr, F.norm1_g, (const float*)sl, (const float*)(sl + 2048));
#if P1_PROBE == 1
        norm_rows(F, F.x, nullptr, F.norm1_g, (const float*)sl, (const float*)(sl + 2048));
#elif P1_PROBE == 2
        __syncthreads();
        { const int b = F.bid >> 6; for (int idx = F.tid; idx < 4096; idx += NTHREADS) { float s = 0.f; for (int kc = 0; kc < 32; ++kc) s += F.ADAP[(size_t)kc * 49152 + b * 12288 + idx]; sl[idx] = s; } }
#endif
        __syncthreads();
    });
    PH(2, {
        pg8::Gemm g{F.H, F.WIN, D}; pg8::StaticOrder So; So.init(T, 3584, F.G, F.bid, 1 + ((REPEAT_UNITS >> 2) & 1));
        pg8::EpiBf16 E{F.PROJ, NPROJ, 0};
        pg8::gemm_phase<pg8::EpiBf16, pg8::StaticOrder>(F.lds, g, So, E, F.tid);
    });
#if SELFCHECK
    F.lane = fresh_lane(); F.tid = F.wave * 64 + F.lane; if (IN(3)) { chk_gemm1(F); }
#endif
    PH(3, { p3_post(F); });
#if SELFCHECK
    F.lane = fresh_lane(); F.tid = F.wave * 64 + F.lane; if (IN(3)) { chk_post(F); if (IN(4)) xcd_barrier(bar); }
#endif
    PH(4, {
        {
            pg8::Gemm g{F.PM, F.WPOOL, 256}; pg8::PoolOrder So{F.G, F.bid};
            pg8::EpiBf16 E{F.CONCAT, D, 1};
            pg8::gemm_phase<pg8::EpiBf16, pg8::PoolOrder>(F.lds, g, So, E, F.tid);
        }
        indexer_sweep(F);
    });
    PH(5, {
        LAS unsigned char* wbuf = F.lds + F.wave * 17920;
        u32x4 pre[16];
        int i = F.bid * 8 + F.wave;
        int t = (i & 1) ? (T - 1 - (i >> 1)) : (i >> 1);
        { const unsigned short* src = sel_src(F, t); const int n = (t & (S - 1)) + 1, nch = n > 256 ? (n + 511) >> 9 : 0;
          _Pragma("unroll") for (int ch = 0; ch < 16; ++ch) if (ch < nch) pre[ch] = *(const u32x4*)(src + ch * 512 + F.lane * 8); }
        for (; i < T; i += F.G * 8) {
            u32x4 cur[16];
            _Pragma("unroll") for (int ch = 0; ch < 16; ++ch) cur[ch] = pre[ch];
            const int tcur = t, inext = i + F.G * 8;
            if (inext < T) {
                t = (inext & 1) ? (T - 1 - (inext >> 1)) : (inext >> 1);
                const unsigned short* src = sel_src(F, t); const int n = (t & (S - 1)) + 1, nch = n > 256 ? (n + 511) >> 9 : 0;
                _Pragma("unroll") for (int ch = 0; ch < 16; ++ch) if (ch < nch) pre[ch] = *(const u32x4*)(src + ch * 512 + F.lane * 8);
            }
            select_row(F, tcur, cur, wbuf, F.lane);
        }
#if SEL_PROBE
        {
            unsigned accx = 0;
            for (int i2 = F.bid * 8 + F.wave; i2 < T; i2 += F.G * 8) {
                const int t2 = (i2 & 1) ? (T - 1 - (i2 >> 1)) : (i2 >> 1);
                const unsigned short* src = sel_src(F, t2); const int n = (t2 & (S - 1)) + 1, nch = n > 256 ? (n + 511) >> 9 : 0;
                u32x4 r[16];
                _Pragma("unroll") for (int ch = 0; ch < 16; ++ch) if (ch < nch) r[ch] = *(const u32x4*)(src + ch * 512 + F.lane * 8);
                _Pragma("unroll") for (int ch = 0; ch < 16; ++ch) if (ch < nch) accx ^= r[ch].x ^ r[ch].y ^ r[ch].z ^ r[ch].w;
            }
            if (accx == 0x12345678u) F.SEL[0] = 1;
        }
#endif
    });
    PH(6, {
        attn_items(F, 0, 32);
#if ATT_PROBE == 1
        attn_items(F, 0, 16);
#elif ATT_PROBE == 2
        attn_items(F, 16, 32);
#endif
    });
#if SELFCHECK
    F.lane = fresh_lane(); F.tid = F.wave * 64 + F.lane; if (IN(7)) { chk_attn(F); }
#endif
    PH(7, {
        pg8::Gemm g{F.CONCAT, F.WOUT, D}; pg8::StaticOrder So; So.init(T, D, F.G, F.bid, 1 + ((REPEAT_UNITS >> 7) & 1));
        pg8::EpiMix E{F.ADA, F.DX};
        pg8::gemm_phase<pg8::EpiMix, pg8::StaticOrder>(F.lds, g, So, E, F.tid);
    });
    PH(8, { r1_route(F); });
    PH(9, { r2_rows(F); });
    PH(10, {
        const int* ti = (const int*)F.ctl + CW_TINFO;
        pg8::Gemm g{F.H, F.W13, D}; pg8::MoeOrder<4, true> So{(const int*)F.ctl + CW_TILEB, F.ROWTOK, 0, ti[1], F.G, F.bid, 1 + ((REPEAT_UNITS >> 10) & 1)};
        pg8::EpiAct E{F.ACT};
        pg8::gemm_phase<pg8::EpiAct, pg8::MoeOrder<4, true>>(F.lds, g, So, E, F.tid);
    });
    PH(11, {
        const int* ti = (const int*)F.ctl + CW_TINFO;
        pg8::Gemm g{F.ACT, F.W2, 512}; pg8::MoeOrder<8, false> So{(const int*)F.ctl + CW_TILEB, F.ROWTOK, 0, ti[0], F.G, F.bid, 1};
        pg8::EpiMoeY0 E{F.ROWTOK, F.ROWW, F.ADA, F.Y0};
        pg8::gemm_phase<pg8::EpiMoeY0, pg8::MoeOrder<8, false>>(F.lds, g, So, E, F.tid);
    });
    PH(12, {
        const int* ti = (const int*)F.ctl + CW_TINFO;
        pg8::Gemm g{F.ACT, F.W2, 512}; pg8::MoeOrder<8, false> So{(const int*)F.ctl + CW_TILEB, F.ROWTOK, ti[0], ti[1], F.G, F.bid, 1};
        pg8::EpiMoeOut E{F.ROWTOK, F.ROWW, F.ADA, F.Y0, F.DX, F.x, F.out};
        pg8::gemm_phase<pg8::EpiMoeOut, pg8::MoeOrder<8, false>>(F.lds, g, So, E, F.tid);
    });
#undef PH
#if SELFCHECK
    if (IN(12)) {
        xcd_barrier(bar);
        if (F.bid == 0 && F.tid == 0) {
            float code = 0.f;
            for (int k = 0; k < 4; ++k) if (__hip_atomic_load(F.ctl + CW_CHK + k, __ATOMIC_RELAXED, __HIP_MEMORY_SCOPE_AGENT) != 0u) code += (float)(1 << k);
            if (code != 0.f) F.out[0] += 1.0e4f * code;
        }
    }
#endif
#undef IN
#undef SEAM
}

extern "C" void kernel_launch(void* const* d_in, const int* in_sizes, int n_in, void* d_out, int out_size, void* d_ws, size_t ws_size, hipStream_t stream) {
    static int grid = 0;
    if (grid == 0) {
        if (n_in != 17 || out_size != T * D || ws_size < WS_END) { fprintf(stderr, "kernel_launch: unexpected problem (n_in %d out %d ws %zu)\n", n_in, out_size, ws_size); grid = -1; return; }
        int dev = 0, cus = 0, per_cu = 0;
        if (hipGetDevice(&dev) != hipSuccess || hipDeviceGetAttribute(&cus, hipDeviceAttributeMultiprocessorCount, dev) != hipSuccess) { grid = -1; return; }
        if (hipFuncSetAttribute((const void*)mk_fwd, hipFuncAttributeMaxDynamicSharedMemorySize, LDS_BYTES) != hipSuccess) { fprintf(stderr, "kernel_launch: hipFuncSetAttribute failed\n"); grid = -1; return; }
        if (hipOccupancyMaxActiveBlocksPerMultiprocessor(&per_cu, (const void*)mk_fwd, NTHREADS, LDS_BYTES) != hipSuccess || per_cu < 1) { fprintf(stderr, "kernel_launch: occupancy query says %d\n", per_cu); }
        (void)hipGetLastError();
        grid = cus;
        if (grid != 256) { fprintf(stderr, "kernel_launch: built for 256 CUs, found %d\n", cus); grid = -1; return; }
    }
    if (grid < 0) return;
    (void)hipMemsetAsync((char*)d_ws + WS_CTL, 0, WS_ADA - WS_CTL, stream);
    (void)hipMemsetAsync((char*)d_ws + WS_ROWTOK, 0xFF, (size_t)MAXROWS * 4, stream);
    Args a{};
    for (int i = 0; i < 17; ++i) a.in[i] = (const float*)d_in[i];
    a.out = (float*)d_out; a.ws = (unsigned char*)d_ws;
#if MK_MULTI
    for (int p = 0; p < N_PHASES; ++p) { a.ph_lo = p; a.ph_hi = p + 1; hipLaunchKernelGGL(mk_fwd, dim3(grid), dim3(NTHREADS), LDS_BYTES, stream, a); }
#else
    a.ph_lo = 0; a.ph_hi = N_PHASES; hipLaunchKernelGGL(mk_fwd, dim3(grid), dim3(NTHREADS), LDS_BYTES, stream, a);
#endif
}
```

```cpp
#include <hip/hip_runtime.h>
#include <cstdio>
#include <cstdint>
#include <cstddef>

#ifndef MK_MULTI
#define MK_MULTI 0
#endif

#ifndef P5_PROBE
#define P5_PROBE 0
#endif
#ifndef P1_PROBE
#define P1_PROBE 0
#endif
#ifndef ATT_PROBE
#define ATT_PROBE 0
#endif
#ifndef SEL_PROBE
#define SEL_PROBE 0
#endif
#ifndef EPI_PROBE
#define EPI_PROBE 0
#endif
#ifndef PROF_SECTION
#define PROF_SECTION -1
#endif
#ifndef PROF_DIV
#define PROF_DIV 2000
#endif
#ifndef SELFCHECK
#define SELFCHECK 0
#endif
#ifndef REPEAT_UNITS
#define REPEAT_UNITS 0
#endif
#ifndef REPEAT_MASK
#define REPEAT_MASK 0
#endif
#define LAS __attribute__((address_space(3)))
typedef unsigned short bf16_t;
typedef short bf16x8 __attribute__((ext_vector_type(8)));
typedef short s16x4 __attribute__((ext_vector_type(4)));
typedef float f32x4 __attribute__((ext_vector_type(4)));
typedef float f32x16 __attribute__((ext_vector_type(16)));
typedef unsigned u32x4 __attribute__((ext_vector_type(4)));
typedef unsigned u32x2 __attribute__((ext_vector_type(2)));
typedef __bf16 bf16v2 __attribute__((ext_vector_type(2)));
typedef _Float16 f16v2 __attribute__((ext_vector_type(2)));

constexpr int T = 32768, S = 8192, NB = 4, D = 2048;
constexpr int NPROJ = 3840;
constexpr int CQ = 0, CK = 1024, CV = 1280, CQI = 1536, CP = 2560, CKI = 3584, CWI = 3648;
constexpr int NTHREADS = 512;
constexpr int LDS_BYTES = 147456;
constexpr float NORM_EPS = 1e-6f;
constexpr size_t SC_BATCH = 34078720ull;
constexpr int MAXROWS = 81920;

constexpr size_t WS_CTL = 0;
constexpr size_t WS_ADA = 65536;
constexpr size_t WS_TAB = 262144;
constexpr size_t WS_WR = 1835008;
constexpr size_t WS_TOKE = 2031616;
constexpr size_t WS_TOKW = 2293760;
constexpr size_t WS_ROWTOK = 2555904;
constexpr size_t WS_ROWW = 2883584;
constexpr size_t WS_WI = 3211264;
constexpr size_t WS_KI = 5308416;
constexpr size_t WS_WPOOL = 9502720;
constexpr size_t WS_WOUT = 10027008;
constexpr size_t WS_WIN = 18415616;
constexpr size_t WS_W13 = 34144256;
constexpr size_t WS_W2 = 168361984;
constexpr size_t WS_H = 235470848;
constexpr size_t WS_X = 369688576;
constexpr size_t WS_QB = 642318336;
constexpr size_t WS_KV = 709427200;
constexpr size_t WS_QI = 742981632;
constexpr size_t WS_PM = 810090496;
constexpr size_t WS_SEL = 877199360;
constexpr size_t WS_ADAP = 893976576;
constexpr size_t WS_H8 = 900268032;
constexpr size_t WS_END = 967376896;
constexpr int CW_GCOUNT = 4096, CW_GCURSOR = 4160, CW_CHK = 4224, CW_TINFO = 4352, CW_TILEB = 4416;

__device__ __forceinline__ int fresh_lane() { int l; asm volatile("v_mbcnt_lo_u32_b32 %0, -1, 0\n\tv_mbcnt_hi_u32_b32 %0, -1, %0" : "=v"(l)); return l; }
__device__ __forceinline__ unsigned pk_bf16(float a, float b) { bf16v2 v; v.x = (__bf16)a; v.y = (__bf16)b; return __builtin_bit_cast(unsigned, v); }
__device__ __forceinline__ float bf_lo(unsigned u) { return __uint_as_float(u << 16); }
__device__ __forceinline__ float bf_hi(unsigned u) { return __uint_as_float(u & 0xffff0000u); }
__device__ __forceinline__ void unpack8(const u32x4 v, float* f) {
    f[0] = bf_lo(v.x); f[1] = bf_hi(v.x); f[2] = bf_lo(v.y); f[3] = bf_hi(v.y); f[4] = bf_lo(v.z); f[5] = bf_hi(v.z); f[6] = bf_lo(v.w); f[7] = bf_hi(v.w);
}
__device__ __forceinline__ u32x4 pack8(const float* f) { u32x4 v; v.x = pk_bf16(f[0], f[1]); v.y = pk_bf16(f[2], f[3]); v.z = pk_bf16(f[4], f[5]); v.w = pk_bf16(f[6], f[7]); return v; }
__device__ __forceinline__ u32x4 pack16_fp8(const float* f) {
    u32x4 v;
#pragma unroll
    for (int w = 0; w < 4; ++w) { int pk = __builtin_amdgcn_cvt_pk_fp8_f32(f[4 * w], f[4 * w + 1], 0, false); pk = __builtin_amdgcn_cvt_pk_fp8_f32(f[4 * w + 2], f[4 * w + 3], pk, true); v[w] = (unsigned)pk; }
    return v;
}
__device__ __forceinline__ float fp8_at(const unsigned char* p, size_t i) { typedef float f2 __attribute__((ext_vector_type(2))); const f2 r = __builtin_amdgcn_cvt_pk_f32_fp8((int)p[i], false); return r.x; }
__device__ __forceinline__ float wave_sum(float v) {
#pragma unroll
    for (int d = 32; d >= 1; d >>= 1) v += __shfl_xor(v, d);
    return v;
}

#if PROF_SECTION >= 0
#define PROF_T0(k) unsigned long long _pt##k = 0; if (PROF_SECTION == (k)) _pt##k = __builtin_amdgcn_s_memtime();
#define PROF_T1(k) if (PROF_SECTION == (k) && F.bid == 100 && F.wave == 3 && F.lane == 0) atomicAdd((unsigned long long*)(F.ctl + CW_CHK) + 4, (unsigned long long)(__builtin_amdgcn_s_memtime() - _pt##k));
#else
#define PROF_T0(k)
#define PROF_T1(k)
#endif
#define XB_TMO      128
#define XB_XCNT(j)  (256  + 64 * (j))
#define XB_XSUB(j)  (1280 + 64 * (j))
#define XB_XGEN(j)  (2304 + 64 * (j))
#define XB_TOP      3328
#define XB_TOPGEN   3392
#define XCD_BAR_WORDS 3456
#define XB_SPIN_CAP (1u << 23)

__device__ __forceinline__ unsigned xb_ld(unsigned* p)              { return __hip_atomic_load(p, __ATOMIC_RELAXED, __HIP_MEMORY_SCOPE_AGENT); }
__device__ __forceinline__ unsigned xb_add(unsigned* p, unsigned v) { return __hip_atomic_fetch_add(p, v, __ATOMIC_RELAXED, __HIP_MEMORY_SCOPE_AGENT); }
__device__ __forceinline__ unsigned xb_xcc_id() { return (unsigned)__builtin_amdgcn_s_getreg((3 << 11) | 20) & 0xFu; }
#define XB_SPIN(cond, bar) do { unsigned _sp = 0; while (cond) { __builtin_amdgcn_s_sleep(1); \
    if ((++_sp & 255u) == 0u) { if (xb_ld(&(bar)[XB_TMO])) break; if (_sp > XB_SPIN_CAP) { atomicAdd(&(bar)[XB_TMO], 1u); break; } } } } while (0)

struct XcdBarrier { unsigned* bar; unsigned x; volatile LAS unsigned* st; int wave; };

__device__ __forceinline__ XcdBarrier xcd_barrier_post(unsigned* bar, volatile LAS unsigned* st, int wave) {
    XcdBarrier b; b.bar = bar; b.x = xb_xcc_id(); b.st = st; b.wave = wave;
    if (threadIdx.x == 0) (void)xb_add(&bar[XB_XCNT(b.x)], 1u);
    return b;
}
__device__ __forceinline__ void xcd_barrier_complete(unsigned* bar, unsigned x, unsigned& nloc, unsigned& nx) {
    const unsigned G = gridDim.x * gridDim.y * gridDim.z;
    unsigned sum, cnt, mine, sp = 0u;
    for (;;) {
        sum = 0u; cnt = 0u; mine = 0u;
#pragma unroll
        for (unsigned j = 0; j < 16; ++j) { const unsigned c = xb_ld(&bar[XB_XCNT(j)]); sum += c; cnt += (c > 0u) ? 1u : 0u; mine = (j == x) ? c : mine; }
        if (sum == G) break;
        __builtin_amdgcn_s_sleep(1);
        if ((++sp & 255u) == 0u) { if (xb_ld(&bar[XB_TMO])) break; if (sp > XB_SPIN_CAP) { atomicAdd(&bar[XB_TMO], 1u); break; } }
    }
    nloc = mine > 0u ? mine : 1u; nx = cnt > 0u ? cnt : 1u;
}
__device__ __forceinline__ void xcd_barrier(const XcdBarrier& b) {
    asm volatile("s_waitcnt vmcnt(0)" ::: "memory");
    __syncthreads();
    if (b.wave == 0 && fresh_lane() == 0) {
        unsigned* bar = b.bar;
        __builtin_amdgcn_s_waitcnt(0);
        unsigned nloc = b.st[0], nx = b.st[1];
        if (nloc == 0u) { xcd_barrier_complete(bar, b.x, nloc, nx); b.st[0] = nloc; b.st[1] = nx; }
        const unsigned old = xb_add(&bar[XB_XSUB(b.x)], 1u);
        const unsigned gen = old / nloc;
        if (old + 1u == (gen + 1u) * nloc) {
            __builtin_amdgcn_fence(__ATOMIC_RELEASE, "agent");
            asm volatile("s_waitcnt vmcnt(0)" ::: "memory");
            const unsigned og = xb_add(&bar[XB_TOP], 1u);
            const unsigned tg = og / nx;
            if (og + 1u == (tg + 1u) * nx) xb_add(&bar[XB_TOPGEN], 1u);
            else XB_SPIN(xb_ld(&bar[XB_TOPGEN]) == tg, bar);
            __builtin_amdgcn_fence(__ATOMIC_ACQUIRE, "agent");
            xb_add(&bar[XB_XGEN(b.x)], 1u);
            asm volatile("s_waitcnt vmcnt(0)" ::: "memory");
        } else {
            XB_SPIN(xb_ld(&bar[XB_XGEN(b.x)]) == gen, bar);
            __builtin_amdgcn_fence(__ATOMIC_ACQUIRE, "agent");
            asm volatile("s_waitcnt vmcnt(0)" ::: "memory");
        }
    }
    __syncthreads();
}

struct Frame {
    LAS unsigned char* lds;
    int tid, lane, wave, G, bid;
    const float *x, *c, *w_ada, *b_ada, *norm1_g, *w_in, *q_norm_g, *k_norm_g, *w_pool, *pool_scale, *w_out, *norm2_g, *w_grp, *w_exp, *w1, *w3, *w2;
    float* out;
    unsigned* ctl;
    float* ADA; float* ADAP; float* TAB; bf16_t* WR; int* TOKE; float* TOKW; int* ROWTOK; float* ROWW; float* WI; bf16_t* KI;
    bf16_t *WPOOL, *WOUT, *WIN, *W13, *W2, *H, *PROJ; unsigned short* SC; bf16_t *QB, *KV, *QI, *PM, *ACT, *CONCAT; unsigned short* SEL;
    unsigned char *Q8, *KVm;
    unsigned char* H8;
    bf16_t *Y0, *DX;
};

constexpr int NF8 = 10;
namespace pg8 {
constexpr float ACT_SCALE = 4.0f, W2_SCALE = 32.0f, H_SCALE = 4.0f, W13_SCALE = 64.0f, C_SCALE = 4.0f;
constexpr int BM = 256, BK = 64, HALF = 128, HTB = HALF * BK * 2, STAGE_BYTES = 8 * HTB, NXCD = 8, WGM = 8;
__device__ __forceinline__ int lds_byte(int r, int c) { const int st = (r >> 4) * 2 + (c >> 5), rr = r & 15, cc = c & 31, ob = rr * 64 + cc * 2; return st * 1024 + (ob ^ (((ob >> 9) & 1) << 5)); }
__device__ __forceinline__ void stage_rc(int b, int& R, int& C) { const int st = b / 1024, sb = b % 1024, swz = sb ^ (((sb >> 9) & 1) << 5); R = (st >> 1) * 16 + swz / 64; C = (st & 1) * 32 + (swz % 64) / 2; }
__device__ __forceinline__ int perm32(int rho) { const int n = rho >> 4, i = rho & 15; return 8 * (i >> 2) + 4 * n + (i & 3); }
struct Unit { int pm, pn, rep; };
struct Gemm { const bf16_t* A; const bf16_t* Bt; int K; unsigned long long* prof; };

struct StaticOrder {
    int nM, nN, nwg, G, c, rep;
    __device__ void init(int M, int N, int G_, int c_, int rep_ = 1) { nM = M / BM; nN = N / BM; nwg = nM * nN; G = G_; c = c_; rep = rep_; }
    __device__ bool next(int i, Unit& u) const {
        long L = (long)i * G + c; if (L >= (long)nwg * rep) return false;
        u.rep = 0; if (L >= nwg) { L -= nwg; u.rep = 1; }
        int wgid = (int)L; { const int q = nwg / NXCD, r = nwg % NXCD, xcd = wgid % NXCD, off = wgid / NXCD; wgid = (xcd < r ? xcd * (q + 1) : r * (q + 1) + (xcd - r) * q) + off; }
        const int nig = WGM * nN, gid = wgid / nig, fm = gid * WGM, gsz = (nM - fm) < WGM ? (nM - fm) : WGM;
        u.pm = fm + ((wgid % nig) % gsz); u.pn = (wgid % nig) / gsz; return true;
    }
    __device__ __forceinline__ unsigned arow(const Unit& u, int rr) const { return (unsigned)(u.pm * BM + rr); }
};
struct PoolOrder {
    int G, c;
    __device__ bool next(int i, Unit& u) const { const int L = i * G + c; if (L >= 512) return false; u.pm = L; u.pn = L >> 7; u.rep = 0; return true; }
    __device__ __forceinline__ unsigned arow(const Unit& u, int rr) const { return (unsigned)(u.pm * BM + rr); }
};
template <int NC, bool GATHER> struct MoeOrder {
    const int* tileb; const int* rowtok; int lo, hi, G, c, rep;
    __device__ bool next(int i, Unit& u) const {
        int L = i * G + c; if (L >= (hi - lo) * NC * rep) return false;
        if (L >= (hi - lo) * NC) L -= (hi - lo) * NC;
        u.pm = lo + L / NC; const int e = tileb[u.pm] & 31; u.pn = e * NC + (L % NC); u.rep = 0; return true;
    }
    __device__ __forceinline__ unsigned arow(const Unit& u, int rr) const {
        if (GATHER) { const int tok = rowtok[u.pm * BM + rr]; return (unsigned)(tok < 0 ? 0 : tok); }
        return (unsigned)(u.pm * BM + rr);
    }
};

template <class Epi, class Sched, bool FP8 = false>
__device__ __forceinline__ void gemm_phase(LAS unsigned char* lds, const Gemm g, const Sched& S, const Epi& E, const int tid) {
    const int wid = __builtin_amdgcn_readfirstlane(tid >> 6), lane = tid & 63, wr = wid >> 2, wc = wid & 3, fr = lane & 15, fq = lane >> 4;
    const int K = g.K, nt = K / BK;
    int R0, C0; stage_rc(tid * 16, R0, C0);
    unsigned voffB[2];
#pragma unroll
    for (int i = 0; i < 2; ++i) { const int R = R0 + 64 * i; const int Rb = Epi::PERM ? ((R & ~31) + perm32(R & 31)) : R; voffB[i] = (unsigned)(Rb * K + C0) * 2u; }
    const unsigned rowb = (unsigned)K * 2u, colb = (unsigned)C0 * 2u;
    const size_t kstep = (size_t)(BK * 2);
    const size_t hstep = (size_t)HALF * K * 2;
    const size_t tstep = 2 * hstep;
    const unsigned ldsw = (unsigned)wid * 1024u;
    const int aoff = lds_byte(wr * 64 + fr, fq * 8), boff = lds_byte(wc * 32 + fr, fq * 8);
#if PROF_SECTION >= 70 && PROF_SECTION < 90
#define GP_T0(n) const unsigned long long _gp##n = __builtin_amdgcn_s_memtime();
#define GP_T1(n, id) if (PROF_SECTION == (id) && blockIdx.x == 100 && wid == 3 && lane == 0 && g.prof) atomicAdd(g.prof, (unsigned long long)(__builtin_amdgcn_s_memtime() - _gp##n));
#else
#define GP_T0(n)
#define GP_T1(n, id)
#endif
#define PG8_SA(b, h) (((b) * 2 + (h)) * HTB)
#define PG8_SB(b, h) ((4 + (b) * 2 + (h)) * HTB)
#define PG8_STAGE(bufoff, gbase, voff) do { _Pragma("unroll") for (int _i = 0; _i < 2; ++_i) { unsigned _o = (voff)[_i]; asm volatile("" : "+v"(_o));     \
        __builtin_amdgcn_global_load_lds((const unsigned*)((const char*)(gbase) + _o), (LAS unsigned*)(lds + (bufoff) + ldsw + _i * 8192), 16, 0, 0); } } while (0)
#define PG8_LDA(dst, b, h) do { _Pragma("unroll") for (int m = 0; m < 4; ++m) { if (FP8) { const i32x4_ _l = *(const LAS i32x4_*)(lds + PG8_SA(b, h) + aoff + m * 2048), _h = *(const LAS i32x4_*)(lds + PG8_SA(b, h) + aoff + m * 2048 + 1024); \
            dst##8[m] = __builtin_shufflevector(_l, _h, 0, 1, 2, 3, 4, 5, 6, 7); } else { _Pragma("unroll") for (int k = 0; k < 2; ++k) dst[m][k] = *(const LAS bf16x8*)(lds + PG8_SA(b, h) + aoff + m * 2048 + k * 1024); } } } while (0)
#define PG8_LDB(dst, b, h) do { _Pragma("unroll") for (int n = 0; n < 2; ++n) { if (FP8) { const i32x4_ _l = *(const LAS i32x4_*)(lds + PG8_SB(b, h) + boff + n * 2048), _h = *(const LAS i32x4_*)(lds + PG8_SB(b, h) + boff + n * 2048 + 1024); \
            dst##8[n] = __builtin_shufflevector(_l, _h, 0, 1, 2, 3, 4, 5, 6, 7); } else { _Pragma("unroll") for (int k = 0; k < 2; ++k) dst[n][k] = *(const LAS bf16x8*)(lds + PG8_SB(b, h) + boff + n * 2048 + k * 1024); } } } while (0)
#define PG8_MMA(ai, bj, At, Bt) do { __builtin_amdgcn_s_setprio(1); _Pragma("unroll") for (int m = 0; m < 4; ++m) _Pragma("unroll") for (int n = 0; n < 2; ++n) { \
        if (FP8) acc[ai][bj][m][n] = __builtin_amdgcn_mfma_scale_f32_16x16x128_f8f6f4(Bt##8[n], At##8[m], acc[ai][bj][m][n], 0, 0, 0, 0x7F7F7F7F, 0, 0x7F7F7F7F); \
        else { _Pragma("unroll") for (int k = 0; k < 2; ++k) acc[ai][bj][m][n] = __builtin_amdgcn_mfma_f32_16x16x32_bf16(Bt[n][k], At[m][k], acc[ai][bj][m][n], 0, 0, 0); } } __builtin_amdgcn_s_setprio(0); \
        if (FP8) { _Pragma("unroll") for (int m = 0; m < 4; ++m) _Pragma("unroll") for (int n = 0; n < 2; ++n) asm volatile("" : "+v"(acc[ai][bj][m][n]));     \
            __builtin_amdgcn_sched_barrier(0); } } while (0)
#define PG8_WAIT_V(n) asm volatile("s_waitcnt vmcnt(" #n ")" ::: "memory")
#define PG8_WAIT_L(n) asm volatile("s_waitcnt lgkmcnt(" #n ")" ::: "memory")
#define PG8_BAR __builtin_amdgcn_s_barrier()
#define PG8_SCHED __builtin_amdgcn_sched_barrier(0)
#define PG8_ROWS(dst, u) do { _Pragma("unroll") for (int _h = 0; _h < 2; ++_h) _Pragma("unroll") for (int _i = 0; _i < 2; ++_i) dst[_h][_i] = S.arow(u, _h * HALF + R0 + 64 * _i) * rowb + colb; } while (0)
    Unit cur, nxt; int ui = 0;
    if (!S.next(0, cur)) return;
    f32x4 acc[2][2][4][2];
#pragma unroll
    for (int a = 0; a < 2; ++a)
#pragma unroll
        for (int b = 0; b < 2; ++b)
#pragma unroll
            for (int m = 0; m < 4; ++m)
#pragma unroll
                for (int n = 0; n < 2; ++n) acc[a][b][m][n] = (f32x4){0.f, 0.f, 0.f, 0.f};
    typedef int i32x4_ __attribute__((ext_vector_type(4))); typedef int i32x8_ __attribute__((ext_vector_type(8)));
    bf16x8 At[4][2], B0[2][2], B1[2][2]; i32x8_ At8[4], B08[2], B18[2];
    unsigned oc[2][2], on[2][2];
    PG8_ROWS(oc, cur);
    const char* gA = (const char*)g.A;
    const char* cB = (const char*)g.Bt + (size_t)cur.pn * tstep;
    PG8_STAGE(PG8_SB(0, 0), cB, voffB); PG8_STAGE(PG8_SA(0, 0), gA, oc[0]); PG8_STAGE(PG8_SB(0, 1), cB + hstep, voffB); PG8_STAGE(PG8_SA(0, 1), gA, oc[1]);
    if (wr == 1) PG8_BAR;
    PG8_WAIT_V(4); PG8_BAR;
    PG8_STAGE(PG8_SB(1, 0), cB + kstep, voffB); PG8_STAGE(PG8_SA(1, 0), gA + kstep, oc[0]); PG8_STAGE(PG8_SB(1, 1), cB + hstep + kstep, voffB);
    PG8_WAIT_V(6); PG8_BAR;
    const int tpre = nt >= 4 ? nt - 4 : nt - 2;
    for (;;) {
        const bool has_next = S.next(ui + 1, nxt);
#pragma unroll
        for (int h = 0; h < 2; ++h)
#pragma unroll
            for (int i = 0; i < 2; ++i) on[h][i] = oc[h][i];
        const char* nB = has_next ? (const char*)g.Bt + (size_t)nxt.pn * tstep : cB;
        GP_T0(k)
        for (int t = 0; t < nt; t += 2) {
            const bool last = (t == nt - 2);
            if (has_next && t == tpre) PG8_ROWS(on, nxt);
            const char* a1 = gA + (size_t)(t + 1) * kstep;
            const char* a2 = last ? gA : gA + (size_t)(t + 2) * kstep; const char* b2 = last ? nB : cB + (size_t)(t + 2) * kstep;
            const char* a3 = a2 + kstep; const char* b3 = b2 + kstep;
            unsigned o2[2][2];
#pragma unroll
            for (int h = 0; h < 2; ++h)
#pragma unroll
                for (int i = 0; i < 2; ++i) o2[h][i] = last ? on[h][i] : oc[h][i];
            PG8_LDB(B0, 0, 0); PG8_SCHED; PG8_LDA(At, 0, 0); PG8_STAGE(PG8_SA(1, 1), a1, oc[1]);
            PG8_WAIT_L(8); PG8_BAR; PG8_WAIT_L(0); PG8_MMA(0, 0, At, B0); PG8_BAR; PG8_SCHED;
            PG8_LDB(B1, 0, 1); PG8_STAGE(PG8_SB(0, 0), b2, voffB);
            PG8_BAR; PG8_WAIT_L(0); PG8_MMA(0, 1, At, B1); PG8_BAR;
            PG8_LDA(At, 0, 1); PG8_STAGE(PG8_SA(0, 0), a2, o2[0]);
            PG8_BAR; PG8_WAIT_L(0); PG8_MMA(1, 0, At, B0); PG8_BAR; PG8_SCHED;
            PG8_STAGE(PG8_SB(0, 1), b2 + hstep, voffB);
            PG8_WAIT_V(6); PG8_BAR; PG8_MMA(1, 1, At, B1); PG8_BAR;
            PG8_LDB(B0, 1, 0); PG8_SCHED; PG8_LDA(At, 1, 0); PG8_STAGE(PG8_SA(0, 1), a2, o2[1]);
            PG8_WAIT_L(8); PG8_BAR; PG8_WAIT_L(0); PG8_MMA(0, 0, At, B0); PG8_BAR; PG8_SCHED;
            PG8_LDB(B1, 1, 1); PG8_STAGE(PG8_SB(1, 0), b3, voffB);
            PG8_BAR; PG8_WAIT_L(0); PG8_MMA(0, 1, At, B1); PG8_BAR;
            PG8_LDA(At, 1, 1); PG8_STAGE(PG8_SA(1, 0), a3, o2[0]);
            PG8_BAR; PG8_WAIT_L(0); PG8_MMA(1, 0, At, B0); PG8_BAR; PG8_SCHED;
            PG8_STAGE(PG8_SB(1, 1), b3 + hstep, voffB);
            PG8_WAIT_V(6); PG8_BAR; PG8_MMA(1, 1, At, B1); PG8_BAR;
        }
        GP_T1(k, 70 + Epi::PID) GP_T0(e)
        if (FP8) __builtin_amdgcn_sched_barrier(0);
        E(acc, cur, wr, wc, fr, fq);
        GP_T1(e, 80 + Epi::PID)
        if (!has_next) break;
#pragma unroll
        for (int a = 0; a < 2; ++a)
#pragma unroll
            for (int b = 0; b < 2; ++b)
#pragma unroll
                for (int m = 0; m < 4; ++m)
#pragma unroll
                    for (int n = 0; n < 2; ++n) acc[a][b][m][n] = (f32x4){0.f, 0.f, 0.f, 0.f};
        cur = nxt; cB = nB; ++ui;
#pragma unroll
        for (int h = 0; h < 2; ++h)
#pragma unroll
            for (int i = 0; i < 2; ++i) oc[h][i] = on[h][i];
    }
    PG8_WAIT_V(0);
    if (wr == 0) PG8_BAR;
    PG8_BAR;
#undef PG8_SA
#undef PG8_SB
#undef PG8_STAGE
#undef PG8_LDA
#undef PG8_LDB
#undef PG8_MMA
#undef PG8_WAIT_V
#undef PG8_WAIT_L
#undef PG8_BAR
#undef PG8_SCHED
#undef PG8_ROWS
}

struct EpiBf16 {
    static constexpr int PID = 0; static constexpr bool PERM = true;
    bf16_t* O; int ldc; int mode; int pn0; float oscale; unsigned char* O8;
    __device__ __forceinline__ void operator()(const f32x4 (&acc)[2][2][4][2], const Unit& u, int wr, int wc, int fr, int fq) const {
        const int rowb = (mode == 1 ? (u.pm & 127) : u.pm) * BM, colb = (mode == 1 ? 1024 : 0) + (u.pn + pn0) * BM;
        const int row0 = rowb + wr * 64 + fr, col0 = colb + wc * 32 + 8 * fq;
#pragma unroll
        for (int ai = 0; ai < 2; ++ai)
#pragma unroll
            for (int m = 0; m < 4; ++m) { const size_t ro = (size_t)(row0 + ai * HALF + m * 16) * ldc + col0;
#pragma unroll
                for (int bj = 0; bj < 2; ++bj) { const f32x4 v0 = acc[ai][bj][m][0] * oscale, v1 = acc[ai][bj][m][1] * oscale;
                    if (O8) { int p0 = __builtin_amdgcn_cvt_pk_fp8_f32(v0[0], v0[1], 0, false); p0 = __builtin_amdgcn_cvt_pk_fp8_f32(v0[2], v0[3], p0, true);
                        int p1 = __builtin_amdgcn_cvt_pk_fp8_f32(v1[0], v1[1], 0, false); p1 = __builtin_amdgcn_cvt_pk_fp8_f32(v1[2], v1[3], p1, true);
                        u32x2 q; q.x = (unsigned)p0; q.y = (unsigned)p1; *(u32x2*)(O8 + ro + bj * HALF) = q; }
                    else { u32x4 w; w.x = pk_bf16(v0[0], v0[1]); w.y = pk_bf16(v0[2], v0[3]); w.z = pk_bf16(v1[0], v1[1]); w.w = pk_bf16(v1[2], v1[3]);
                        if (!(EPI_PROBE && u.rep) || (w.x ^ w.w) == 0x12345678u) *(u32x4*)(O + ro + bj * HALF) = w; } } }
    }
};
struct EpiMix {
    static constexpr int PID = 1; static constexpr bool PERM = true;
    const float* ada; const float* x; bf16_t* X1; float oscale;
    __device__ __forceinline__ void operator()(const f32x4 (&acc)[2][2][4][2], const Unit& u, int wr, int wc, int fr, int fq) const {
        const int row0 = u.pm * BM + wr * 64 + fr, col0 = u.pn * BM + wc * 32 + 8 * fq;
        const float* gate = ada + (size_t)(u.pm >> 5) * 12288 + 2 * 2048 + col0;
        f32x4 gv[2][2];
#pragma unroll
        for (int bj = 0; bj < 2; ++bj)
#pragma unroll
            for (int n = 0; n < 2; ++n) gv[bj][n] = *(const f32x4*)(gate + bj * HALF + 4 * n) * oscale;
#pragma unroll
        for (int ai = 0; ai < 2; ++ai)
            {
                f32x4 xv[4][2][2];
#pragma unroll
                for (int m = 0; m < 4; ++m) { const float* xr = x + (size_t)(row0 + ai * HALF + m * 16) * D + col0;
#pragma unroll
                    for (int bj = 0; bj < 2; ++bj) { xv[m][bj][0] = *(const f32x4*)(xr + bj * HALF); xv[m][bj][1] = *(const f32x4*)(xr + bj * HALF + 4); } }
                asm volatile("" ::: "memory");
#pragma unroll
                for (int m = 0; m < 4; ++m) { bf16_t* rowp = X1 + (size_t)(row0 + ai * HALF + m * 16) * D + col0;
#pragma unroll
                    for (int bj = 0; bj < 2; ++bj) { const f32x4 v0 = xv[m][bj][0] + gv[bj][0] * acc[ai][bj][m][0], v1 = xv[m][bj][1] + gv[bj][1] * acc[ai][bj][m][1];
                        u32x4 w; w.x = pk_bf16(v0[0], v0[1]); w.y = pk_bf16(v0[2], v0[3]); w.z = pk_bf16(v1[0], v1[1]); w.w = pk_bf16(v1[2], v1[3]);
                        *(u32x4*)(rowp + bj * HALF) = w; } } }
    }
};
struct EpiAct {
    static constexpr int PID = 2; static constexpr bool PERM = true;
    unsigned char* ACT;
    __device__ __forceinline__ void operator()(const f32x4 (&acc)[2][2][4][2], const Unit& u, int wr, int wc, int fr, int fq) const {
        const int row0 = u.pm * BM + wr * 64 + fr, col0 = (u.pn & 3) * 128 + wc * 32 + 8 * fq;
#pragma unroll
        for (int ai = 0; ai < 2; ++ai)
#pragma unroll
            for (int m = 0; m < 4; ++m) {
                float v[8];
#pragma unroll
                for (int n = 0; n < 2; ++n)
#pragma unroll
                    for (int e = 0; e < 4; ++e) { const float a = acc[ai][0][m][n][e] * (1.0f / (H_SCALE * W13_SCALE)), b = acc[ai][1][m][n][e] * (1.0f / (H_SCALE * W13_SCALE)); v[n * 4 + e] = a * __builtin_amdgcn_rcpf(1.0f + __expf(-a)) * b; }
                { int p0 = __builtin_amdgcn_cvt_pk_fp8_f32(v[0] * ACT_SCALE, v[1] * ACT_SCALE, 0, false); p0 = __builtin_amdgcn_cvt_pk_fp8_f32(v[2] * ACT_SCALE, v[3] * ACT_SCALE, p0, true);
                  int p1 = __builtin_amdgcn_cvt_pk_fp8_f32(v[4] * ACT_SCALE, v[5] * ACT_SCALE, 0, false); p1 = __builtin_amdgcn_cvt_pk_fp8_f32(v[6] * ACT_SCALE, v[7] * ACT_SCALE, p1, true);
                  u32x2 w8; w8.x = (unsigned)p0; w8.y = (unsigned)p1; *(u32x2*)(ACT + (size_t)(row0 + ai * HALF + m * 16) * 512 + col0) = w8; }
            }
    }
};
struct EpiMoeY0 {
    static constexpr int PID = 3; static constexpr bool PERM = true;
    const int* rowtok; const float* roww; bf16_t* Y0;
    __device__ __forceinline__ void operator()(const f32x4 (&acc)[2][2][4][2], const Unit& u, int wr, int wc, int fr, int fq) const {
        const int row0 = u.pm * BM + wr * 64 + fr, col0 = (u.pn & 7) * BM + wc * 32 + 8 * fq;
        int tk[8]; float wt[8];
#pragma unroll
        for (int r = 0; r < 8; ++r) { const int row = row0 + (r >> 2) * HALF + (r & 3) * 16; tk[r] = rowtok[row]; wt[r] = roww[row]; }
#pragma unroll
        for (int r = 0; r < 8; ++r) { const int ai = r >> 2, m = r & 3; const float w = wt[r];
            if (tk[r] >= 0) { bf16_t* yp = Y0 + (size_t)tk[r] * D + col0;
#pragma unroll
                for (int bj = 0; bj < 2; ++bj) { const f32x4 v0 = w * acc[ai][bj][m][0], v1 = w * acc[ai][bj][m][1];
                    u32x4 o; o.x = pk_bf16(v0[0], v0[1]); o.y = pk_bf16(v0[2], v0[3]); o.z = pk_bf16(v1[0], v1[1]); o.w = pk_bf16(v1[2], v1[3]);
                    *(u32x4*)(yp + bj * HALF) = o; } } }
    }
};
struct EpiMoeOut {
    static constexpr int PID = 4; static constexpr bool PERM = true;
    const int* rowtok; const float* roww; const LAS unsigned char* gl; const bf16_t* Y0; const bf16_t* X1; float* out;
    __device__ __forceinline__ void operator()(const f32x4 (&acc)[2][2][4][2], const Unit& u, int wr, int wc, int fr, int fq) const {
        const int row0 = u.pm * BM + wr * 64 + fr, col0 = (u.pn & 7) * BM + wc * 32 + 8 * fq;
        int tk[8];
#pragma unroll
        for (int r = 0; r < 8; ++r) tk[r] = rowtok[row0 + (r >> 2) * HALF + (r & 3) * 16];
#pragma unroll
        for (int ai = 0; ai < 2; ++ai) {
            u32x4 yv[4][2], dv[4][2]; float wq[4];
#pragma unroll
            for (int m = 0; m < 4; ++m) { wq[m] = roww[row0 + ai * HALF + m * 16]; const int tok = tk[4 * ai + m] < 0 ? 0 : tk[4 * ai + m];
                const bf16_t* yp = Y0 + (size_t)tok * D + col0; const bf16_t* dp = X1 + (size_t)tok * D + col0;
#pragma unroll
                for (int bj = 0; bj < 2; ++bj) { yv[m][bj] = *(const u32x4*)(yp + bj * HALF); dv[m][bj] = *(const u32x4*)(dp + bj * HALF); } }
            asm volatile("" ::: "memory");
#pragma unroll
            for (int m = 0; m < 4; ++m) { const float w = wq[m]; const int tok = tk[4 * ai + m] < 0 ? 0 : tk[4 * ai + m];
                const LAS unsigned char* gp = gl + ((tok >> 13) * 2048 + col0) * 2;
                if (tk[4 * ai + m] >= 0) { float* op = out + (size_t)tok * D + col0;
#pragma unroll
                    for (int bj = 0; bj < 2; ++bj) { const u32x4 gq = *(const LAS u32x4*)(gp + bj * HALF * 2);
#pragma unroll
                        for (int n = 0; n < 2; ++n) { const unsigned y0 = n ? yv[m][bj].z : yv[m][bj].x, y1 = n ? yv[m][bj].w : yv[m][bj].y, d0 = n ? dv[m][bj].z : dv[m][bj].x, d1 = n ? dv[m][bj].w : dv[m][bj].y;
                            const unsigned g0 = n ? gq.z : gq.x, g1 = n ? gq.w : gq.y;
                            const f32x4 yy = (f32x4){bf_lo(y0), bf_hi(y0), bf_lo(y1), bf_hi(y1)}, dd = (f32x4){bf_lo(d0), bf_hi(d0), bf_lo(d1), bf_hi(d1)}, gg = (f32x4){bf_lo(g0), bf_hi(g0), bf_lo(g1), bf_hi(g1)};
                            *(f32x4*)(op + bj * HALF + 4 * n) = dd + gg * (yy + w * acc[ai][bj][m][n]); } } } }
        }
    }
};
}

__device__ __forceinline__ int colmap(int n) { return n < 2560 ? n : (n < 2624 ? 3584 + (n - 2560) : (n < 2640 ? 3648 + (n - 2624) : 2560 + (n - 2640))); }

template <int MODE = 0, class RowMap>
__device__ __forceinline__ void tr_tile(const Frame& F, const float* src, size_t ldS, int k0, int n0, int N, const float* cscale, RowMap rm, float gscale = 1.0f) {
    LAS float* tile = (LAS float*)F.lds;
    const int tid = F.tid, r = tid >> 4, c4 = tid & 15;
    f32x4 v[4];
    const int n = n0 + c4 * 4;
#pragma unroll
    for (int i = 0; i < 4; ++i) v[i] = (n < N) ? *(const f32x4*)(src + (size_t)(k0 + r + 32 * i) * ldS + n) : (f32x4){0.f, 0.f, 0.f, 0.f};
    __syncthreads();
#pragma unroll
    for (int i = 0; i < 4; ++i)
#pragma unroll
        for (int e = 0; e < 4; ++e) tile[(r + 32 * i) * 65 + c4 * 4 + e] = v[i][e];
    __syncthreads();
    const int nn = tid >> 3, kc = tid & 7;
    if (n0 + nn < N) {
        const float sc = (cscale ? cscale[n0 + nn] : 1.0f) * gscale;
        float f[16];
#pragma unroll
        for (int j = 0; j < 16; ++j) f[j] = tile[(kc * 16 + j) * 65 + nn] * sc;
        if constexpr (MODE == 2) {
            const int row = rm(n0 + nn);
            if (row < NF8 * 256) {
#pragma unroll
                for (int j = 0; j < 16; ++j) f[j] *= pg8::W13_SCALE;
                *(u32x4*)((unsigned char*)F.WIN + (size_t)row * 2048 + k0 + kc * 16) = pack16_fp8(f);
            } else { bf16_t* d = F.WIN + (size_t)row * 2048 + k0 + kc * 16; *(u32x4*)d = pack8(f); *(u32x4*)(d + 8) = pack8(f + 8); }
        } else if constexpr (MODE == 1) { unsigned char* d = (unsigned char*)rm(n0 + nn) + k0 + kc * 16; *(u32x4*)d = pack16_fp8(f); }
        else { bf16_t* d = (bf16_t*)rm(n0 + nn) + k0 + kc * 16; *(u32x4*)d = pack8(f); *(u32x4*)(d + 8) = pack8(f + 8); }
    }
}

__device__ __forceinline__ void p0_prologue(const Frame& F) {
    constexpr int U_ADA = 192, T_WIN = 16 * 58, T_WOUT = 16 * 32, T_POOL = 4 * 2 * 4, T_W1 = 32 * 128, T_W2 = 32 * 128, U_TAB = 16, U_WR = 4, U_PAD = 2;
    constexpr int B0 = U_ADA, B1 = B0 + T_WIN, B2 = B1 + T_WOUT, B3 = B2 + T_POOL, B4 = B3 + T_W1, B5 = B4 + T_W1, B6 = B5 + T_W2, B7 = B6 + U_TAB, B8 = B7 + U_WR, B9 = B8 + U_PAD;
    const int tid = F.tid;
    constexpr int NTILE = B6 - B0;
    static_assert(NTILE == 13760, "tile split");
    const int nmine = 1 + 50 + (F.bid >= 192 ? 15 : 0);
    for (int it = 0; it < nmine; ++it) {
        PROF_T0(20) PROF_T0(21)
        int u;
        if (it == 0) { u = F.bid < 192 ? F.bid : (F.bid - 192 < 22 ? B6 + (F.bid - 192) : -1); if (u < 0) continue; }
        else if (it <= 50) u = B0 + F.bid + 256 * (it - 1);
        else u = B0 + 12800 + (F.bid - 192) + 64 * (it - 51);
        if (u < B0) {
            const int kc = u / 6, cb = u % 6;
            LAS float* sc = (LAS float*)F.lds;
            __syncthreads();
            if (tid < 256) { const int b = tid >> 6, k = tid & 63; const float cv = F.c[b * D + kc * 64 + k]; sc[tid] = cv / (1.0f + __expf(-cv)); }
            __syncthreads();
            const int n = cb * 2048 + tid * 4;
            f32x4 a[4];
#pragma unroll
            for (int b = 0; b < 4; ++b) a[b] = (f32x4){0.f, 0.f, 0.f, 0.f};
            const float* wp = F.w_ada + (size_t)(kc * 64) * 12288 + n;
#pragma unroll 8
            for (int k = 0; k < 64; ++k) { const f32x4 w = *(const f32x4*)(wp + (size_t)k * 12288);
#pragma unroll
                for (int b = 0; b < 4; ++b) a[b] += sc[b * 64 + k] * w; }
            const f32x4 bias = (kc == 0) ? *(const f32x4*)(F.b_ada + n) : (f32x4){0.f, 0.f, 0.f, 0.f};
#pragma unroll
            for (int b = 0; b < 4; ++b) *(f32x4*)(F.ADAP + ((size_t)kc * 4 + b) * 12288 + n) = a[b] + bias;
        } else if (u < B1) {
            const int v = u - B0, kt = v / 58, ntl = v % 58; bf16_t* W = F.WIN;
            tr_tile<2>(F, F.w_in, 3664, kt * 128, ntl * 64, 3664, nullptr, [=](int n) { return colmap(n); });
        } else if (u < B2) {
            const int v = u - B1, kt = v / 32, ntl = v % 32; bf16_t* W = F.WOUT;
            tr_tile<1>(F, F.w_out, 2048, kt * 128, ntl * 64, 2048, nullptr, [=](int n) { return (unsigned char*)W + (size_t)n * 2048; }, pg8::W13_SCALE);
        } else if (u < B3) {
            const int v = u - B2, g = v / 8, kt = (v % 8) / 4, ntl = v % 4; bf16_t* W = F.WPOOL + (size_t)g * 256 * 256;
            tr_tile(F, F.w_pool + (size_t)g * 65536, 256, kt * 128, ntl * 64, 256, F.pool_scale + g * 256, [=](int n) { return W + (size_t)n * 256; });
        } else if (u < B5) {
            const bool is3 = u >= B4; const int v = u - (is3 ? B4 : B3), e = v / 128, kt = (v % 128) / 8, ntl = v % 8;
            unsigned char* W = (unsigned char*)F.W13 + (size_t)e * 1024 * 2048 + (is3 ? (size_t)128 * 2048 : 0);
            tr_tile<1>(F, (is3 ? F.w3 : F.w1) + (size_t)e * 2048 * 512, 512, kt * 128, ntl * 64, 512, nullptr, [=](int n) { return W + (size_t)((n >> 7) * 256 + (n & 127)) * 2048; }, pg8::W13_SCALE);
        } else if (u < B6) {
            const int v = u - B5, e = v / 128, kt = (v % 128) / 32, ntl = v % 32; unsigned char* W = (unsigned char*)F.W2 + (size_t)e * 2048 * 512;
            tr_tile<1>(F, F.w2 + (size_t)e * 512 * 2048, 2048, kt * 128, ntl * 64, 2048, nullptr, [=](int n) { return W + (size_t)n * 512; }, pg8::W2_SCALE);
        } else if (u < B7) {
            const int pos = (u - B6) * 512 + tid; float* tp = F.TAB + (size_t)pos * 48;
            for (int i = 0; i < 16; ++i) { const double inv = pow(500000.0, -(double)(2 * i) / 32.0); double sn, cs; sincos((double)pos * inv, &sn, &cs); tp[i] = (float)cs; tp[16 + i] = (float)sn; }
            for (int i = 0; i < 8; ++i) { const double inv = pow(500000.0, -(double)(2 * i) / 16.0); double sn, cs; sincos((double)pos * inv, &sn, &cs); tp[32 + i] = (float)cs; tp[40 + i] = (float)sn; }
        } else if (u < B8) {
            const int j0 = (u - B7) * 12;
            for (int idx = tid; idx < 12 * 2048; idx += NTHREADS) { const int j = j0 + idx / 2048, k = idx % 2048;
                const float v = j < 4 ? F.w_grp[k * 4 + j] : (j < 36 ? F.w_exp[k * 32 + (j - 4)] : 0.f);
                bf16v2 t; t.x = (__bf16)v; t.y = (__bf16)0.f; F.WR[(size_t)j * 2048 + k] = (bf16_t)(__builtin_bit_cast(unsigned, t) & 0xffffu); }
        } else {
            const int h = u - B8; u32x4* p = (u32x4*)(F.WIN + (size_t)3664 * 2048) + (size_t)h * 22528;
            for (int i = tid; i < 22528; i += NTHREADS) p[i] = (u32x4){0u, 0u, 0u, 0u};
        }
        if (it == 0) { PROF_T1(20) } else { PROF_T1(21) }
    }
}

__device__ __forceinline__ size_t qi_off(size_t t, int head, int d) { return (t >> 1) * 2048 + (size_t)((d >> 4) * 512 + (((head & 3) + 4 * (int)(t & 1) + 8 * (head >> 2)) + 32 * ((d >> 3) & 1)) * 8 + (d & 7)); }
__device__ __forceinline__ size_t ki_off(size_t s, int d) { const int kin = (int)(s & 127); return (s >> 7) * 8192 + (size_t)(((kin & 3) * 4 + (d >> 4)) * 512 + ((kin >> 2) + 32 * ((d >> 3) & 1)) * 8 + (d & 7)); }

__device__ __forceinline__ void norm_rows(const Frame& F, const float* src, const bf16_t* delta, const float* gain, const float* shiftp, const float* scalep, unsigned char* h8) {
    const int lane = F.lane;
    f32x4 Gv[8], Sv[8];
#pragma unroll
    for (int i = 0; i < 8; ++i) { const int col = 4 * lane + 256 * i; const f32x4 g = *(const f32x4*)(gain + col), sc = *(const f32x4*)(scalep + col);
        Gv[i] = g * (1.0f + sc); Sv[i] = *(const f32x4*)(shiftp + col); }
    f32x4 v[8], vn[8]; u32x2 dv[8], dn[8];
    { const size_t ro = (size_t)(F.bid * 128 + F.wave) * D;
#pragma unroll
      for (int i = 0; i < 8; ++i) { v[i] = *(const f32x4*)(src + ro + 4 * lane + 256 * i); if (delta) dv[i] = *(const u32x2*)(delta + ro + 4 * lane + 256 * i); } }
    for (int j = 0; j < 16; ++j) {
        const int t = F.bid * 128 + F.wave + 8 * j;
        if (j < 15) { const size_t ro = (size_t)(t + 8) * D;
#pragma unroll
            for (int i = 0; i < 8; ++i) { vn[i] = *(const f32x4*)(src + ro + 4 * lane + 256 * i); if (delta) dn[i] = *(const u32x2*)(delta + ro + 4 * lane + 256 * i); } }
        if (delta) {
#pragma unroll
            for (int i = 0; i < 8; ++i) v[i] += (f32x4){bf_lo(dv[i].x), bf_hi(dv[i].x), bf_lo(dv[i].y), bf_hi(dv[i].y)}; }
        float ss = 0.f;
#pragma unroll
        for (int i = 0; i < 8; ++i) ss += v[i][0] * v[i][0] + v[i][1] * v[i][1] + v[i][2] * v[i][2] + v[i][3] * v[i][3];
        ss = wave_sum(ss);
        const float rstd = rsqrtf(ss * (1.0f / 2048.0f) + NORM_EPS);
        bf16_t* hr = F.H + (size_t)t * D;
#pragma unroll
        for (int i = 0; i < 8; ++i) { const f32x4 y = v[i] * rstd * Gv[i] + Sv[i]; u32x2 w; w.x = pk_bf16(y[0], y[1]); w.y = pk_bf16(y[2], y[3]); *(u32x2*)(hr + 4 * lane + 256 * i) = w;
            if (h8) { int p8 = __builtin_amdgcn_cvt_pk_fp8_f32(y[0] * pg8::H_SCALE, y[1] * pg8::H_SCALE, 0, false); p8 = __builtin_amdgcn_cvt_pk_fp8_f32(y[2] * pg8::H_SCALE, y[3] * pg8::H_SCALE, p8, true);
                *(unsigned*)(h8 + (size_t)t * D + 4 * lane + 256 * i) = (unsigned)p8; } }
        if (j < 15) {
#pragma unroll
            for (int i = 0; i < 8; ++i) { v[i] = vn[i]; dv[i] = dn[i]; } }
    }
}

__device__ __forceinline__ void norm_rows_x1(const Frame& F, const bf16_t* X1, const float* gain, const float* shiftp, const float* scalep, unsigned char* h8) {
    const int lane = F.lane;
    f32x4 Gv[4][2], Sv[4][2];
#pragma unroll
    for (int i = 0; i < 4; ++i)
#pragma unroll
        for (int n = 0; n < 2; ++n) { const int col = 8 * lane + 512 * i + 4 * n; const f32x4 g = *(const f32x4*)(gain + col), sc = *(const f32x4*)(scalep + col);
            Gv[i][n] = g * (1.0f + sc); Sv[i][n] = *(const f32x4*)(shiftp + col); }
    u32x4 xv[4], xn[4];
    { const size_t ro = (size_t)(F.bid * 128 + F.wave) * D;
#pragma unroll
      for (int i = 0; i < 4; ++i) xv[i] = *(const u32x4*)(X1 + ro + 8 * lane + 512 * i); }
    for (int j = 0; j < 16; ++j) {
        const int t = F.bid * 128 + F.wave + 8 * j;
        if (j < 15) { const size_t ro = (size_t)(t + 8) * D;
#pragma unroll
            for (int i = 0; i < 4; ++i) xn[i] = *(const u32x4*)(X1 + ro + 8 * lane + 512 * i); }
        f32x4 v[4][2];
#pragma unroll
        for (int i = 0; i < 4; ++i) { v[i][0] = (f32x4){bf_lo(xv[i].x), bf_hi(xv[i].x), bf_lo(xv[i].y), bf_hi(xv[i].y)}; v[i][1] = (f32x4){bf_lo(xv[i].z), bf_hi(xv[i].z), bf_lo(xv[i].w), bf_hi(xv[i].w)}; }
        float ss = 0.f;
#pragma unroll
        for (int i = 0; i < 4; ++i)
#pragma unroll
            for (int n = 0; n < 2; ++n) ss += v[i][n][0] * v[i][n][0] + v[i][n][1] * v[i][n][1] + v[i][n][2] * v[i][n][2] + v[i][n][3] * v[i][n][3];
        ss = wave_sum(ss);
        const float rstd = rsqrtf(ss * (1.0f / 2048.0f) + NORM_EPS);
        bf16_t* hr = F.H + (size_t)t * D;
#pragma unroll
        for (int i = 0; i < 4; ++i) { const f32x4 y0 = v[i][0] * rstd * Gv[i][0] + Sv[i][0], y1 = v[i][1] * rstd * Gv[i][1] + Sv[i][1];
            u32x4 w; w.x = pk_bf16(y0[0], y0[1]); w.y = pk_bf16(y0[2], y0[3]); w.z = pk_bf16(y1[0], y1[1]); w.w = pk_bf16(y1[2], y1[3]);
            *(u32x4*)(hr + 8 * lane + 512 * i) = w;
            int p0 = __builtin_amdgcn_cvt_pk_fp8_f32(y0[0] * pg8::H_SCALE, y0[1] * pg8::H_SCALE, 0, false); p0 = __builtin_amdgcn_cvt_pk_fp8_f32(y0[2] * pg8::H_SCALE, y0[3] * pg8::H_SCALE, p0, true);
            int p1 = __builtin_amdgcn_cvt_pk_fp8_f32(y1[0] * pg8::H_SCALE, y1[1] * pg8::H_SCALE, 0, false); p1 = __builtin_amdgcn_cvt_pk_fp8_f32(y1[2] * pg8::H_SCALE, y1[3] * pg8::H_SCALE, p1, true);
            u32x2 q; q.x = (unsigned)p0; q.y = (unsigned)p1;
            *(u32x2*)(h8 + (size_t)t * D + 8 * lane + 512 * i) = q; }
        if (j < 15) {
#pragma unroll
            for (int i = 0; i < 4; ++i) xv[i] = xn[i]; }
    }
}

__device__ __forceinline__ void p3_post(const Frame& F) {
    const int lane = F.lane;
    LAS float* kw = (LAS float*)F.lds + F.wave * 1280;
    PROF_T0(30)
    {
        const int li = lane & 15, q4 = lane >> 4;
        f32x4 acc[5];
#pragma unroll
        for (int nb = 0; nb < 5; ++nb) acc[nb] = (f32x4){0.f, 0.f, 0.f, 0.f};
        const bf16_t* hp = F.H + (size_t)(F.bid * 128 + F.wave * 16 + li) * D + 8 * q4;
        LAS bf16_t* bs = (LAS bf16_t*)(F.lds + 40960);
        u32x4 st[5]; bf16x8 a[8];
#define KW_LOAD(kc_) do { _Pragma("unroll") for (int i = 0; i < 5; ++i) { const int piece = F.tid + 512 * i, row = piece >> 5, pc = piece & 31; st[i] = *(const u32x4*)(F.WIN + (size_t)(3584 + row) * D + (kc_) * 256 + pc * 8); } \
            _Pragma("unroll") for (int ks = 0; ks < 8; ++ks) a[ks] = *(const bf16x8*)(hp + 32 * ((kc_) * 8 + ks)); asm volatile("" ::: "memory"); } while (0)
        KW_LOAD(0);
#pragma unroll
        for (int kc = 0; kc < 8; ++kc) {
            bf16x8 ac[8];
#pragma unroll
            for (int ks = 0; ks < 8; ++ks) ac[ks] = a[ks];
            __syncthreads();
#pragma unroll
            for (int i = 0; i < 5; ++i) { const int piece = F.tid + 512 * i, row = piece >> 5, pc = piece & 31; *(LAS u32x4*)(bs + row * 264 + pc * 8) = st[i]; }
            KW_LOAD(kc < 7 ? kc + 1 : 7);
            __syncthreads();
#pragma unroll
            for (int ks = 0; ks < 8; ++ks)
#pragma unroll
                for (int nb = 0; nb < 5; ++nb) { const bf16x8 bb = *(const LAS bf16x8*)(bs + (nb * 16 + li) * 264 + ks * 32 + 8 * q4); acc[nb] = __builtin_amdgcn_mfma_f32_16x16x32_bf16(ac[ks], bb, acc[nb], 0, 0, 0); }
        }
#undef KW_LOAD
#pragma unroll
        for (int nb = 0; nb < 5; ++nb)
#pragma unroll
            for (int i = 0; i < 4; ++i) kw[(4 * q4 + i) * 80 + nb * 16 + li] = acc[nb][i];
        asm volatile("s_waitcnt lgkmcnt(0)" ::: "memory");
    }
    PROF_T1(30) PROF_T0(31)
    LAS float* tabl = (LAS float*)(F.lds + 98304);
    { const float* tg = F.TAB + (size_t)((F.bid * 128) & (S - 1)) * 48;
      for (int i = F.tid; i < 128 * 48 / 4; i += NTHREADS) *(LAS f32x4*)(tabl + 4 * i) = *(const f32x4*)(tg + 4 * i); }
    __syncthreads();
    const float IDX_SCALE = 0.125f * 0.25f;
    float gq[16], gk[16];
#pragma unroll
    for (int e = 0; e < 16; ++e) { gq[e] = F.q_norm_g[(lane & 7) * 16 + e]; gk[e] = F.k_norm_g[(lane & 7) * 16 + e]; }
    float wsum[16];
    const int gpl = lane >> 4, wpl = 2 << gpl;
    u32x4 nL[10];
#define P3_FETCH(jj) do { const int _t = F.bid * 128 + F.wave * 16 + (jj), _pos = _t & (S - 1); const bf16_t* _pr = F.PROJ + (size_t)_t * NPROJ; \
        nL[0] = *(const u32x4*)(_pr + CQ + 16 * lane); nL[1] = *(const u32x4*)(_pr + CQ + 16 * lane + 8); \
        nL[2] = *(const u32x4*)(_pr + CK + 16 * (lane & 31)); nL[3] = *(const u32x4*)(_pr + CK + 16 * (lane & 31) + 8); \
        nL[4] = *(const u32x4*)(_pr + CQI + 16 * lane); nL[5] = *(const u32x4*)(_pr + CQI + 16 * lane + 8); \
        nL[6] = *(const u32x4*)(_pr + CP + 16 * lane); nL[7] = *(const u32x4*)(_pr + CP + 16 * lane + 8); \
        { const int _rr = wpl <= _pos ? wpl : _pos; const bf16_t* _pp = _pr - (size_t)_rr * NPROJ + CP + 16 * lane; nL[8] = *(const u32x4*)_pp; nL[9] = *(const u32x4*)(_pp + 8); } \
        asm volatile("" ::: "memory"); } while (0)
    P3_FETCH(0);
    for (int j = 0; j < 16; ++j) {
        const int t = F.bid * 128 + F.wave * 16 + j, pos = t & (S - 1);
        const bf16_t* pr = F.PROJ + (size_t)t * NPROJ;
        const u32x4 Lq0 = nL[0], Lq1 = nL[1], Lk0 = nL[2], Lk1 = nL[3], Li0 = nL[4], Li1 = nL[5], Lp0 = nL[6], Lp1 = nL[7], Lo0 = nL[8], Lo1 = nL[9];
        f32x4 tq[8], ti[4];
        { const LAS float* tab = tabl + (F.wave * 16 + j) * 48;
#pragma unroll
          for (int i = 0; i < 8; ++i) tq[i] = *(const LAS f32x4*)(tab + 4 * i);
#pragma unroll
          for (int i = 0; i < 4; ++i) ti[i] = *(const LAS f32x4*)(tab + 32 + 4 * i); }
        if (j < 15) P3_FETCH(j + 1);
        {
            float f[16]; unpack8(Lq0, f); unpack8(Lq1, f + 8);
            float ss = 0.f;
#pragma unroll
            for (int e = 0; e < 16; ++e) ss += f[e] * f[e];
            ss += __shfl_xor(ss, 1); ss += __shfl_xor(ss, 2); ss += __shfl_xor(ss, 4);
            const float rstd = rsqrtf(ss * (1.0f / 128.0f) + NORM_EPS);
            const int d0 = (lane & 7) * 16;
#pragma unroll
            for (int e = 0; e < 16; ++e) f[e] = f[e] * rstd * gq[e];
            float o[16];
#pragma unroll
            for (int e = 0; e < 16; ++e) o[e] = __shfl_xor(f[e], 1);
            const int l8 = lane & 7;
            if (l8 < 2) {
#pragma unroll
                for (int e = 0; e < 16; ++e) { const float cs = tq[e >> 2][e & 3], sn = tq[4 + (e >> 2)][e & 3]; f[e] = (l8 == 0) ? (f[e] * cs - o[e] * sn) : (f[e] * cs + o[e] * sn); }
            }
            *(u32x4*)(F.Q8 + (size_t)t * 1024 + 16 * lane) = pack16_fp8(f);
        }
        {
            const int l = lane & 31;
            float f[16]; unpack8(Lk0, f); unpack8(Lk1, f + 8);
            float kf[16]; float ss = 0.f;
#pragma unroll
            for (int e = 0; e < 16; ++e) ss += f[e] * f[e];
            ss += __shfl_xor(ss, 1); ss += __shfl_xor(ss, 2); ss += __shfl_xor(ss, 4);
            const float rstd = rsqrtf(ss * (1.0f / 128.0f) + NORM_EPS);
            const int d0 = (l & 7) * 16;
#pragma unroll
            for (int e = 0; e < 16; ++e) kf[e] = f[e] * rstd * gk[e];
            float o[16];
#pragma unroll
            for (int e = 0; e < 16; ++e) o[e] = __shfl_xor(kf[e], 1);
            const int l8 = l & 7;
            if (l8 < 2) {
#pragma unroll
                for (int e = 0; e < 16; ++e) { const float cs = tq[e >> 2][e & 3], sn = tq[4 + (e >> 2)][e & 3]; kf[e] = (l8 == 0) ? (kf[e] * cs - o[e] * sn) : (kf[e] * cs + o[e] * sn); }
            }
            if (lane < 32) {
                const bool isv = lane >= 16; const int ll = lane & 15, g = ll >> 3, dd = (ll & 7) * 16;
                *(u32x4*)(F.KVm + (size_t)t * 512 + g * 256 + (isv ? 128 : 0) + dd) = pack16_fp8(isv ? f : kf);
            }
        }
        {
            float f[16]; unpack8(Li0, f); unpack8(Li1, f + 8);
            if ((lane & 3) == 0) {
#pragma unroll
                for (int i = 0; i < 8; ++i) { const float cs = ti[i >> 2][i & 3], sn = ti[2 + (i >> 2)][i & 3]; const float x1 = f[i], x2 = f[i + 8]; f[i] = x1 * cs - x2 * sn; f[i + 8] = x2 * cs + x1 * sn; }
            }
            const int hd = lane >> 2, d0 = (lane & 3) * 16;
            *(u32x4*)(F.QI + qi_off((size_t)t, hd, d0)) = pack8(f); *(u32x4*)(F.QI + qi_off((size_t)t, hd, d0 + 8)) = pack8(f + 8);
        }
        if (lane < 12) {
            if (lane < 8) {
                const int d0 = 8 * lane;
                float f[8];
#pragma unroll
                for (int e = 0; e < 8; ++e) f[e] = kw[j * 80 + d0 + e];
                if (lane < 2) {
#pragma unroll
                    for (int i = 0; i < 8; ++i) { const float cs = ti[i >> 2][i & 3], sn = ti[2 + (i >> 2)][i & 3]; const float oth = kw[j * 80 + (d0 ^ 8) + i];
                        f[i] = lane == 0 ? f[i] * cs - oth * sn : f[i] * cs + oth * sn; }
                }
                *(u32x4*)(F.KI + ki_off((size_t)t, d0)) = pack8(f);
            } else {
                const int h0 = 4 * (lane - 8);
                f32x4 wv4;
#pragma unroll
                for (int e = 0; e < 4; ++e) wv4[e] = kw[j * 80 + 64 + h0 + e] * IDX_SCALE;
                *(f32x4*)(F.WI + (size_t)t * 16 + h0) = wv4;
            }
        }
        {
            const int g = lane >> 4, w = 2 << g;
            float cur[16], sum[16];
            unpack8(Lp0, cur); unpack8(Lp1, cur + 8);
            if (j == 0) {
#pragma unroll
                for (int e = 0; e < 16; ++e) wsum[e] = cur[e];
                for (int r = 1; r < 16; ++r) {
                    if (r < w && r <= pos) { float f[16]; const bf16_t* pp = pr - (size_t)r * NPROJ + CP + 16 * lane; unpack8(*(const u32x4*)pp, f); unpack8(*(const u32x4*)(pp + 8), f + 8);
#pragma unroll
                        for (int e = 0; e < 16; ++e) wsum[e] += f[e]; }
                }
            } else {
                float old[16]; unpack8(Lo0, old); unpack8(Lo1, old + 8);
                const float useo = (pos >= w) ? 1.0f : 0.0f;
#pragma unroll
                for (int e = 0; e < 16; ++e) wsum[e] += cur[e] - useo * old[e];
            }
            const float inv = 1.0f / (float)((pos + 1) < w ? (pos + 1) : w);
#pragma unroll
            for (int e = 0; e < 16; ++e) sum[e] = wsum[e] * inv - cur[e];
            bf16_t* po = F.PM + ((size_t)g * T + t) * 256 + (lane & 15) * 16;
            *(u32x4*)po = pack8(sum); *(u32x4*)(po + 8) = pack8(sum + 8);
        }
    }
    PROF_T1(31)
#undef P3_FETCH
}

__device__ __forceinline__ unsigned okey2(unsigned x) { typedef short s16x2 __attribute__((ext_vector_type(2))); const s16x2 sg = __builtin_bit_cast(s16x2, x) >> (s16x2){15, 15};
    return x ^ (0x80008000u | (__builtin_bit_cast(unsigned, sg) & 0x7fff7fffu)); }
__device__ __forceinline__ size_t sc_block_base(int b, int qb) { return (size_t)b * SC_BATCH + (size_t)16384 * ((size_t)qb * (qb + 1) / 2); }

__device__ __forceinline__ void indexer_sweep(const Frame& F) {
    const int lane = F.lane, wid = F.wave, c = lane & 31, hf = lane >> 5;
    const int b = F.bid >> 6, j0 = F.bid & 63;
    LAS unsigned char* kbuf = F.lds;
    for (int half = 0; half < 2; ++half) {
        const int qb64 = half == 0 ? j0 : 127 - j0, nkb = (qb64 >> 1) + 1, qb128 = qb64 >> 1;
        const size_t tq0 = (size_t)b * S + qb64 * 64 + wid * 8;
        bf16x8 af[4][4]; f32x4 wv[4][4];
#pragma unroll
        for (int p = 0; p < 4; ++p) {
#pragma unroll
            for (int kk = 0; kk < 4; ++kk) af[p][kk] = *(const bf16x8*)(F.QI + ((tq0 >> 1) + p) * 2048 + kk * 512 + lane * 8);
#pragma unroll
            for (int i = 0; i < 4; ++i) wv[p][i] = *(const f32x4*)(F.WI + (tq0 + 2 * p + hf) * 16 + 4 * i);
        }
        const size_t rowlen = (size_t)(qb128 + 1) * 128;
        unsigned short* scb = F.SC + sc_block_base(b, qb128) + (size_t)((qb64 & 1) * 64 + wid * 8 + hf) * rowlen + 4 * c;
        const bf16_t* kib = F.KI + (((size_t)b * S) >> 7) * 8192 + (2 * wid) * 512 + lane * 8;
        __syncthreads();
#define IX_BUF(kb) ((((kb) >> 1) & 1) * 32768 + ((kb) & 1) * 16384)
#define IX_DMA(kb) do { _Pragma("unroll") for (int _i = 0; _i < 2; ++_i) \
            __builtin_amdgcn_global_load_lds((const unsigned*)(kib + (size_t)(kb) * 8192 + _i * 512), (LAS unsigned*)(kbuf + IX_BUF(kb) + (2 * wid + _i) * 1024), 16, 0, 0); } while (0)
        IX_DMA(0); if (nkb > 1) IX_DMA(1);
        for (int kb0 = 0; kb0 < nkb; kb0 += 2) {
            PROF_T0(60)
            if (kb0 == 0) asm volatile("s_waitcnt vmcnt(0)" ::: "memory"); else asm volatile("s_waitcnt vmcnt(8)" ::: "memory");
            __syncthreads();
            if (kb0 + 2 < nkb) { IX_DMA(kb0 + 2); if (kb0 + 3 < nkb) IX_DMA(kb0 + 3); }
            PROF_T1(60) PROF_T0(61)
            for (int kb = kb0; kb < kb0 + 2 && kb < nkb; ++kb) {
            float sc[4][4];
            bf16x8 kf[2][4];
#pragma unroll
            for (int kk = 0; kk < 4; ++kk) kf[0][kk] = *(const LAS bf16x8*)(kbuf + IX_BUF(kb) + kk * 1024 + lane * 16);
            f32x16 accs[2];
#pragma unroll
            for (int i = 0; i < 16; ++i) accs[0][i] = 0.f;
#pragma unroll
            for (int kk = 0; kk < 4; ++kk) accs[0] = __builtin_amdgcn_mfma_f32_32x32x16_bf16(af[0][kk], kf[0][kk], accs[0], 0, 0, 0);
#pragma unroll
            for (int n = 0; n < 16; ++n) {
                const int sub = n >> 2, p = n & 3;
                if (p == 0 && sub < 3) {
#pragma unroll
                    for (int kk = 0; kk < 4; ++kk) kf[(sub + 1) & 1][kk] = *(const LAS bf16x8*)(kbuf + IX_BUF(kb) + ((sub + 1) * 4 + kk) * 1024 + lane * 16);
                }
                if (n < 15) {
                    const int sub1 = (n + 1) >> 2, p1 = (n + 1) & 3;
#pragma unroll
                    for (int i = 0; i < 16; ++i) accs[(n + 1) & 1][i] = 0.f;
#pragma unroll
                    for (int kk = 0; kk < 4; ++kk) accs[(n + 1) & 1] = __builtin_amdgcn_mfma_f32_32x32x16_bf16(af[p1][kk], kf[sub1 & 1][kk], accs[(n + 1) & 1], 0, 0, 0);
                }
                float sm = 0.f;
#pragma unroll
                for (int i = 0; i < 16; ++i) { const float av = accs[n & 1][i]; const int ai = __float_as_int(av); const float rl = __int_as_float(ai > 0 ? ai : 0); const float wi_ = wv[p][i >> 2][i & 3];
                    asm("v_fmac_f32 %0, %1, %2" : "+v"(sm) : "v"(wi_), "v"(rl)); }
                sc[p][sub] = sm;
            }
#pragma unroll
            for (int p = 0; p < 4; ++p) {
                f16v2 h0, h1; h0.x = (_Float16)sc[p][0]; h0.y = (_Float16)sc[p][1]; h1.x = (_Float16)sc[p][2]; h1.y = (_Float16)sc[p][3];
                u32x2 w; w.x = okey2(__builtin_bit_cast(unsigned, h0)); w.y = okey2(__builtin_bit_cast(unsigned, h1));
                *(u32x2*)(scb + (size_t)(2 * p) * rowlen + kb * 128) = w;
            }
            }
            PROF_T1(61)
        }
#undef IX_DMA
#undef IX_BUF
    }
    __syncthreads();
}

__device__ __forceinline__ void find_bin(LAS unsigned* hist, int lane, unsigned need, unsigned& bin, unsigned& above) {
    const u32x4 h = *(const LAS u32x4*)(hist + 4 * lane);
    const unsigned s = h.x + h.y + h.z + h.w;
    unsigned v = s;
#pragma unroll
    for (int d = 1; d < 64; d <<= 1) { const unsigned tt = __shfl_down(v, d); if (lane + d < 64) v += tt; }
    unsigned run = v - s;
    int fb = -1; unsigned fa = 0;
    const unsigned hh[4] = {h.x, h.y, h.z, h.w};
#pragma unroll
    for (int j = 3; j >= 0; --j) { if (fb < 0 && run < need && run + hh[j] >= need) { fb = 4 * lane + j; fa = run; } run += hh[j]; }
    const unsigned long long m = __ballot(fb >= 0);
    const int src = m ? (int)__builtin_ctzll(m) : 0;
    bin = (unsigned)__shfl(fb, src); above = __shfl(fa, src);
}

__device__ __forceinline__ unsigned okey(unsigned h) { return (h & 0x8000u) ? (~h & 0xffffu) : (h | 0x8000u); }
__device__ __forceinline__ const unsigned short* sel_src(const Frame& F, int t) { const int pos = t & (S - 1), qb = pos >> 7; return F.SC + sc_block_base(t >> 13, qb) + (size_t)(pos & 127) * (qb + 1) * 128; }
__device__ __forceinline__ void sel_fetch(const Frame& F, int t, u32x4 (&pre)[16]) {
    const unsigned short* src = sel_src(F, t); const int n = (t & (S - 1)) + 1, nch = n > 256 ? (n + 511) >> 9 : 0;
#pragma unroll
    for (int ch = 0; ch < 16; ++ch) if (ch < nch) pre[ch] = *(const u32x4*)(src + ch * 512 + F.lane * 8);
    asm volatile("" ::: "memory");
}
__device__ __forceinline__ void select_row(const Frame& F, int t, const u32x4 (&pre)[16], LAS unsigned char* wbuf, int lane) {
    LAS unsigned* rowb = (LAS unsigned*)wbuf;
    LAS unsigned* hist = (LAS unsigned*)(wbuf + 16384);
    LAS unsigned short* lst = (LAS unsigned short*)(wbuf + 16384 + 1024);
    LAS unsigned* dump32 = (LAS unsigned*)(wbuf + 16384 + 1024 + 640);
    const int pos = t & (S - 1), n = pos + 1;
    unsigned short* out = F.SEL + (size_t)t * 256;
    if (n <= 256) { for (int j = lane; j < 256; j += 64) out[j] = (unsigned short)(j < n ? j : 0); return; }
    const int nch = (n + 511) >> 9;
    PROF_T0(0) PROF_T0(1)
#pragma unroll
    for (int ch = 0; ch < 16; ++ch) if (ch < nch) {
        u32x4 v = pre[ch];
        if (ch == nch - 1) {
#pragma unroll
            for (int w = 0; w < 4; ++w) { const int e0 = ch * 512 + lane * 8 + 2 * w; v[w] = (e0 < n ? v[w] & 0xffffu : 0u) | (e0 + 1 < n ? v[w] & 0xffff0000u : 0u); }
        }
        *(LAS u32x4*)(rowb + ch * 256 + lane * 4) = v;
    }
#pragma unroll
    for (int i = 0; i < 4; ++i) hist[lane + 64 * i] = 0u;
    PROF_T1(1) PROF_T0(2)
    u32x4 rnx = *(const LAS u32x4*)(rowb + lane * 4);
    for (int ch = 0; ch < nch; ++ch) {
        const u32x4 raw = rnx; rnx = *(const LAS u32x4*)(rowb + (ch + 1 < nch ? ch + 1 : ch) * 256 + lane * 4);
#pragma unroll
        for (int w = 0; w < 4; ++w) {
            __hip_atomic_fetch_add(hist + ((raw[w] >> 8) & 255u), 1u, __ATOMIC_RELAXED, __HIP_MEMORY_SCOPE_WORKGROUP);
            __hip_atomic_fetch_add(hist + (raw[w] >> 24), 1u, __ATOMIC_RELAXED, __HIP_MEMORY_SCOPE_WORKGROUP);
        }
    }
    PROF_T1(2) PROF_T0(3)
    unsigned bin1, above1; find_bin(hist, lane, 256u, bin1, above1);
    const unsigned r1 = 256u - above1;
#pragma unroll
    for (int i = 0; i < 4; ++i) hist[lane + 64 * i] = 0u;
    PROF_T1(3) PROF_T0(4)
    rnx = *(const LAS u32x4*)(rowb + lane * 4);
    for (int ch = 0; ch < nch; ++ch) {
        const u32x4 raw = rnx; rnx = *(const LAS u32x4*)(rowb + (ch + 1 < nch ? ch + 1 : ch) * 256 + lane * 4);
        unsigned mb = 0;
#pragma unroll
        for (int e = 0; e < 8; ++e) { const unsigned key = (raw[e >> 1] >> ((e & 1) * 16)) & 0xffffu; mb |= ((key >> 8) == bin1 ? 1u : 0u) << e; }
#pragma unroll
        for (int rep = 0; rep < 2; ++rep) {
            const bool has = mb != 0u; const int e = __builtin_ctz(mb | 0x100u); mb &= mb - 1u;
            const unsigned wsel = e < 4 ? (e < 2 ? raw[0] : raw[1]) : (e < 6 ? raw[2] : raw[3]);
            const unsigned key = (wsel >> ((e & 1) * 16)) & 0xffffu;
            __hip_atomic_fetch_add(has ? hist + (key & 255u) : dump32 + lane, has ? 1u : 0u, __ATOMIC_RELAXED, __HIP_MEMORY_SCOPE_WORKGROUP);
        }
        while (mb) { const int e = __builtin_ctz(mb); mb &= mb - 1u;
            const unsigned wsel = e < 4 ? (e < 2 ? raw[0] : raw[1]) : (e < 6 ? raw[2] : raw[3]);
            const unsigned key = (wsel >> ((e & 1) * 16)) & 0xffffu;
            __hip_atomic_fetch_add(hist + (key & 255u), 1u, __ATOMIC_RELAXED, __HIP_MEMORY_SCOPE_WORKGROUP); }
    }
    PROF_T1(4) PROF_T0(5)
    unsigned bin2, above2; find_bin(hist, lane, r1, bin2, above2);
    PROF_T1(5) PROF_T0(6)
    const unsigned r2 = r1 - above2, thr = (bin1 << 8) | bin2;
    LAS unsigned short* msk = (LAS unsigned short*)hist;
    unsigned cg = 0, ce = 0;
    rnx = *(const LAS u32x4*)(rowb + lane * 4);
    for (int ch = 0; ch < nch; ++ch) {
        const u32x4 raw = rnx; if (ch + 1 < nch) rnx = *(const LAS u32x4*)(rowb + (ch + 1) * 256 + lane * 4);
        unsigned mg = 0, me = 0;
#pragma unroll
        for (int e = 0; e < 8; ++e) { const unsigned key = (raw[e >> 1] >> ((e & 1) * 16)) & 0xffffu; mg |= (key > thr ? 1u : 0u) << e; me |= (key == thr ? 1u : 0u) << e; }
        cg += (unsigned)__builtin_popcount(mg); ce += (unsigned)__builtin_popcount(me);
        rowb[ch * 256 + lane * 4] = mg | (me << 8);
    }
    (void)msk;
    PROF_T1(6) PROF_T0(7)
    unsigned og = cg, oe = ce;
#pragma unroll
    for (int d = 1; d < 64; d <<= 1) { const unsigned tg = __shfl_up(og, d), te = __shfl_up(oe, d); if (lane >= d) { og += tg; oe += te; } }
    og -= cg; oe -= ce;
    const unsigned G = above1 + above2;
    PROF_T1(7) PROF_T0(8)
    unsigned mnx = rowb[lane * 4];
    for (int ch = 0; ch < nch; ++ch) {
        const unsigned m = mnx; mnx = rowb[(ch + 1 < nch ? ch + 1 : ch) * 256 + lane * 4];
        unsigned mg = m & 255u, me = (m >> 8) & 255u;
#pragma unroll
        for (int rep = 0; rep < 2; ++rep) {
            const bool has = mg != 0u; const int e = __builtin_ctz(mg | 0x100u); mg &= mg - 1u;
            lst[has ? og : 256u + (unsigned)lane] = (unsigned short)(ch * 512 + lane * 8 + e); og += has ? 1u : 0u;
        }
        while (mg) { const int e = __builtin_ctz(mg); mg &= mg - 1u; lst[og] = (unsigned short)(ch * 512 + lane * 8 + e); ++og; }
        while (me) { const int e = __builtin_ctz(me); me &= me - 1u; if (oe < r2 && G + oe < 256u) lst[G + oe] = (unsigned short)(ch * 512 + lane * 8 + e); ++oe; }
    }
    PROF_T1(8) PROF_T0(9)
    *(u32x2*)(out + 4 * lane) = *(const LAS u32x2*)(lst + 4 * lane);
    PROF_T1(9) PROF_T1(0)
}

__device__ __forceinline__ bf16x8 tr_read2(unsigned a0, unsigned a1) {
    s16x4 x, y;
    asm volatile("ds_read_b64_tr_b16 %0, %2\n\tds_read_b64_tr_b16 %1, %3\n\ts_waitcnt lgkmcnt(0)" : "=&v"(x), "=&v"(y) : "v"(a0), "v"(a1) : "memory");
    return (bf16x8){x[0], x[1], x[2], x[3], y[0], y[1], y[2], y[3]};
}

__device__ __forceinline__ void tr_read16(const unsigned (&va)[4], s16x4 (&r)[16]) {
    asm volatile(
        "ds_read_b64_tr_b16 %0, %16\n\tds_read_b64_tr_b16 %1, %16 offset:4096\n\tds_read_b64_tr_b16 %2, %17\n\tds_read_b64_tr_b16 %3, %17 offset:4096\n\t"
        "ds_read_b64_tr_b16 %4, %18\n\tds_read_b64_tr_b16 %5, %18 offset:4096\n\tds_read_b64_tr_b16 %6, %19\n\tds_read_b64_tr_b16 %7, %19 offset:4096\n\t"
        "ds_read_b64_tr_b16 %8, %16 offset:512\n\tds_read_b64_tr_b16 %9, %16 offset:4608\n\tds_read_b64_tr_b16 %10, %17 offset:512\n\tds_read_b64_tr_b16 %11, %17 offset:4608\n\t"
        "ds_read_b64_tr_b16 %12, %18 offset:512\n\tds_read_b64_tr_b16 %13, %18 offset:4608\n\tds_read_b64_tr_b16 %14, %19 offset:512\n\tds_read_b64_tr_b16 %15, %19 offset:4608\n\t"
        "s_waitcnt lgkmcnt(0)"
        : "=&v"(r[0]), "=&v"(r[1]), "=&v"(r[2]), "=&v"(r[3]), "=&v"(r[4]), "=&v"(r[5]), "=&v"(r[6]), "=&v"(r[7]),
          "=&v"(r[8]), "=&v"(r[9]), "=&v"(r[10]), "=&v"(r[11]), "=&v"(r[12]), "=&v"(r[13]), "=&v"(r[14]), "=&v"(r[15])
        : "v"(va[0]), "v"(va[1]), "v"(va[2]), "v"(va[3]) : "memory");
}
#define AT_WAITV(n) asm volatile("s_waitcnt vmcnt(" #n ")" ::: "memory")
__device__ __forceinline__ int rot_k(int p) { return ((p & 1) ? 3 : 1) + ((p >> 2) & 1) * 4; }
__device__ __forceinline__ int rot_v(int r) { return ((r >> 1) & 3) + 4 * ((r >> 4) & 1); }
__device__ __forceinline__ void tr8_read8(const unsigned (&va)[8], long (&r)[8]) {
    asm volatile(
        "ds_read_b64_tr_b8 %0, %8\n\tds_read_b64_tr_b8 %1, %9\n\tds_read_b64_tr_b8 %2, %10\n\tds_read_b64_tr_b8 %3, %11\n\t"
        "ds_read_b64_tr_b8 %4, %12\n\tds_read_b64_tr_b8 %5, %13\n\tds_read_b64_tr_b8 %6, %14\n\tds_read_b64_tr_b8 %7, %15\n\ts_waitcnt lgkmcnt(0)"
        : "=&v"(r[0]), "=&v"(r[1]), "=&v"(r[2]), "=&v"(r[3]), "=&v"(r[4]), "=&v"(r[5]), "=&v"(r[6]), "=&v"(r[7])
        : "v"(va[0]), "v"(va[1]), "v"(va[2]), "v"(va[3]), "v"(va[4]), "v"(va[5]), "v"(va[6]), "v"(va[7]) : "memory");
}
__device__ __forceinline__ void attn_items(const Frame& F, int klo, int khi) {
    typedef long i64x2 __attribute__((ext_vector_type(2)));
    const float QSCALE = 0.08838834764831845f * 1.4426950408889634f;
    const int lane = F.lane, li = lane & 15, q4 = lane >> 4;
    const int xg = F.bid & 7, b = xg >> 1, g = xg & 1;
    const int wq = (F.bid >> 3) * 8 + F.wave;
    LAS unsigned char* wb = F.lds + F.wave * 16384;
    const unsigned wbu = (unsigned)(uintptr_t)wb;
    const unsigned char* kvb = F.KVm + (size_t)b * S * 512 + g * 256;
    const int da = lane >> 3, dr = lane & 7;
    const unsigned kra0 = (unsigned)((li >> 3) * 1024 + (8 * (li & 7) + ((q4 - rot_k(li >> 1)) & 7)) * 16);
    unsigned vrb; int vrot;
    { const int q = li >> 1, p = li & 1, R = q < 4 ? 4 * q4 + q : 16 + 4 * q4 + (q - 4); vrb = wbu + (unsigned)((R >> 3) * 1024 + (R & 7) * 128 + 8 * p); vrot = 8 - rot_v(R); }
#define AT_KDMA(c) do { _Pragma("unroll") for (int _j = 0; _j < 2; ++_j) { const int _row = 8 * _j + da; const int _ix = (__shfl(idx2[(c) >> 1], _row) >> (((c) & 1) * 16)) & 0xffff; \
        unsigned _o = (unsigned)(_ix * 512 + 16 * ((dr + rot_k(_row >> 1)) & 7)); asm volatile("" : "+v"(_o));     \
        __builtin_amdgcn_global_load_lds((const unsigned*)(kvb + _o), (LAS unsigned*)(wb + ((c) & 7) * 2048 + _j * 1024), 16, 0, 0); } } while (0)
#define AT_VDMA(ks) do { _Pragma("unroll") for (int _j = 0; _j < 4; ++_j) { const int _row = 8 * _j + da; const int _ix = (__shfl(idx2[ks], _row & 15) >> ((_j >> 1) * 16)) & 0xffff; \
        unsigned _o = (unsigned)(_ix * 512 + 128 + 16 * ((dr + rot_v(_row)) & 7)); asm volatile("" : "+v"(_o)); \
        __builtin_amdgcn_global_load_lds((const unsigned*)(kvb + _o), (LAS unsigned*)(wb + ((ks) & 3) * 4096 + _j * 1024), 16, 0, 0); } } while (0)
    u32x2 nsel; i64x2 nbq[2];
#define AT_FETCH(kk_) do { const size_t _t = (size_t)(b * S + wq + 256 * (kk_)); \
        nsel = *(const u32x2*)(F.SEL + _t * 256 + 4 * lane); \
        _Pragma("unroll") for (int _sp = 0; _sp < 2; ++_sp) { nbq[_sp] = (i64x2){0, 0}; if (li < 4) nbq[_sp] = *(const i64x2*)(F.Q8 + _t * 1024 + (4 * g + li) * 128 + 16 * (q4 + 4 * _sp)); } } while (0)
    AT_FETCH(klo);
    for (int k = klo; k < khi; ++k) {
        const int pos = wq + 256 * k, t = b * S + pos, cnt = (pos + 1) < 256 ? (pos + 1) : 256;
        int idx2[8]; long bq[4];
#pragma unroll
        for (int i = 0; i < 8; ++i) {
            const int s0 = 32 * i + li, s1 = s0 + 16, sl = 8 * i + (li >> 2);
            const unsigned x0 = (unsigned)__shfl((int)nsel.x, sl), y0 = (unsigned)__shfl((int)nsel.y, sl), x1 = (unsigned)__shfl((int)nsel.x, sl + 4), y1 = (unsigned)__shfl((int)nsel.y, sl + 4);
            const unsigned a0 = (li & 2) ? y0 : x0, a1 = (li & 2) ? y1 : x1;
            const int v0 = (int)((a0 >> ((li & 1) * 16)) & 0xffffu), v1 = (int)((a1 >> ((li & 1) * 16)) & 0xffffu);
            idx2[i] = (s0 < cnt ? v0 : 0) | ((s1 < cnt ? v1 : 0) << 16); }
        bq[0] = nbq[0].x; bq[1] = nbq[0].y; bq[2] = nbq[1].x; bq[3] = nbq[1].y;
        if (k + 1 < khi) AT_FETCH(k + 1);
        PROF_T0(40) PROF_T0(41)
        AT_KDMA(0); AT_KDMA(1); AT_KDMA(2); AT_KDMA(3); AT_KDMA(4); AT_KDMA(5); AT_KDMA(6); AT_KDMA(7);
        f32x4 s[16];
#pragma unroll
        for (int c = 0; c < 16; ++c) {
            if (c <= 8 || c == 10 || c == 12 || c == 14) AT_WAITV(14); else AT_WAITV(12);
            f32x4 acc = (f32x4){0.f, 0.f, 0.f, 0.f};
            const i64x2 a0 = *(const LAS i64x2*)(wb + (c & 7) * 2048 + kra0), a1 = *(const LAS i64x2*)(wb + (c & 7) * 2048 + (kra0 ^ 64u));
            acc = __builtin_amdgcn_mfma_f32_16x16x32_fp8_fp8(a0.x, bq[0], acc, 0, 0, 0);
            acc = __builtin_amdgcn_mfma_f32_16x16x32_fp8_fp8(a0.y, bq[1], acc, 0, 0, 0);
            acc = __builtin_amdgcn_mfma_f32_16x16x32_fp8_fp8(a1.x, bq[2], acc, 0, 0, 0);
            acc = __builtin_amdgcn_mfma_f32_16x16x32_fp8_fp8(a1.y, bq[3], acc, 0, 0, 0);
            s[c] = acc;
            asm volatile("s_waitcnt lgkmcnt(0)" ::: "memory");
            if (c + 8 <= 15) AT_KDMA(c + 8);
            if (c == 9) AT_VDMA(0); if (c == 11) AT_VDMA(1); if (c == 13) AT_VDMA(2); if (c == 15) AT_VDMA(3);
            __builtin_amdgcn_sched_barrier(0);
        }
        PROF_T1(41) PROF_T0(42)
        float m = -INFINITY;
#pragma unroll
        for (int c = 0; c < 16; ++c)
#pragma unroll
            for (int i = 0; i < 4; ++i) { const int slot = c * 16 + 4 * q4 + i; if (slot >= cnt) s[c][i] = -INFINITY; m = fmaxf(m, s[c][i]); }
        m = fmaxf(m, __shfl_xor(m, 16)); m = fmaxf(m, __shfl_xor(m, 32));
        const float mq = m * QSCALE;
        float sum = 0.f;
#pragma unroll
        for (int c = 0; c < 16; ++c)
#pragma unroll
            for (int i = 0; i < 4; ++i) { const float p = exp2f(fmaf(s[c][i], QSCALE, -mq)); s[c][i] = p; sum += p; }
        sum += __shfl_xor(sum, 16); sum += __shfl_xor(sum, 32);
        PROF_T1(42) PROF_T0(43)
        f32x4 o[8];
#pragma unroll
        for (int d = 0; d < 8; ++d) o[d] = (f32x4){0.f, 0.f, 0.f, 0.f};
#pragma unroll
        for (int ks = 0; ks < 8; ++ks) {
            int p0 = __builtin_amdgcn_cvt_pk_fp8_f32(s[2 * ks][0], s[2 * ks][1], 0, false); p0 = __builtin_amdgcn_cvt_pk_fp8_f32(s[2 * ks][2], s[2 * ks][3], p0, true);
            int p1 = __builtin_amdgcn_cvt_pk_fp8_f32(s[2 * ks + 1][0], s[2 * ks + 1][1], 0, false); p1 = __builtin_amdgcn_cvt_pk_fp8_f32(s[2 * ks + 1][2], s[2 * ks + 1][3], p1, true);
            const long bp = (long)(((unsigned long long)(unsigned)p1 << 32) | (unsigned long long)(unsigned)p0);
            if (ks <= 4) AT_WAITV(12); else if (ks == 5) AT_WAITV(8); else if (ks == 6) AT_WAITV(4); else AT_WAITV(0);
            unsigned va[8];
#pragma unroll
            for (int d = 0; d < 8; ++d) va[d] = vrb + (unsigned)((ks & 3) * 4096) + (unsigned)(((vrot + d) & 7) << 4);
            long tr[8];
            tr8_read8(va, tr);
#pragma unroll
            for (int d = 0; d < 8; ++d) o[d] = __builtin_amdgcn_mfma_f32_16x16x32_fp8_fp8(tr[d], bp, o[d], 0, 0, 0);
            if (ks + 4 <= 7) AT_VDMA(ks + 4);
            __builtin_amdgcn_sched_barrier(0);
        }
        PROF_T1(43)
        const float inv = 1.0f / sum;
        if (li < 4) {
            unsigned char* op8 = F.H8 + (size_t)t * D + g * 512 + li * 128 + 4 * q4;
            const float inv8 = inv * pg8::C_SCALE;
#pragma unroll
            for (int d = 0; d < 8; ++d) { int p8 = __builtin_amdgcn_cvt_pk_fp8_f32(o[d][0] * inv8, o[d][1] * inv8, 0, false); p8 = __builtin_amdgcn_cvt_pk_fp8_f32(o[d][2] * inv8, o[d][3] * inv8, p8, true);
                *(unsigned*)(op8 + d * 16) = (unsigned)p8; }
#if SELFCHECK
            bf16_t* op = F.CONCAT + (size_t)t * D + g * 512 + li * 128 + 4 * q4;
#pragma unroll
            for (int d = 0; d < 8; ++d) { u32x2 w; w.x = pk_bf16(o[d][0] * inv, o[d][1] * inv); w.y = pk_bf16(o[d][2] * inv, o[d][3] * inv); *(u32x2*)(op + d * 16) = w; }
#endif
        }
        PROF_T1(40)
    }
#undef AT_FETCH
#undef AT_KDMA
#undef AT_VDMA
}

#if SELFCHECK
__device__ __forceinline__ float bfv(const bf16_t* p, size_t i) { return __uint_as_float(((unsigned)p[i]) << 16); }
__device__ __forceinline__ unsigned hash_u(unsigned x) { x ^= x >> 16; x *= 0x7feb352dU; x ^= x >> 15; x *= 0x846ca68bU; x ^= x >> 16; return x; }
__device__ __forceinline__ void chk_flag(const Frame& F, int k) { __hip_atomic_fetch_add(F.ctl + CW_CHK + k, 1u, __ATOMIC_RELAXED, __HIP_MEMORY_SCOPE_AGENT); }
__device__ __forceinline__ void chk_gemm1(const Frame& F) {
    for (int j = 0; j < 16; ++j) {
        const unsigned hsh = hash_u((unsigned)((F.bid * 8 + F.wave) * 16 + j) * 2654435761u + 12345u);
        const int t = (int)(hsh % (unsigned)T), n = (int)((hsh >> 7) % 3664u);
        float s = 0.f, sa = 0.f;
        for (int k = F.lane; k < D; k += 64) { const float a = bfv(F.H, (size_t)t * D + k), w = F.w_in[(size_t)k * 3664 + n]; s += a * w; sa += fabsf(a * w); }
        s = wave_sum(s); sa = wave_sum(sa);
        const float got = colmap(n) < 3584 ? bfv(F.PROJ, (size_t)t * NPROJ + colmap(n)) : s;
        if (F.lane == 0 && !(fabsf(got - s) <= 0.001f * sa + 0.02f)) chk_flag(F, 0);
    }
}
__device__ __forceinline__ void chk_post(const Frame& F) {
    const int gw = F.bid * 8 + F.wave;
    const int t = (gw * 16 + (gw & 15)) % T, pos = t & (S - 1), lane = F.lane;
    const bf16_t* pr = F.PROJ + (size_t)t * NPROJ;
    const float QSCALE = 0.08838834764831845f * 1.4426950408889634f;
    int bad = 0;
    for (int hh = 0; hh < 10; ++hh) {
        const int cb = hh < 8 ? CQ + hh * 128 : CK + (hh - 8) * 128; const float* gn = hh < 8 ? F.q_norm_g : F.k_norm_g;
        float ss = 0.f; for (int d = lane; d < 128; d += 64) { const float v = bfv(pr, cb + d); ss += v * v; } ss = wave_sum(ss);
        const float rstd = 1.0f / sqrtf(ss / 128.0f + NORM_EPS);
        for (int d = lane; d < 128; d += 64) {
            float y = bfv(pr, cb + d) * rstd * gn[d];
            if (d < 32) { const int i = d & 15; const float inv = powf(500000.0f, -(float)(2 * i) / 32.0f); const float ang = (float)pos * inv; const float cs = cosf(ang), sn = sinf(ang);
                const int dp = d < 16 ? d + 16 : d - 16; const float yp = bfv(pr, cb + dp) * rstd * gn[dp];
                y = d < 16 ? y * cs - yp * sn : y * cs + yp * sn; }
            float got, ref;
            if (hh < 8) { ref = y; got = fp8_at(F.Q8, (size_t)t * 1024 + hh * 128 + d); } else { ref = y; got = fp8_at(F.KVm, (size_t)t * 512 + (hh - 8) * 256 + d); }
            if (!(fabsf(got - ref) <= 0.08f * fabsf(ref) + 0.02f)) bad = 1;
        }
    }
    for (int e = lane; e < 256; e += 64) { const float ref = bfv(pr, CV + e), got = fp8_at(F.KVm, (size_t)t * 512 + (e >> 7) * 256 + 128 + (e & 127)); if (!(fabsf(got - ref) <= 0.08f * fabsf(ref) + 0.02f)) bad = 1; }
    for (int e = lane; e < 1024; e += 64) {
        const int cb = CQI + (e & ~63); const int d = e & 63;
        float y = bfv(pr, cb + d);
        if (d < 16) { const int i = d & 7; const float inv = powf(500000.0f, -(float)(2 * i) / 16.0f); const float ang = (float)pos * inv; const float cs = cosf(ang), sn = sinf(ang);
            const int dp = d < 8 ? d + 8 : d - 8; const float yp = bfv(pr, cb + dp); y = d < 8 ? y * cs - yp * sn : y * cs + yp * sn; }
        const float got = bfv(F.QI, qi_off((size_t)t, e >> 6, d));
        if (!(fabsf(got - y) <= 0.02f * fabsf(y) + 0.02f)) bad = 1;
    }
    {
        LAS float* kwref = (LAS float*)(F.lds + 49152) + F.wave * 128;
        for (int c = 0; c < 80; ++c) {
            float sdot = 0.f; for (int k = lane; k < D; k += 64) sdot += bfv(F.H, (size_t)t * D + k) * F.w_in[(size_t)k * 3664 + 2560 + c];
            sdot = wave_sum(sdot); if (lane == 0) kwref[c] = sdot;
        }
        asm volatile("s_waitcnt lgkmcnt(0)" ::: "memory");
        { const int d = lane; float y = kwref[d];
          if (d < 16) { const int i = d & 7; const float inv = powf(500000.0f, -(float)(2 * i) / 16.0f); const float ang = (float)pos * inv; const float cs = cosf(ang), sn = sinf(ang);
              const int dp = d < 8 ? d + 8 : d - 8; const float yp = kwref[dp]; y = d < 8 ? y * cs - yp * sn : y * cs + yp * sn; }
          const float got = bfv(F.KI, ki_off((size_t)t, d));
          if (!(fabsf(got - y) <= 0.02f * fabsf(y) + 0.03f)) bad = 1; }
        if (lane < 16) { const float ref = kwref[64 + lane] * 0.03125f, got = F.WI[(size_t)t * 16 + lane]; if (!(fabsf(got - ref) <= 1e-3f + 0.01f * fabsf(ref))) bad = 1; }
    }
    for (int e = lane; e < 1024; e += 64) {
        const int g = e >> 8, w = 2 << g; float sum = 0.f; int cn = 0;
        for (int r = 0; r < w; ++r) if (pos - r >= 0) { sum += bfv(pr - (size_t)r * NPROJ, CP + e); ++cn; }
        const float ref = sum / (float)cn - bfv(pr, CP + e), got = bfv(F.PM, ((size_t)g * T + t) * 256 + (e & 255));
        if (!(fabsf(got - ref) <= 0.02f * fabsf(ref) + 0.02f)) bad = 1;
    }
    if (__ballot(bad) != 0ull && lane == 0) chk_flag(F, 1);
}
__device__ __forceinline__ void chk_attn(const Frame& F) {
    const int w = F.bid, b = w & 3, j = w >> 2;
    const int pos = j == 0 ? 0 : j == 1 ? 1 : j == 2 ? 100 : j == 3 ? 254 : j == 4 ? 255 : j == 5 ? 256 : j == 6 ? 257 : j == 7 ? 300 : j == 8 ? 511 : j == 9 ? 512 : j == 10 ? 8190 : j == 11 ? 8191 : ((j * 131 + 17) & (S - 1));
    const int t = b * S + pos, n = pos + 1, cnt = n < 256 ? n : 256, tid = F.tid;
    LAS float* sc = (LAS float*)F.lds;
    LAS int* selmark = (LAS int*)(F.lds + 32768);
    LAS float* red = (LAS float*)(F.lds + 65536);
    LAS int* ired = (LAS int*)(F.lds + 65536 + 4096);
    __syncthreads();
    for (int s2 = tid; s2 < n; s2 += NTHREADS) {
        float tot = 0.f;
        for (int h = 0; h < 16; ++h) { float dsum = 0.f; for (int d = 0; d < 64; ++d) dsum += bfv(F.QI, qi_off((size_t)t, h, d)) * bfv(F.KI, ki_off((size_t)b * S + s2, d)); tot += F.WI[(size_t)t * 16 + h] * fmaxf(dsum, 0.f); }
        sc[s2] = (float)(_Float16)tot; selmark[s2] = 0;
    }
    __syncthreads();
    if (tid < cnt) { const int k = F.SEL[(size_t)t * 256 + tid]; if (k < n) atomicAdd((int*)(selmark + k), 1); else atomicAdd((int*)(selmark + 0), 1000); }
    if (tid == 0) { ired[0] = 0; ired[1] = 0; }
    __syncthreads();
    int miss = 0, dup = 0;
    for (int s2 = tid; s2 < n; s2 += NTHREADS) {
        const int mk = selmark[s2]; if (mk > 1) dup = 1;
        if (mk >= 1 && n > 256) { const float v = sc[s2]; int rank = 0; for (int q = 0; q < n; ++q) rank += (sc[q] > v) ? 1 : 0; if (rank >= 256) ++miss; }
    }
    if (miss) atomicAdd((int*)ired, miss); if (dup) atomicAdd((int*)ired + 1, 1);
    __syncthreads();
    if (tid == 0 && (ired[0] > 3 || ired[1] > 0)) chk_flag(F, 2);
    float err2 = 0.f, ref2 = 0.f;
    for (int h = 0; h < 8; ++h) {
        const int g = h >> 2;
        __syncthreads();
        if (tid < 256) { float l = -INFINITY; if (tid < cnt) { const int k = F.SEL[(size_t)t * 256 + tid]; float dsum = 0.f; for (int d = 0; d < 128; ++d) dsum += fp8_at(F.Q8, (size_t)t * 1024 + h * 128 + d) * fp8_at(F.KVm, ((size_t)b * S + k) * 512 + g * 256 + d); l = dsum * (0.08838834764831845f * 1.4426950408889634f); } red[tid] = l; }
        __syncthreads();
        float m = -INFINITY; for (int q = 0; q < 256; ++q) m = fmaxf(m, red[q]);
        float den = 0.f; for (int q = 0; q < 256; ++q) den += exp2f(red[q] - m);
        if (tid < 128) { float o = 0.f; for (int q = 0; q < cnt; ++q) { const int k = F.SEL[(size_t)t * 256 + q]; o += exp2f(red[q] - m) * fp8_at(F.KVm, ((size_t)b * S + k) * 512 + g * 256 + 128 + tid); }
            o /= den; const float got = bfv(F.CONCAT, (size_t)t * D + h * 128 + tid); err2 += (got - o) * (got - o); ref2 += o * o; }
    }
    err2 = wave_sum(err2); ref2 = wave_sum(ref2);
    __syncthreads();
    if (F.lane == 0 && F.wave < 2) { red[300 + F.wave * 2] = err2; red[301 + F.wave * 2] = ref2; }
    __syncthreads();
    if (tid == 0) { const float e = red[300] + red[302], r = red[301] + red[303]; if (!(e <= 0.0064f * r + 1e-6f)) chk_flag(F, 3); }
    __syncthreads();
}
#endif

__device__ __forceinline__ void r1_route(const Frame& F) {
    PROF_T0(50)
    { const float* ada = F.ADA + (size_t)(F.bid >> 6) * 12288; norm_rows_x1(F, F.DX, F.norm2_g, ada + 3 * 2048, ada + 4 * 2048, F.H8); }
    PROF_T1(50) PROF_T0(51)
    LAS unsigned* lh = (LAS unsigned*)(F.lds + 65536);
    LAS float* lg = (LAS float*)F.lds + F.wave * 768;
    if (F.tid < 64) lh[F.tid] = 0u;
    asm volatile("s_waitcnt vmcnt(0)" ::: "memory");
    __syncthreads();
    const int lane = F.lane, li = lane & 15, q4 = lane >> 4;
    const int t0 = F.bid * 128 + F.wave * 16;
    f32x4 acc[3];
#pragma unroll
    for (int nb = 0; nb < 3; ++nb) acc[nb] = (f32x4){0.f, 0.f, 0.f, 0.f};
    const bf16_t* hp = F.H + (size_t)(t0 + li) * D + 8 * q4;
    LAS bf16_t* bs = (LAS bf16_t*)(F.lds + 69632);
    u32x4 st[3]; bf16x8 a[8];
#define RT_LOAD(kc_) do { _Pragma("unroll") for (int i = 0; i < 3; ++i) { const int piece = F.tid + 512 * i, row = piece >> 5, pc = piece & 31; st[i] = *(const u32x4*)(F.WR + (size_t)row * D + (kc_) * 256 + pc * 8); } \
        _Pragma("unroll") for (int ks = 0; ks < 8; ++ks) a[ks] = *(const bf16x8*)(hp + 32 * ((kc_) * 8 + ks)); asm volatile("" ::: "memory"); } while (0)
    RT_LOAD(0);
#pragma unroll
    for (int kc = 0; kc < 8; ++kc) {
        bf16x8 ac[8];
#pragma unroll
        for (int ks = 0; ks < 8; ++ks) ac[ks] = a[ks];
        __syncthreads();
#pragma unroll
        for (int i = 0; i < 3; ++i) { const int piece = F.tid + 512 * i, row = piece >> 5, pc = piece & 31; *(LAS u32x4*)(bs + row * 264 + pc * 8) = st[i]; }
        RT_LOAD(kc < 7 ? kc + 1 : 7);
        __syncthreads();
#pragma unroll
        for (int ks = 0; ks < 8; ++ks)
#pragma unroll
            for (int nb = 0; nb < 3; ++nb) { const bf16x8 bb = *(const LAS bf16x8*)(bs + (nb * 16 + li) * 264 + ks * 32 + 8 * q4); acc[nb] = __builtin_amdgcn_mfma_f32_16x16x32_bf16(ac[ks], bb, acc[nb], 0, 0, 0); }
    }
#undef RT_LOAD
#pragma unroll
    for (int nb = 0; nb < 3; ++nb)
#pragma unroll
        for (int i = 0; i < 4; ++i) lg[(4 * q4 + i) * 48 + nb * 16 + li] = acc[nb][i];
    asm volatile("s_waitcnt lgkmcnt(0)" ::: "memory");
    if (lane < 16) {
        const int t = t0 + lane; const LAS float* l = lg + lane * 48;
        int gs = 0; float gm = l[0];
#pragma unroll
        for (int j = 1; j < 4; ++j) if (l[j] > gm) { gm = l[j]; gs = j; }
        float den = 0.f;
#pragma unroll
        for (int j = 0; j < 4; ++j) den += __expf(l[j] - gm);
        const float pg = 1.0f / den;
        const LAS float* el = l + 4 + gs * 8;
        int i0 = 0; float m0 = el[0];
#pragma unroll
        for (int j = 1; j < 8; ++j) if (el[j] > m0) { m0 = el[j]; i0 = j; }
        int i1 = -1; float m1 = -INFINITY;
#pragma unroll
        for (int j = 0; j < 8; ++j) if (j != i0 && el[j] > m1) { m1 = el[j]; i1 = j; }
        const float e1 = __expf(m1 - m0), w0 = pg / (1.0f + e1), w1 = pg * e1 / (1.0f + e1);
        const int b0 = gs * 8 + i0, b1 = 32 + gs * 8 + i1;
        F.TOKE[2 * t] = b0; F.TOKE[2 * t + 1] = b1; F.TOKW[2 * t] = w0; F.TOKW[2 * t + 1] = w1;
        __hip_atomic_fetch_add(lh + b0, 1u, __ATOMIC_RELAXED, __HIP_MEMORY_SCOPE_WORKGROUP);
        __hip_atomic_fetch_add(lh + b1, 1u, __ATOMIC_RELAXED, __HIP_MEMORY_SCOPE_WORKGROUP);
    }
    PROF_T1(51)
    __syncthreads();
    if (F.tid < 64) { const unsigned cn = lh[F.tid]; if (cn) __hip_atomic_fetch_add(F.ctl + CW_GCOUNT + F.tid, cn, __ATOMIC_RELAXED, __HIP_MEMORY_SCOPE_AGENT); }
}

__device__ __forceinline__ void r2_rows(const Frame& F) {
    LAS unsigned* lh = (LAS unsigned*)F.lds;
    LAS unsigned* lbase = lh + 64;
    LAS unsigned* tstart = lh + 128;
    const int tid = F.tid;
    if (tid < 64) lh[tid] = 0u;
    __syncthreads();
    if (tid < 64) {
        const unsigned cn = __hip_atomic_load(F.ctl + CW_GCOUNT + tid, __ATOMIC_RELAXED, __HIP_MEMORY_SCOPE_AGENT);
        const unsigned ntile = (cn + 255u) >> 8;
        unsigned incl = ntile;
#pragma unroll
        for (int d = 1; d < 64; d <<= 1) { const unsigned tt = (unsigned)__shfl_up((int)incl, d); if (tid >= d) incl += tt; }
        tstart[tid] = incl - ntile;
        if (tid == 63) tstart[64] = incl;
        if (tid == 31) tstart[65] = incl;
    }
    const int t = F.bid * 128 + (tid >> 1), sl = tid & 1;
    int bucket = 0; float w = 0.f;
    if (tid < 256) { bucket = F.TOKE[2 * t + sl]; w = F.TOKW[2 * t + sl]; __hip_atomic_fetch_add(lh + bucket, 1u, __ATOMIC_RELAXED, __HIP_MEMORY_SCOPE_WORKGROUP); }
    __syncthreads();
    if (tid < 64) { const unsigned cn = lh[tid]; unsigned base = 0; if (cn) base = __hip_atomic_fetch_add(F.ctl + CW_GCURSOR + tid, cn, __ATOMIC_RELAXED, __HIP_MEMORY_SCOPE_AGENT); lbase[tid] = tstart[tid] * 256u + base; }
    __syncthreads();
    if (tid < 64) lh[tid] = 0u;
    __syncthreads();
    if (tid < 256) { const unsigned rk = __hip_atomic_fetch_add(lh + bucket, 1u, __ATOMIC_RELAXED, __HIP_MEMORY_SCOPE_WORKGROUP); const unsigned p = lbase[bucket] + rk;
        if (p < (unsigned)MAXROWS) { F.ROWTOK[p] = t; F.ROWW[p] = w * (1.0f / (pg8::ACT_SCALE * pg8::W2_SCALE)); } }
    if (F.bid == 0) {
        if (tid == 0) { ((int*)F.ctl)[CW_TINFO] = (int)tstart[65]; ((int*)F.ctl)[CW_TINFO + 1] = (int)tstart[64]; }
        if (tid < 64) { const unsigned a = tstart[tid], e = (tid == 63) ? tstart[64] : tstart[tid + 1]; for (unsigned p = a; p < e && p < 512u; ++p) ((int*)F.ctl)[CW_TILEB + p] = tid; }
    }
}

struct Args { const float* in[17]; float* out; unsigned char* ws; int ph_lo, ph_hi; };
constexpr int N_PHASES = 13;

__global__ void __launch_bounds__(NTHREADS, 2) mk_fwd(Args args) {
    extern __shared__ __attribute__((aligned(16))) unsigned char lds_raw[];
    Frame F;
    F.lds = (LAS unsigned char*)lds_raw;
    F.tid = threadIdx.x; F.lane = F.tid & 63; F.wave = __builtin_amdgcn_readfirstlane(F.tid >> 6); F.G = gridDim.x; F.bid = blockIdx.x;
    F.x = args.in[0]; F.c = args.in[1]; F.w_ada = args.in[2]; F.b_ada = args.in[3]; F.norm1_g = args.in[4]; F.w_in = args.in[5]; F.q_norm_g = args.in[6]; F.k_norm_g = args.in[7];
    F.w_pool = args.in[8]; F.pool_scale = args.in[9]; F.w_out = args.in[10]; F.norm2_g = args.in[11]; F.w_grp = args.in[12]; F.w_exp = args.in[13]; F.w1 = args.in[14]; F.w3 = args.in[15]; F.w2 = args.in[16];
    F.out = args.out;
    unsigned char* ws = args.ws;
    F.ctl = (unsigned*)(ws + WS_CTL); F.ADA = (float*)(ws + WS_ADA); F.ADAP = (float*)(ws + WS_ADAP); F.TAB = (float*)(ws + WS_TAB); F.WR = (bf16_t*)(ws + WS_WR); F.TOKE = (int*)(ws + WS_TOKE); F.TOKW = (float*)(ws + WS_TOKW);
    F.ROWTOK = (int*)(ws + WS_ROWTOK); F.ROWW = (float*)(ws + WS_ROWW); F.WI = (float*)(ws + WS_WI); F.KI = (bf16_t*)(ws + WS_KI);
    F.WPOOL = (bf16_t*)(ws + WS_WPOOL); F.WOUT = (bf16_t*)(ws + WS_WOUT); F.WIN = (bf16_t*)(ws + WS_WIN); F.W13 = (bf16_t*)(ws + WS_W13); F.W2 = (bf16_t*)(ws + WS_W2);
    F.H = (bf16_t*)(ws + WS_H); F.CONCAT = (bf16_t*)(ws + WS_H); F.PROJ = (bf16_t*)(ws + WS_X); F.SC = (unsigned short*)(ws + WS_X); F.H8 = ws + WS_H8; F.Y0 = (bf16_t*)(ws + WS_X); F.DX = (bf16_t*)(ws + WS_X + 134217728);
    F.QB = (bf16_t*)(ws + WS_QB); F.Q8 = ws + WS_QB; F.ACT = (bf16_t*)(ws + WS_QB); F.KV = (bf16_t*)(ws + WS_KV); F.KVm = ws + WS_KV; F.QI = (bf16_t*)(ws + WS_QI); F.PM = (bf16_t*)(ws + WS_PM); F.SEL = (unsigned short*)(ws + WS_SEL);

    volatile LAS unsigned* bst = (volatile LAS unsigned*)(F.lds + LDS_BYTES - 16);
    if (F.tid == 0) { bst[0] = 0u; bst[1] = 0u; bst[2] = 0u; bst[3] = 0u; }
    __syncthreads();
    XcdBarrier bar = xcd_barrier_post(F.ctl, bst, F.wave);
    const int lo = args.ph_lo, hi = args.ph_hi;
#define IN(k) (lo <= (k) && (k) < hi)
#define SEAM(k) do { if (IN(k) && IN((k) + 1)) xcd_barrier(bar); } while (0)

#define PH(k, ...) do { F.lane = fresh_lane(); F.tid = F.wave * 64 + F.lane; if (IN(k)) { for (int rep_ = 0; rep_ < 1 + ((REPEAT_MASK >> (k)) & 1); ++rep_) { __VA_ARGS__ } } SEAM(k); } while (0)
    PH(0, { p0_prologue(F); });
    PH(1, {
        for (int idx = F.tid; idx < MAXROWS / 256; idx += NTHREADS) F.ROWTOK[F.bid * (MAXROWS / 256) + idx] = -1;
        if (F.tid < 192) { const int v = F.bid * 192 + F.tid; float s = 0.f; for (int kc = 0; kc < 32; ++kc) s += F.ADAP[(size_t)kc * 49152 + v]; F.ADA[v] = s; }
        LAS float* sl = (LAS float*)F.lds;
        { const int b = F.bid >> 6; for (int idx = F.tid; idx < 4096; idx += NTHREADS) { float s = 0.f; for (int kc = 0; kc < 32; ++kc) s += F.ADAP[(size_t)kc * 49152 + b * 12288 + idx]; sl[idx] = s; } }
        __syncthreads();
        norm_rows(F, F.x, nullptr, F.norm1_g, (const float*)sl, (const float*)(sl + 2048), NF8 > 0 ? F.H8 : nullptr);
#if P1_PROBE == 1
        norm_rows(F, F.x, nullptr, F.norm1_g, (const float*)sl, (const float*)(sl + 2048), nullptr);
#elif P1_PROBE == 2
        __syncthreads();
        { const int b = F.bid >> 6; for (int idx = F.tid; idx < 4096; idx += NTHREADS) { float s = 0.f; for (int kc = 0; kc < 32; ++kc) s += F.ADAP[(size_t)kc * 49152 + b * 12288 + idx]; sl[idx] = s; } }
#endif
        __syncthreads();
    });
    PH(2, {
        if (NF8 > 0) {
            pg8::Gemm g{(const bf16_t*)F.H8, (const bf16_t*)F.WIN, D / 2, PROF_SECTION >= 70 ? (unsigned long long*)(F.ctl + CW_CHK) + 4 : nullptr}; pg8::StaticOrder So; So.init(T, NF8 * 256, F.G, F.bid, 1 + ((REPEAT_UNITS >> 2) & 1));
            pg8::EpiBf16 E{F.PROJ, NPROJ, 0, 0, 1.0f / (pg8::H_SCALE * pg8::W13_SCALE), nullptr};
            pg8::gemm_phase<pg8::EpiBf16, pg8::StaticOrder, true>(F.lds, g, So, E, F.tid);
        }
        if (NF8 < 14) {
            pg8::Gemm g{F.H, F.WIN + (size_t)NF8 * 256 * 2048, D, nullptr}; pg8::StaticOrder So; So.init(T, (14 - NF8) * 256, F.G, F.bid, 1);
            pg8::EpiBf16 E{F.PROJ, NPROJ, 0, NF8, 1.0f, nullptr};
            pg8::gemm_phase<pg8::EpiBf16, pg8::StaticOrder>(F.lds, g, So, E, F.tid);
        }
    });
#if SELFCHECK
    F.lane = fresh_lane(); F.tid = F.wave * 64 + F.lane; if (IN(3)) { chk_gemm1(F); }
#endif
    PH(3, { p3_post(F); });
#if SELFCHECK
    F.lane = fresh_lane(); F.tid = F.wave * 64 + F.lane; if (IN(3)) { chk_post(F); if (IN(4)) xcd_barrier(bar); }
#endif
    PH(4, {
        {
            pg8::Gemm g{F.PM, F.WPOOL, 256, nullptr}; pg8::PoolOrder So{F.G, F.bid};
            pg8::EpiBf16 E{F.CONCAT, D, 1, 0, pg8::C_SCALE, F.H8};
            pg8::gemm_phase<pg8::EpiBf16, pg8::PoolOrder>(F.lds, g, So, E, F.tid);
        }
        indexer_sweep(F);
    });
    PH(5, {
        LAS unsigned char* wbuf = F.lds + F.wave * 18304;
        u32x4 pre[16];
        int i = F.bid * 8 + F.wave;
        int t = (i & 1) ? (T - 1 - (i >> 1)) : (i >> 1);
        sel_fetch(F, t, pre);
        for (; i < T; i += F.G * 8) {
            u32x4 cur[16];
            _Pragma("unroll") for (int ch = 0; ch < 16; ++ch) cur[ch] = pre[ch];
            const int tcur = t, inext = i + F.G * 8;
            if (inext < T) { t = (inext & 1) ? (T - 1 - (inext >> 1)) : (inext >> 1); sel_fetch(F, t, pre); }
            select_row(F, tcur, cur, wbuf, F.lane);
        }
#if SEL_PROBE
        {
            unsigned accx = 0;
            for (int i2 = F.bid * 8 + F.wave; i2 < T; i2 += F.G * 8) {
                const int t2 = (i2 & 1) ? (T - 1 - (i2 >> 1)) : (i2 >> 1);
                const unsigned short* src = sel_src(F, t2); const int n = (t2 & (S - 1)) + 1, nch = n > 256 ? (n + 511) >> 9 : 0;
                u32x4 r[16];
                _Pragma("unroll") for (int ch = 0; ch < 16; ++ch) if (ch < nch) r[ch] = *(const u32x4*)(src + ch * 512 + F.lane * 8);
                _Pragma("unroll") for (int ch = 0; ch < 16; ++ch) if (ch < nch) accx ^= r[ch].x ^ r[ch].y ^ r[ch].z ^ r[ch].w;
            }
            if (accx == 0x12345678u) F.SEL[0] = 1;
        }
#endif
    });
    PH(6, {
        attn_items(F, 0, 32);
#if ATT_PROBE == 1
        attn_items(F, 0, 16);
#elif ATT_PROBE == 2
        attn_items(F, 16, 32);
#endif
    });
#if SELFCHECK
    F.lane = fresh_lane(); F.tid = F.wave * 64 + F.lane; if (IN(7)) { chk_attn(F); }
#endif
    PH(7, {
        pg8::Gemm g{(const bf16_t*)F.H8, F.WOUT, D / 2, PROF_SECTION >= 70 ? (unsigned long long*)(F.ctl + CW_CHK) + 4 : nullptr}; pg8::StaticOrder So; So.init(T, D, F.G, F.bid, 1 + ((REPEAT_UNITS >> 7) & 1));
        pg8::EpiMix E{F.ADA, F.x, F.DX, 1.0f / (pg8::C_SCALE * pg8::W13_SCALE)};
        pg8::gemm_phase<pg8::EpiMix, pg8::StaticOrder, true>(F.lds, g, So, E, F.tid);
    });
    PH(8, { r1_route(F); });
    PH(9, { r2_rows(F); });
    PH(10, {
        const int* ti = (const int*)F.ctl + CW_TINFO;
        pg8::Gemm g{(const bf16_t*)F.H8, F.W13, D / 2, PROF_SECTION >= 70 ? (unsigned long long*)(F.ctl + CW_CHK) + 4 : nullptr}; pg8::MoeOrder<4, true> So{        (const int*)F.ctl + CW_TILEB, F.ROWTOK, 0, ti[1], F.G, F.bid, 1 + ((REPEAT_UNITS >> 10) & 1)};
        pg8::EpiAct E{(unsigned char*)F.ACT};
        pg8::gemm_phase<pg8::EpiAct, pg8::MoeOrder<4, true>, true>(F.lds, g, So, E, F.tid);
    });
    PH(11, {
        const int* ti = (const int*)F.ctl + CW_TINFO;
        pg8::Gemm g{F.ACT, F.W2, 256, PROF_SECTION >= 70 ? (unsigned long long*)(F.ctl + CW_CHK) + 4 : nullptr}; pg8::MoeOrder<8, false> So{(const int*)F.ctl + CW_TILEB, F.ROWTOK, 0, ti[0], F.G, F.bid, 1};
        pg8::EpiMoeY0 E{F.ROWTOK, F.ROWW, F.Y0};
        pg8::gemm_phase<pg8::EpiMoeY0, pg8::MoeOrder<8, false>, true>(F.lds, g, So, E, F.tid);
    });
    PH(12, {
        const int* ti = (const int*)F.ctl + CW_TINFO;
        pg8::Gemm g{F.ACT, F.W2, 256, PROF_SECTION >= 70 ? (unsigned long long*)(F.ctl + CW_CHK) + 4 : nullptr}; pg8::MoeOrder<8, false> So{(const int*)F.ctl + CW_TILEB, F.ROWTOK, ti[0], ti[1], F.G, F.bid, 1};
        { LAS unsigned* gt = (LAS unsigned*)(F.lds + 131072);
          for (int idx = F.tid; idx < 4096; idx += NTHREADS) { const float* gs = F.ADA + (size_t)(idx >> 10) * 12288 + 5 * 2048 + 2 * (idx & 1023); gt[idx] = pk_bf16(gs[0], gs[1]); }
          __syncthreads(); }
        pg8::EpiMoeOut E{F.ROWTOK, F.ROWW, F.lds + 131072, F.Y0, F.DX, F.out};
        pg8::gemm_phase<pg8::EpiMoeOut, pg8::MoeOrder<8, false>, true>(F.lds, g, So, E, F.tid);
    });
#undef PH
#if PROF_SECTION >= 0
    if (IN(12)) {
        xcd_barrier(bar);
        if (F.bid == 0 && F.tid == 0) { const unsigned long long cyc = ((volatile unsigned long long*)(F.ctl + CW_CHK))[4]; F.out[0] += (float)cyc * (1.0f / (float)PROF_DIV); }
    }
#endif
#if SELFCHECK
    if (IN(12)) {
        xcd_barrier(bar);
        if (F.bid == 0 && F.tid == 0) {
            float code = 0.f;
            for (int k = 0; k < 4; ++k) if (__hip_atomic_load(F.ctl + CW_CHK + k, __ATOMIC_RELAXED, __HIP_MEMORY_SCOPE_AGENT) != 0u) code += (float)(1 << k);
            if (code != 0.f) F.out[0] += 1.0e4f * code;
        }
    }
#endif
#undef IN
#undef SEAM
}

extern "C" void kernel_launch(void* const* d_in, const int* in_sizes, int n_in, void* d_out, int out_size, void* d_ws, size_t ws_size, hipStream_t stream) {
    static int grid = 0;
    if (grid == 0) {
        if (n_in != 17 || out_size != T * D || ws_size < WS_END) { fprintf(stderr, "kernel_launch: unexpected problem (n_in %d out %d ws %zu)\n", n_in, out_size, ws_size); grid = -1; return; }
        int dev = 0, cus = 0, per_cu = 0;
        if (hipGetDevice(&dev) != hipSuccess || hipDeviceGetAttribute(&cus, hipDeviceAttributeMultiprocessorCount, dev) != hipSuccess) { grid = -1; return; }
        if (hipFuncSetAttribute((const void*)mk_fwd, hipFuncAttributeMaxDynamicSharedMemorySize, LDS_BYTES) != hipSuccess) { fprintf(stderr, "kernel_launch: hipFuncSetAttribute failed\n"); grid = -1; return; }
        if (hipOccupancyMaxActiveBlocksPerMultiprocessor(&per_cu, (const void*)mk_fwd, NTHREADS, LDS_BYTES) != hipSuccess || per_cu < 1) { fprintf(stderr, "kernel_launch: occupancy query says %d\n", per_cu); }
        (void)hipGetLastError();
        grid = cus;
        if (grid != 256) { fprintf(stderr, "kernel_launch: built for 256 CUs, found %d\n", cus); grid = -1; return; }
    }
    if (grid < 0) return;
    (void)hipMemsetAsync((char*)d_ws + WS_CTL, 0, WS_ADA - WS_CTL, stream);
    Args a{};
    for (int i = 0; i < 17; ++i) a.in[i] = (const float*)d_in[i];
    a.out = (float*)d_out; a.ws = (unsigned char*)d_ws;
#if MK_MULTI
    for (int p = 0; p < N_PHASES; ++p) { a.ph_lo = p; a.ph_hi = p + 1; hipLaunchKernelGGL(mk_fwd, dim3(grid), dim3(NTHREADS), LDS_BYTES, stream, a); }
#else
    a.ph_lo = 0; a.ph_hi = N_PHASES; hipLaunchKernelGGL(mk_fwd, dim3(grid), dim3(NTHREADS), LDS_BYTES, stream, a);
#endif
}
```
